# Optimizing an MI355X kernel written in HIP

```python
import jax, jax.numpy as jnp
from jax import lax
import numpy as np

D_MODEL = 1024
BATCH = 4
SEQ = 8192
DEPTH = 4

N_MIXERS = 3
RMS_EPS = 1e-6
LN_EPS = 1e-5
CONV_WIDTH = 3
SGU_CHUNK = 128
SGU_HALF = 2 * D_MODEL
SGU_GROUPS = 8
SGU_GROUP_DIM = SGU_HALF // SGU_GROUPS
RET_HEADS = 4
RET_QK_DIM = D_MODEL // RET_HEADS
RET_V_DIM = 2 * D_MODEL // RET_HEADS
RET_CHUNK = 128
ROPE_BASE = 10000.0
D_FF = -(-8 * D_MODEL // (3 * 256)) * 256
N_CONV = (DEPTH + 2) // 3
N_SGU = (DEPTH + 1) // 3
N_RET = DEPTH // 3

kernel_name = "hybrid_conv_sgu_retention_trunk"


def rmsnorm(x, g):
    xf = x.astype(jnp.float32)
    y = xf * lax.rsqrt(jnp.mean(xf * xf, axis=-1, keepdims=True) + RMS_EPS)
    return (y * g.astype(jnp.float32)).astype(x.dtype)


def layernorm(x, g, b):
    xf = x.astype(jnp.float32)
    mu = jnp.mean(xf, axis=-1, keepdims=True)
    xc = xf - mu
    y = xc * lax.rsqrt(jnp.mean(xc * xc, axis=-1, keepdims=True) + LN_EPS)
    return (y * g.astype(jnp.float32) + b.astype(jnp.float32)).astype(x.dtype)


def short_conv_mixer(h, w_in, conv_w, w_out):
    bch = h @ w_in
    b_gate, c_gate, z = jnp.split(bch, 3, axis=-1)
    cz = c_gate * z
    conv = lax.conv_general_dilated(
        cz, conv_w[:, None, :].astype(cz.dtype), window_strides=(1,),
        padding=[(CONV_WIDTH - 1, 0)], dimension_numbers=("NWC", "WIO", "NWC"),
        feature_group_count=D_MODEL)
    return (b_gate * conv) @ w_out


def chunked_sgu_mixer(h, w_in, ln_g, ln_b, w_s, b_s, w_out):
    bsz, seq = h.shape[0], h.shape[1]
    n_chunks = seq // SGU_CHUNK
    zz = jax.nn.gelu(h @ w_in, approximate=False)
    u, v = jnp.split(zz, 2, axis=-1)
    v = layernorm(v, ln_g, ln_b)
    v = v.reshape(bsz, n_chunks, SGU_CHUNK, SGU_GROUPS, SGU_GROUP_DIM)
    causal = jnp.tril(jnp.ones((SGU_CHUNK, SGU_CHUNK), dtype=bool))
    w = jnp.where(causal[None], w_s, jnp.zeros((), w_s.dtype))
    s = jnp.einsum("gts,bcsgd->bctgd", w, v) + b_s.T[None, None, :, :, None]
    s = s.reshape(bsz, seq, SGU_HALF)
    return (u * s) @ w_out


def rotary(x, cos, sin):
    half = x.shape[-1] // 2
    x1, x2 = x[..., :half], x[..., half:]
    return jnp.concatenate([x1 * cos - x2 * sin, x2 * cos + x1 * sin], axis=-1)


def retention_mixer(h, w_in, w_out):
    bsz, seq = h.shape[0], h.shape[1]
    n_chunks = seq // RET_CHUNK
    proj = h @ w_in
    q, k, v, g = jnp.split(proj, [D_MODEL, 2 * D_MODEL, 4 * D_MODEL], axis=-1)
    q = q.astype(jnp.float32).reshape(bsz, seq, RET_HEADS, RET_QK_DIM).transpose(0, 2, 1, 3)
    k = k.astype(jnp.float32).reshape(bsz, seq, RET_HEADS, RET_QK_DIM).transpose(0, 2, 1, 3)
    v = v.astype(jnp.float32).reshape(bsz, seq, RET_HEADS, RET_V_DIM).transpose(0, 2, 1, 3)
    half = RET_QK_DIM // 2
    pos = jnp.arange(seq, dtype=jnp.float32)
    inv_freq = ROPE_BASE ** (-(jnp.arange(half, dtype=jnp.float32) / half))
    ang = pos[:, None] * inv_freq[None, :]
    cos, sin = jnp.cos(ang), jnp.sin(ang)
    q = rotary(q, cos, sin)
    k = rotary(k, cos, sin) * (RET_QK_DIM ** -0.5)
    log_gamma = jnp.log(1.0 - 2.0 ** (-5.0 - jnp.arange(RET_HEADS, dtype=jnp.float32)))
    idx = jnp.arange(RET_CHUNK, dtype=jnp.float32)
    diff = idx[:, None] - idx[None, :]
    d_inner = jnp.where(diff[None] >= 0,
                        jnp.exp(jnp.maximum(diff, 0.0)[None] * log_gamma[:, None, None]), 0.0)
    k_decay = jnp.exp((RET_CHUNK - 1 - idx)[None, :] * log_gamma[:, None])
    q_decay = jnp.exp((idx + 1.0)[None, :] * log_gamma[:, None])
    chunk_decay = jnp.exp(RET_CHUNK * log_gamma)
    qc = q.reshape(bsz, RET_HEADS, n_chunks, RET_CHUNK, RET_QK_DIM)
    kc = k.reshape(bsz, RET_HEADS, n_chunks, RET_CHUNK, RET_QK_DIM)
    vc = v.reshape(bsz, RET_HEADS, n_chunks, RET_CHUNK, RET_V_DIM)
    scores = jnp.einsum("bhcjd,bhcmd->bhcjm", qc, kc) * d_inner[None, :, None]
    inner = jnp.einsum("bhcjm,bhcme->bhcje", scores, vc)

    def step(state, inp):
        q_i, k_i, v_i = inp
        cross = jnp.einsum("bhjd,bhde->bhje", q_i, state) * q_decay[None, :, :, None]
        new_state = state * chunk_decay[None, :, None, None] + jnp.einsum(
            "bhmd,bhme->bhde", k_i * k_decay[None, :, :, None], v_i)
        return new_state, cross

    state0 = jnp.zeros((bsz, RET_HEADS, RET_QK_DIM, RET_V_DIM), jnp.float32)
    _, cross = lax.scan(step, state0, (jnp.moveaxis(qc, 2, 0), jnp.moveaxis(kc, 2, 0), jnp.moveaxis(vc, 2, 0)))
    ret = inner + jnp.moveaxis(cross, 0, 2)
    o = ret.reshape(bsz, RET_HEADS, seq, RET_V_DIM).transpose(0, 2, 1, 3)
    o = o * lax.rsqrt(jnp.mean(o * o, axis=-1, keepdims=True) + RMS_EPS)
    o = o.reshape(bsz, seq, RET_HEADS * RET_V_DIM)
    y = jax.nn.silu(g.astype(jnp.float32)) * o
    return y.astype(h.dtype) @ w_out


def swiglu_ffn(h, w_gate, w_up, w_down):
    return (jax.nn.silu(h @ w_gate) * (h @ w_up)) @ w_down


def setup_inputs(seed: int = 0) -> dict:
    key = jax.random.key(seed)
    ks = jax.random.split(key, 20)
    f32 = jnp.float32
    nrm = lambda k, shape, scale: jax.random.normal(k, shape, f32) * scale
    D = D_MODEL
    return {
        "x": nrm(ks[0], (BATCH, SEQ, D), 1.0),
        "norm_mix_g": 1.0 + nrm(ks[1], (DEPTH, D), 0.01),
        "norm_ffn_g": 1.0 + nrm(ks[2], (DEPTH, D), 0.01),
        "final_norm_g": 1.0 + nrm(ks[3], (D,), 0.01),
        "conv_w_in": nrm(ks[4], (N_CONV, D, 3 * D), D ** -0.5),
        "conv_w": nrm(ks[5], (N_CONV, CONV_WIDTH, D), CONV_WIDTH ** -0.5),
        "conv_w_out": nrm(ks[6], (N_CONV, D, D), D ** -0.5),
        "sgu_w_in": nrm(ks[7], (N_SGU, D, 2 * SGU_HALF), D ** -0.5),
        "sgu_ln_g": 1.0 + nrm(ks[8], (N_SGU, SGU_HALF), 0.01),
        "sgu_ln_b": nrm(ks[9], (N_SGU, SGU_HALF), 0.01),
        "sgu_w_s": nrm(ks[10], (N_SGU, SGU_GROUPS, SGU_CHUNK, SGU_CHUNK), SGU_CHUNK ** -0.5),
        "sgu_b_s": 1.0 + nrm(ks[11], (N_SGU, SGU_GROUPS, SGU_CHUNK), 0.1),
        "sgu_w_out": nrm(ks[12], (N_SGU, SGU_HALF, D), SGU_HALF ** -0.5),
        "ret_w_in": nrm(ks[13], (N_RET, D, 6 * D), D ** -0.5),
        "ret_w_out": nrm(ks[14], (N_RET, 2 * D, D), (2 * D) ** -0.5),
        "ffn_w_gate": nrm(ks[15], (DEPTH, D, D_FF), D ** -0.5),
        "ffn_w_up": nrm(ks[16], (DEPTH, D, D_FF), D ** -0.5),
        "ffn_w_down": nrm(ks[17], (DEPTH, D_FF, D), D_FF ** -0.5),
    }


def reference(x, norm_mix_g, norm_ffn_g, final_norm_g, conv_w_in, conv_w, conv_w_out,
              sgu_w_in, sgu_ln_g, sgu_ln_b, sgu_w_s, sgu_b_s, sgu_w_out,
              ret_w_in, ret_w_out, ffn_w_gate, ffn_w_up, ffn_w_down):
    for i in range(DEPTH):
        kind = i % N_MIXERS
        j = i // N_MIXERS
        h = rmsnorm(x, norm_mix_g[i])
        if kind == 0:
            m = short_conv_mixer(h, conv_w_in[j], conv_w[j], conv_w_out[j])
        elif kind == 1:
            m = chunked_sgu_mixer(h, sgu_w_in[j], sgu_ln_g[j], sgu_ln_b[j], sgu_w_s[j], sgu_b_s[j], sgu_w_out[j])
        else:
            m = retention_mixer(h, ret_w_in[j], ret_w_out[j])
        x = x + m
        h = rmsnorm(x, norm_ffn_g[i])
        x = x + swiglu_ffn(h, ffn_w_gate[i], ffn_w_up[i], ffn_w_down[i])
    return rmsnorm(x, final_norm_g)
```

```cpp
#include <hip/hip_runtime.h>
#include <cstdio>
#include <cstdint>

#ifndef MK_ONE_LAUNCH
#define MK_ONE_LAUNCH 1
#endif

#define LAS __attribute__((address_space(3)))
#define GAS __attribute__((address_space(1)))
typedef unsigned short bf16_t;
typedef short bf16x8 __attribute__((ext_vector_type(8)));
typedef short bf16x4 __attribute__((ext_vector_type(4)));
typedef float f32x4 __attribute__((ext_vector_type(4)));
typedef float f32x2 __attribute__((ext_vector_type(2)));
typedef unsigned u32x4 __attribute__((ext_vector_type(4)));
typedef unsigned u32x2 __attribute__((ext_vector_type(2)));
typedef int i32x4 __attribute__((ext_vector_type(4)));
typedef int i32x8 __attribute__((ext_vector_type(8)));

constexpr int D = 1024, NB = 4, SEQ = 8192, M = NB * SEQ, DFF = 2816, NLAYER = 4;
constexpr int RH = 4, RQK = 256, RV = 512, RC = 128;
constexpr float RMS_EPS = 1e-6f, LN_EPS = 1e-5f;
constexpr int F8_LAYERS = 0xC;
constexpr int F8_F1_LAYERS = 0x8;
constexpr float FD_WSCALE = 64.0f, FI_WSCALE = 32.0f;

constexpr size_t MiB = 1u << 20;
constexpr size_t WS_CTL = 0, CTL_BYTES = 1 * MiB;
constexpr size_t WS_SSQ = 1 * MiB;
constexpr size_t WS_W = 3 * MiB;
constexpr size_t W_CI = WS_W, W_CI_SZ = (size_t)3072 * 1024 * 2;
constexpr size_t W_CO = W_CI + 2 * W_CI_SZ, W_CO_SZ = (size_t)1024 * 1024 * 2;
constexpr size_t W_SI = W_CO + 2 * W_CO_SZ, W_SI_SZ = (size_t)4096 * 1024 * 2;
constexpr size_t W_SO = W_SI + W_SI_SZ, W_SO_SZ = (size_t)1024 * 2048 * 2;
constexpr size_t W_RQ = W_SO + W_SO_SZ, W_RQ_SZ = (size_t)4096 * 1024 * 2;
constexpr size_t W_RG = W_RQ + W_RQ_SZ, W_RG_SZ = (size_t)2048 * 1024 * 2;
constexpr size_t W_RO = W_RG + W_RG_SZ, W_RO_SZ = (size_t)1024 * 2048 * 2;
constexpr size_t W_FI = W_RO + W_RO_SZ, W_FI_SZ = (size_t)5632 * 1024 * 2;
constexpr size_t W_FD = W_FI + 4 * W_FI_SZ, W_FD_SZ = (size_t)1024 * 2816 * 2;
constexpr size_t W_WS = W_FD + 4 * W_FD_SZ, W_WS_SZ = (size_t)8 * 128 * 128 * 2;
constexpr size_t WS_WEND = W_WS + W_WS_SZ;
static_assert(WS_WEND <= 114 * MiB, "weights");
constexpr size_t WS_ROT = 114 * MiB;
constexpr size_t WS_HSS = WS_ROT;
constexpr size_t WS_XB = 122 * MiB;
constexpr size_t WS_AR = 186 * MiB;
constexpr size_t WS_X8 = 458 * MiB;
constexpr size_t WS_KT = 442 * MiB;
constexpr size_t WS_LNP = WS_KT;
constexpr size_t WS_END = 506 * MiB;
constexpr size_t AR_CB = WS_AR, AR_CZ = WS_AR + 64 * MiB, AR_CY = WS_AR + 128 * MiB;
constexpr size_t AR_SU = WS_AR, AR_SV = WS_AR + 128 * MiB;
constexpr size_t AR_RQ = WS_AR, AR_RK = WS_AR + 64 * MiB, AR_RV = WS_AR + 128 * MiB;
constexpr size_t AR_FA = WS_AR;

constexpr int NPH = 26;
constexpr int LDS_BYTES = 159744;
constexpr int LDS_MISC = 159232;

#define RLX_AGENT __ATOMIC_RELAXED, __HIP_MEMORY_SCOPE_AGENT
__device__ __forceinline__ unsigned f2bf(float f) { unsigned u = __builtin_bit_cast(unsigned, f); return (u + 0x7fffu + ((u >> 16) & 1u)) >> 16; }
typedef __bf16 bf16v2 __attribute__((ext_vector_type(2)));
__device__ __forceinline__ unsigned pk2(float lo, float hi) { const f32x2 v = {lo, hi}; return __builtin_bit_cast(unsigned, __builtin_convertvector(v, bf16v2)); }
__device__ __forceinline__ float bf_lo(unsigned w) { return __builtin_bit_cast(float, w << 16); }
__device__ __forceinline__ float bf_hi(unsigned w) { return __builtin_bit_cast(float, w & 0xffff0000u); }
__device__ __forceinline__ float wave_sum(float v) {
#pragma unroll
    for (int o = 1; o < 64; o <<= 1) v += __shfl_xor(v, o);
    return v;
}
template <class T> __device__ __forceinline__ T* opq(T* p) { asm volatile("" : "+s"(p)); return p; }
__device__ __forceinline__ int opq_tid() { int t = threadIdx.x; asm volatile("" : "+v"(t)); return t; }
__device__ __forceinline__ float fast_rcp(float x) { return __builtin_amdgcn_rcpf(x); }
__device__ __forceinline__ float silu_f(float x) { return x * fast_rcp(1.0f + __builtin_amdgcn_exp2f(-1.44269504089f * x)); }

#define XB_TMO      128
#define XB_XCNT(j)  (256  + 64 * (j))
#define XB_XSUB(j)  (1280 + 64 * (j))
#define XB_XGEN(j)  (2304 + 64 * (j))
#define XB_TOP      3328
#define XB_TOPGEN   3392
#define XCD_BAR_WORDS 3456
#define XB_SPIN_CAP (1u << 18)
__device__ __forceinline__ unsigned xb_ld(unsigned* p)              { return __hip_atomic_load(p, __ATOMIC_RELAXED, __HIP_MEMORY_SCOPE_AGENT); }
__device__ __forceinline__ unsigned xb_add(unsigned* p, unsigned v) { return __hip_atomic_fetch_add(p, v, __ATOMIC_RELAXED, __HIP_MEMORY_SCOPE_AGENT); }
__device__ __forceinline__ unsigned xb_xcc_id() { return (unsigned)__builtin_amdgcn_s_getreg((3 << 11) | 20) & 0xFu; }
#define XB_SPIN(cond, bar) do { unsigned _sp = 0; while (cond) { __builtin_amdgcn_s_sleep(1); \
    if ((++_sp & 255u) == 0u) { if (xb_ld(&(bar)[XB_TMO])) break; if (_sp > XB_SPIN_CAP) { atomicAdd(&(bar)[XB_TMO], 1u); break; } } } } while (0)
struct XcdBarrier { unsigned* bar; unsigned x; volatile LAS unsigned* st; };
__device__ __forceinline__ XcdBarrier xcd_barrier_post(unsigned* bar, volatile LAS unsigned* st) {
    XcdBarrier b; b.bar = bar; b.x = xb_xcc_id(); b.st = st;
    if (threadIdx.x == 0) (void)xb_add(&bar[XB_XCNT(b.x)], 1u);
    return b;
}
__device__ __forceinline__ void xcd_barrier_complete(unsigned* bar, unsigned x, unsigned& nloc, unsigned& nx) {
    const unsigned G = gridDim.x * gridDim.y * gridDim.z;
    unsigned sum, cnt, mine, sp = 0u;
    for (;;) {
        sum = 0u; cnt = 0u; mine = 0u;
#pragma unroll
        for (unsigned j = 0; j < 16; ++j) { const unsigned c = xb_ld(&bar[XB_XCNT(j)]); sum += c; cnt += (c > 0u) ? 1u : 0u; mine = (j == x) ? c : mine; }
        if (sum == G) break;
        __builtin_amdgcn_s_sleep(1);
        if ((++sp & 255u) == 0u) { if (xb_ld(&bar[XB_TMO])) break; if (sp > XB_SPIN_CAP) { atomicAdd(&bar[XB_TMO], 1u); break; } }
    }
    nloc = mine > 0u ? mine : 1u; nx = cnt > 0u ? cnt : 1u;
}
__device__ __forceinline__ void xcd_barrier(const XcdBarrier& b) {
    asm volatile("s_waitcnt vmcnt(0)" ::: "memory");
    __syncthreads();
    if (threadIdx.x == 0) {
        unsigned* bar = b.bar;
        __builtin_amdgcn_s_waitcnt(0);
        unsigned nloc = b.st[0], nx = b.st[1];
        if (nloc == 0u) { xcd_barrier_complete(bar, b.x, nloc, nx); b.st[0] = nloc; b.st[1] = nx; }
        const unsigned old = xb_add(&bar[XB_XSUB(b.x)], 1u);
        const unsigned gen = old / nloc;
        if (old + 1u == (gen + 1u) * nloc) {
            __builtin_amdgcn_fence(__ATOMIC_RELEASE, "agent");
            asm volatile("s_waitcnt vmcnt(0)" ::: "memory");
            const unsigned og = xb_add(&bar[XB_TOP], 1u);
            const unsigned tg = og / nx;
            if (og + 1u == (tg + 1u) * nx) xb_add(&bar[XB_TOPGEN], 1u);
            else XB_SPIN(xb_ld(&bar[XB_TOPGEN]) == tg, bar);
            __builtin_amdgcn_fence(__ATOMIC_ACQUIRE, "agent");
            xb_add(&bar[XB_XGEN(b.x)], 1u);
            asm volatile("s_waitcnt vmcnt(0)" ::: "memory");
        } else {
            XB_SPIN(xb_ld(&bar[XB_XGEN(b.x)]) == gen, bar);
            __builtin_amdgcn_fence(__ATOMIC_ACQUIRE, "agent");
            asm volatile("s_waitcnt vmcnt(0)" ::: "memory");
        }
    }
    __syncthreads();
}

namespace pg8 {
constexpr int BM = 256, BK = 64, HALF = 128, HTB = HALF * BK * 2, STAGE_BYTES = 8 * HTB, NXCD = 8, WGM = 8;
__host__ __device__ __forceinline__ int lds_byte(int r, int c) { const int st = (r >> 4) * 2 + (c >> 5), rr = r & 15, cc = c & 31, ob = rr * 64 + cc * 2; return st * 1024 + (ob ^ (((ob >> 9) & 1) << 5)); }
__host__ __device__ __forceinline__ void stage_rc(int b, int& R, int& C) { const int st = b / 1024, sb = b % 1024, swz = sb ^ (((sb >> 9) & 1) << 5); R = (st >> 1) * 16 + swz / 64; C = (st & 1) * 32 + (swz % 64) / 2; }
__host__ __device__ __forceinline__ int perm32(int rho) { const int n = rho >> 4, i = rho & 15; return 8 * (i >> 2) + 4 * n + (i & 3); }

struct Unit { int pm, pn; };
struct Gemm { const bf16_t* A; const bf16_t* Bt; int M, N, K; };
struct StaticOrder {
    int nM, nN, nwg, G, c;
    __host__ __device__ void init(int M_, int N_, int G_, int c_) { nM = M_ / BM; nN = N_ / BM; nwg = nM * nN; G = G_; c = c_; }
    __host__ __device__ bool next(int i, Unit& u) const {
        const long L = (long)i * G + c; if (L >= nwg) return false;
        int wgid = (int)L; { const int q = nwg / NXCD, r = nwg % NXCD, xcd = wgid % NXCD, off = wgid / NXCD; wgid = (xcd < r ? xcd * (q + 1) : r * (q + 1) + (xcd - r) * q) + off; }
        const int nig = WGM * nN, gid = wgid / nig, fm = gid * WGM, gsz = (nM - fm) < WGM ? (nM - fm) : WGM;
        u.pm = fm + ((wgid % nig) % gsz); u.pn = (wgid % nig) / gsz; return true;
    }
};

template <class Epi, bool ALIGN_EPI = true, bool SP2 = true, bool F8 = false>
__device__ __forceinline__ void gemm_phase(LAS unsigned char* lds, const Gemm g, const StaticOrder& S, const Epi& E) {
    const int tid = opq_tid(), wid = __builtin_amdgcn_readfirstlane(tid >> 6), lane = tid & 63, wr = wid >> 2, wc = wid & 3, fr = lane & 15, fq = lane >> 4;
    const int K = g.K, nt = K / BK;
    unsigned voffA[2];
#pragma unroll
    for (int i = 0; i < 2; ++i) { int R, C; stage_rc(tid * 16 + i * 8192, R, C); voffA[i] = (unsigned)(R * K + C) * 2u; }
    const size_t kstep = (size_t)(BK * 2);
    const size_t hstep = (size_t)HALF * K * 2;
    const size_t tstep = 2 * hstep;
    const unsigned ldsw = (unsigned)wid * 1024u;
    const int aoff = lds_byte(wr * 64 + fr, fq * 8), boff = lds_byte(wc * 32 + fr, fq * 8);
#define PG8_SA(b, h) (((b) * 2 + (h)) * HTB)
#define PG8_SB(b, h) ((4 + (b) * 2 + (h)) * HTB)
#define PG8_STAGE(bufoff, gbase, voff) do { _Pragma("unroll") for (int _i = 0; _i < 2; ++_i) \
        __builtin_amdgcn_global_load_lds((const unsigned*)((const char*)(gbase) + (voff)[_i]), (LAS unsigned*)(lds + (bufoff) + ldsw + _i * 8192), 16, 0, 0); } while (0)
#define PG8_LDA(dst, b, h) do { _Pragma("unroll") for (int m = 0; m < 4; ++m) _Pragma("unroll") for (int k = 0; k < 2; ++k) dst[m][k] = *(const LAS bf16x8*)(lds + PG8_SA(b, h) + aoff + m * 2048 + k * 1024); } while (0)
#define PG8_LDB(dst, b, h) do { _Pragma("unroll") for (int n = 0; n < 2; ++n) _Pragma("unroll") for (int k = 0; k < 2; ++k) dst[n][k] = *(const LAS bf16x8*)(lds + PG8_SB(b, h) + boff + n * 2048 + k * 1024); } while (0)
#define PG8_CAT8(lo, hi) __builtin_shufflevector(__builtin_bit_cast(i32x4, lo), __builtin_bit_cast(i32x4, hi), 0, 1, 2, 3, 4, 5, 6, 7)
#define PG8_MMA(ai, bj, At, Bt) do { __builtin_amdgcn_s_setprio(1); _Pragma("unroll") for (int m = 0; m < 4; ++m) _Pragma("unroll") for (int n = 0; n < 2; ++n) { \
        if constexpr (F8) { const i32x8 b8_ = PG8_CAT8(Bt[n][0], Bt[n][1]), a8_ = PG8_CAT8(At[m][0], At[m][1]); asm volatile("v_mfma_f32_16x16x128_f8f6f4 %0, %1, %2, %0" : "+v"(acc[ai][bj][m][n]) : "v"(b8_), "v"(a8_)); } \
        else { _Pragma("unroll") for (int k = 0; k < 2; ++k) acc[ai][bj][m][n] = __builtin_amdgcn_mfma_f32_16x16x32_bf16(Bt[n][k], At[m][k], acc[ai][bj][m][n], 0, 0, 0); } } __builtin_amdgcn_s_setprio(0); } while (0)
#define PG8_WAIT_V(n) asm volatile("s_waitcnt vmcnt(" #n ")" ::: "memory")
#define PG8_WAIT_L(n) asm volatile("s_waitcnt lgkmcnt(" #n ")" ::: "memory")
#define PG8_BAR __builtin_amdgcn_s_barrier()
#define PG8_SCHED __builtin_amdgcn_sched_barrier(0)
    LAS int* utab = (LAS int*)(lds + LDS_MISC + 128);
    if (tid < 16) { Unit tu; tu.pm = 0; tu.pn = 0; const bool ok = S.next(tid, tu); utab[2 * tid] = ok ? tu.pm : -1; utab[2 * tid + 1] = tu.pn; }
    __syncthreads();
#define PG8_NEXT(i, u) ((i) < 16 && ((u).pm = __builtin_amdgcn_readfirstlane(utab[2 * (i)]), (u).pn = __builtin_amdgcn_readfirstlane(utab[2 * (i) + 1]), (u).pm >= 0))
    Unit cur, nxt; int ui = 0;
    if (!PG8_NEXT(0, cur)) return;
    const char* cA = (const char*)g.A + (size_t)cur.pm * tstep; const char* cB = (const char*)g.Bt + (size_t)cur.pn * tstep;
    if constexpr (SP2) {
        PG8_STAGE(PG8_SB(0, 0), cB, voffA); PG8_STAGE(PG8_SB(0, 1), cB + hstep, voffA); PG8_STAGE(PG8_SA(0, 0), cA, voffA); PG8_STAGE(PG8_SA(0, 1), cA + hstep, voffA);
    }
    if constexpr (Epi::NEEDS_RS) {
        LAS float* rst = (LAS float*)(lds + STAGE_BYTES);
        for (int q = tid; q < 16 * 256; q += 512) { const int i = q >> 8, r = q & 255, pm = utab[2 * i];
            if (pm >= 0) { const GAS f32x4* p = (const GAS f32x4*)(E.ssq + (size_t)(pm * 256 + r) * 16); const f32x4 a0 = p[0], a1 = p[1], a2 = p[2], a3 = p[3];
                rst[q] = rsqrtf((((a0.x + a0.y) + (a0.z + a0.w)) + ((a1.x + a1.y) + (a1.z + a1.w)) + ((a2.x + a2.y) + (a2.z + a2.w)) + ((a3.x + a3.y) + (a3.z + a3.w))) * (1.0f / D) + RMS_EPS); } }
        if constexpr (Epi::NEEDS_RH) {
            LAS float* rht = (LAS float*)(lds + STAGE_BYTES + 16384);
            for (int q = tid; q < 8 * 256; q += 512) { const int i = q >> 8, r = q & 255, pm = utab[2 * i], hh = utab[2 * i + 1] >> 1;
                if (pm >= 0) { const GAS f32x4* p = (const GAS f32x4*)(E.hss + ((size_t)(pm * 256 + r) * RH + hh) * 16); const f32x4 a0 = p[0], a1 = p[1], a2 = p[2], a3 = p[3];
                    rht[q] = rsqrtf((((a0.x + a0.y) + (a0.z + a0.w)) + ((a1.x + a1.y) + (a1.z + a1.w)) + ((a2.x + a2.y) + (a2.z + a2.w)) + ((a3.x + a3.y) + (a3.z + a3.w))) * (1.0f / RV) + RMS_EPS); } }
        }
        __syncthreads();
    }
    f32x4 acc[2][2][4][2];
#define PG8_ZERO_ACC do { bf16x8 z_ = (bf16x8){0, 0, 0, 0, 0, 0, 0, 0}; asm volatile("" : "+v"(z_)); \
        _Pragma("unroll") for (int a = 0; a < 2; ++a) _Pragma("unroll") for (int b = 0; b < 2; ++b) _Pragma("unroll") for (int m = 0; m < 4; ++m) _Pragma("unroll") for (int n = 0; n < 2; ++n) \
            acc[a][b][m][n] = __builtin_amdgcn_mfma_f32_16x16x32_bf16(z_, z_, (f32x4){0.f, 0.f, 0.f, 0.f}, 0, 0, 0); } while (0)
    PG8_ZERO_ACC;
    bf16x8 At[4][2], B0[2][2], B1[2][2];
    if constexpr (SP2) {
        if (wr == 1) PG8_BAR;
        PG8_WAIT_V(2); PG8_BAR;
        PG8_STAGE(PG8_SB(1, 0), cB + kstep, voffA); PG8_STAGE(PG8_SA(1, 0), cA + kstep, voffA); PG8_STAGE(PG8_SB(1, 1), cB + hstep + kstep, voffA);
        PG8_WAIT_V(6); PG8_BAR;
    } else {
        PG8_STAGE(PG8_SB(0, 0), cB, voffA); PG8_STAGE(PG8_SA(0, 0), cA, voffA); PG8_STAGE(PG8_SB(0, 1), cB + hstep, voffA); PG8_STAGE(PG8_SA(0, 1), cA + hstep, voffA);
        if (wr == 1) PG8_BAR;
        PG8_WAIT_V(4); PG8_BAR;
        PG8_STAGE(PG8_SB(1, 0), cB + kstep, voffA); PG8_STAGE(PG8_SA(1, 0), cA + kstep, voffA); PG8_STAGE(PG8_SB(1, 1), cB + hstep + kstep, voffA);
        PG8_WAIT_V(6); PG8_BAR;
    }
    for (;;) {
        const bool has_next = PG8_NEXT(ui + 1, nxt);
        const char* nA = has_next ? (const char*)g.A + (size_t)nxt.pm * tstep : cA; const char* nB = has_next ? (const char*)g.Bt + (size_t)nxt.pn * tstep : cB;
        __builtin_amdgcn_s_waitcnt(0xC07F);
        for (int t = 0; t < nt; t += 2) {
            const bool last = (t == nt - 2);
            const char* a1 = cA + (size_t)(t + 1) * kstep;
            const char* a2 = last ? nA : cA + (size_t)(t + 2) * kstep; const char* b2 = last ? nB : cB + (size_t)(t + 2) * kstep;
            const char* a3 = a2 + kstep; const char* b3 = b2 + kstep;
            if constexpr (SP2) {
            PG8_LDB(B0, 0, 0); PG8_LDB(B1, 0, 1); PG8_SCHED; PG8_LDA(At, 0, 0); PG8_STAGE(PG8_SA(1, 1), a1 + hstep, voffA);
            PG8_WAIT_V(8); PG8_WAIT_L(0); PG8_BAR; PG8_MMA(0, 0, At, B0); PG8_MMA(0, 1, At, B1); PG8_BAR; PG8_SCHED;
            PG8_LDA(At, 0, 1); PG8_STAGE(PG8_SB(0, 0), b2, voffA); PG8_STAGE(PG8_SB(0, 1), b2 + hstep, voffA); PG8_STAGE(PG8_SA(0, 0), a2, voffA);
            PG8_WAIT_V(8); PG8_WAIT_L(0); PG8_BAR; PG8_MMA(1, 0, At, B0); PG8_MMA(1, 1, At, B1); PG8_BAR; PG8_SCHED;
            PG8_LDB(B0, 1, 0); PG8_LDB(B1, 1, 1); PG8_SCHED; PG8_LDA(At, 1, 0); PG8_STAGE(PG8_SA(0, 1), a2 + hstep, voffA);
            PG8_WAIT_V(8); PG8_WAIT_L(0); PG8_BAR; PG8_MMA(0, 0, At, B0); PG8_MMA(0, 1, At, B1); PG8_BAR; PG8_SCHED;
            PG8_LDA(At, 1, 1); PG8_STAGE(PG8_SB(1, 0), b3, voffA); PG8_STAGE(PG8_SB(1, 1), b3 + hstep, voffA); PG8_STAGE(PG8_SA(1, 0), a3, voffA);
            PG8_WAIT_V(8); PG8_WAIT_L(0); PG8_BAR; PG8_MMA(1, 0, At, B0); PG8_MMA(1, 1, At, B1); PG8_BAR; PG8_SCHED;
            } else {
            PG8_LDB(B0, 0, 0); PG8_SCHED; PG8_LDA(At, 0, 0); PG8_STAGE(PG8_SA(1, 1), a1 + hstep, voffA);
            PG8_WAIT_L(8); PG8_BAR; PG8_WAIT_L(0); PG8_MMA(0, 0, At, B0); PG8_BAR; PG8_SCHED;
            PG8_LDB(B1, 0, 1); PG8_STAGE(PG8_SB(0, 0), b2, voffA);
            PG8_BAR; PG8_WAIT_L(0); PG8_MMA(0, 1, At, B1); PG8_BAR;
            PG8_LDA(At, 0, 1); PG8_STAGE(PG8_SA(0, 0), a2, voffA);
            PG8_BAR; PG8_WAIT_L(0); PG8_MMA(1, 0, At, B0); PG8_BAR; PG8_SCHED;
            PG8_STAGE(PG8_SB(0, 1), b2 + hstep, voffA);
            PG8_WAIT_V(6); PG8_BAR; PG8_MMA(1, 1, At, B1); PG8_BAR;
            PG8_LDB(B0, 1, 0); PG8_SCHED; PG8_LDA(At, 1, 0); PG8_STAGE(PG8_SA(0, 1), a2 + hstep, voffA);
            PG8_WAIT_L(8); PG8_BAR; PG8_WAIT_L(0); PG8_MMA(0, 0, At, B0); PG8_BAR; PG8_SCHED;
            PG8_LDB(B1, 1, 1); PG8_STAGE(PG8_SB(1, 0), b3, voffA);
            PG8_BAR; PG8_WAIT_L(0); PG8_MMA(0, 1, At, B1); PG8_BAR;
            PG8_LDA(At, 1, 1); PG8_STAGE(PG8_SA(1, 0), a3, voffA);
            PG8_BAR; PG8_WAIT_L(0); PG8_MMA(1, 0, At, B0); PG8_BAR; PG8_SCHED;
            PG8_STAGE(PG8_SB(1, 1), b3 + hstep, voffA);
            PG8_WAIT_V(6); PG8_BAR; PG8_MMA(1, 1, At, B1); PG8_BAR;
            }
        }
        if constexpr (ALIGN_EPI) { if (wr == 0) PG8_BAR; }
        if constexpr (F8) asm volatile("s_nop 15\n\ts_nop 7" ::: "memory");
        { int efr = fr, efq = fq; asm volatile("" : "+v"(efr), "+v"(efq));
          E(acc, cur, wr, wc, efr, efq, (const LAS float*)(lds + STAGE_BYTES) + ui * 256 + wr * 64 + efr); }
        if (!has_next) break;
        PG8_ZERO_ACC;
        cur = nxt; cA = nA; cB = nB; ++ui;
        if constexpr (ALIGN_EPI) { if (wr == 1) PG8_BAR; }
    }
    PG8_WAIT_V(0);
    if constexpr (!ALIGN_EPI) { if (wr == 0) PG8_BAR; }
    PG8_BAR;
#undef PG8_NEXT
#undef PG8_SA
#undef PG8_SB
#undef PG8_STAGE
#undef PG8_LDA
#undef PG8_LDB
#undef PG8_MMA
#undef PG8_CAT8
#undef PG8_ZERO_ACC
#undef PG8_WAIT_V
#undef PG8_WAIT_L
#undef PG8_BAR
#undef PG8_SCHED
}
}

typedef f32x4 Acc[2][2][4][2];
__device__ __forceinline__ u32x4 pack8(const f32x4 a, const f32x4 b) { u32x4 w; w.x = pk2(a.x, a.y); w.y = pk2(a.z, a.w); w.z = pk2(b.x, b.y); w.w = pk2(b.z, b.w); return w; }
__device__ __forceinline__ void row_scales(const GAS float* part, size_t stride, int row0, int fq, float inv_n, float eps, float (&sc)[8]) {
    f32x4 v[8];
#pragma unroll
    for (int k = 0; k < 8; ++k) v[k] = *(const GAS f32x4*)(part + (size_t)(row0 + (k >> 2) * 128 + (k & 3) * 16) * stride + 4 * fq);
#pragma unroll
    for (int k = 0; k < 8; ++k) { float t = (v[k].x + v[k].y) + (v[k].z + v[k].w); t += __shfl_xor(t, 16); t += __shfl_xor(t, 32); sc[k] = rsqrtf(t * inv_n + eps); }
}

struct EpiConvIn {
    static constexpr bool NEEDS_RS = true, NEEDS_RH = false;
    const GAS float* ssq; GAS bf16_t* Bo; GAS bf16_t* CZ;
    __device__ __forceinline__ void operator()(const Acc& acc, const pg8::Unit& u, int wr, int wc, int fr, int fq, const LAS float* rst) const {
        const int row0 = u.pm * 256 + wr * 64 + fr;
        float rs[8];
#pragma unroll
        for (int k = 0; k < 8; ++k) rs[k] = rst[(k >> 2) * 128 + (k & 3) * 16];
#pragma unroll
        for (int ai = 0; ai < 2; ++ai)
#pragma unroll
            for (int m = 0; m < 4; ++m) {
                const int row = row0 + ai * 128 + m * 16; const float r1 = rs[4 * ai + m];
                if (u.pn < 4) {
#pragma unroll
                    for (int bj = 0; bj < 2; ++bj)
                        *(GAS u32x4*)(Bo + (size_t)row * D + u.pn * 256 + bj * 128 + wc * 32 + fq * 8) = pack8(acc[ai][bj][m][0] * r1, acc[ai][bj][m][1] * r1);
                } else {
                    const float r2 = r1 * r1;
                    const f32x4 p0 = acc[ai][0][m][0] * acc[ai][0][m][1] * r2, p1 = acc[ai][1][m][0] * acc[ai][1][m][1] * r2;
                    *(GAS u32x4*)(CZ + (size_t)row * D + (u.pn - 4) * 128 + wc * 32 + fq * 8) = pack8(p0, p1);
                }
            }
    }
};
struct EpiFfnIn {
    static constexpr bool NEEDS_RS = true, NEEDS_RH = false;
    const GAS float* ssq; GAS unsigned char* ACT; bool f8; float isc;
    __device__ __forceinline__ void operator()(const Acc& acc, const pg8::Unit& u, int wr, int wc, int fr, int fq, const LAS float* rst) const {
        const int row0 = u.pm * 256 + wr * 64 + fr;
        float rs[8];
#pragma unroll
        for (int k = 0; k < 8; ++k) rs[k] = rst[(k >> 2) * 128 + (k & 3) * 16];
#pragma unroll
        for (int ai = 0; ai < 2; ++ai)
#pragma unroll
            for (int m = 0; m < 4; ++m) {
                const int row = row0 + ai * 128 + m * 16; const float r1 = rs[4 * ai + m] * isc;
                const float c1 = -1.44269504089f * r1, r2 = r1 * r1;
                f32x2 g[4], p[4], e[4];
#pragma unroll
                for (int bj = 0; bj < 2; ++bj) { const f32x4 gt = acc[ai][bj][m][0], up = acc[ai][bj][m][1];
                    g[2 * bj] = (f32x2){gt.x, gt.y}; g[2 * bj + 1] = (f32x2){gt.z, gt.w};
                    p[2 * bj] = (f32x2){gt.x, gt.y} * (f32x2){up.x, up.y}; p[2 * bj + 1] = (f32x2){gt.z, gt.w} * (f32x2){up.z, up.w}; }
#pragma unroll
                for (int k = 0; k < 4; ++k) { const f32x2 t = g[k] * c1; e[k].x = __builtin_amdgcn_exp2f(t.x); e[k].y = __builtin_amdgcn_exp2f(t.y); }
#pragma unroll
                for (int k = 0; k < 4; ++k) { const f32x2 d = e[k] + 1.0f; e[k].x = __builtin_amdgcn_rcpf(d.x); e[k].y = __builtin_amdgcn_rcpf(d.y); }
#pragma unroll
                for (int k = 0; k < 4; ++k) p[k] = (p[k] * r2) * e[k];
                const size_t eoff = (size_t)row * DFF + u.pn * 128 + wc * 32 + fq * 8;
                if (f8) {
                    u32x2 w;
                    w.x = (unsigned)__builtin_amdgcn_cvt_pk_fp8_f32(p[1].x, p[1].y, __builtin_amdgcn_cvt_pk_fp8_f32(p[0].x, p[0].y, 0, false), true);
                    w.y = (unsigned)__builtin_amdgcn_cvt_pk_fp8_f32(p[3].x, p[3].y, __builtin_amdgcn_cvt_pk_fp8_f32(p[2].x, p[2].y, 0, false), true);
                    __builtin_nontemporal_store(w, (GAS u32x2*)(ACT + eoff));
                } else {
                    u32x4 w; w.x = pk2(p[0].x, p[0].y); w.y = pk2(p[1].x, p[1].y); w.z = pk2(p[2].x, p[2].y); w.w = pk2(p[3].x, p[3].y);
                    __builtin_nontemporal_store(w, (GAS u32x4*)(ACT + 2 * eoff));
                }
            }
    }
};
__device__ __forceinline__ f32x2 gelu_pk(f32x2 v) {
    const f32x2 av = __builtin_elementwise_abs(v), d = av * 0.2316418882f + 1.0f;
    f32x2 t; t.x = __builtin_amdgcn_rcpf(d.x); t.y = __builtin_amdgcn_rcpf(d.y);
    f32x2 q = t * 0.5307027145f + (-0.7265760135f); q = q * t + 0.7107068705f; q = q * t + (-0.142248368f); q = q * t + 0.127414796f; q = q * t;
    const f32x2 s = (v * v) * (-0.72134752044f);
    f32x2 e; e.x = __builtin_amdgcn_exp2f(s.x); e.y = __builtin_amdgcn_exp2f(s.y);
    return v * 0.5f + av * (0.5f - q * e);
}
__device__ __forceinline__ f32x4 gelu4(f32x4 v) { const f32x2 a = gelu_pk((f32x2){v.x, v.y}), b = gelu_pk((f32x2){v.z, v.w}); return (f32x4){a.x, a.y, b.x, b.y}; }
struct EpiSguIn {
    static constexpr bool NEEDS_RS = true, NEEDS_RH = false;
    const GAS float* ssq; GAS bf16_t* U; GAS bf16_t* V; GAS float* lnp;
    __device__ __forceinline__ void operator()(const Acc& acc, const pg8::Unit& u, int wr, int wc, int fr, int fq, const LAS float* rst) const {
        const int row0 = u.pm * 256 + wr * 64 + fr;
        const bool isv = u.pn >= 8;
        GAS bf16_t* dst = isv ? V + (u.pn - 8) * 256 : U + u.pn * 256;
        float rs[8];
#pragma unroll
        for (int k = 0; k < 8; ++k) rs[k] = rst[(k >> 2) * 128 + (k & 3) * 16];
#pragma unroll
        for (int ai = 0; ai < 2; ++ai)
#pragma unroll
            for (int m = 0; m < 4; ++m) {
                const int row = row0 + ai * 128 + m * 16; const float r1 = rs[4 * ai + m];
                float s1 = 0.f, s2 = 0.f;
#pragma unroll
                for (int bj = 0; bj < 2; ++bj) {
                    const f32x4 a = gelu4(acc[ai][bj][m][0] * r1), b = gelu4(acc[ai][bj][m][1] * r1);
                    *(GAS u32x4*)(dst + (size_t)row * 2048 + bj * 128 + wc * 32 + fq * 8) = pack8(a, b);
                    s1 += (a.x + a.y) + (a.z + a.w) + (b.x + b.y) + (b.z + b.w);
                    s2 += (a.x * a.x + a.y * a.y) + (a.z * a.z + a.w * a.w) + (b.x * b.x + b.y * b.y) + (b.z * b.z + b.w * b.w);
                }
                if (isv) {
                    s1 += __shfl_xor(s1, 16); s1 += __shfl_xor(s1, 32); s2 += __shfl_xor(s2, 16); s2 += __shfl_xor(s2, 32);
                    if (fq == 0) *(GAS f32x2*)(lnp + ((size_t)row * 32 + (u.pn - 8) * 4 + wc) * 2) = (f32x2){s1, s2};
                }
            }
    }
};
struct EpiRetQkv {
    static constexpr bool NEEDS_RS = true, NEEDS_RH = false;
    const GAS float* ssq; const GAS float* rcos; const GAS float* rsin; GAS bf16_t* Q; GAS bf16_t* Kn; GAS bf16_t* V;
    __device__ __forceinline__ void operator()(const Acc& acc, const pg8::Unit& u, int wr, int wc, int fr, int fq, const LAS float* rst) const {
        const int row0 = u.pm * 256 + wr * 64 + fr;
        const int i0 = wc * 32 + fq * 8;
        const bool isk = u.pn >= 4; const int h = u.pn & 3;
        const float l2g = __builtin_amdgcn_logf(1.0f - __builtin_amdgcn_exp2f(-5.0f - (float)h));
        float rs[8];
#pragma unroll
        for (int k = 0; k < 8; ++k) rs[k] = rst[(k >> 2) * 128 + (k & 3) * 16];
        if (u.pn >= 8) {
#pragma unroll
            for (int ai = 0; ai < 2; ++ai)
#pragma unroll
                for (int m = 0; m < 4; ++m) { const int row = row0 + ai * 128 + m * 16; const float r1 = rs[4 * ai + m];
#pragma unroll
                    for (int bj = 0; bj < 2; ++bj)
                        *(GAS u32x4*)(V + (size_t)row * 2048 + (u.pn - 8) * 256 + bj * 128 + i0) = pack8(acc[ai][bj][m][0] * r1, acc[ai][bj][m][1] * r1); }
        } else {
#pragma unroll
            for (int hp = 0; hp < 4; ++hp) {
                const int ai = hp >> 1;
                f32x4 cs[2][2], sn[2][2];
#pragma unroll
                for (int mm = 0; mm < 2; ++mm) { const int pos = (row0 + ai * 128 + (2 * (hp & 1) + mm) * 16) & (SEQ - 1);
#pragma unroll
                    for (int bj = 0; bj < 2; ++bj) { cs[mm][bj] = *(const GAS f32x4*)(rcos + (size_t)pos * 128 + i0 + 4 * bj); sn[mm][bj] = *(const GAS f32x4*)(rsin + (size_t)pos * 128 + i0 + 4 * bj); } }
#pragma unroll
                for (int mm = 0; mm < 2; ++mm) {
                    const int m = 2 * (hp & 1) + mm;
                    const int row = row0 + ai * 128 + m * 16, pos = row & (SEQ - 1); const float r1 = rs[4 * ai + m];
                    const float sc = isk ? r1 * 0.0625f * __builtin_amdgcn_exp2f(l2g * (float)(127 - (pos & 127))) : r1;
                    f32x4 o1[2], o2[2];
#pragma unroll
                    for (int bj = 0; bj < 2; ++bj) { const f32x4 x1 = acc[ai][bj][m][0] * sc, x2 = acc[ai][bj][m][1] * sc;
                        o1[bj] = x1 * cs[mm][bj] - x2 * sn[mm][bj]; o2[bj] = x2 * cs[mm][bj] + x1 * sn[mm][bj]; }
                    GAS bf16_t* dst = (isk ? Kn : Q) + (size_t)row * D + h * 256 + i0;
                    *(GAS u32x4*)dst = pack8(o1[0], o1[1]); *(GAS u32x4*)(dst + 128) = pack8(o2[0], o2[1]);
                }
            }
        }
    }
};
struct EpiRetG {
    static constexpr bool NEEDS_RS = true, NEEDS_RH = true;
    const GAS float* ssq; const GAS float* hss; GAS bf16_t* Y;
    __device__ __forceinline__ void operator()(const Acc& acc, const pg8::Unit& u, int wr, int wc, int fr, int fq, const LAS float* rst) const {
        const int row0 = u.pm * 256 + wr * 64 + fr; const int h = u.pn >> 1;
        float rs[8], rh[8];
#pragma unroll
        for (int k = 0; k < 8; ++k) { rs[k] = rst[(k >> 2) * 128 + (k & 3) * 16]; rh[k] = rst[4096 + (k >> 2) * 128 + (k & 3) * 16]; }
#pragma unroll
        for (int ai = 0; ai < 2; ++ai) {
            u32x4 ov[4][2];
#pragma unroll
            for (int m = 0; m < 4; ++m)
#pragma unroll
                for (int bj = 0; bj < 2; ++bj) ov[m][bj] = *(const GAS u32x4*)(Y + (size_t)(row0 + ai * 128 + m * 16) * 2048 + u.pn * 256 + bj * 128 + wc * 32 + fq * 8);
#pragma unroll
            for (int m = 0; m < 4; ++m) {
                const int row = row0 + ai * 128 + m * 16; const float r1 = rs[4 * ai + m], r3 = rh[4 * ai + m];
#pragma unroll
                for (int bj = 0; bj < 2; ++bj) {
                    GAS bf16_t* p = Y + (size_t)row * 2048 + u.pn * 256 + bj * 128 + wc * 32 + fq * 8;
                    const u32x4 o = ov[m][bj];
                    const f32x4 g0 = acc[ai][bj][m][0] * r1, g1 = acc[ai][bj][m][1] * r1;
                    const f32x4 a = (f32x4){silu_f(g0.x) * bf_lo(o.x), silu_f(g0.y) * bf_hi(o.x), silu_f(g0.z) * bf_lo(o.y), silu_f(g0.w) * bf_hi(o.y)} * r3;
                    const f32x4 b = (f32x4){silu_f(g1.x) * bf_lo(o.z), silu_f(g1.y) * bf_hi(o.z), silu_f(g1.z) * bf_lo(o.w), silu_f(g1.w) * bf_hi(o.w)} * r3;
                    *(GAS u32x4*)p = pack8(a, b);
                }
            }
        }
    }
};
template <int MB = 4> struct EpiResidT {
    static constexpr bool NEEDS_RS = false, NEEDS_RH = false;
    GAS bf16_t* xb; GAS float* ssq; float osc; GAS unsigned char* x8;
    __device__ __forceinline__ void operator()(const Acc& acc, const pg8::Unit& u, int wr, int wc, int fr, int fq, const LAS float* rst) const {
        const int row0 = u.pm * 256 + wr * 64 + fr, col0 = u.pn * 256 + wc * 32 + fq * 8;
#pragma unroll
        for (int ai = 0; ai < 2; ++ai)
#pragma unroll
        for (int mh = 0; mh < 4; mh += MB) {
            u32x4 bv[4][2];
#pragma unroll
            for (int m = mh; m < mh + MB; ++m)
#pragma unroll
                for (int bj = 0; bj < 2; ++bj) bv[m][bj] = *(const GAS u32x4*)(xb + (size_t)(row0 + ai * 128 + m * 16) * D + col0 + bj * 128);
#pragma unroll
            for (int m = mh; m < mh + MB; ++m) {
                const int row = row0 + ai * 128 + m * 16;
                GAS bf16_t* p = xb + (size_t)row * D + col0;
                float s2 = 0.f;
#pragma unroll
                for (int bj = 0; bj < 2; ++bj) {
                    const u32x4 b = bv[m][bj];
                    const f32x4 x0 = (f32x4){bf_lo(b.x), bf_hi(b.x), bf_lo(b.y), bf_hi(b.y)} + acc[ai][bj][m][0] * osc;
                    const f32x4 x1 = (f32x4){bf_lo(b.z), bf_hi(b.z), bf_lo(b.w), bf_hi(b.w)} + acc[ai][bj][m][1] * osc;
                    *(GAS u32x4*)(p + bj * 128) = pack8(x0, x1);
                    if (x8) { u32x2 w8;
                        w8.x = (unsigned)__builtin_amdgcn_cvt_pk_fp8_f32(x0.z, x0.w, __builtin_amdgcn_cvt_pk_fp8_f32(x0.x, x0.y, 0, false), true);
                        w8.y = (unsigned)__builtin_amdgcn_cvt_pk_fp8_f32(x1.z, x1.w, __builtin_amdgcn_cvt_pk_fp8_f32(x1.x, x1.y, 0, false), true);
                        *(GAS u32x2*)(x8 + (size_t)row * D + col0 + bj * 128) = w8; }
                    s2 += (x0.x * x0.x + x0.y * x0.y) + (x0.z * x0.z + x0.w * x0.w) + (x1.x * x1.x + x1.y * x1.y) + (x1.z * x1.z + x1.w * x1.w);
                }
                s2 += __shfl_xor(s2, 16); s2 += __shfl_xor(s2, 32);
                if (fq == 0) ssq[(size_t)row * 16 + u.pn * 4 + wc] = s2;
            }
        }
    }
};
typedef EpiResidT<4> EpiResid;

struct Args { const float* in[18]; float* out; unsigned char* ws; int ph_lo, ph_hi, li, pad; };

struct Frame {
    LAS unsigned char* lds;
    int tid, lane, wave, vcu, G;
};

enum { MAP_NAT = 0, MAP_P8 = 1, MAP_CONV = 2, MAP_RETQKV = 3, MAP_FFN = 4 };
struct PrepJob { const GAS float* src; const GAS float* src2; const GAS float* gain; GAS bf16_t* dst; int ld, N, K, map; float f8scale; };
__device__ __forceinline__ void prep_item(const PrepJob& J, int item, LAS float* scr, int lane) {
    const int nb = J.N / 64, kb = item / nb, r = item % nb, pn = r >> 2, wc = r & 3;
    const int k0 = kb * 64;
    const int sl = 128 * (lane >> 5) + 32 * wc + (lane & 31);
    const int slot = 256 * pn + sl;
    const GAS float* src = J.src; int col;
    {
        const int bj = sl >> 7, n = (sl >> 4) & 1, fq = (sl >> 2) & 3, j = sl & 3, ch = 32 * wc + 8 * fq + 4 * bj + j;
        const int p8 = (slot & ~31) + pg8::perm32(slot & 31);
        if (J.map == MAP_NAT) col = slot;
        else if (J.map == MAP_P8) col = p8;
        else if (J.map == MAP_CONV) col = (pn < 4) ? p8 : (1024 + 1024 * n + 128 * (pn - 4) + ch);
        else if (J.map == MAP_RETQKV) col = (pn < 8) ? (256 * pn + 128 * n + ch) : p8;
        else { col = 128 * pn + ch; if (n) src = J.src2; }
    }
    const GAS float* sp = src + (size_t)k0 * J.ld + col;
#pragma unroll
    for (int hk = 0; hk < 2; ++hk) {
        float wv[32];
#pragma unroll
        for (int k = 0; k < 32; ++k) wv[k] = sp[(size_t)(32 * hk + k) * J.ld];
#pragma unroll
        for (int k = 0; k < 32; ++k) scr[(32 * hk + k) * 65 + lane] = wv[k];
    }
    asm volatile("s_waitcnt lgkmcnt(0)" ::: "memory");
    const int c = lane & 7;
    float gn[8];
#pragma unroll
    for (int e = 0; e < 8; ++e) gn[e] = J.gain ? J.gain[k0 + 8 * c + e] : 1.0f;
#pragma unroll
    for (int it = 0; it < 8; ++it) {
        const int l2 = it * 8 + (lane >> 3);
        const int slot2 = 256 * pn + 128 * (l2 >> 5) + 32 * wc + (l2 & 31);
        const LAS float* s = scr + (8 * c) * 65 + l2;
        if (J.f8scale != 0.f) {
            const float f = J.f8scale; u32x2 o8;
            o8.x = (unsigned)__builtin_amdgcn_cvt_pk_fp8_f32(s[2 * 65] * gn[2] * f, s[3 * 65] * gn[3] * f, __builtin_amdgcn_cvt_pk_fp8_f32(s[0] * gn[0] * f, s[65] * gn[1] * f, 0, false), true);
            o8.y = (unsigned)__builtin_amdgcn_cvt_pk_fp8_f32(s[6 * 65] * gn[6] * f, s[7 * 65] * gn[7] * f, __builtin_amdgcn_cvt_pk_fp8_f32(s[4 * 65] * gn[4] * f, s[5 * 65] * gn[5] * f, 0, false), true);
            *(GAS u32x2*)((GAS unsigned char*)J.dst + (size_t)slot2 * J.K + k0 + 8 * c) = o8;
        } else {
        u32x4 o; o.x = pk2(s[0] * gn[0], s[65] * gn[1]); o.y = pk2(s[2 * 65] * gn[2], s[3 * 65] * gn[3]); o.z = pk2(s[4 * 65] * gn[4], s[5 * 65] * gn[5]); o.w = pk2(s[6 * 65] * gn[6], s[7 * 65] * gn[7]);
        *(GAS u32x4*)(J.dst + (size_t)slot2 * J.K + k0 + 8 * c) = o;
        }
    }
    asm volatile("s_waitcnt lgkmcnt(0)" ::: "memory");
}
__device__ __forceinline__ void p0_prologue(const Frame& F, const Args& a) {
    unsigned char* ws = a.ws;
    const int tid_ = opq_tid(), lane_ = tid_ & 63, wave_ = __builtin_amdgcn_readfirstlane(tid_ >> 6);
    LAS float* scr = (LAS float*)(F.lds + wave_ * 16640);
    const int gw = F.vcu * 8 + wave_, NGW = F.G * 8;
    constexpr int NJOB = 17;
    int start = 0;
#pragma unroll 1
    for (int jb = 0; jb < NJOB; ++jb) {
        PrepJob J; J.f8scale = 0.f;
        if (jb < 2)       { J.src = (const GAS float*)(a.in[4] + (size_t)jb * 1024 * 3072); J.src2 = nullptr; J.gain = (const GAS float*)(a.in[1] + (jb == 0 ? 0 : 3) * D); J.dst = (GAS bf16_t*)(ws + W_CI + jb * W_CI_SZ); J.ld = 3072; J.N = 3072; J.K = 1024; J.map = MAP_CONV; }
        else if (jb < 4)  { const int j = jb - 2; J.src = (const GAS float*)(a.in[6] + (size_t)j * 1024 * 1024); J.src2 = nullptr; J.gain = nullptr; J.dst = (GAS bf16_t*)(ws + W_CO + j * W_CO_SZ); J.ld = 1024; J.N = 1024; J.K = 1024; J.map = MAP_P8; }
        else if (jb == 4) { J.src = (const GAS float*)(a.in[7]); J.src2 = nullptr; J.gain = (const GAS float*)(a.in[1] + 1 * D); J.dst = (GAS bf16_t*)(ws + W_SI); J.ld = 4096; J.N = 4096; J.K = 1024; J.map = MAP_P8; }
        else if (jb == 5) { J.src = (const GAS float*)(a.in[12]); J.src2 = nullptr; J.gain = nullptr; J.dst = (GAS bf16_t*)(ws + W_SO); J.ld = 1024; J.N = 1024; J.K = 2048; J.map = MAP_P8; }
        else if (jb == 6) { J.src = (const GAS float*)(a.in[13]); J.src2 = nullptr; J.gain = (const GAS float*)(a.in[1] + 2 * D); J.dst = (GAS bf16_t*)(ws + W_RQ); J.ld = 6144; J.N = 4096; J.K = 1024; J.map = MAP_RETQKV; }
        else if (jb == 7) { J.src = (const GAS float*)(a.in[13] + 4096); J.src2 = nullptr; J.gain = (const GAS float*)(a.in[1] + 2 * D); J.dst = (GAS bf16_t*)(ws + W_RG); J.ld = 6144; J.N = 2048; J.K = 1024; J.map = MAP_P8; }
        else if (jb == 8) { J.src = (const GAS float*)(a.in[14]); J.src2 = nullptr; J.gain = nullptr; J.dst = (GAS bf16_t*)(ws + W_RO); J.ld = 1024; J.N = 1024; J.K = 2048; J.map = MAP_P8; }
        else if (jb < 13) { const int L = jb - 9; J.src = (const GAS float*)(a.in[15] + (size_t)L * 1024 * DFF); J.src2 = (const GAS float*)(a.in[16] + (size_t)L * 1024 * DFF); J.gain = (const GAS float*)(a.in[2] + L * D); J.dst = (GAS bf16_t*)(ws + W_FI + L * W_FI_SZ); J.ld = DFF; J.N = 2 * DFF; J.K = 1024; J.map = MAP_FFN; J.f8scale = ((F8_F1_LAYERS >> L) & 1) ? FI_WSCALE : 0.f; }
        else              { const int L = jb - 13; J.src = (const GAS float*)(a.in[17] + (size_t)L * DFF * 1024); J.src2 = nullptr; J.gain = nullptr; J.dst = (GAS bf16_t*)(ws + W_FD + L * W_FD_SZ); J.ld = 1024; J.N = 1024; J.K = DFF; J.map = MAP_P8; J.f8scale = ((F8_LAYERS >> L) & 1) ? FD_WSCALE : 0.f; }
        const int nitems = (J.K / 64) * (J.N / 64);
        int first = (gw - start % NGW + NGW) % NGW;
        for (int it = first; it < nitems; it += NGW) prep_item(J, it, scr, lane_);
        start += nitems;
    }
    {
        const GAS float* x = (const GAS float*)a.in[0]; GAS bf16_t* xb = (GAS bf16_t*)(ws + WS_XB); GAS float* ssq = (GAS float*)(ws + WS_SSQ);
        for (int row = 4 * gw; row < M; row += 4 * NGW) {
            f32x4 v[4][4];
#pragma unroll
            for (int r = 0; r < 4; ++r)
#pragma unroll
                for (int j = 0; j < 4; ++j) v[r][j] = ((const GAS f32x4*)(x + (size_t)(row + r) * D))[lane_ + 64 * j];
#pragma unroll
            for (int r = 0; r < 4; ++r) {
                float sq = 0.f;
#pragma unroll
                for (int j = 0; j < 4; ++j) sq += (v[r][j].x * v[r][j].x + v[r][j].y * v[r][j].y) + (v[r][j].z * v[r][j].z + v[r][j].w * v[r][j].w);
                sq = wave_sum(sq);
                GAS u32x2* o8 = (GAS u32x2*)(xb + (size_t)(row + r) * D) + lane_;
#pragma unroll
                for (int j = 0; j < 4; ++j) { u32x2 w; w.x = pk2(v[r][j].x, v[r][j].y); w.y = pk2(v[r][j].z, v[r][j].w); o8[64 * j] = w; }
                if (lane_ < 16) ssq[(size_t)(row + r) * 16 + lane_] = (lane_ == 0) ? sq : 0.f;
            }
        }
    }
    {
        GAS float* rc = (GAS float*)(ws + WS_ROT); GAS float* rsn = rc + (size_t)SEQ * 128;
        const int gt = F.vcu * 512 + tid_, NGT = F.G * 512;
        for (int idx = gt; idx < SEQ * 128; idx += NGT) {
            const int i = idx & 127, pos = idx >> 7;
            const float inv = __builtin_amdgcn_exp2f(-(float)i * (13.287712379549449f / 128.0f));
            const float ang = (float)pos * inv;
            const double ad = (double)ang;
            const double kq = __builtin_rint(ad * 0.63661977236758134308);
            const double y = __builtin_fma(-kq, 1.57079632679489661923, ad) - kq * 6.123233995736766e-17;
            const double y2 = y * y;
            const double sp = y * (1.0 + y2 * (-1.0 / 6 + y2 * (1.0 / 120 + y2 * (-1.0 / 5040 + y2 * (1.0 / 362880 + y2 * (-1.0 / 39916800))))));
            const double cp = 1.0 + y2 * (-0.5 + y2 * (1.0 / 24 + y2 * (-1.0 / 720 + y2 * (1.0 / 40320 + y2 * (-1.0 / 3628800 + y2 * (1.0 / 479001600))))));
            const int q = ((int)(long long)kq) & 3;
            const double sv = (q == 0) ? sp : (q == 1) ? cp : (q == 2) ? -sp : -cp;
            const double cv = (q == 0) ? cp : (q == 1) ? -sp : (q == 2) ? -cp : sp;
            rc[idx] = (float)cv; rsn[idx] = (float)sv;
        }
        const GAS float* wsp = (const GAS float*)a.in[10]; GAS bf16_t* wd = (GAS bf16_t*)(ws + W_WS);
        for (int idx = gt; idx < 8 * 128 * 128; idx += NGT) { const int s = idx & 127, t = (idx >> 7) & 127; wd[idx] = (bf16_t)f2bf(s <= t ? wsp[idx] : 0.f); }
    }
}

__device__ __forceinline__ void conv_phase(const Frame& F, const GAS bf16_t* Bo, const GAS bf16_t* CZ, const GAS float* cw, GAS bf16_t* Y) {
    constexpr int RB = 16;
    const int nitem = (M / RB) * 128;
    const int tid_ = opq_tid();
    for (int it = F.vcu * 512 + tid_; it < nitem; it += F.G * 512) {
        const int cc = it & 127, rb = it >> 7, r0 = rb * RB, c0 = cc * 8;
        float w0[8], w1[8], w2[8];
#pragma unroll
        for (int e = 0; e < 8; ++e) { w0[e] = cw[c0 + e]; w1[e] = cw[D + c0 + e]; w2[e] = cw[2 * D + c0 + e]; }
        u32x4 p2 = (u32x4){0, 0, 0, 0}, p1 = (u32x4){0, 0, 0, 0};
        if ((r0 & (SEQ - 1)) != 0) { p2 = *(const GAS u32x4*)(CZ + (size_t)(r0 - 2) * D + c0); p1 = *(const GAS u32x4*)(CZ + (size_t)(r0 - 1) * D + c0); }
#pragma unroll
        for (int hb = 0; hb < 2; ++hb) {
            u32x4 pz[8], pb[8];
#pragma unroll
            for (int r = 0; r < 8; ++r) { const size_t off = (size_t)(r0 + 8 * hb + r) * D + c0; pz[r] = *(const GAS u32x4*)(CZ + off); pb[r] = *(const GAS u32x4*)(Bo + off); }
#pragma unroll
            for (int r = 0; r < 8; ++r) {
                const size_t off = (size_t)(r0 + 8 * hb + r) * D + c0;
                const u32x4 p0 = pz[r], bv = pb[r];
                u32x4 o;
#pragma unroll
                for (int q = 0; q < 4; ++q) {
                    const float lo = bf_lo(bv[q]) * (w0[2 * q] * bf_lo(p2[q]) + w1[2 * q] * bf_lo(p1[q]) + w2[2 * q] * bf_lo(p0[q]));
                    const float hi = bf_hi(bv[q]) * (w0[2 * q + 1] * bf_hi(p2[q]) + w1[2 * q + 1] * bf_hi(p1[q]) + w2[2 * q + 1] * bf_hi(p0[q]));
                    o[q] = pk2(lo, hi);
                }
                *(GAS u32x4*)(Y + off) = o;
                p2 = p1; p1 = p0;
            }
        }
    }
}

constexpr int SG_W = 0, SG_WSTR = 272, SG_T = 128 * SG_WSTR, SG_TSTR = 272, SG_ST = SG_T + 256 * SG_TSTR, SG_LG = SG_ST + 1024, SG_END = SG_LG + 2048;
static_assert(SG_END <= LDS_MISC, "sgu lds");
__device__ __forceinline__ void sgu_phase(const Frame& F, GAS bf16_t* U, const GAS bf16_t* V, const GAS float* lnp, const GAS bf16_t* Wt, const GAS float* lng, const GAS float* lnb, const GAS float* bs) {
    LAS unsigned char* lds = F.lds;
    const int tid = opq_tid(), lane = tid & 63, w = __builtin_amdgcn_readfirstlane(tid >> 6), fr = lane & 15, fq = lane >> 4;
    const int s = tid & 127, dg = tid >> 7;
    const int srow = tid >> 2, spart = tid & 3;
    int gcur = -1;
    u32x4 vreg[8]; f32x4 lnv[4];
    int un = F.vcu;
    if (un < 2048) {
        const int g = un & 7, row0 = (un >> 3) * 128;
        const GAS bf16_t* vp = V + (size_t)(row0 + s) * 2048 + g * 256;
#pragma unroll
        for (int i = 0; i < 8; ++i) vreg[i] = *(const GAS u32x4*)(vp + (dg + 4 * i) * 8);
        const GAS f32x4* lp = (const GAS f32x4*)(lnp + (size_t)(row0 + srow) * 64 + spart * 16);
#pragma unroll
        for (int i = 0; i < 4; ++i) lnv[i] = lp[i];
    }
    for (; un < 2048; un += F.G) {
        const int g = un & 7, c = un >> 3, row0 = c * 128;
        __syncthreads();
        if (g != gcur) {
            gcur = g;
            const GAS bf16_t* wg = Wt + (size_t)g * 128 * 128;
#pragma unroll
            for (int i = 0; i < 4; ++i) { const int p = tid + 512 * i, t = p >> 4, c16 = p & 15; *(LAS u32x4*)(lds + SG_W + t * SG_WSTR + c16 * 16) = *(const GAS u32x4*)(wg + t * 128 + c16 * 8); }
            if (tid < 256) { ((LAS float*)(lds + SG_LG))[tid] = lng[g * 256 + tid]; } else { ((LAS float*)(lds + SG_LG))[tid] = lnb[g * 256 + tid - 256]; }
        }
        {
            float s1 = 0.f, s2 = 0.f;
#pragma unroll
            for (int i = 0; i < 4; ++i) { s1 += lnv[i].x + lnv[i].z; s2 += lnv[i].y + lnv[i].w; }
            s1 += __shfl_xor(s1, 1); s2 += __shfl_xor(s2, 1); s1 += __shfl_xor(s1, 2); s2 += __shfl_xor(s2, 2);
            const float mu = s1 * (1.0f / 2048.0f), var = s2 * (1.0f / 2048.0f) - mu * mu;
            if (spart == 0) { ((LAS float*)(lds + SG_ST))[srow] = mu; ((LAS float*)(lds + SG_ST))[128 + srow] = rsqrtf(fmaxf(var, 0.f) + LN_EPS); }
        }
        __syncthreads();
        {
            const float mu = ((LAS float*)(lds + SG_ST))[s], r = ((LAS float*)(lds + SG_ST))[128 + s];
#pragma unroll
            for (int i = 0; i < 8; ++i) {
                const int dc = dg + 4 * i, d0 = dc * 8;
                const u32x4 v = vreg[i];
                const f32x4 g0 = *(const LAS f32x4*)(lds + SG_LG + d0 * 4), g1 = *(const LAS f32x4*)(lds + SG_LG + d0 * 4 + 16);
                const f32x4 b0 = *(const LAS f32x4*)(lds + SG_LG + 1024 + d0 * 4), b1 = *(const LAS f32x4*)(lds + SG_LG + 1024 + d0 * 4 + 16);
                LAS bf16_t* tp = (LAS bf16_t*)(lds + SG_T + d0 * SG_TSTR) + s;
                tp[0 * (SG_TSTR / 2)] = (bf16_t)f2bf((bf_lo(v.x) - mu) * r * g0.x + b0.x);
                tp[1 * (SG_TSTR / 2)] = (bf16_t)f2bf((bf_hi(v.x) - mu) * r * g0.y + b0.y);
                tp[2 * (SG_TSTR / 2)] = (bf16_t)f2bf((bf_lo(v.y) - mu) * r * g0.z + b0.z);
                tp[3 * (SG_TSTR / 2)] = (bf16_t)f2bf((bf_hi(v.y) - mu) * r * g0.w + b0.w);
                tp[4 * (SG_TSTR / 2)] = (bf16_t)f2bf((bf_lo(v.z) - mu) * r * g1.x + b1.x);
                tp[5 * (SG_TSTR / 2)] = (bf16_t)f2bf((bf_hi(v.z) - mu) * r * g1.y + b1.y);
                tp[6 * (SG_TSTR / 2)] = (bf16_t)f2bf((bf_lo(v.w) - mu) * r * g1.z + b1.z);
                tp[7 * (SG_TSTR / 2)] = (bf16_t)f2bf((bf_hi(v.w) - mu) * r * g1.w + b1.w);
            }
        }
        u32x4 uv[8];
#pragma unroll
        for (int tb = 0; tb < 8; ++tb) uv[tb] = *(const GAS u32x4*)(U + (size_t)(row0 + 16 * tb + fr) * 2048 + g * 256 + 32 * w + 8 * fq);
        if (un + F.G < 2048) {
            const int un2 = un + F.G, g2 = un2 & 7, row2 = (un2 >> 3) * 128;
            const GAS bf16_t* vp = V + (size_t)(row2 + s) * 2048 + g2 * 256;
#pragma unroll
            for (int i = 0; i < 8; ++i) vreg[i] = *(const GAS u32x4*)(vp + (dg + 4 * i) * 8);
            const GAS f32x4* lp = (const GAS f32x4*)(lnp + (size_t)(row2 + srow) * 64 + spart * 16);
#pragma unroll
            for (int i = 0; i < 4; ++i) lnv[i] = lp[i];
        }
        __syncthreads();
        f32x4 acc[8][2];
#pragma unroll
        for (int tb = 0; tb < 8; ++tb) { acc[tb][0] = (f32x4){0.f, 0.f, 0.f, 0.f}; acc[tb][1] = (f32x4){0.f, 0.f, 0.f, 0.f}; }
        const int drow0 = 32 * w + 8 * (fr >> 2) + (fr & 3);
#pragma unroll
        for (int ks = 0; ks < 4; ++ks) {
            const bf16x8 t0 = *(const LAS bf16x8*)(lds + SG_T + drow0 * SG_TSTR + ks * 64 + fq * 16);
            const bf16x8 t1 = *(const LAS bf16x8*)(lds + SG_T + (drow0 + 4) * SG_TSTR + ks * 64 + fq * 16);
#pragma unroll
            for (int tb = 2 * ks; tb < 8; ++tb) {
                const bf16x8 wf = *(const LAS bf16x8*)(lds + SG_W + (16 * tb + fr) * SG_WSTR + ks * 64 + fq * 16);
                acc[tb][0] = __builtin_amdgcn_mfma_f32_16x16x32_bf16(t0, wf, acc[tb][0], 0, 0, 0);
                acc[tb][1] = __builtin_amdgcn_mfma_f32_16x16x32_bf16(t1, wf, acc[tb][1], 0, 0, 0);
            }
        }
#pragma unroll
        for (int tb = 0; tb < 8; ++tb) {
            const int t = 16 * tb + fr;
            const float bb = bs[g * 128 + t];
            GAS bf16_t* up = U + (size_t)(row0 + t) * 2048 + g * 256 + 32 * w + 8 * fq;
            const f32x4 a = acc[tb][0] + bb, b = acc[tb][1] + bb;
            const f32x4 ya = (f32x4){a.x * bf_lo(uv[tb].x), a.y * bf_hi(uv[tb].x), a.z * bf_lo(uv[tb].y), a.w * bf_hi(uv[tb].y)};
            const f32x4 yb = (f32x4){b.x * bf_lo(uv[tb].z), b.y * bf_hi(uv[tb].z), b.z * bf_lo(uv[tb].w), b.w * bf_hi(uv[tb].w)};
            *(GAS u32x4*)up = pack8(ya, yb);
        }
    }
    __syncthreads();
}

constexpr int RT_K0 = 0, RT_KB = 65536, RT_ST = 131072, RT_STSTR = 528, RT_VT = RT_ST + 32 * RT_STSTR, RT_VTSTR = 288, RT_END = RT_VT + 32 * RT_VTSTR;
static_assert(RT_END <= LDS_MISC, "ret lds");
typedef short s16x4 __attribute__((ext_vector_type(4)));
__device__ __forceinline__ void ret_phase(const Frame& F, const GAS bf16_t* Q, const GAS bf16_t* Kn, GAS bf16_t* Vb, GAS float* hss) {
    LAS unsigned char* lds = F.lds;
    const int tid = opq_tid(), lane = tid & 63, w = __builtin_amdgcn_readfirstlane(tid >> 6), fr = lane & 15, fq = lane >> 4;
    const int jb = (w < 4) ? w : 11 - w;
    const int srow = tid >> 5, sslot = tid & 31, spiece = ((sslot & 15) ^ (srow & 15)) | (sslot & 16);
    const unsigned voffK = (unsigned)(srow * D + 8 * spiece) * 2u;
    int koffx[4];
#pragma unroll
    for (int k4 = 0; k4 < 4; ++k4) koffx[k4] = fr * 512 + ((((4 * k4 + fq) & 15) ^ fr) << 4);
    int troff[2][2];
#pragma unroll
    for (int db = 0; db < 2; ++db)
#pragma unroll
        for (int t = 0; t < 2; ++t) {
            const int q = fr >> 2, p = fr & 3, m = 8 * fq + 4 * t + q, c = 4 * w + 2 * db + (p >> 1);
            troff[db][t] = m * 512 + ((((c & 15) ^ (m & 15)) | (c & 16)) << 4) + 8 * (p & 1);
        }
    for (int item = F.vcu; item < 256; item += F.G) {
        const int es = item & 15, bh = item >> 4, h = bh & 3, b = bh >> 2;
        const float gam = 1.0f - __builtin_amdgcn_exp2f(-5.0f - (float)h);
        const float l2g = __builtin_amdgcn_logf(gam);
        const float cdec = __builtin_amdgcn_exp2f(128.0f * l2g);
        const size_t rowb = (size_t)b * SEQ;
        const GAS bf16_t* Qh = Q + rowb * D + h * 256;
        const GAS char* Kh = (const GAS char*)(Kn + rowb * D + h * 256);
        GAS bf16_t* Vh = Vb + rowb * 2048 + h * 512 + es * 32;
        GAS float* hs = hss + (rowb * RH + h) * 16 + es;
        __syncthreads();
        for (int i = tid; i < 32 * RT_STSTR / 4; i += 512) ((LAS unsigned*)(lds + RT_ST))[i] = 0u;
        f32x4 sst[2][2];
#pragma unroll
        for (int eb = 0; eb < 2; ++eb)
#pragma unroll
            for (int db = 0; db < 2; ++db) sst[eb][db] = (f32x4){0.f, 0.f, 0.f, 0.f};
#define RT_STAGE_K(buf, ci) do { _Pragma("unroll") for (int _i = 0; _i < 8; ++_i) \
            __builtin_amdgcn_global_load_lds((const GAS unsigned*)(Kh + (size_t)(ci) * 128 * D * 2 + (size_t)_i * 16 * D * 2 + voffK), (LAS unsigned*)(lds + (buf) + _i * 8192 + w * 1024), 16, 0, 0); } while (0)
        RT_STAGE_K(RT_K0, 0);
        const int vm = tid >> 2, vp = tid & 3;
        u32x4 vreg = *(const GAS u32x4*)(Vh + (size_t)vm * 2048 + vp * 8);
        bf16x8 qf[8];
#pragma unroll
        for (int ks = 0; ks < 8; ++ks) qf[ks] = *(const GAS bf16x8*)(Qh + (size_t)(16 * jb + fr) * D + 32 * ks + 8 * fq);
        {
            LAS bf16_t* vt = (LAS bf16_t*)(lds + RT_VT + (8 * vp) * RT_VTSTR) + vm;
#pragma unroll
            for (int q = 0; q < 4; ++q) { vt[(2 * q) * (RT_VTSTR / 2)] = (bf16_t)(vreg[q] & 0xffffu); vt[(2 * q + 1) * (RT_VTSTR / 2)] = (bf16_t)(vreg[q] >> 16); }
        }
        u32x2 pend_ow[2] = {(u32x2){0u, 0u}, (u32x2){0u, 0u}}; float pend_ss = 0.f;
        const int jrow = 16 * jb + fr;
        const float qdec = __builtin_amdgcn_exp2f(l2g * (float)(jrow + 1));
        const float pdec = __builtin_amdgcn_exp2f(l2g * (float)(jrow - 127));
#pragma unroll 1
        for (int ci = 0; ci < SEQ / RC; ++ci) {
            const int kbuf = (ci & 1) ? RT_KB : RT_K0;
            asm volatile("s_waitcnt vmcnt(0) lgkmcnt(0)" ::: "memory"); __builtin_amdgcn_s_barrier(); asm volatile("" ::: "memory");
            const bool more = ci + 1 < SEQ / RC;
#pragma unroll
            for (int ks = 0; ks < 8; ++ks) asm volatile("" : "+v"(qf[ks]));
            if (more) {
                if (ci & 1) RT_STAGE_K(RT_K0, ci + 1); else RT_STAGE_K(RT_KB, ci + 1);
                vreg = *(const GAS u32x4*)(Vh + (size_t)((ci + 1) * 128 + vm) * 2048 + vp * 8);
            }
            if (ci > 0) {
                const size_t row = (size_t)(ci - 1) * 128 + jrow;
#pragma unroll
                for (int eb = 0; eb < 2; ++eb) *(GAS u32x2*)(Vh + row * 2048 + 16 * eb + 4 * fq) = pend_ow[eb];
                if (fq == 0) hs[row * RH * 16] = pend_ss;
            }
            f32x4 oacc[2] = {(f32x4){0.f, 0.f, 0.f, 0.f}, (f32x4){0.f, 0.f, 0.f, 0.f}};
            {
                bf16x8 sf[2][8];
#pragma unroll
                for (int ks = 0; ks < 8; ++ks)
#pragma unroll
                    for (int eb = 0; eb < 2; ++eb) sf[eb][ks] = *(const LAS bf16x8*)(lds + RT_ST + (16 * eb + fr) * RT_STSTR + ks * 64 + fq * 16);
                __builtin_amdgcn_sched_barrier(0);
#pragma unroll
                for (int ks = 0; ks < 8; ++ks)
#pragma unroll
                    for (int eb = 0; eb < 2; ++eb) oacc[eb] = __builtin_amdgcn_mfma_f32_16x16x32_bf16(sf[eb][ks], qf[ks], oacc[eb], 0, 0, 0);
            }
            oacc[0] *= qdec; oacc[1] *= qdec;
#pragma unroll
            for (int kp = 0; kp < 4; ++kp) {
                if (2 * kp <= jb) {
                    const bool two = (2 * kp + 1 <= jb);
                    bf16x8 k0[8], k1[8];
#pragma unroll
                    for (int ks = 0; ks < 8; ++ks) k0[ks] = *(const LAS bf16x8*)(lds + kbuf + (2 * kp) * 8192 + koffx[ks & 3] + (ks >> 2) * 256);
                    if (two) {
#pragma unroll
                        for (int ks = 0; ks < 8; ++ks) k1[ks] = *(const LAS bf16x8*)(lds + kbuf + (2 * kp + 1) * 8192 + koffx[ks & 3] + (ks >> 2) * 256);
                    }
                    u32x2 vlo[2], vhi[2];
#pragma unroll
                    for (int eb = 0; eb < 2; ++eb) { const LAS unsigned char* vb = lds + RT_VT + (16 * eb + fr) * RT_VTSTR + (32 * kp + 4 * fq) * 2; vlo[eb] = *(const LAS u32x2*)vb; vhi[eb] = *(const LAS u32x2*)(vb + 32); }
                    __builtin_amdgcn_sched_barrier(0);
                    f32x4 s0 = (f32x4){0.f, 0.f, 0.f, 0.f}, s1 = (f32x4){0.f, 0.f, 0.f, 0.f};
#pragma unroll
                    for (int ks = 0; ks < 8; ++ks) s0 = __builtin_amdgcn_mfma_f32_16x16x32_bf16(k0[ks], qf[ks], s0, 0, 0, 0);
                    if (two) {
#pragma unroll
                        for (int ks = 0; ks < 8; ++ks) s1 = __builtin_amdgcn_mfma_f32_16x16x32_bf16(k1[ks], qf[ks], s1, 0, 0, 0);
                    }
                    s0 *= pdec; s1 *= pdec;
                    if (2 * kp == jb) {
#pragma unroll
                        for (int r = 0; r < 4; ++r) s0[r] = (4 * fq + r <= fr) ? s0[r] : 0.f;
                    }
                    if (2 * kp + 1 == jb) {
#pragma unroll
                        for (int r = 0; r < 4; ++r) s1[r] = (4 * fq + r <= fr) ? s1[r] : 0.f;
                    }
                    u32x4 pw; pw.x = pk2(s0[0], s0[1]); pw.y = pk2(s0[2], s0[3]); pw.z = pk2(s1[0], s1[1]); pw.w = pk2(s1[2], s1[3]);
                    const bf16x8 pf = __builtin_bit_cast(bf16x8, pw);
#pragma unroll
                    for (int eb = 0; eb < 2; ++eb) {
                        u32x4 vw; vw.x = vlo[eb].x; vw.y = vlo[eb].y; vw.z = vhi[eb].x; vw.w = vhi[eb].y;
                        oacc[eb] = __builtin_amdgcn_mfma_f32_16x16x32_bf16(__builtin_bit_cast(bf16x8, vw), pf, oacc[eb], 0, 0, 0);
                    }
                }
            }
            if (more) {
#pragma unroll
                for (int ks = 0; ks < 8; ++ks) qf[ks] = *(const GAS bf16x8*)(Qh + (size_t)((ci + 1) * 128 + 16 * jb + fr) * D + 32 * ks + 8 * fq);
            }
            {
                float ss = 0.f;
#pragma unroll
                for (int eb = 0; eb < 2; ++eb) {
                    pend_ow[eb].x = pk2(oacc[eb].x, oacc[eb].y); pend_ow[eb].y = pk2(oacc[eb].z, oacc[eb].w);
                    ss += (oacc[eb].x * oacc[eb].x + oacc[eb].y * oacc[eb].y) + (oacc[eb].z * oacc[eb].z + oacc[eb].w * oacc[eb].w);
                }
                ss += __shfl_xor(ss, 16); ss += __shfl_xor(ss, 32);
                pend_ss = ss;
            }
            bf16x8 vtn[2][4]; u32x2 kt[2][4][2];
#pragma unroll
            for (int eb = 0; eb < 2; ++eb)
#pragma unroll
                for (int ks = 0; ks < 4; ++ks) vtn[eb][ks] = *(const LAS bf16x8*)(lds + RT_VT + (16 * eb + fr) * RT_VTSTR + ks * 64 + fq * 16);
            {
                const unsigned a00 = (unsigned)(kbuf + troff[0][0]), a01 = (unsigned)(kbuf + troff[0][1]), a10 = (unsigned)(kbuf + troff[1][0]), a11 = (unsigned)(kbuf + troff[1][1]);
                asm volatile(
                    "ds_read_b64_tr_b16 %0, %16\n\t"  "ds_read_b64_tr_b16 %1, %17\n\t"
                    "ds_read_b64_tr_b16 %2, %16 offset:16384\n\t"  "ds_read_b64_tr_b16 %3, %17 offset:16384\n\t"
                    "ds_read_b64_tr_b16 %4, %16 offset:32768\n\t"  "ds_read_b64_tr_b16 %5, %17 offset:32768\n\t"
                    "ds_read_b64_tr_b16 %6, %16 offset:49152\n\t"  "ds_read_b64_tr_b16 %7, %17 offset:49152\n\t"
                    "ds_read_b64_tr_b16 %8, %18\n\t"  "ds_read_b64_tr_b16 %9, %19\n\t"
                    "ds_read_b64_tr_b16 %10, %18 offset:16384\n\t"  "ds_read_b64_tr_b16 %11, %19 offset:16384\n\t"
                    "ds_read_b64_tr_b16 %12, %18 offset:32768\n\t"  "ds_read_b64_tr_b16 %13, %19 offset:32768\n\t"
                    "ds_read_b64_tr_b16 %14, %18 offset:49152\n\t"  "ds_read_b64_tr_b16 %15, %19 offset:49152\n\t"
                    "s_waitcnt lgkmcnt(0)"
                    : "=&v"(kt[0][0][0]), "=&v"(kt[0][0][1]), "=&v"(kt[0][1][0]), "=&v"(kt[0][1][1]), "=&v"(kt[0][2][0]), "=&v"(kt[0][2][1]), "=&v"(kt[0][3][0]), "=&v"(kt[0][3][1]),
                      "=&v"(kt[1][0][0]), "=&v"(kt[1][0][1]), "=&v"(kt[1][1][0]), "=&v"(kt[1][1][1]), "=&v"(kt[1][2][0]), "=&v"(kt[1][2][1]), "=&v"(kt[1][3][0]), "=&v"(kt[1][3][1])
                    : "v"(a00), "v"(a01), "v"(a10), "v"(a11)
                    : "memory");
            }
            asm volatile("s_waitcnt lgkmcnt(0)" ::: "memory"); __builtin_amdgcn_s_barrier(); asm volatile("" ::: "memory");
#pragma unroll
            for (int eb = 0; eb < 2; ++eb)
#pragma unroll
                for (int db = 0; db < 2; ++db) {
                    sst[eb][db] *= cdec;
#pragma unroll
                    for (int ks = 0; ks < 4; ++ks) {
                        u32x4 kw; kw.x = kt[db][ks][0].x; kw.y = kt[db][ks][0].y; kw.z = kt[db][ks][1].x; kw.w = kt[db][ks][1].y;
                        sst[eb][db] = __builtin_amdgcn_mfma_f32_16x16x32_bf16(__builtin_bit_cast(bf16x8, kw), vtn[eb][ks], sst[eb][db], 0, 0, 0);
                    }
                    u32x2 sw; sw.x = pk2(sst[eb][db].x, sst[eb][db].y); sw.y = pk2(sst[eb][db].z, sst[eb][db].w);
                    *(LAS u32x2*)(lds + RT_ST + (16 * eb + fr) * RT_STSTR + (32 * w + 16 * db + 4 * fq) * 2) = sw;
                }
            __builtin_amdgcn_sched_barrier(0);
            if (more) {
                LAS bf16_t* vt = (LAS bf16_t*)(lds + RT_VT + (8 * vp) * RT_VTSTR) + vm;
#pragma unroll
                for (int q = 0; q < 4; ++q) { vt[(2 * q) * (RT_VTSTR / 2)] = (bf16_t)(vreg[q] & 0xffffu); vt[(2 * q + 1) * (RT_VTSTR / 2)] = (bf16_t)(vreg[q] >> 16); }
            }
        }
        {
            const size_t row = (size_t)(SEQ / RC - 1) * 128 + jrow;
#pragma unroll
            for (int eb = 0; eb < 2; ++eb) *(GAS u32x2*)(Vh + row * 2048 + 16 * eb + 4 * fq) = pend_ow[eb];
            if (fq == 0) hs[row * RH * 16] = pend_ss;
        }
#undef RT_STAGE_K
    }
    __syncthreads();
}

__device__ __forceinline__ void final_phase(const Frame& F, const GAS bf16_t* xb, GAS float* out, const GAS float* g) {
    const int tid_ = opq_tid(), lane_ = tid_ & 63, wave_ = __builtin_amdgcn_readfirstlane(tid_ >> 6);
    const int gw = F.vcu * 8 + wave_, NGW = F.G * 8;
    f32x4 gv[2][2];
#pragma unroll
    for (int j = 0; j < 2; ++j) { gv[j][0] = ((const GAS f32x4*)g)[2 * (lane_ + 64 * j)]; gv[j][1] = ((const GAS f32x4*)g)[2 * (lane_ + 64 * j) + 1]; }
    for (int row = 4 * gw; row < M; row += 4 * NGW) {
        u32x4 w[4][2];
#pragma unroll
        for (int r = 0; r < 4; ++r)
#pragma unroll
            for (int j = 0; j < 2; ++j) w[r][j] = ((const GAS u32x4*)(xb + (size_t)(row + r) * D))[lane_ + 64 * j];
#pragma unroll
        for (int r = 0; r < 4; ++r) {
            f32x4 v[2][2]; float s = 0.f;
#pragma unroll
            for (int j = 0; j < 2; ++j) { const u32x4 ww = w[r][j];
                v[j][0] = (f32x4){bf_lo(ww.x), bf_hi(ww.x), bf_lo(ww.y), bf_hi(ww.y)}; v[j][1] = (f32x4){bf_lo(ww.z), bf_hi(ww.z), bf_lo(ww.w), bf_hi(ww.w)};
                s += (v[j][0].x * v[j][0].x + v[j][0].y * v[j][0].y) + (v[j][0].z * v[j][0].z + v[j][0].w * v[j][0].w) + (v[j][1].x * v[j][1].x + v[j][1].y * v[j][1].y) + (v[j][1].z * v[j][1].z + v[j][1].w * v[j][1].w); }
            const float rs = rsqrtf(wave_sum(s) * (1.0f / D) + RMS_EPS);
            GAS f32x4* o = (GAS f32x4*)(out + (size_t)(row + r) * D) + 2 * lane_;
#pragma unroll
            for (int j = 0; j < 2; ++j) { o[128 * j] = v[j][0] * rs * gv[j][0]; o[128 * j + 1] = v[j][1] * rs * gv[j][1]; }
        }
    }
}

__global__ void __launch_bounds__(512, 2) trunk_fwd(Args args) {
    extern __shared__ __attribute__((aligned(16))) unsigned char lds_raw[];
    Frame F;
    F.lds = (LAS unsigned char*)lds_raw;
    F.tid = threadIdx.x; F.lane = F.tid & 63; F.wave = __builtin_amdgcn_readfirstlane(F.tid >> 6);
    F.G = gridDim.x; { const int bx = blockIdx.x; F.vcu = (F.G % 8 == 0) ? (bx % 8) * (F.G / 8) + bx / 8 : bx; }
    unsigned char* ws = args.ws;
    unsigned* ctl = (unsigned*)(ws + WS_CTL);
    volatile LAS unsigned* MISC = (volatile LAS unsigned*)(F.lds + LDS_MISC);
    for (int u = F.tid; u < (LDS_BYTES - LDS_MISC) / 4; u += 512) ((LAS unsigned*)(F.lds + LDS_MISC))[u] = 0u;
    __syncthreads();
    XcdBarrier bar = xcd_barrier_post(ctl + 4096 + args.li * XCD_BAR_WORDS, MISC + 8);
    const int lo = args.ph_lo, hi = args.ph_hi;
#define IN(k) (lo <= (k) && (k) < hi)
#define GRID_BAR(k) do { if (hi > (k) + 1) xcd_barrier(bar); } while (0)

    bf16_t* xb = (bf16_t*)(ws + WS_XB);
    float* ssq = (float*)(ws + WS_SSQ);

    if (IN(0)) { p0_prologue(F, args); GRID_BAR(0); }

#pragma unroll 1
    for (int L = 0; L < NLAYER; ++L) {
        const int pb = 1 + 6 * L;
        const int kind = (L == 1) ? 1 : (L == 2) ? 2 : 0;
        int pmo;
        const bf16_t* moA; const bf16_t* moB; int moK;
        if (kind == 0) {
            const int j = (L == 0) ? 0 : 1;
            bf16_t* Bo = (bf16_t*)(ws + AR_CB); bf16_t* CZ = (bf16_t*)(ws + AR_CZ); bf16_t* CY = (bf16_t*)(ws + AR_CY);
            if (IN(pb)) {
                pg8::Gemm g{opq(xb), opq((const bf16_t*)(ws + W_CI + j * W_CI_SZ)), M, 3072, 1024}; pg8::StaticOrder S; S.init(M, 3072, F.G, (int)blockIdx.x);
                EpiConvIn E{(const GAS float*)opq(ssq), (GAS bf16_t*)opq(Bo), (GAS bf16_t*)opq(CZ)};
                pg8::gemm_phase<EpiConvIn>(F.lds, g, S, E);
                GRID_BAR(pb);
            }
            if (IN(pb + 1)) { conv_phase(F, (const GAS bf16_t*)opq(Bo), (const GAS bf16_t*)opq(CZ), (const GAS float*)opq(args.in[5] + (size_t)j * 3 * D), (GAS bf16_t*)opq(CY)); GRID_BAR(pb + 1); }
            pmo = pb + 2; moA = CY; moB = (const bf16_t*)(ws + W_CO + j * W_CO_SZ); moK = 1024;
        } else if (kind == 1) {
            bf16_t* U = (bf16_t*)(ws + AR_SU); bf16_t* V = (bf16_t*)(ws + AR_SV); float* lnp = (float*)(ws + WS_LNP);
            {
            if (IN(pb)) {
                pg8::Gemm g{opq(xb), opq((const bf16_t*)(ws + W_SI)), M, 4096, 1024}; pg8::StaticOrder S; S.init(M, 4096, F.G, (int)blockIdx.x);
                EpiSguIn E{(const GAS float*)opq(ssq), (GAS bf16_t*)opq(U), (GAS bf16_t*)opq(V), (GAS float*)opq(lnp)};
                pg8::gemm_phase<EpiSguIn>(F.lds, g, S, E);
                GRID_BAR(pb);
            }
            if (IN(pb + 1)) { sgu_phase(F, (GAS bf16_t*)opq(U), (const GAS bf16_t*)opq(V), (const GAS float*)opq(lnp), (const GAS bf16_t*)opq((const bf16_t*)(ws + W_WS)), (const GAS float*)opq(args.in[8]), (const GAS float*)opq(args.in[9]), (const GAS float*)opq(args.in[11])); GRID_BAR(pb + 1); }
            }
            pmo = pb + 2; moA = U; moB = (const bf16_t*)(ws + W_SO); moK = 2048;
        } else {
            bf16_t* Q = (bf16_t*)(ws + AR_RQ); bf16_t* Kn = (bf16_t*)(ws + AR_RK); bf16_t* V = (bf16_t*)(ws + AR_RV);
            float* hss = args.out;
            {
            {
            if (IN(pb)) {
                pg8::Gemm g{opq(xb), opq((const bf16_t*)(ws + W_RQ)), M, 4096, 1024}; pg8::StaticOrder S; S.init(M, 4096, F.G, (int)blockIdx.x);
                EpiRetQkv E{(const GAS float*)opq(ssq), (const GAS float*)opq((const float*)(ws + WS_ROT)), (const GAS float*)opq((const float*)(ws + WS_ROT) + (size_t)SEQ * 128), (GAS bf16_t*)opq(Q), (GAS bf16_t*)opq(Kn), (GAS bf16_t*)opq(V)};
                pg8::gemm_phase<EpiRetQkv>(F.lds, g, S, E);
                GRID_BAR(pb);
            }
            if (IN(pb + 1)) { ret_phase(F, (const GAS bf16_t*)opq(Q), (const GAS bf16_t*)opq(Kn), (GAS bf16_t*)opq(V), (GAS float*)opq(hss)); GRID_BAR(pb + 1); }
            }
            if (IN(pb + 2)) {
                pg8::Gemm g{opq(xb), opq((const bf16_t*)(ws + W_RG)), M, 2048, 1024}; pg8::StaticOrder S; S.init(M, 2048, F.G, (int)blockIdx.x);
                EpiRetG E{(const GAS float*)opq(ssq), (const GAS float*)opq(hss), (GAS bf16_t*)opq(V)};
                pg8::gemm_phase<EpiRetG>(F.lds, g, S, E);
                GRID_BAR(pb + 2);
            }
            }
            pmo = pb + 3; moA = V; moB = (const bf16_t*)(ws + W_RO); moK = 2048;
        }
        if (IN(pmo)) {
            pg8::Gemm g{opq(moA), opq(moB), M, 1024, moK}; pg8::StaticOrder S; S.init(M, 1024, F.G, (int)blockIdx.x);
            EpiResid E{(GAS bf16_t*)opq(xb), (GAS float*)opq(ssq), 1.0f, ((F8_F1_LAYERS >> L) & 1) ? (GAS unsigned char*)opq(ws + WS_X8) : (GAS unsigned char*)nullptr};
            pg8::gemm_phase<EpiResid>(F.lds, g, S, E);
            GRID_BAR(pmo);
        }
        if (IN(pb + 4)) {
            if ((F8_F1_LAYERS >> L) & 1) {
                pg8::Gemm g{opq((const bf16_t*)(ws + WS_X8)), opq((const bf16_t*)(ws + W_FI + L * W_FI_SZ)), M, 2 * DFF, 1024 / 2}; pg8::StaticOrder S; S.init(M, 2 * DFF, F.G, (int)blockIdx.x);
                EpiFfnIn E{(const GAS float*)opq(ssq), (GAS unsigned char*)opq(ws + AR_FA), ((F8_LAYERS >> L) & 1) != 0, 1.0f / FI_WSCALE};
                pg8::gemm_phase<EpiFfnIn, true, true, true>(F.lds, g, S, E);
            } else {
                pg8::Gemm g{opq(xb), opq((const bf16_t*)(ws + W_FI + L * W_FI_SZ)), M, 2 * DFF, 1024}; pg8::StaticOrder S; S.init(M, 2 * DFF, F.G, (int)blockIdx.x);
                EpiFfnIn E{(const GAS float*)opq(ssq), (GAS unsigned char*)opq(ws + AR_FA), ((F8_LAYERS >> L) & 1) != 0, 1.0f};
                pg8::gemm_phase<EpiFfnIn>(F.lds, g, S, E);
            }
            GRID_BAR(pb + 4);
        }
        if (IN(pb + 5)) {
            if ((F8_LAYERS >> L) & 1) {
                pg8::Gemm g{opq((const bf16_t*)(ws + AR_FA)), opq((const bf16_t*)(ws + W_FD + L * W_FD_SZ)), M, 1024, DFF / 2}; pg8::StaticOrder S; S.init(M, 1024, F.G, (int)blockIdx.x);
                EpiResidT<2> E{(GAS bf16_t*)opq(xb), (GAS float*)opq(ssq), 1.0f / FD_WSCALE, (GAS unsigned char*)nullptr};
                pg8::gemm_phase<EpiResidT<2>, true, true, true>(F.lds, g, S, E);
            } else {
                pg8::Gemm g{opq((const bf16_t*)(ws + AR_FA)), opq((const bf16_t*)(ws + W_FD + L * W_FD_SZ)), M, 1024, DFF}; pg8::StaticOrder S; S.init(M, 1024, F.G, (int)blockIdx.x);
                EpiResid E{(GAS bf16_t*)opq(xb), (GAS float*)opq(ssq), 1.0f, (GAS unsigned char*)nullptr};
                pg8::gemm_phase<EpiResid>(F.lds, g, S, E);
            }
            GRID_BAR(pb + 5);
        }
    }
    if (IN(NPH - 1)) final_phase(F, (const GAS bf16_t*)opq((const bf16_t*)xb), (GAS float*)opq(args.out), (const GAS float*)opq(args.in[3]));
#undef IN
#undef GRID_BAR
}

extern "C" void kernel_launch(void* const* d_in, const int* in_sizes, int n_in, void* d_out, int out_size, void* d_ws, size_t ws_size, hipStream_t stream) {
    static int grid = 0;
    if (grid == 0) {
        if (n_in != 18 || out_size != M * D || ws_size < WS_END) { fprintf(stderr, "kernel_launch: unexpected shapes (n_in %d out %d ws %zu)\n", n_in, out_size, ws_size); grid = -1; return; }
        int dev = 0, cus = 0, per_cu = 0;
        if (hipGetDevice(&dev) != hipSuccess || hipDeviceGetAttribute(&cus, hipDeviceAttributeMultiprocessorCount, dev) != hipSuccess) { grid = -1; return; }
        if (hipFuncSetAttribute((const void*)trunk_fwd, hipFuncAttributeMaxDynamicSharedMemorySize, LDS_BYTES) != hipSuccess) { fprintf(stderr, "kernel_launch: hipFuncSetAttribute failed\n"); grid = -1; return; }
        if (hipOccupancyMaxActiveBlocksPerMultiprocessor(&per_cu, (const void*)trunk_fwd, 512, LDS_BYTES) != hipSuccess || per_cu < 1)
            fprintf(stderr, "kernel_launch: occupancy query reports %d\n", per_cu);
        (void)hipGetLastError();
        grid = cus;
    }
    if (grid < 0) return;
    (void)in_sizes;
    if (hipMemsetAsync((char*)d_ws + WS_CTL, 0, CTL_BYTES, stream) != hipSuccess) return;
    Args a{};
    for (int i = 0; i < 18; ++i) a.in[i] = (const float*)d_in[i];
    a.out = (float*)d_out; a.ws = (unsigned char*)d_ws; a.pad = 0;
#if MK_ONE_LAUNCH
    a.ph_lo = 0; a.ph_hi = NPH; a.li = 0;
    hipLaunchKernelGGL(trunk_fwd, dim3(grid), dim3(512), LDS_BYTES, stream, a);
#else
    int li = 0;
    for (int ph = 0; ph < NPH; ++ph) {
        const int r = (ph - 1) % 6, L = (ph - 1) / 6;
        if (ph >= 1 && ph < NPH - 1 && r == 3 && L != 2) continue;
        a.ph_lo = ph; a.ph_hi = ph + 1; a.li = li++;
        hipLaunchKernelGGL(trunk_fwd, dim3(grid), dim3(512), LDS_BYTES, stream, a);
    }
#endif
}
```

```cpp
#include <hip/hip_runtime.h>
#include <cstdio>
#include <cstdint>

#ifndef MK_ONE_LAUNCH
#define MK_ONE_LAUNCH 1
#endif

#define LAS __attribute__((address_space(3)))
#define GAS __attribute__((address_space(1)))
typedef unsigned short bf16_t;
typedef short bf16x8 __attribute__((ext_vector_type(8)));
typedef short bf16x4 __attribute__((ext_vector_type(4)));
typedef float f32x4 __attribute__((ext_vector_type(4)));
typedef float f32x2 __attribute__((ext_vector_type(2)));
typedef unsigned u32x4 __attribute__((ext_vector_type(4)));
typedef unsigned u32x2 __attribute__((ext_vector_type(2)));
typedef int i32x4 __attribute__((ext_vector_type(4)));
typedef int i32x8 __attribute__((ext_vector_type(8)));

constexpr int D = 1024, NB = 4, SEQ = 8192, M = NB * SEQ, DFF = 2816, NLAYER = 4;
constexpr int RH = 4, RQK = 256, RV = 512, RC = 128;
constexpr float RMS_EPS = 1e-6f, LN_EPS = 1e-5f;
constexpr int F8_LAYERS = 0xC;
constexpr int I8_F1_LAYERS = 0xF;
constexpr int F8_F1_LAYERS = 0x0;
constexpr float FD_WSCALE = 64.0f, FI_WSCALE = 32.0f;

constexpr size_t MiB = 1u << 20;
constexpr size_t WS_CTL = 0, CTL_BYTES = 1 * MiB;
constexpr size_t WS_SSQ = 1 * MiB;
constexpr size_t WS_W = 3 * MiB;
constexpr size_t W_CI = WS_W, W_CI_SZ = (size_t)3072 * 1024 * 2;
constexpr size_t W_CO = W_CI + 2 * W_CI_SZ, W_CO_SZ = (size_t)1024 * 1024 * 2;
constexpr size_t W_SI = W_CO + 2 * W_CO_SZ, W_SI_SZ = (size_t)4096 * 1024 * 2;
constexpr size_t W_SO = W_SI + W_SI_SZ, W_SO_SZ = (size_t)1024 * 2048 * 2;
constexpr size_t W_RQ = W_SO + W_SO_SZ, W_RQ_SZ = (size_t)4096 * 1024 * 2;
constexpr size_t W_RG = W_RQ + W_RQ_SZ, W_RG_SZ = (size_t)2048 * 1024 * 2;
constexpr size_t W_RO = W_RG + W_RG_SZ, W_RO_SZ = (size_t)1024 * 2048 * 2;
constexpr size_t W_FI = W_RO + W_RO_SZ, W_FI_SZ = (size_t)5632 * 1024 * 2;
constexpr size_t W_FD = W_FI + 4 * W_FI_SZ, W_FD_SZ = (size_t)1024 * 2816 * 2;
constexpr size_t W_WS = W_FD + 4 * W_FD_SZ, W_WS_SZ = (size_t)8 * 128 * 128 * 2;
constexpr size_t WS_WEND = W_WS + W_WS_SZ;
static_assert(WS_WEND <= 114 * MiB, "weights");
constexpr size_t WS_ROT = 114 * MiB;
constexpr size_t WS_HSS = WS_ROT;
constexpr size_t WS_XB = 122 * MiB;
constexpr size_t WS_AR = 186 * MiB;
constexpr size_t WS_SA = 491 * MiB;
constexpr size_t WS_X8 = 458 * MiB;
constexpr size_t WS_KT = 442 * MiB;
constexpr size_t WS_LNP = WS_KT;
constexpr size_t WS_END = 506 * MiB;
constexpr size_t AR_CB = WS_AR, AR_CZ = WS_AR + 64 * MiB, AR_CY = WS_AR + 128 * MiB;
constexpr size_t AR_SU = WS_AR, AR_SV = WS_AR + 128 * MiB;
constexpr size_t AR_RQ = WS_AR, AR_RK = WS_AR + 64 * MiB, AR_RV = WS_AR + 128 * MiB;
constexpr size_t AR_FA = WS_AR;

constexpr int NPH = 26;
constexpr int LDS_BYTES = 159744;
constexpr int LDS_MISC = 159232;

#define RLX_AGENT __ATOMIC_RELAXED, __HIP_MEMORY_SCOPE_AGENT
__device__ __forceinline__ unsigned f2bf(float f) { unsigned u = __builtin_bit_cast(unsigned, f); return (u + 0x7fffu + ((u >> 16) & 1u)) >> 16; }
typedef __bf16 bf16v2 __attribute__((ext_vector_type(2)));
__device__ __forceinline__ unsigned pk2(float lo, float hi) { const f32x2 v = {lo, hi}; return __builtin_bit_cast(unsigned, __builtin_convertvector(v, bf16v2)); }
__device__ __forceinline__ float bf_lo(unsigned w) { return __builtin_bit_cast(float, w << 16); }
__device__ __forceinline__ float bf_hi(unsigned w) { return __builtin_bit_cast(float, w & 0xffff0000u); }
__device__ __forceinline__ float wave_max(float v) {
#pragma unroll
    for (int o = 1; o < 64; o <<= 1) v = fmaxf(v, __shfl_xor(v, o));
    return v;
}
__device__ __forceinline__ float wave_sum(float v) {
#pragma unroll
    for (int o = 1; o < 64; o <<= 1) v += __shfl_xor(v, o);
    return v;
}
template <class T> __device__ __forceinline__ T* opq(T* p) { asm volatile("" : "+s"(p)); return p; }
__device__ __forceinline__ int opq_tid() { int t = threadIdx.x; asm volatile("" : "+v"(t)); return t; }
__device__ __forceinline__ float fast_rcp(float x) { return __builtin_amdgcn_rcpf(x); }
__device__ __forceinline__ float silu_f(float x) { return x * fast_rcp(1.0f + __builtin_amdgcn_exp2f(-1.44269504089f * x)); }

#define XB_TMO      128
#define XB_XCNT(j)  (256  + 64 * (j))
#define XB_XSUB(j)  (1280 + 64 * (j))
#define XB_XGEN(j)  (2304 + 64 * (j))
#define XB_TOP      3328
#define XB_TOPGEN   3392
#define XCD_BAR_WORDS 3456
#define XB_SPIN_CAP (1u << 18)
__device__ __forceinline__ unsigned xb_ld(unsigned* p)              { return __hip_atomic_load(p, __ATOMIC_RELAXED, __HIP_MEMORY_SCOPE_AGENT); }
__device__ __forceinline__ unsigned xb_add(unsigned* p, unsigned v) { return __hip_atomic_fetch_add(p, v, __ATOMIC_RELAXED, __HIP_MEMORY_SCOPE_AGENT); }
__device__ __forceinline__ unsigned xb_xcc_id() { return (unsigned)__builtin_amdgcn_s_getreg((3 << 11) | 20) & 0xFu; }
#define XB_SPIN(cond, bar) do { unsigned _sp = 0; while (cond) { __builtin_amdgcn_s_sleep(1); \
    if ((++_sp & 255u) == 0u) { if (xb_ld(&(bar)[XB_TMO])) break; if (_sp > XB_SPIN_CAP) { atomicAdd(&(bar)[XB_TMO], 1u); break; } } } } while (0)
struct XcdBarrier { unsigned* bar; unsigned x; volatile LAS unsigned* st; };
__device__ __forceinline__ XcdBarrier xcd_barrier_post(unsigned* bar, volatile LAS unsigned* st) {
    XcdBarrier b; b.bar = bar; b.x = xb_xcc_id(); b.st = st;
    if (threadIdx.x == 0) (void)xb_add(&bar[XB_XCNT(b.x)], 1u);
    return b;
}
__device__ __forceinline__ void xcd_barrier_complete(unsigned* bar, unsigned x, unsigned& nloc, unsigned& nx) {
    const unsigned G = gridDim.x * gridDim.y * gridDim.z;
    unsigned sum, cnt, mine, sp = 0u;
    for (;;) {
        sum = 0u; cnt = 0u; mine = 0u;
#pragma unroll
        for (unsigned j = 0; j < 16; ++j) { const unsigned c = xb_ld(&bar[XB_XCNT(j)]); sum += c; cnt += (c > 0u) ? 1u : 0u; mine = (j == x) ? c : mine; }
        if (sum == G) break;
        __builtin_amdgcn_s_sleep(1);
        if ((++sp & 255u) == 0u) { if (xb_ld(&bar[XB_TMO])) break; if (sp > XB_SPIN_CAP) { atomicAdd(&bar[XB_TMO], 1u); break; } }
    }
    nloc = mine > 0u ? mine : 1u; nx = cnt > 0u ? cnt : 1u;
}
__device__ __forceinline__ void xcd_barrier(const XcdBarrier& b) {
    asm volatile("s_waitcnt vmcnt(0)" ::: "memory");
    __syncthreads();
    if (threadIdx.x == 0) {
        unsigned* bar = b.bar;
        __builtin_amdgcn_s_waitcnt(0);
        unsigned nloc = b.st[0], nx = b.st[1];
        if (nloc == 0u) { xcd_barrier_complete(bar, b.x, nloc, nx); b.st[0] = nloc; b.st[1] = nx; }
        const unsigned old = xb_add(&bar[XB_XSUB(b.x)], 1u);
        const unsigned gen = old / nloc;
        if (old + 1u == (gen + 1u) * nloc) {
            __builtin_amdgcn_fence(__ATOMIC_RELEASE, "agent");
            asm volatile("s_waitcnt vmcnt(0)" ::: "memory");
            const unsigned og = xb_add(&bar[XB_TOP], 1u);
            const unsigned tg = og / nx;
            if (og + 1u == (tg + 1u) * nx) xb_add(&bar[XB_TOPGEN], 1u);
            else XB_SPIN(xb_ld(&bar[XB_TOPGEN]) == tg, bar);
            __builtin_amdgcn_fence(__ATOMIC_ACQUIRE, "agent");
            xb_add(&bar[XB_XGEN(b.x)], 1u);
            asm volatile("s_waitcnt vmcnt(0)" ::: "memory");
        } else {
            XB_SPIN(xb_ld(&bar[XB_XGEN(b.x)]) == gen, bar);
            __builtin_amdgcn_fence(__ATOMIC_ACQUIRE, "agent");
            asm volatile("s_waitcnt vmcnt(0)" ::: "memory");
        }
    }
    __syncthreads();
}

namespace pg8 {
constexpr int BM = 256, BK = 64, HALF = 128, HTB = HALF * BK * 2, STAGE_BYTES = 8 * HTB, NXCD = 8, WGM = 8;
__host__ __device__ __forceinline__ int lds_byte(int r, int c) { const int st = (r >> 4) * 2 + (c >> 5), rr = r & 15, cc = c & 31, ob = rr * 64 + cc * 2; return st * 1024 + (ob ^ (((ob >> 9) & 1) << 5)); }
__host__ __device__ __forceinline__ void stage_rc(int b, int& R, int& C) { const int st = b / 1024, sb = b % 1024, swz = sb ^ (((sb >> 9) & 1) << 5); R = (st >> 1) * 16 + swz / 64; C = (st & 1) * 32 + (swz % 64) / 2; }
__host__ __device__ __forceinline__ int perm32(int rho) { const int n = rho >> 4, i = rho & 15; return 8 * (i >> 2) + 4 * n + (i & 3); }

struct Unit { int pm, pn; };
struct Gemm { const bf16_t* A; const bf16_t* Bt; int M, N, K; };
struct StaticOrder {
    int nM, nN, nwg, G, c;
    __host__ __device__ void init(int M_, int N_, int G_, int c_) { nM = M_ / BM; nN = N_ / BM; nwg = nM * nN; G = G_; c = c_; }
    __host__ __device__ bool next(int i, Unit& u) const {
        const long L = (long)i * G + c; if (L >= nwg) return false;
        int wgid = (int)L; { const int q = nwg / NXCD, r = nwg % NXCD, xcd = wgid % NXCD, off = wgid / NXCD; wgid = (xcd < r ? xcd * (q + 1) : r * (q + 1) + (xcd - r) * q) + off; }
        const int nig = WGM * nN, gid = wgid / nig, fm = gid * WGM, gsz = (nM - fm) < WGM ? (nM - fm) : WGM;
        u.pm = fm + ((wgid % nig) % gsz); u.pn = (wgid % nig) / gsz; return true;
    }
};

template <class E_> __device__ __forceinline__ auto rowsc_of(const E_& e, int) -> decltype(e.rowsc) { return e.rowsc; }
template <class E_> __device__ __forceinline__ const GAS float* rowsc_of(const E_&, long) { return nullptr; }
template <class Epi, bool ALIGN_EPI = true, bool SP2 = true, bool F8 = false, bool I8 = false>
__device__ __forceinline__ void gemm_phase(LAS unsigned char* lds, const Gemm g, const StaticOrder& S, const Epi& E) {
    const int tid = opq_tid(), wid = __builtin_amdgcn_readfirstlane(tid >> 6), lane = tid & 63, wr = wid >> 2, wc = wid & 3, fr = lane & 15, fq = lane >> 4;
    const int K = g.K, nt = K / BK;
    unsigned voffA[2];
#pragma unroll
    for (int i = 0; i < 2; ++i) { int R, C; stage_rc(tid * 16 + i * 8192, R, C); voffA[i] = (unsigned)(R * K + C) * 2u; }
    const size_t kstep = (size_t)(BK * 2);
    const size_t hstep = (size_t)HALF * K * 2;
    const size_t tstep = 2 * hstep;
    const unsigned ldsw = (unsigned)wid * 1024u;
    const int aoff = lds_byte(wr * 64 + fr, fq * 8), boff = lds_byte(wc * 32 + fr, fq * 8);
#define PG8_SA(b, h) (((b) * 2 + (h)) * HTB)
#define PG8_SB(b, h) ((4 + (b) * 2 + (h)) * HTB)
#define PG8_STAGE(bufoff, gbase, voff) do { _Pragma("unroll") for (int _i = 0; _i < 2; ++_i) \
        __builtin_amdgcn_global_load_lds((const unsigned*)((const char*)(gbase) + (voff)[_i]), (LAS unsigned*)(lds + (bufoff) + ldsw + _i * 8192), 16, 0, 0); } while (0)
#define PG8_LDA(dst, b, h) do { _Pragma("unroll") for (int m = 0; m < 4; ++m) _Pragma("unroll") for (int k = 0; k < 2; ++k) dst[m][k] = *(const LAS bf16x8*)(lds + PG8_SA(b, h) + aoff + m * 2048 + k * 1024); } while (0)
#define PG8_LDB(dst, b, h) do { _Pragma("unroll") for (int n = 0; n < 2; ++n) _Pragma("unroll") for (int k = 0; k < 2; ++k) dst[n][k] = *(const LAS bf16x8*)(lds + PG8_SB(b, h) + boff + n * 2048 + k * 1024); } while (0)
#define PG8_CAT8(lo, hi) __builtin_shufflevector(__builtin_bit_cast(i32x4, lo), __builtin_bit_cast(i32x4, hi), 0, 1, 2, 3, 4, 5, 6, 7)
#define PG8_MMA(ai, bj, At, Bt) do { __builtin_amdgcn_s_setprio(1); _Pragma("unroll") for (int m = 0; m < 4; ++m) _Pragma("unroll") for (int n = 0; n < 2; ++n) { \
        if constexpr (F8) { const i32x8 b8_ = PG8_CAT8(Bt[n][0], Bt[n][1]), a8_ = PG8_CAT8(At[m][0], At[m][1]); asm volatile("v_mfma_f32_16x16x128_f8f6f4 %0, %1, %2, %0" : "+v"(acc[ai][bj][m][n]) : "v"(b8_), "v"(a8_)); } \
        else if constexpr (I8) { _Pragma("unroll") for (int k = 0; k < 2; ++k) acc[ai][bj][m][n] = __builtin_bit_cast(f32x4, __builtin_amdgcn_mfma_i32_16x16x64_i8(__builtin_bit_cast(i32x4, Bt[n][k]), __builtin_bit_cast(i32x4, At[m][k]), __builtin_bit_cast(i32x4, acc[ai][bj][m][n]), 0, 0, 0)); } \
        else { _Pragma("unroll") for (int k = 0; k < 2; ++k) acc[ai][bj][m][n] = __builtin_amdgcn_mfma_f32_16x16x32_bf16(Bt[n][k], At[m][k], acc[ai][bj][m][n], 0, 0, 0); } } __builtin_amdgcn_s_setprio(0); } while (0)
#define PG8_WAIT_V(n) asm volatile("s_waitcnt vmcnt(" #n ")" ::: "memory")
#define PG8_WAIT_L(n) asm volatile("s_waitcnt lgkmcnt(" #n ")" ::: "memory")
#define PG8_BAR __builtin_amdgcn_s_barrier()
#define PG8_SCHED __builtin_amdgcn_sched_barrier(0)
    LAS int* utab = (LAS int*)(lds + LDS_MISC + 128);
    if (tid < 16) { Unit tu; tu.pm = 0; tu.pn = 0; const bool ok = S.next(tid, tu); utab[2 * tid] = ok ? tu.pm : -1; utab[2 * tid + 1] = tu.pn; }
    __syncthreads();
#define PG8_NEXT(i, u) ((i) < 16 && ((u).pm = __builtin_amdgcn_readfirstlane(utab[2 * (i)]), (u).pn = __builtin_amdgcn_readfirstlane(utab[2 * (i) + 1]), (u).pm >= 0))
    Unit cur, nxt; int ui = 0;
    if (!PG8_NEXT(0, cur)) return;
    const char* cA = (const char*)g.A + (size_t)cur.pm * tstep; const char* cB = (const char*)g.Bt + (size_t)cur.pn * tstep;
    if constexpr (SP2) {
        PG8_STAGE(PG8_SB(0, 0), cB, voffA); PG8_STAGE(PG8_SB(0, 1), cB + hstep, voffA); PG8_STAGE(PG8_SA(0, 0), cA, voffA); PG8_STAGE(PG8_SA(0, 1), cA + hstep, voffA);
    }
    if constexpr (Epi::NEEDS_RS) {
        LAS float* rst = (LAS float*)(lds + STAGE_BYTES);
        const GAS float* rsc = rowsc_of(E, 0);
        for (int q = tid; q < 16 * 256; q += 512) { const int i = q >> 8, r = q & 255, pm = utab[2 * i];
            if (pm >= 0) { const GAS f32x4* p = (const GAS f32x4*)(E.ssq + (size_t)(pm * 256 + r) * 16); const f32x4 a0 = p[0], a1 = p[1], a2 = p[2], a3 = p[3];
                const float xs = rsc ? rsc[pm * 256 + r] : 1.0f;
                rst[q] = xs * rsqrtf((((a0.x + a0.y) + (a0.z + a0.w)) + ((a1.x + a1.y) + (a1.z + a1.w)) + ((a2.x + a2.y) + (a2.z + a2.w)) + ((a3.x + a3.y) + (a3.z + a3.w))) * (1.0f / D) + RMS_EPS); } }
        if constexpr (Epi::NEEDS_RH) {
            LAS float* rht = (LAS float*)(lds + STAGE_BYTES + 16384);
            for (int q = tid; q < 8 * 256; q += 512) { const int i = q >> 8, r = q & 255, pm = utab[2 * i], hh = utab[2 * i + 1] >> 1;
                if (pm >= 0) { const GAS f32x4* p = (const GAS f32x4*)(E.hss + ((size_t)(pm * 256 + r) * RH + hh) * 16); const f32x4 a0 = p[0], a1 = p[1], a2 = p[2], a3 = p[3];
                    rht[q] = rsqrtf((((a0.x + a0.y) + (a0.z + a0.w)) + ((a1.x + a1.y) + (a1.z + a1.w)) + ((a2.x + a2.y) + (a2.z + a2.w)) + ((a3.x + a3.y) + (a3.z + a3.w))) * (1.0f / RV) + RMS_EPS); } }
        }
        __syncthreads();
    }
    f32x4 acc[2][2][4][2];
#define PG8_ZERO_ACC do { bf16x8 z_ = (bf16x8){0, 0, 0, 0, 0, 0, 0, 0}; asm volatile("" : "+v"(z_)); \
        _Pragma("unroll") for (int a = 0; a < 2; ++a) _Pragma("unroll") for (int b = 0; b < 2; ++b) _Pragma("unroll") for (int m = 0; m < 4; ++m) _Pragma("unroll") for (int n = 0; n < 2; ++n) \
            acc[a][b][m][n] = __builtin_amdgcn_mfma_f32_16x16x32_bf16(z_, z_, (f32x4){0.f, 0.f, 0.f, 0.f}, 0, 0, 0); } while (0)
    PG8_ZERO_ACC;
    bf16x8 At[4][2], B0[2][2], B1[2][2];
    if constexpr (SP2) {
        if (wr == 1) PG8_BAR;
        PG8_WAIT_V(2); PG8_BAR;
        PG8_STAGE(PG8_SB(1, 0), cB + kstep, voffA); PG8_STAGE(PG8_SA(1, 0), cA + kstep, voffA); PG8_STAGE(PG8_SB(1, 1), cB + hstep + kstep, voffA);
        PG8_WAIT_V(6); PG8_BAR;
    } else {
        PG8_STAGE(PG8_SB(0, 0), cB, voffA); PG8_STAGE(PG8_SA(0, 0), cA, voffA); PG8_STAGE(PG8_SB(0, 1), cB + hstep, voffA); PG8_STAGE(PG8_SA(0, 1), cA + hstep, voffA);
        if (wr == 1) PG8_BAR;
        PG8_WAIT_V(4); PG8_BAR;
        PG8_STAGE(PG8_SB(1, 0), cB + kstep, voffA); PG8_STAGE(PG8_SA(1, 0), cA + kstep, voffA); PG8_STAGE(PG8_SB(1, 1), cB + hstep + kstep, voffA);
        PG8_WAIT_V(6); PG8_BAR;
    }
    for (;;) {
        const bool has_next = PG8_NEXT(ui + 1, nxt);
        const char* nA = has_next ? (const char*)g.A + (size_t)nxt.pm * tstep : cA; const char* nB = has_next ? (const char*)g.Bt + (size_t)nxt.pn * tstep : cB;
        __builtin_amdgcn_s_waitcnt(0xC07F);
        for (int t = 0; t < nt; t += 2) {
            const bool last = (t == nt - 2);
            const char* a1 = cA + (size_t)(t + 1) * kstep;
            const char* a2 = last ? nA : cA + (size_t)(t + 2) * kstep; const char* b2 = last ? nB : cB + (size_t)(t + 2) * kstep;
            const char* a3 = a2 + kstep; const char* b3 = b2 + kstep;
            if constexpr (SP2) {
            PG8_LDB(B0, 0, 0); PG8_LDB(B1, 0, 1); PG8_SCHED; PG8_LDA(At, 0, 0); PG8_STAGE(PG8_SA(1, 1), a1 + hstep, voffA);
            PG8_WAIT_V(8); PG8_WAIT_L(0); PG8_BAR; PG8_MMA(0, 0, At, B0); PG8_MMA(0, 1, At, B1); PG8_BAR; PG8_SCHED;
            PG8_LDA(At, 0, 1); PG8_STAGE(PG8_SB(0, 0), b2, voffA); PG8_STAGE(PG8_SB(0, 1), b2 + hstep, voffA); PG8_STAGE(PG8_SA(0, 0), a2, voffA);
            PG8_WAIT_V(8); PG8_WAIT_L(0); PG8_BAR; PG8_MMA(1, 0, At, B0); PG8_MMA(1, 1, At, B1); PG8_BAR; PG8_SCHED;
            PG8_LDB(B0, 1, 0); PG8_LDB(B1, 1, 1); PG8_SCHED; PG8_LDA(At, 1, 0); PG8_STAGE(PG8_SA(0, 1), a2 + hstep, voffA);
            PG8_WAIT_V(8); PG8_WAIT_L(0); PG8_BAR; PG8_MMA(0, 0, At, B0); PG8_MMA(0, 1, At, B1); PG8_BAR; PG8_SCHED;
            PG8_LDA(At, 1, 1); PG8_STAGE(PG8_SB(1, 0), b3, voffA); PG8_STAGE(PG8_SB(1, 1), b3 + hstep, voffA); PG8_STAGE(PG8_SA(1, 0), a3, voffA);
            PG8_WAIT_V(8); PG8_WAIT_L(0); PG8_BAR; PG8_MMA(1, 0, At, B0); PG8_MMA(1, 1, At, B1); PG8_BAR; PG8_SCHED;
            } else {
            PG8_LDB(B0, 0, 0); PG8_SCHED; PG8_LDA(At, 0, 0); PG8_STAGE(PG8_SA(1, 1), a1 + hstep, voffA);
            PG8_WAIT_L(8); PG8_BAR; PG8_WAIT_L(0); PG8_MMA(0, 0, At, B0); PG8_BAR; PG8_SCHED;
            PG8_LDB(B1, 0, 1); PG8_STAGE(PG8_SB(0, 0), b2, voffA);
            PG8_BAR; PG8_WAIT_L(0); PG8_MMA(0, 1, At, B1); PG8_BAR;
            PG8_LDA(At, 0, 1); PG8_STAGE(PG8_SA(0, 0), a2, voffA);
            PG8_BAR; PG8_WAIT_L(0); PG8_MMA(1, 0, At, B0); PG8_BAR; PG8_SCHED;
            PG8_STAGE(PG8_SB(0, 1), b2 + hstep, voffA);
            PG8_WAIT_V(6); PG8_BAR; PG8_MMA(1, 1, At, B1); PG8_BAR;
            PG8_LDB(B0, 1, 0); PG8_SCHED; PG8_LDA(At, 1, 0); PG8_STAGE(PG8_SA(0, 1), a2 + hstep, voffA);
            PG8_WAIT_L(8); PG8_BAR; PG8_WAIT_L(0); PG8_MMA(0, 0, At, B0); PG8_BAR; PG8_SCHED;
            PG8_LDB(B1, 1, 1); PG8_STAGE(PG8_SB(1, 0), b3, voffA);
            PG8_BAR; PG8_WAIT_L(0); PG8_MMA(0, 1, At, B1); PG8_BAR;
            PG8_LDA(At, 1, 1); PG8_STAGE(PG8_SA(1, 0), a3, voffA);
            PG8_BAR; PG8_WAIT_L(0); PG8_MMA(1, 0, At, B0); PG8_BAR; PG8_SCHED;
            PG8_STAGE(PG8_SB(1, 1), b3 + hstep, voffA);
            PG8_WAIT_V(6); PG8_BAR; PG8_MMA(1, 1, At, B1); PG8_BAR;
            }
        }
        if constexpr (ALIGN_EPI) { if (wr == 0) PG8_BAR; }
        if constexpr (F8) asm volatile("s_nop 15\n\ts_nop 7" ::: "memory");
        { int efr = fr, efq = fq; asm volatile("" : "+v"(efr), "+v"(efq));
          E(acc, cur, wr, wc, efr, efq, (const LAS float*)(lds + STAGE_BYTES) + ui * 256 + wr * 64 + efr); }
        if (!has_next) break;
        PG8_ZERO_ACC;
        cur = nxt; cA = nA; cB = nB; ++ui;
        if constexpr (ALIGN_EPI) { if (wr == 1) PG8_BAR; }
    }
    PG8_WAIT_V(0);
    if constexpr (!ALIGN_EPI) { if (wr == 0) PG8_BAR; }
    PG8_BAR;
#undef PG8_NEXT
#undef PG8_SA
#undef PG8_SB
#undef PG8_STAGE
#undef PG8_LDA
#undef PG8_LDB
#undef PG8_MMA
#undef PG8_CAT8
#undef PG8_ZERO_ACC
#undef PG8_WAIT_V
#undef PG8_WAIT_L
#undef PG8_BAR
#undef PG8_SCHED
}
}

typedef f32x4 Acc[2][2][4][2];
__device__ __forceinline__ u32x4 pack8(const f32x4 a, const f32x4 b) { u32x4 w; w.x = pk2(a.x, a.y); w.y = pk2(a.z, a.w); w.z = pk2(b.x, b.y); w.w = pk2(b.z, b.w); return w; }
__device__ __forceinline__ void row_scales(const GAS float* part, size_t stride, int row0, int fq, float inv_n, float eps, float (&sc)[8]) {
    f32x4 v[8];
#pragma unroll
    for (int k = 0; k < 8; ++k) v[k] = *(const GAS f32x4*)(part + (size_t)(row0 + (k >> 2) * 128 + (k & 3) * 16) * stride + 4 * fq);
#pragma unroll
    for (int k = 0; k < 8; ++k) { float t = (v[k].x + v[k].y) + (v[k].z + v[k].w); t += __shfl_xor(t, 16); t += __shfl_xor(t, 32); sc[k] = rsqrtf(t * inv_n + eps); }
}

struct EpiConvIn {
    static constexpr bool NEEDS_RS = true, NEEDS_RH = false;
    const GAS float* ssq; GAS bf16_t* Bo; GAS bf16_t* CZ;
    __device__ __forceinline__ void operator()(const Acc& acc, const pg8::Unit& u, int wr, int wc, int fr, int fq, const LAS float* rst) const {
        const int row0 = u.pm * 256 + wr * 64 + fr;
        float rs[8];
#pragma unroll
        for (int k = 0; k < 8; ++k) rs[k] = rst[(k >> 2) * 128 + (k & 3) * 16];
#pragma unroll
        for (int ai = 0; ai < 2; ++ai)
#pragma unroll
            for (int m = 0; m < 4; ++m) {
                const int row = row0 + ai * 128 + m * 16; const float r1 = rs[4 * ai + m];
                if (u.pn < 4) {
#pragma unroll
                    for (int bj = 0; bj < 2; ++bj)
                        *(GAS u32x4*)(Bo + (size_t)row * D + u.pn * 256 + bj * 128 + wc * 32 + fq * 8) = pack8(acc[ai][bj][m][0] * r1, acc[ai][bj][m][1] * r1);
                } else {
                    const float r2 = r1 * r1;
                    const f32x4 p0 = acc[ai][0][m][0] * acc[ai][0][m][1] * r2, p1 = acc[ai][1][m][0] * acc[ai][1][m][1] * r2;
                    *(GAS u32x4*)(CZ + (size_t)row * D + (u.pn - 4) * 128 + wc * 32 + fq * 8) = pack8(p0, p1);
                }
            }
    }
};
struct EpiFfnIn {
    static constexpr bool NEEDS_RS = true, NEEDS_RH = false;
    const GAS float* ssq; GAS unsigned char* ACT; bool f8; float isc; const GAS float* rowsc; bool i8;
    __device__ __forceinline__ void operator()(const Acc& acc, const pg8::Unit& u, int wr, int wc, int fr, int fq, const LAS float* rst) const {
        const int row0 = u.pm * 256 + wr * 64 + fr;
        float rs[8];
#pragma unroll
        for (int k = 0; k < 8; ++k) rs[k] = rst[(k >> 2) * 128 + (k & 3) * 16];
#pragma unroll
        for (int ai = 0; ai < 2; ++ai)
#pragma unroll
            for (int m = 0; m < 4; ++m) {
                const int row = row0 + ai * 128 + m * 16; const float r1 = rs[4 * ai + m] * isc;
                const float c1 = -1.44269504089f * r1, r2 = r1 * r1;
                f32x2 g[4], p[4], e[4];
#pragma unroll
                for (int bj = 0; bj < 2; ++bj) { f32x4 gt = acc[ai][bj][m][0], up = acc[ai][bj][m][1];
                    if (i8) { gt = __builtin_convertvector(__builtin_bit_cast(i32x4, gt), f32x4); up = __builtin_convertvector(__builtin_bit_cast(i32x4, up), f32x4); }
                    g[2 * bj] = (f32x2){gt.x, gt.y}; g[2 * bj + 1] = (f32x2){gt.z, gt.w};
                    p[2 * bj] = (f32x2){gt.x, gt.y} * (f32x2){up.x, up.y}; p[2 * bj + 1] = (f32x2){gt.z, gt.w} * (f32x2){up.z, up.w}; }
#pragma unroll
                for (int k = 0; k < 4; ++k) { const f32x2 t = g[k] * c1; e[k].x = __builtin_amdgcn_exp2f(t.x); e[k].y = __builtin_amdgcn_exp2f(t.y); }
#pragma unroll
                for (int k = 0; k < 4; ++k) { const f32x2 d = e[k] + 1.0f; e[k].x = __builtin_amdgcn_rcpf(d.x); e[k].y = __builtin_amdgcn_rcpf(d.y); }
#pragma unroll
                for (int k = 0; k < 4; ++k) p[k] = (p[k] * r2) * e[k];
                const size_t eoff = (size_t)row * DFF + u.pn * 128 + wc * 32 + fq * 8;
                if (f8) {
                    u32x2 w;
                    w.x = (unsigned)__builtin_amdgcn_cvt_pk_fp8_f32(p[1].x, p[1].y, __builtin_amdgcn_cvt_pk_fp8_f32(p[0].x, p[0].y, 0, false), true);
                    w.y = (unsigned)__builtin_amdgcn_cvt_pk_fp8_f32(p[3].x, p[3].y, __builtin_amdgcn_cvt_pk_fp8_f32(p[2].x, p[2].y, 0, false), true);
                    __builtin_nontemporal_store(w, (GAS u32x2*)(ACT + eoff));
                } else {
                    u32x4 w; w.x = pk2(p[0].x, p[0].y); w.y = pk2(p[1].x, p[1].y); w.z = pk2(p[2].x, p[2].y); w.w = pk2(p[3].x, p[3].y);
                    __builtin_nontemporal_store(w, (GAS u32x4*)(ACT + 2 * eoff));
                }
            }
    }
};
__device__ __forceinline__ f32x2 gelu_pk(f32x2 v) {
    const f32x2 av = __builtin_elementwise_abs(v), d = av * 0.2316418882f + 1.0f;
    f32x2 t; t.x = __builtin_amdgcn_rcpf(d.x); t.y = __builtin_amdgcn_rcpf(d.y);
    f32x2 q = t * 0.5307027145f + (-0.7265760135f); q = q * t + 0.7107068705f; q = q * t + (-0.142248368f); q = q * t + 0.127414796f; q = q * t;
    const f32x2 s = (v * v) * (-0.72134752044f);
    f32x2 e; e.x = __builtin_amdgcn_exp2f(s.x); e.y = __builtin_amdgcn_exp2f(s.y);
    return v * 0.5f + av * (0.5f - q * e);
}
__device__ __forceinline__ f32x4 gelu4(f32x4 v) { const f32x2 a = gelu_pk((f32x2){v.x, v.y}), b = gelu_pk((f32x2){v.z, v.w}); return (f32x4){a.x, a.y, b.x, b.y}; }
struct EpiSguIn {
    static constexpr bool NEEDS_RS = true, NEEDS_RH = false;
    const GAS float* ssq; GAS bf16_t* U; GAS bf16_t* V; GAS float* lnp;
    __device__ __forceinline__ void operator()(const Acc& acc, const pg8::Unit& u, int wr, int wc, int fr, int fq, const LAS float* rst) const {
        const int row0 = u.pm * 256 + wr * 64 + fr;
        const bool isv = u.pn >= 8;
        GAS bf16_t* dst = isv ? V + (u.pn - 8) * 256 : U + u.pn * 256;
        float rs[8];
#pragma unroll
        for (int k = 0; k < 8; ++k) rs[k] = rst[(k >> 2) * 128 + (k & 3) * 16];
#pragma unroll
        for (int ai = 0; ai < 2; ++ai)
#pragma unroll
            for (int m = 0; m < 4; ++m) {
                const int row = row0 + ai * 128 + m * 16; const float r1 = rs[4 * ai + m];
                float s1 = 0.f, s2 = 0.f;
#pragma unroll
                for (int bj = 0; bj < 2; ++bj) {
                    const f32x4 a = gelu4(acc[ai][bj][m][0] * r1), b = gelu4(acc[ai][bj][m][1] * r1);
                    *(GAS u32x4*)(dst + (size_t)row * 2048 + bj * 128 + wc * 32 + fq * 8) = pack8(a, b);
                    s1 += (a.x + a.y) + (a.z + a.w) + (b.x + b.y) + (b.z + b.w);
                    s2 += (a.x * a.x + a.y * a.y) + (a.z * a.z + a.w * a.w) + (b.x * b.x + b.y * b.y) + (b.z * b.z + b.w * b.w);
                }
                if (isv) {
                    s1 += __shfl_xor(s1, 16); s1 += __shfl_xor(s1, 32); s2 += __shfl_xor(s2, 16); s2 += __shfl_xor(s2, 32);
                    if (fq == 0) *(GAS f32x2*)(lnp + ((size_t)row * 32 + (u.pn - 8) * 4 + wc) * 2) = (f32x2){s1, s2};
                }
            }
    }
};
struct EpiRetQkv {
    static constexpr bool NEEDS_RS = true, NEEDS_RH = false;
    const GAS float* ssq; const GAS float* rcos; const GAS float* rsin; GAS bf16_t* Q; GAS bf16_t* Kn; GAS bf16_t* V;
    __device__ __forceinline__ void operator()(const Acc& acc, const pg8::Unit& u, int wr, int wc, int fr, int fq, const LAS float* rst) const {
        const int row0 = u.pm * 256 + wr * 64 + fr;
        const int i0 = wc * 32 + fq * 8;
        const bool isk = u.pn >= 4; const int h = u.pn & 3;
        const float l2g = __builtin_amdgcn_logf(1.0f - __builtin_amdgcn_exp2f(-5.0f - (float)h));
        float rs[8];
#pragma unroll
        for (int k = 0; k < 8; ++k) rs[k] = rst[(k >> 2) * 128 + (k & 3) * 16];
        if (u.pn >= 8) {
#pragma unroll
            for (int ai = 0; ai < 2; ++ai)
#pragma unroll
                for (int m = 0; m < 4; ++m) { const int row = row0 + ai * 128 + m * 16; const float r1 = rs[4 * ai + m];
#pragma unroll
                    for (int bj = 0; bj < 2; ++bj)
                        *(GAS u32x4*)(V + (size_t)row * 2048 + (u.pn - 8) * 256 + bj * 128 + i0) = pack8(acc[ai][bj][m][0] * r1, acc[ai][bj][m][1] * r1); }
        } else {
#pragma unroll
            for (int hp = 0; hp < 4; ++hp) {
                const int ai = hp >> 1;
                f32x4 cs[2][2], sn[2][2];
#pragma unroll
                for (int mm = 0; mm < 2; ++mm) { const int pos = (row0 + ai * 128 + (2 * (hp & 1) + mm) * 16) & (SEQ - 1);
#pragma unroll
                    for (int bj = 0; bj < 2; ++bj) { cs[mm][bj] = *(const GAS f32x4*)(rcos + (size_t)pos * 128 + i0 + 4 * bj); sn[mm][bj] = *(const GAS f32x4*)(rsin + (size_t)pos * 128 + i0 + 4 * bj); } }
#pragma unroll
                for (int mm = 0; mm < 2; ++mm) {
                    const int m = 2 * (hp & 1) + mm;
                    const int row = row0 + ai * 128 + m * 16, pos = row & (SEQ - 1); const float r1 = rs[4 * ai + m];
                    const float sc = isk ? r1 * 0.0625f * __builtin_amdgcn_exp2f(l2g * (float)(127 - (pos & 127))) : r1;
                    f32x4 o1[2], o2[2];
#pragma unroll
                    for (int bj = 0; bj < 2; ++bj) { const f32x4 x1 = acc[ai][bj][m][0] * sc, x2 = acc[ai][bj][m][1] * sc;
                        o1[bj] = x1 * cs[mm][bj] - x2 * sn[mm][bj]; o2[bj] = x2 * cs[mm][bj] + x1 * sn[mm][bj]; }
                    GAS bf16_t* dst = (isk ? Kn : Q) + (size_t)row * D + h * 256 + i0;
                    *(GAS u32x4*)dst = pack8(o1[0], o1[1]); *(GAS u32x4*)(dst + 128) = pack8(o2[0], o2[1]);
                }
            }
        }
    }
};
struct EpiRetG {
    static constexpr bool NEEDS_RS = true, NEEDS_RH = true;
    const GAS float* ssq; const GAS float* hss; GAS bf16_t* Y;
    __device__ __forceinline__ void operator()(const Acc& acc, const pg8::Unit& u, int wr, int wc, int fr, int fq, const LAS float* rst) const {
        const int row0 = u.pm * 256 + wr * 64 + fr; const int h = u.pn >> 1;
        float rs[8], rh[8];
#pragma unroll
        for (int k = 0; k < 8; ++k) { rs[k] = rst[(k >> 2) * 128 + (k & 3) * 16]; rh[k] = rst[4096 + (k >> 2) * 128 + (k & 3) * 16]; }
#pragma unroll
        for (int ai = 0; ai < 2; ++ai) {
            u32x4 ov[4][2];
#pragma unroll
            for (int m = 0; m < 4; ++m)
#pragma unroll
                for (int bj = 0; bj < 2; ++bj) ov[m][bj] = *(const GAS u32x4*)(Y + (size_t)(row0 + ai * 128 + m * 16) * 2048 + u.pn * 256 + bj * 128 + wc * 32 + fq * 8);
#pragma unroll
            for (int m = 0; m < 4; ++m) {
                const int row = row0 + ai * 128 + m * 16; const float r1 = rs[4 * ai + m], r3 = rh[4 * ai + m];
#pragma unroll
                for (int bj = 0; bj < 2; ++bj) {
                    GAS bf16_t* p = Y + (size_t)row * 2048 + u.pn * 256 + bj * 128 + wc * 32 + fq * 8;
                    const u32x4 o = ov[m][bj];
                    const f32x4 g0 = acc[ai][bj][m][0] * r1, g1 = acc[ai][bj][m][1] * r1;
                    const f32x4 a = (f32x4){silu_f(g0.x) * bf_lo(o.x), silu_f(g0.y) * bf_hi(o.x), silu_f(g0.z) * bf_lo(o.y), silu_f(g0.w) * bf_hi(o.y)} * r3;
                    const f32x4 b = (f32x4){silu_f(g1.x) * bf_lo(o.z), silu_f(g1.y) * bf_hi(o.z), silu_f(g1.z) * bf_lo(o.w), silu_f(g1.w) * bf_hi(o.w)} * r3;
                    *(GAS u32x4*)p = pack8(a, b);
                }
            }
        }
    }
};
template <int MB = 4> struct EpiResidT {
    static constexpr bool NEEDS_RS = false, NEEDS_RH = false;
    GAS bf16_t* xb; GAS float* ssq; float osc; GAS unsigned char* x8;
    __device__ __forceinline__ void operator()(const Acc& acc, const pg8::Unit& u, int wr, int wc, int fr, int fq, const LAS float* rst) const {
        const int row0 = u.pm * 256 + wr * 64 + fr, col0 = u.pn * 256 + wc * 32 + fq * 8;
#pragma unroll
        for (int ai = 0; ai < 2; ++ai)
#pragma unroll
        for (int mh = 0; mh < 4; mh += MB) {
            u32x4 bv[4][2];
#pragma unroll
            for (int m = mh; m < mh + MB; ++m)
#pragma unroll
                for (int bj = 0; bj < 2; ++bj) bv[m][bj] = *(const GAS u32x4*)(xb + (size_t)(row0 + ai * 128 + m * 16) * D + col0 + bj * 128);
#pragma unroll
            for (int m = mh; m < mh + MB; ++m) {
                const int row = row0 + ai * 128 + m * 16;
                GAS bf16_t* p = xb + (size_t)row * D + col0;
                float s2 = 0.f;
#pragma unroll
                for (int bj = 0; bj < 2; ++bj) {
                    const u32x4 b = bv[m][bj];
                    const f32x4 x0 = (f32x4){bf_lo(b.x), bf_hi(b.x), bf_lo(b.y), bf_hi(b.y)} + acc[ai][bj][m][0] * osc;
                    const f32x4 x1 = (f32x4){bf_lo(b.z), bf_hi(b.z), bf_lo(b.w), bf_hi(b.w)} + acc[ai][bj][m][1] * osc;
                    *(GAS u32x4*)(p + bj * 128) = pack8(x0, x1);
                    if (x8) { u32x2 w8;
                        w8.x = (unsigned)__builtin_amdgcn_cvt_pk_fp8_f32(x0.z, x0.w, __builtin_amdgcn_cvt_pk_fp8_f32(x0.x, x0.y, 0, false), true);
                        w8.y = (unsigned)__builtin_amdgcn_cvt_pk_fp8_f32(x1.z, x1.w, __builtin_amdgcn_cvt_pk_fp8_f32(x1.x, x1.y, 0, false), true);
                        *(GAS u32x2*)(x8 + (size_t)row * D + col0 + bj * 128) = w8; }
                    s2 += (x0.x * x0.x + x0.y * x0.y) + (x0.z * x0.z + x0.w * x0.w) + (x1.x * x1.x + x1.y * x1.y) + (x1.z * x1.z + x1.w * x1.w);
                }
                s2 += __shfl_xor(s2, 16); s2 += __shfl_xor(s2, 32);
                if (fq == 0) ssq[(size_t)row * 16 + u.pn * 4 + wc] = s2;
            }
        }
    }
};
typedef EpiResidT<4> EpiResid;

struct Args { const float* in[18]; float* out; unsigned char* ws; int ph_lo, ph_hi, li, pad; };

struct Frame {
    LAS unsigned char* lds;
    int tid, lane, wave, vcu, G;
};

enum { MAP_NAT = 0, MAP_P8 = 1, MAP_CONV = 2, MAP_RETQKV = 3, MAP_FFN = 4 };
struct PrepJob { const GAS float* src; const GAS float* src2; const GAS float* gain; GAS bf16_t* dst; int ld, N, K, map; float f8scale, i8scale; };
__device__ __forceinline__ void prep_item(const PrepJob& J, int item, LAS float* scr, int lane) {
    const int nb = J.N / 64, kb = item / nb, r = item % nb, pn = r >> 2, wc = r & 3;
    const int k0 = kb * 64;
    const int sl = 128 * (lane >> 5) + 32 * wc + (lane & 31);
    const int slot = 256 * pn + sl;
    const GAS float* src = J.src; int col;
    {
        const int bj = sl >> 7, n = (sl >> 4) & 1, fq = (sl >> 2) & 3, j = sl & 3, ch = 32 * wc + 8 * fq + 4 * bj + j;
        const int p8 = (slot & ~31) + pg8::perm32(slot & 31);
        if (J.map == MAP_NAT) col = slot;
        else if (J.map == MAP_P8) col = p8;
        else if (J.map == MAP_CONV) col = (pn < 4) ? p8 : (1024 + 1024 * n + 128 * (pn - 4) + ch);
        else if (J.map == MAP_RETQKV) col = (pn < 8) ? (256 * pn + 128 * n + ch) : p8;
        else { col = 128 * pn + ch; if (n) src = J.src2; }
    }
    const GAS float* sp = src + (size_t)k0 * J.ld + col;
#pragma unroll
    for (int hk = 0; hk < 2; ++hk) {
        float wv[32];
#pragma unroll
        for (int k = 0; k < 32; ++k) wv[k] = sp[(size_t)(32 * hk + k) * J.ld];
#pragma unroll
        for (int k = 0; k < 32; ++k) scr[(32 * hk + k) * 65 + lane] = wv[k];
    }
    asm volatile("s_waitcnt lgkmcnt(0)" ::: "memory");
    const int c = lane & 7;
    float gn[8];
#pragma unroll
    for (int e = 0; e < 8; ++e) gn[e] = J.gain ? J.gain[k0 + 8 * c + e] : 1.0f;
#pragma unroll
    for (int it = 0; it < 8; ++it) {
        const int l2 = it * 8 + (lane >> 3);
        const int slot2 = 256 * pn + 128 * (l2 >> 5) + 32 * wc + (l2 & 31);
        const LAS float* s = scr + (8 * c) * 65 + l2;
        if (J.i8scale != 0.f) {
            const float f = J.i8scale; unsigned b8[8];
#pragma unroll
            for (int e = 0; e < 8; ++e) b8[e] = (unsigned)(int)fminf(fmaxf(rintf(s[e * 65] * gn[e] * f), -127.f), 127.f) & 255u;
            u32x2 o8; o8.x = b8[0] | (b8[1] << 8) | (b8[2] << 16) | (b8[3] << 24); o8.y = b8[4] | (b8[5] << 8) | (b8[6] << 16) | (b8[7] << 24);
            *(GAS u32x2*)((GAS unsigned char*)J.dst + (size_t)slot2 * J.K + k0 + 8 * c) = o8;
        } else if (J.f8scale != 0.f) {
            const float f = J.f8scale; u32x2 o8;
            o8.x = (unsigned)__builtin_amdgcn_cvt_pk_fp8_f32(s[2 * 65] * gn[2] * f, s[3 * 65] * gn[3] * f, __builtin_amdgcn_cvt_pk_fp8_f32(s[0] * gn[0] * f, s[65] * gn[1] * f, 0, false), true);
            o8.y = (unsigned)__builtin_amdgcn_cvt_pk_fp8_f32(s[6 * 65] * gn[6] * f, s[7 * 65] * gn[7] * f, __builtin_amdgcn_cvt_pk_fp8_f32(s[4 * 65] * gn[4] * f, s[5 * 65] * gn[5] * f, 0, false), true);
            *(GAS u32x2*)((GAS unsigned char*)J.dst + (size_t)slot2 * J.K + k0 + 8 * c) = o8;
        } else {
        u32x4 o; o.x = pk2(s[0] * gn[0], s[65] * gn[1]); o.y = pk2(s[2 * 65] * gn[2], s[3 * 65] * gn[3]); o.z = pk2(s[4 * 65] * gn[4], s[5 * 65] * gn[5]); o.w = pk2(s[6 * 65] * gn[6], s[7 * 65] * gn[7]);
        *(GAS u32x4*)(J.dst + (size_t)slot2 * J.K + k0 + 8 * c) = o;
        }
    }
    asm volatile("s_waitcnt lgkmcnt(0)" ::: "memory");
}
__device__ __forceinline__ void p0_wabs(const Frame& F, const Args& a) {
    const int tid_ = opq_tid(), lane_ = tid_ & 63, wave_ = __builtin_amdgcn_readfirstlane(tid_ >> 6);
    const int gw = F.vcu * 8 + wave_, NGW = F.G * 8;
#pragma unroll 1
    for (int L = 0; L < NLAYER; ++L) {
        if (!((I8_F1_LAYERS >> L) & 1)) continue;
        float mx = 0.f;
        for (int rr = gw; rr < 2 * 1024; rr += NGW) {
            const int k = rr & 1023; const GAS float* src = (const GAS float*)((rr < 1024 ? a.in[15] : a.in[16]) + ((size_t)L * 1024 + k) * DFF);
            const float gk = fabsf(((const GAS float*)a.in[2])[L * D + k]);
            float m = 0.f;
#pragma unroll
            for (int j = 0; j < 11; ++j) { const f32x4 v = ((const GAS f32x4*)src)[lane_ + 64 * j]; m = fmaxf(fmaxf(fmaxf(fabsf(v.x), fabsf(v.y)), fmaxf(fabsf(v.z), fabsf(v.w))), m); }
            mx = fmaxf(mx, m * gk);
        }
        mx = wave_max(mx);
        if (lane_ == 0) atomicMax((unsigned*)(a.ws + WS_CTL) + 64 + L, __builtin_bit_cast(unsigned, mx));
    }
}
__device__ __forceinline__ void quant_phase(const Frame& F, const GAS bf16_t* xb, GAS unsigned char* x8, GAS float* sa) {
    const int tid_ = opq_tid(), lane_ = tid_ & 63, wave_ = __builtin_amdgcn_readfirstlane(tid_ >> 6);
    const int gw = F.vcu * 8 + wave_, NGW = F.G * 8;
    for (int row = 4 * gw; row < M; row += 4 * NGW) {
        u32x4 v[4][2];
#pragma unroll
        for (int r = 0; r < 4; ++r) { const GAS u32x4* p = (const GAS u32x4*)(xb + (size_t)(row + r) * D) + 2 * lane_; v[r][0] = p[0]; v[r][1] = p[1]; }
#pragma unroll
        for (int r = 0; r < 4; ++r) {
            float x[16];
#pragma unroll
            for (int h = 0; h < 2; ++h)
#pragma unroll
                for (int e = 0; e < 4; ++e) { x[8 * h + 2 * e] = bf_lo(v[r][h][e]); x[8 * h + 2 * e + 1] = bf_hi(v[r][h][e]); }
            float m = 0.f;
#pragma unroll
            for (int e = 0; e < 16; ++e) m = fmaxf(m, fabsf(x[e]));
            m = fmaxf(wave_max(m), 1e-30f);
            const float qs = 127.0f / m;
            unsigned w[4];
#pragma unroll
            for (int d = 0; d < 4; ++d) { unsigned t = 0u;
#pragma unroll
                for (int e = 0; e < 4; ++e) t |= ((unsigned)(int)rintf(x[4 * d + e] * qs) & 255u) << (8 * e);
                w[d] = t; }
            *((GAS u32x4*)(x8 + (size_t)(row + r) * D) + lane_) = (u32x4){w[0], w[1], w[2], w[3]};
            if (lane_ == 0) sa[row + r] = m * (1.0f / 127.0f);
        }
    }
}
__device__ __forceinline__ void p0_prologue(const Frame& F, const Args& a) {
    unsigned char* ws = a.ws;
    const int tid_ = opq_tid(), lane_ = tid_ & 63, wave_ = __builtin_amdgcn_readfirstlane(tid_ >> 6);
    LAS float* scr = (LAS float*)(F.lds + wave_ * 16640);
    const int gw = F.vcu * 8 + wave_, NGW = F.G * 8;
    constexpr int NJOB = 17;
    int start = 0;
#pragma unroll 1
    for (int jb = 0; jb < NJOB; ++jb) {
        PrepJob J; J.f8scale = 0.f; J.i8scale = 0.f;
        if (jb < 2)       { J.src = (const GAS float*)(a.in[4] + (size_t)jb * 1024 * 3072); J.src2 = nullptr; J.gain = (const GAS float*)(a.in[1] + (jb == 0 ? 0 : 3) * D); J.dst = (GAS bf16_t*)(ws + W_CI + jb * W_CI_SZ); J.ld = 3072; J.N = 3072; J.K = 1024; J.map = MAP_CONV; }
        else if (jb < 4)  { const int j = jb - 2; J.src = (const GAS float*)(a.in[6] + (size_t)j * 1024 * 1024); J.src2 = nullptr; J.gain = nullptr; J.dst = (GAS bf16_t*)(ws + W_CO + j * W_CO_SZ); J.ld = 1024; J.N = 1024; J.K = 1024; J.map = MAP_P8; }
        else if (jb == 4) { J.src = (const GAS float*)(a.in[7]); J.src2 = nullptr; J.gain = (const GAS float*)(a.in[1] + 1 * D); J.dst = (GAS bf16_t*)(ws + W_SI); J.ld = 4096; J.N = 4096; J.K = 1024; J.map = MAP_P8; }
        else if (jb == 5) { J.src = (const GAS float*)(a.in[12]); J.src2 = nullptr; J.gain = nullptr; J.dst = (GAS bf16_t*)(ws + W_SO); J.ld = 1024; J.N = 1024; J.K = 2048; J.map = MAP_P8; }
        else if (jb == 6) { J.src = (const GAS float*)(a.in[13]); J.src2 = nullptr; J.gain = (const GAS float*)(a.in[1] + 2 * D); J.dst = (GAS bf16_t*)(ws + W_RQ); J.ld = 6144; J.N = 4096; J.K = 1024; J.map = MAP_RETQKV; }
        else if (jb == 7) { J.src = (const GAS float*)(a.in[13] + 4096); J.src2 = nullptr; J.gain = (const GAS float*)(a.in[1] + 2 * D); J.dst = (GAS bf16_t*)(ws + W_RG); J.ld = 6144; J.N = 2048; J.K = 1024; J.map = MAP_P8; }
        else if (jb == 8) { J.src = (const GAS float*)(a.in[14]); J.src2 = nullptr; J.gain = nullptr; J.dst = (GAS bf16_t*)(ws + W_RO); J.ld = 1024; J.N = 1024; J.K = 2048; J.map = MAP_P8; }
        else if (jb < 13) { const int L = jb - 9; J.src = (const GAS float*)(a.in[15] + (size_t)L * 1024 * DFF); J.src2 = (const GAS float*)(a.in[16] + (size_t)L * 1024 * DFF); J.gain = (const GAS float*)(a.in[2] + L * D); J.dst = (GAS bf16_t*)(ws + W_FI + L * W_FI_SZ); J.ld = DFF; J.N = 2 * DFF; J.K = 1024; J.map = MAP_FFN; J.f8scale = ((F8_F1_LAYERS >> L) & 1) ? FI_WSCALE : 0.f;
                            if ((I8_F1_LAYERS >> L) & 1) J.i8scale = 127.0f / fmaxf(__builtin_bit_cast(float, xb_ld((unsigned*)(ws + WS_CTL) + 64 + L)), 1e-30f); }
        else              { const int L = jb - 13; J.src = (const GAS float*)(a.in[17] + (size_t)L * DFF * 1024); J.src2 = nullptr; J.gain = nullptr; J.dst = (GAS bf16_t*)(ws + W_FD + L * W_FD_SZ); J.ld = 1024; J.N = 1024; J.K = DFF; J.map = MAP_P8; J.f8scale = ((F8_LAYERS >> L) & 1) ? FD_WSCALE : 0.f; }
        const int nitems = (J.K / 64) * (J.N / 64);
        int first = (gw - start % NGW + NGW) % NGW;
        for (int it = first; it < nitems; it += NGW) prep_item(J, it, scr, lane_);
        start += nitems;
    }
    {
        const GAS float* x = (const GAS float*)a.in[0]; GAS bf16_t* xb = (GAS bf16_t*)(ws + WS_XB); GAS float* ssq = (GAS float*)(ws + WS_SSQ);
        for (int row = 4 * gw; row < M; row += 4 * NGW) {
            f32x4 v[4][4];
#pragma unroll
            for (int r = 0; r < 4; ++r)
#pragma unroll
                for (int j = 0; j < 4; ++j) v[r][j] = ((const GAS f32x4*)(x + (size_t)(row + r) * D))[lane_ + 64 * j];
#pragma unroll
            for (int r = 0; r < 4; ++r) {
                float sq = 0.f;
#pragma unroll
                for (int j = 0; j < 4; ++j) sq += (v[r][j].x * v[r][j].x + v[r][j].y * v[r][j].y) + (v[r][j].z * v[r][j].z + v[r][j].w * v[r][j].w);
                sq = wave_sum(sq);
                GAS u32x2* o8 = (GAS u32x2*)(xb + (size_t)(row + r) * D) + lane_;
#pragma unroll
                for (int j = 0; j < 4; ++j) { u32x2 w; w.x = pk2(v[r][j].x, v[r][j].y); w.y = pk2(v[r][j].z, v[r][j].w); o8[64 * j] = w; }
                if (lane_ < 16) ssq[(size_t)(row + r) * 16 + lane_] = (lane_ == 0) ? sq : 0.f;
            }
        }
    }
    {
        GAS float* rc = (GAS float*)(ws + WS_ROT); GAS float* rsn = rc + (size_t)SEQ * 128;
        const int gt = F.vcu * 512 + tid_, NGT = F.G * 512;
        for (int idx = gt; idx < SEQ * 128; idx += NGT) {
            const int i = idx & 127, pos = idx >> 7;
            const float inv = __builtin_amdgcn_exp2f(-(float)i * (13.287712379549449f / 128.0f));
            const float ang = (float)pos * inv;
            const double ad = (double)ang;
            const double kq = __builtin_rint(ad * 0.63661977236758134308);
            const double y = __builtin_fma(-kq, 1.57079632679489661923, ad) - kq * 6.123233995736766e-17;
            const double y2 = y * y;
            const double sp = y * (1.0 + y2 * (-1.0 / 6 + y2 * (1.0 / 120 + y2 * (-1.0 / 5040 + y2 * (1.0 / 362880 + y2 * (-1.0 / 39916800))))));
            const double cp = 1.0 + y2 * (-0.5 + y2 * (1.0 / 24 + y2 * (-1.0 / 720 + y2 * (1.0 / 40320 + y2 * (-1.0 / 3628800 + y2 * (1.0 / 479001600))))));
            const int q = ((int)(long long)kq) & 3;
            const double sv = (q == 0) ? sp : (q == 1) ? cp : (q == 2) ? -sp : -cp;
            const double cv = (q == 0) ? cp : (q == 1) ? -sp : (q == 2) ? -cp : sp;
            rc[idx] = (float)cv; rsn[idx] = (float)sv;
        }
        const GAS float* wsp = (const GAS float*)a.in[10]; GAS bf16_t* wd = (GAS bf16_t*)(ws + W_WS);
        for (int idx = gt; idx < 8 * 128 * 128; idx += NGT) { const int s = idx & 127, t = (idx >> 7) & 127; wd[idx] = (bf16_t)f2bf(s <= t ? wsp[idx] : 0.f); }
    }
}

__device__ __forceinline__ void conv_phase(const Frame& F, const GAS bf16_t* Bo, const GAS bf16_t* CZ, const GAS float* cw, GAS bf16_t* Y) {
    constexpr int RB = 16;
    const int nitem = (M / RB) * 128;
    const int tid_ = opq_tid();
    for (int it = F.vcu * 512 + tid_; it < nitem; it += F.G * 512) {
        const int cc = it & 127, rb = it >> 7, r0 = rb * RB, c0 = cc * 8;
        float w0[8], w1[8], w2[8];
#pragma unroll
        for (int e = 0; e < 8; ++e) { w0[e] = cw[c0 + e]; w1[e] = cw[D + c0 + e]; w2[e] = cw[2 * D + c0 + e]; }
        u32x4 p2 = (u32x4){0, 0, 0, 0}, p1 = (u32x4){0, 0, 0, 0};
        if ((r0 & (SEQ - 1)) != 0) { p2 = *(const GAS u32x4*)(CZ + (size_t)(r0 - 2) * D + c0); p1 = *(const GAS u32x4*)(CZ + (size_t)(r0 - 1) * D + c0); }
#pragma unroll
        for (int hb = 0; hb < 2; ++hb) {
            u32x4 pz[8], pb[8];
#pragma unroll
            for (int r = 0; r < 8; ++r) { const size_t off = (size_t)(r0 + 8 * hb + r) * D + c0; pz[r] = *(const GAS u32x4*)(CZ + off); pb[r] = *(const GAS u32x4*)(Bo + off); }
#pragma unroll
            for (int r = 0; r < 8; ++r) {
                const size_t off = (size_t)(r0 + 8 * hb + r) * D + c0;
                const u32x4 p0 = pz[r], bv = pb[r];
                u32x4 o;
#pragma unroll
                for (int q = 0; q < 4; ++q) {
                    const float lo = bf_lo(bv[q]) * (w0[2 * q] * bf_lo(p2[q]) + w1[2 * q] * bf_lo(p1[q]) + w2[2 * q] * bf_lo(p0[q]));
                    const float hi = bf_hi(bv[q]) * (w0[2 * q + 1] * bf_hi(p2[q]) + w1[2 * q + 1] * bf_hi(p1[q]) + w2[2 * q + 1] * bf_hi(p0[q]));
                    o[q] = pk2(lo, hi);
                }
                *(GAS u32x4*)(Y + off) = o;
                p2 = p1; p1 = p0;
            }
        }
    }
}

constexpr int SG_W = 0, SG_WSTR = 272, SG_T = 128 * SG_WSTR, SG_TSTR = 272, SG_ST = SG_T + 256 * SG_TSTR, SG_LG = SG_ST + 1024, SG_END = SG_LG + 2048;
static_assert(SG_END <= LDS_MISC, "sgu lds");
__device__ __forceinline__ void sgu_phase(const Frame& F, GAS bf16_t* U, const GAS bf16_t* V, const GAS float* lnp, const GAS bf16_t* Wt, const GAS float* lng, const GAS float* lnb, const GAS float* bs) {
    LAS unsigned char* lds = F.lds;
    const int tid = opq_tid(), lane = tid & 63, w = __builtin_amdgcn_readfirstlane(tid >> 6), fr = lane & 15, fq = lane >> 4;
    const int s = tid & 127, dg = tid >> 7;
    const int srow = tid >> 2, spart = tid & 3;
    int gcur = -1;
    u32x4 vreg[8]; f32x4 lnv[4];
    int un = F.vcu;
    if (un < 2048) {
        const int g = un & 7, row0 = (un >> 3) * 128;
        const GAS bf16_t* vp = V + (size_t)(row0 + s) * 2048 + g * 256;
#pragma unroll
        for (int i = 0; i < 8; ++i) vreg[i] = *(const GAS u32x4*)(vp + (dg + 4 * i) * 8);
        const GAS f32x4* lp = (const GAS f32x4*)(lnp + (size_t)(row0 + srow) * 64 + spart * 16);
#pragma unroll
        for (int i = 0; i < 4; ++i) lnv[i] = lp[i];
    }
    for (; un < 2048; un += F.G) {
        const int g = un & 7, c = un >> 3, row0 = c * 128;
        __syncthreads();
        if (g != gcur) {
            gcur = g;
            const GAS bf16_t* wg = Wt + (size_t)g * 128 * 128;
#pragma unroll
            for (int i = 0; i < 4; ++i) { const int p = tid + 512 * i, t = p >> 4, c16 = p & 15; *(LAS u32x4*)(lds + SG_W + t * SG_WSTR + c16 * 16) = *(const GAS u32x4*)(wg + t * 128 + c16 * 8); }
            if (tid < 256) { ((LAS float*)(lds + SG_LG))[tid] = lng[g * 256 + tid]; } else { ((LAS float*)(lds + SG_LG))[tid] = lnb[g * 256 + tid - 256]; }
        }
        {
            float s1 = 0.f, s2 = 0.f;
#pragma unroll
            for (int i = 0; i < 4; ++i) { s1 += lnv[i].x + lnv[i].z; s2 += lnv[i].y + lnv[i].w; }
            s1 += __shfl_xor(s1, 1); s2 += __shfl_xor(s2, 1); s1 += __shfl_xor(s1, 2); s2 += __shfl_xor(s2, 2);
            const float mu = s1 * (1.0f / 2048.0f), var = s2 * (1.0f / 2048.0f) - mu * mu;
            if (spart == 0) { ((LAS float*)(lds + SG_ST))[srow] = mu; ((LAS float*)(lds + SG_ST))[128 + srow] = rsqrtf(fmaxf(var, 0.f) + LN_EPS); }
        }
        __syncthreads();
        {
            const float mu = ((LAS float*)(lds + SG_ST))[s], r = ((LAS float*)(lds + SG_ST))[128 + s];
#pragma unroll
            for (int i = 0; i < 8; ++i) {
                const int dc = dg + 4 * i, d0 = dc * 8;
                const u32x4 v = vreg[i];
                const f32x4 g0 = *(const LAS f32x4*)(lds + SG_LG + d0 * 4), g1 = *(const LAS f32x4*)(lds + SG_LG + d0 * 4 + 16);
                const f32x4 b0 = *(const LAS f32x4*)(lds + SG_LG + 1024 + d0 * 4), b1 = *(const LAS f32x4*)(lds + SG_LG + 1024 + d0 * 4 + 16);
                LAS bf16_t* tp = (LAS bf16_t*)(lds + SG_T + d0 * SG_TSTR) + s;
                tp[0 * (SG_TSTR / 2)] = (bf16_t)f2bf((bf_lo(v.x) - mu) * r * g0.x + b0.x);
                tp[1 * (SG_TSTR / 2)] = (bf16_t)f2bf((bf_hi(v.x) - mu) * r * g0.y + b0.y);
                tp[2 * (SG_TSTR / 2)] = (bf16_t)f2bf((bf_lo(v.y) - mu) * r * g0.z + b0.z);
                tp[3 * (SG_TSTR / 2)] = (bf16_t)f2bf((bf_hi(v.y) - mu) * r * g0.w + b0.w);
                tp[4 * (SG_TSTR / 2)] = (bf16_t)f2bf((bf_lo(v.z) - mu) * r * g1.x + b1.x);
                tp[5 * (SG_TSTR / 2)] = (bf16_t)f2bf((bf_hi(v.z) - mu) * r * g1.y + b1.y);
                tp[6 * (SG_TSTR / 2)] = (bf16_t)f2bf((bf_lo(v.w) - mu) * r * g1.z + b1.z);
                tp[7 * (SG_TSTR / 2)] = (bf16_t)f2bf((bf_hi(v.w) - mu) * r * g1.w + b1.w);
            }
        }
        u32x4 uv[8];
#pragma unroll
        for (int tb = 0; tb < 8; ++tb) uv[tb] = *(const GAS u32x4*)(U + (size_t)(row0 + 16 * tb + fr) * 2048 + g * 256 + 32 * w + 8 * fq);
        if (un + F.G < 2048) {
            const int un2 = un + F.G, g2 = un2 & 7, row2 = (un2 >> 3) * 128;
            const GAS bf16_t* vp = V + (size_t)(row2 + s) * 2048 + g2 * 256;
#pragma unroll
            for (int i = 0; i < 8; ++i) vreg[i] = *(const GAS u32x4*)(vp + (dg + 4 * i) * 8);
            const GAS f32x4* lp = (const GAS f32x4*)(lnp + (size_t)(row2 + srow) * 64 + spart * 16);
#pragma unroll
            for (int i = 0; i < 4; ++i) lnv[i] = lp[i];
        }
        __syncthreads();
        f32x4 acc[8][2];
#pragma unroll
        for (int tb = 0; tb < 8; ++tb) { acc[tb][0] = (f32x4){0.f, 0.f, 0.f, 0.f}; acc[tb][1] = (f32x4){0.f, 0.f, 0.f, 0.f}; }
        const int drow0 = 32 * w + 8 * (fr >> 2) + (fr & 3);
#pragma unroll
        for (int ks = 0; ks < 4; ++ks) {
            const bf16x8 t0 = *(const LAS bf16x8*)(lds + SG_T + drow0 * SG_TSTR + ks * 64 + fq * 16);
            const bf16x8 t1 = *(const LAS bf16x8*)(lds + SG_T + (drow0 + 4) * SG_TSTR + ks * 64 + fq * 16);
#pragma unroll
            for (int tb = 2 * ks; tb < 8; ++tb) {
                const bf16x8 wf = *(const LAS bf16x8*)(lds + SG_W + (16 * tb + fr) * SG_WSTR + ks * 64 + fq * 16);
                acc[tb][0] = __builtin_amdgcn_mfma_f32_16x16x32_bf16(t0, wf, acc[tb][0], 0, 0, 0);
                acc[tb][1] = __builtin_amdgcn_mfma_f32_16x16x32_bf16(t1, wf, acc[tb][1], 0, 0, 0);
            }
        }
#pragma unroll
        for (int tb = 0; tb < 8; ++tb) {
            const int t = 16 * tb + fr;
            const float bb = bs[g * 128 + t];
            GAS bf16_t* up = U + (size_t)(row0 + t) * 2048 + g * 256 + 32 * w + 8 * fq;
            const f32x4 a = acc[tb][0] + bb, b = acc[tb][1] + bb;
            const f32x4 ya = (f32x4){a.x * bf_lo(uv[tb].x), a.y * bf_hi(uv[tb].x), a.z * bf_lo(uv[tb].y), a.w * bf_hi(uv[tb].y)};
            const f32x4 yb = (f32x4){b.x * bf_lo(uv[tb].z), b.y * bf_hi(uv[tb].z), b.z * bf_lo(uv[tb].w), b.w * bf_hi(uv[tb].w)};
            *(GAS u32x4*)up = pack8(ya, yb);
        }
    }
    __syncthreads();
}

constexpr int RT_K0 = 0, RT_KB = 65536, RT_ST = 131072, RT_STSTR = 528, RT_VT = RT_ST + 32 * RT_STSTR, RT_VTSTR = 288, RT_END = RT_VT + 32 * RT_VTSTR;
static_assert(RT_END <= LDS_MISC, "ret lds");
typedef short s16x4 __attribute__((ext_vector_type(4)));
__device__ __forceinline__ void ret_phase(const Frame& F, const GAS bf16_t* Q, const GAS bf16_t* Kn, GAS bf16_t* Vb, GAS float* hss) {
    LAS unsigned char* lds = F.lds;
    const int tid = opq_tid(), lane = tid & 63, w = __builtin_amdgcn_readfirstlane(tid >> 6), fr = lane & 15, fq = lane >> 4;
    const int jb = (w < 4) ? w : 11 - w;
    const int srow = tid >> 5, sslot = tid & 31, spiece = ((sslot & 15) ^ (srow & 15)) | (sslot & 16);
    const unsigned voffK = (unsigned)(srow * D + 8 * spiece) * 2u;
    int koffx[4];
#pragma unroll
    for (int k4 = 0; k4 < 4; ++k4) koffx[k4] = fr * 512 + ((((4 * k4 + fq) & 15) ^ fr) << 4);
    int troff[2][2];
#pragma unroll
    for (int db = 0; db < 2; ++db)
#pragma unroll
        for (int t = 0; t < 2; ++t) {
            const int q = fr >> 2, p = fr & 3, m = 8 * fq + 4 * t + q, c = 4 * w + 2 * db + (p >> 1);
            troff[db][t] = m * 512 + ((((c & 15) ^ (m & 15)) | (c & 16)) << 4) + 8 * (p & 1);
        }
    for (int item = F.vcu; item < 256; item += F.G) {
        const int es = item & 15, bh = item >> 4, h = bh & 3, b = bh >> 2;
        const float gam = 1.0f - __builtin_amdgcn_exp2f(-5.0f - (float)h);
        const float l2g = __builtin_amdgcn_logf(gam);
        const float cdec = __builtin_amdgcn_exp2f(128.0f * l2g);
        const size_t rowb = (size_t)b * SEQ;
        const GAS bf16_t* Qh = Q + rowb * D + h * 256;
        const GAS char* Kh = (const GAS char*)(Kn + rowb * D + h * 256);
        GAS bf16_t* Vh = Vb + rowb * 2048 + h * 512 + es * 32;
        GAS float* hs = hss + (rowb * RH + h) * 16 + es;
        __syncthreads();
        for (int i = tid; i < 32 * RT_STSTR / 4; i += 512) ((LAS unsigned*)(lds + RT_ST))[i] = 0u;
        f32x4 sst[2][2];
#pragma unroll
        for (int eb = 0; eb < 2; ++eb)
#pragma unroll
            for (int db = 0; db < 2; ++db) sst[eb][db] = (f32x4){0.f, 0.f, 0.f, 0.f};
#define RT_STAGE_K(buf, ci) do { _Pragma("unroll") for (int _i = 0; _i < 8; ++_i) \
            __builtin_amdgcn_global_load_lds((const GAS unsigned*)(Kh + (size_t)(ci) * 128 * D * 2 + (size_t)_i * 16 * D * 2 + voffK), (LAS unsigned*)(lds + (buf) + _i * 8192 + w * 1024), 16, 0, 0); } while (0)
        RT_STAGE_K(RT_K0, 0);
        const int vm = tid >> 2, vp = tid & 3;
        u32x4 vreg = *(const GAS u32x4*)(Vh + (size_t)vm * 2048 + vp * 8);
        bf16x8 qf[8];
#pragma unroll
        for (int ks = 0; ks < 8; ++ks) qf[ks] = *(const GAS bf16x8*)(Qh + (size_t)(16 * jb + fr) * D + 32 * ks + 8 * fq);
        {
            LAS bf16_t* vt = (LAS bf16_t*)(lds + RT_VT + (8 * vp) * RT_VTSTR) + vm;
#pragma unroll
            for (int q = 0; q < 4; ++q) { vt[(2 * q) * (RT_VTSTR / 2)] = (bf16_t)(vreg[q] & 0xffffu); vt[(2 * q + 1) * (RT_VTSTR / 2)] = (bf16_t)(vreg[q] >> 16); }
        }
        u32x2 pend_ow[2] = {(u32x2){0u, 0u}, (u32x2){0u, 0u}}; float pend_ss = 0.f;
        const int jrow = 16 * jb + fr;
        const float qdec = __builtin_amdgcn_exp2f(l2g * (float)(jrow + 1));
        const float pdec = __builtin_amdgcn_exp2f(l2g * (float)(jrow - 127));
#pragma unroll 1
        for (int ci = 0; ci < SEQ / RC; ++ci) {
            const int kbuf = (ci & 1) ? RT_KB : RT_K0;
            asm volatile("s_waitcnt vmcnt(0) lgkmcnt(0)" ::: "memory"); __builtin_amdgcn_s_barrier(); asm volatile("" ::: "memory");
            const bool more = ci + 1 < SEQ / RC;
#pragma unroll
            for (int ks = 0; ks < 8; ++ks) asm volatile("" : "+v"(qf[ks]));
            if (more) {
                if (ci & 1) RT_STAGE_K(RT_K0, ci + 1); else RT_STAGE_K(RT_KB, ci + 1);
                vreg = *(const GAS u32x4*)(Vh + (size_t)((ci + 1) * 128 + vm) * 2048 + vp * 8);
            }
            if (ci > 0) {
                const size_t row = (size_t)(ci - 1) * 128 + jrow;
#pragma unroll
                for (int eb = 0; eb < 2; ++eb) *(GAS u32x2*)(Vh + row * 2048 + 16 * eb + 4 * fq) = pend_ow[eb];
                if (fq == 0) hs[row * RH * 16] = pend_ss;
            }
            f32x4 oacc[2] = {(f32x4){0.f, 0.f, 0.f, 0.f}, (f32x4){0.f, 0.f, 0.f, 0.f}};
            {
                bf16x8 sf[2][8];
#pragma unroll
                for (int ks = 0; ks < 8; ++ks)
#pragma unroll
                    for (int eb = 0; eb < 2; ++eb) sf[eb][ks] = *(const LAS bf16x8*)(lds + RT_ST + (16 * eb + fr) * RT_STSTR + ks * 64 + fq * 16);
                __builtin_amdgcn_sched_barrier(0);
#pragma unroll
                for (int ks = 0; ks < 8; ++ks)
#pragma unroll
                    for (int eb = 0; eb < 2; ++eb) oacc[eb] = __builtin_amdgcn_mfma_f32_16x16x32_bf16(sf[eb][ks], qf[ks], oacc[eb], 0, 0, 0);
            }
            oacc[0] *= qdec; oacc[1] *= qdec;
#pragma unroll
            for (int kp = 0; kp < 4; ++kp) {
                if (2 * kp <= jb) {
                    const bool two = (2 * kp + 1 <= jb);
                    bf16x8 k0[8], k1[8];
#pragma unroll
                    for (int ks = 0; ks < 8; ++ks) k0[ks] = *(const LAS bf16x8*)(lds + kbuf + (2 * kp) * 8192 + koffx[ks & 3] + (ks >> 2) * 256);
                    if (two) {
#pragma unroll
                        for (int ks = 0; ks < 8; ++ks) k1[ks] = *(const LAS bf16x8*)(lds + kbuf + (2 * kp + 1) * 8192 + koffx[ks & 3] + (ks >> 2) * 256);
                    }
                    u32x2 vlo[2], vhi[2];
#pragma unroll
                    for (int eb = 0; eb < 2; ++eb) { const LAS unsigned char* vb = lds + RT_VT + (16 * eb + fr) * RT_VTSTR + (32 * kp + 4 * fq) * 2; vlo[eb] = *(const LAS u32x2*)vb; vhi[eb] = *(const LAS u32x2*)(vb + 32); }
                    __builtin_amdgcn_sched_barrier(0);
                    f32x4 s0 = (f32x4){0.f, 0.f, 0.f, 0.f}, s1 = (f32x4){0.f, 0.f, 0.f, 0.f};
#pragma unroll
                    for (int ks = 0; ks < 8; ++ks) s0 = __builtin_amdgcn_mfma_f32_16x16x32_bf16(k0[ks], qf[ks], s0, 0, 0, 0);
                    if (two) {
#pragma unroll
                        for (int ks = 0; ks < 8; ++ks) s1 = __builtin_amdgcn_mfma_f32_16x16x32_bf16(k1[ks], qf[ks], s1, 0, 0, 0);
                    }
                    s0 *= pdec; s1 *= pdec;
                    if (2 * kp == jb) {
#pragma unroll
                        for (int r = 0; r < 4; ++r) s0[r] = (4 * fq + r <= fr) ? s0[r] : 0.f;
                    }
                    if (2 * kp + 1 == jb) {
#pragma unroll
                        for (int r = 0; r < 4; ++r) s1[r] = (4 * fq + r <= fr) ? s1[r] : 0.f;
                    }
                    u32x4 pw; pw.x = pk2(s0[0], s0[1]); pw.y = pk2(s0[2], s0[3]); pw.z = pk2(s1[0], s1[1]); pw.w = pk2(s1[2], s1[3]);
                    const bf16x8 pf = __builtin_bit_cast(bf16x8, pw);
#pragma unroll
                    for (int eb = 0; eb < 2; ++eb) {
                        u32x4 vw; vw.x = vlo[eb].x; vw.y = vlo[eb].y; vw.z = vhi[eb].x; vw.w = vhi[eb].y;
                        oacc[eb] = __builtin_amdgcn_mfma_f32_16x16x32_bf16(__builtin_bit_cast(bf16x8, vw), pf, oacc[eb], 0, 0, 0);
                    }
                }
            }
            if (more) {
#pragma unroll
                for (int ks = 0; ks < 8; ++ks) qf[ks] = *(const GAS bf16x8*)(Qh + (size_t)((ci + 1) * 128 + 16 * jb + fr) * D + 32 * ks + 8 * fq);
            }
            {
                float ss = 0.f;
#pragma unroll
                for (int eb = 0; eb < 2; ++eb) {
                    pend_ow[eb].x = pk2(oacc[eb].x, oacc[eb].y); pend_ow[eb].y = pk2(oacc[eb].z, oacc[eb].w);
                    ss += (oacc[eb].x * oacc[eb].x + oacc[eb].y * oacc[eb].y) + (oacc[eb].z * oacc[eb].z + oacc[eb].w * oacc[eb].w);
                }
                ss += __shfl_xor(ss, 16); ss += __shfl_xor(ss, 32);
                pend_ss = ss;
            }
            bf16x8 vtn[2][4]; u32x2 kt[2][4][2];
#pragma unroll
            for (int eb = 0; eb < 2; ++eb)
#pragma unroll
                for (int ks = 0; ks < 4; ++ks) vtn[eb][ks] = *(const LAS bf16x8*)(lds + RT_VT + (16 * eb + fr) * RT_VTSTR + ks * 64 + fq * 16);
            {
                const unsigned a00 = (unsigned)(kbuf + troff[0][0]), a01 = (unsigned)(kbuf + troff[0][1]), a10 = (unsigned)(kbuf + troff[1][0]), a11 = (unsigned)(kbuf + troff[1][1]);
                asm volatile(
                    "ds_read_b64_tr_b16 %0, %16\n\t"  "ds_read_b64_tr_b16 %1, %17\n\t"
                    "ds_read_b64_tr_b16 %2, %16 offset:16384\n\t"  "ds_read_b64_tr_b16 %3, %17 offset:16384\n\t"
                    "ds_read_b64_tr_b16 %4, %16 offset:32768\n\t"  "ds_read_b64_tr_b16 %5, %17 offset:32768\n\t"
                    "ds_read_b64_tr_b16 %6, %16 offset:49152\n\t"  "ds_read_b64_tr_b16 %7, %17 offset:49152\n\t"
                    "ds_read_b64_tr_b16 %8, %18\n\t"  "ds_read_b64_tr_b16 %9, %19\n\t"
                    "ds_read_b64_tr_b16 %10, %18 offset:16384\n\t"  "ds_read_b64_tr_b16 %11, %19 offset:16384\n\t"
                    "ds_read_b64_tr_b16 %12, %18 offset:32768\n\t"  "ds_read_b64_tr_b16 %13, %19 offset:32768\n\t"
                    "ds_read_b64_tr_b16 %14, %18 offset:49152\n\t"  "ds_read_b64_tr_b16 %15, %19 offset:49152\n\t"
                    "s_waitcnt lgkmcnt(0)"
                    : "=&v"(kt[0][0][0]), "=&v"(kt[0][0][1]), "=&v"(kt[0][1][0]), "=&v"(kt[0][1][1]), "=&v"(kt[0][2][0]), "=&v"(kt[0][2][1]), "=&v"(kt[0][3][0]), "=&v"(kt[0][3][1]),
                      "=&v"(kt[1][0][0]), "=&v"(kt[1][0][1]), "=&v"(kt[1][1][0]), "=&v"(kt[1][1][1]), "=&v"(kt[1][2][0]), "=&v"(kt[1][2][1]), "=&v"(kt[1][3][0]), "=&v"(kt[1][3][1])
                    : "v"(a00), "v"(a01), "v"(a10), "v"(a11)
                    : "memory");
            }
            asm volatile("s_waitcnt lgkmcnt(0)" ::: "memory"); __builtin_amdgcn_s_barrier(); asm volatile("" ::: "memory");
#pragma unroll
            for (int eb = 0; eb < 2; ++eb)
#pragma unroll
                for (int db = 0; db < 2; ++db) {
                    sst[eb][db] *= cdec;
#pragma unroll
                    for (int ks = 0; ks < 4; ++ks) {
                        u32x4 kw; kw.x = kt[db][ks][0].x; kw.y = kt[db][ks][0].y; kw.z = kt[db][ks][1].x; kw.w = kt[db][ks][1].y;
                        sst[eb][db] = __builtin_amdgcn_mfma_f32_16x16x32_bf16(__builtin_bit_cast(bf16x8, kw), vtn[eb][ks], sst[eb][db], 0, 0, 0);
                    }
                    u32x2 sw; sw.x = pk2(sst[eb][db].x, sst[eb][db].y); sw.y = pk2(sst[eb][db].z, sst[eb][db].w);
                    *(LAS u32x2*)(lds + RT_ST + (16 * eb + fr) * RT_STSTR + (32 * w + 16 * db + 4 * fq) * 2) = sw;
                }
            __builtin_amdgcn_sched_barrier(0);
            if (more) {
                LAS bf16_t* vt = (LAS bf16_t*)(lds + RT_VT + (8 * vp) * RT_VTSTR) + vm;
#pragma unroll
                for (int q = 0; q < 4; ++q) { vt[(2 * q) * (RT_VTSTR / 2)] = (bf16_t)(vreg[q] & 0xffffu); vt[(2 * q + 1) * (RT_VTSTR / 2)] = (bf16_t)(vreg[q] >> 16); }
            }
        }
        {
            const size_t row = (size_t)(SEQ / RC - 1) * 128 + jrow;
#pragma unroll
            for (int eb = 0; eb < 2; ++eb) *(GAS u32x2*)(Vh + row * 2048 + 16 * eb + 4 * fq) = pend_ow[eb];
            if (fq == 0) hs[row * RH * 16] = pend_ss;
        }
#undef RT_STAGE_K
    }
    __syncthreads();
}

__device__ __forceinline__ void final_phase(const Frame& F, const GAS bf16_t* xb, GAS float* out, const GAS float* g) {
    const int tid_ = opq_tid(), lane_ = tid_ & 63, wave_ = __builtin_amdgcn_readfirstlane(tid_ >> 6);
    const int gw = F.vcu * 8 + wave_, NGW = F.G * 8;
    f32x4 gv[2][2];
#pragma unroll
    for (int j = 0; j < 2; ++j) { gv[j][0] = ((const GAS f32x4*)g)[2 * (lane_ + 64 * j)]; gv[j][1] = ((const GAS f32x4*)g)[2 * (lane_ + 64 * j) + 1]; }
    for (int row = 4 * gw; row < M; row += 4 * NGW) {
        u32x4 w[4][2];
#pragma unroll
        for (int r = 0; r < 4; ++r)
#pragma unroll
            for (int j = 0; j < 2; ++j) w[r][j] = ((const GAS u32x4*)(xb + (size_t)(row + r) * D))[lane_ + 64 * j];
#pragma unroll
        for (int r = 0; r < 4; ++r) {
            f32x4 v[2][2]; float s = 0.f;
#pragma unroll
            for (int j = 0; j < 2; ++j) { const u32x4 ww = w[r][j];
                v[j][0] = (f32x4){bf_lo(ww.x), bf_hi(ww.x), bf_lo(ww.y), bf_hi(ww.y)}; v[j][1] = (f32x4){bf_lo(ww.z), bf_hi(ww.z), bf_lo(ww.w), bf_hi(ww.w)};
                s += (v[j][0].x * v[j][0].x + v[j][0].y * v[j][0].y) + (v[j][0].z * v[j][0].z + v[j][0].w * v[j][0].w) + (v[j][1].x * v[j][1].x + v[j][1].y * v[j][1].y) + (v[j][1].z * v[j][1].z + v[j][1].w * v[j][1].w); }
            const float rs = rsqrtf(wave_sum(s) * (1.0f / D) + RMS_EPS);
            GAS f32x4* o = (GAS f32x4*)(out + (size_t)(row + r) * D) + 2 * lane_;
#pragma unroll
            for (int j = 0; j < 2; ++j) { o[128 * j] = v[j][0] * rs * gv[j][0]; o[128 * j + 1] = v[j][1] * rs * gv[j][1]; }
        }
    }
}

__global__ void __launch_bounds__(512, 2) trunk_fwd(Args args) {
    extern __shared__ __attribute__((aligned(16))) unsigned char lds_raw[];
    Frame F;
    F.lds = (LAS unsigned char*)lds_raw;
    F.tid = threadIdx.x; F.lane = F.tid & 63; F.wave = __builtin_amdgcn_readfirstlane(F.tid >> 6);
    F.G = gridDim.x; { const int bx = blockIdx.x; F.vcu = (F.G % 8 == 0) ? (bx % 8) * (F.G / 8) + bx / 8 : bx; }
    unsigned char* ws = args.ws;
    unsigned* ctl = (unsigned*)(ws + WS_CTL);
    volatile LAS unsigned* MISC = (volatile LAS unsigned*)(F.lds + LDS_MISC);
    for (int u = F.tid; u < (LDS_BYTES - LDS_MISC) / 4; u += 512) ((LAS unsigned*)(F.lds + LDS_MISC))[u] = 0u;
    __syncthreads();
    XcdBarrier bar = xcd_barrier_post(ctl + 4096 + args.li * XCD_BAR_WORDS, MISC + 8);
    const int lo = args.ph_lo, hi = args.ph_hi;
#define IN(k) (lo <= (k) && (k) < hi)
#define GRID_BAR(k) do { if (hi > (k) + 1) xcd_barrier(bar); } while (0)

    bf16_t* xb = (bf16_t*)(ws + WS_XB);
    float* ssq = (float*)(ws + WS_SSQ);

    if (IN(0)) { if (I8_F1_LAYERS) { p0_wabs(F, args); xcd_barrier(bar); } p0_prologue(F, args); GRID_BAR(0); }

#pragma unroll 1
    for (int L = 0; L < NLAYER; ++L) {
        const int pb = 1 + 6 * L;
        const int kind = (L == 1) ? 1 : (L == 2) ? 2 : 0;
        int pmo;
        const bf16_t* moA; const bf16_t* moB; int moK;
        if (kind == 0) {
            const int j = (L == 0) ? 0 : 1;
            bf16_t* Bo = (bf16_t*)(ws + AR_CB); bf16_t* CZ = (bf16_t*)(ws + AR_CZ); bf16_t* CY = (bf16_t*)(ws + AR_CY);
            if (IN(pb)) {
                pg8::Gemm g{opq(xb), opq((const bf16_t*)(ws + W_CI + j * W_CI_SZ)), M, 3072, 1024}; pg8::StaticOrder S; S.init(M, 3072, F.G, (int)blockIdx.x);
                EpiConvIn E{(const GAS float*)opq(ssq), (GAS bf16_t*)opq(Bo), (GAS bf16_t*)opq(CZ)};
                pg8::gemm_phase<EpiConvIn>(F.lds, g, S, E);
                GRID_BAR(pb);
            }
            if (IN(pb + 1)) { conv_phase(F, (const GAS bf16_t*)opq(Bo), (const GAS bf16_t*)opq(CZ), (const GAS float*)opq(args.in[5] + (size_t)j * 3 * D), (GAS bf16_t*)opq(CY)); GRID_BAR(pb + 1); }
            pmo = pb + 2; moA = CY; moB = (const bf16_t*)(ws + W_CO + j * W_CO_SZ); moK = 1024;
        } else if (kind == 1) {
            bf16_t* U = (bf16_t*)(ws + AR_SU); bf16_t* V = (bf16_t*)(ws + AR_SV); float* lnp = (float*)(ws + WS_LNP);
            {
            if (IN(pb)) {
                pg8::Gemm g{opq(xb), opq((const bf16_t*)(ws + W_SI)), M, 4096, 1024}; pg8::StaticOrder S; S.init(M, 4096, F.G, (int)blockIdx.x);
                EpiSguIn E{(const GAS float*)opq(ssq), (GAS bf16_t*)opq(U), (GAS bf16_t*)opq(V), (GAS float*)opq(lnp)};
                pg8::gemm_phase<EpiSguIn>(F.lds, g, S, E);
                GRID_BAR(pb);
            }
            if (IN(pb + 1)) { sgu_phase(F, (GAS bf16_t*)opq(U), (const GAS bf16_t*)opq(V), (const GAS float*)opq(lnp), (const GAS bf16_t*)opq((const bf16_t*)(ws + W_WS)), (const GAS float*)opq(args.in[8]), (const GAS float*)opq(args.in[9]), (const GAS float*)opq(args.in[11])); GRID_BAR(pb + 1); }
            }
            pmo = pb + 2; moA = U; moB = (const bf16_t*)(ws + W_SO); moK = 2048;
        } else {
            bf16_t* Q = (bf16_t*)(ws + AR_RQ); bf16_t* Kn = (bf16_t*)(ws + AR_RK); bf16_t* V = (bf16_t*)(ws + AR_RV);
            float* hss = args.out;
            {
            {
            if (IN(pb)) {
                pg8::Gemm g{opq(xb), opq((const bf16_t*)(ws + W_RQ)), M, 4096, 1024}; pg8::StaticOrder S; S.init(M, 4096, F.G, (int)blockIdx.x);
                EpiRetQkv E{(const GAS float*)opq(ssq), (const GAS float*)opq((const float*)(ws + WS_ROT)), (const GAS float*)opq((const float*)(ws + WS_ROT) + (size_t)SEQ * 128), (GAS bf16_t*)opq(Q), (GAS bf16_t*)opq(Kn), (GAS bf16_t*)opq(V)};
                pg8::gemm_phase<EpiRetQkv>(F.lds, g, S, E);
                GRID_BAR(pb);
            }
            if (IN(pb + 1)) { ret_phase(F, (const GAS bf16_t*)opq(Q), (const GAS bf16_t*)opq(Kn), (GAS bf16_t*)opq(V), (GAS float*)opq(hss)); GRID_BAR(pb + 1); }
            }
            if (IN(pb + 2)) {
                pg8::Gemm g{opq(xb), opq((const bf16_t*)(ws + W_RG)), M, 2048, 1024}; pg8::StaticOrder S; S.init(M, 2048, F.G, (int)blockIdx.x);
                EpiRetG E{(const GAS float*)opq(ssq), (const GAS float*)opq(hss), (GAS bf16_t*)opq(V)};
                pg8::gemm_phase<EpiRetG>(F.lds, g, S, E);
                GRID_BAR(pb + 2);
            }
            }
            pmo = pb + 3; moA = V; moB = (const bf16_t*)(ws + W_RO); moK = 2048;
        }
        if (IN(pmo)) {
            pg8::Gemm g{opq(moA), opq(moB), M, 1024, moK}; pg8::StaticOrder S; S.init(M, 1024, F.G, (int)blockIdx.x);
            EpiResid E{(GAS bf16_t*)opq(xb), (GAS float*)opq(ssq), 1.0f, ((F8_F1_LAYERS >> L) & 1) ? (GAS unsigned char*)opq(ws + WS_X8) : (GAS unsigned char*)nullptr};
            pg8::gemm_phase<EpiResid>(F.lds, g, S, E);
            GRID_BAR(pmo);
        }
        if (IN(pb + 4)) {
            if ((I8_F1_LAYERS >> L) & 1) {
                quant_phase(F, (const GAS bf16_t*)opq((const bf16_t*)xb), (GAS unsigned char*)opq(ws + WS_X8), (GAS float*)opq((float*)(ws + WS_SA)));
                xcd_barrier(bar);
                pg8::Gemm g{opq((const bf16_t*)(ws + WS_X8)), opq((const bf16_t*)(ws + W_FI + L * W_FI_SZ)), M, 2 * DFF, 1024 / 2}; pg8::StaticOrder S; S.init(M, 2 * DFF, F.G, (int)blockIdx.x);
                const float wsc = __builtin_bit_cast(float, xb_ld(ctl + 64 + L)) * (1.0f / 127.0f);
                EpiFfnIn E{(const GAS float*)opq(ssq), (GAS unsigned char*)opq(ws + AR_FA), ((F8_LAYERS >> L) & 1) != 0, wsc, (const GAS float*)opq((const float*)(ws + WS_SA)), true};
                pg8::gemm_phase<EpiFfnIn, true, true, false, true>(F.lds, g, S, E);
            } else if ((F8_F1_LAYERS >> L) & 1) {
                pg8::Gemm g{opq((const bf16_t*)(ws + WS_X8)), opq((const bf16_t*)(ws + W_FI + L * W_FI_SZ)), M, 2 * DFF, 1024 / 2}; pg8::StaticOrder S; S.init(M, 2 * DFF, F.G, (int)blockIdx.x);
                EpiFfnIn E{(const GAS float*)opq(ssq), (GAS unsigned char*)opq(ws + AR_FA), ((F8_LAYERS >> L) & 1) != 0, 1.0f / FI_WSCALE, (const GAS float*)nullptr, false};
                pg8::gemm_phase<EpiFfnIn, true, true, true>(F.lds, g, S, E);
            } else {
                pg8::Gemm g{opq(xb), opq((const bf16_t*)(ws + W_FI + L * W_FI_SZ)), M, 2 * DFF, 1024}; pg8::StaticOrder S; S.init(M, 2 * DFF, F.G, (int)blockIdx.x);
                EpiFfnIn E{(const GAS float*)opq(ssq), (GAS unsigned char*)opq(ws + AR_FA), ((F8_LAYERS >> L) & 1) != 0, 1.0f, (const GAS float*)nullptr, false};
                pg8::gemm_phase<EpiFfnIn>(F.lds, g, S, E);
            }
            GRID_BAR(pb + 4);
        }
        if (IN(pb + 5)) {
            if ((F8_LAYERS >> L) & 1) {
                pg8::Gemm g{opq((const bf16_t*)(ws + AR_FA)), opq((const bf16_t*)(ws + W_FD + L * W_FD_SZ)), M, 1024, DFF / 2}; pg8::StaticOrder S; S.init(M, 1024, F.G, (int)blockIdx.x);
                EpiResidT<2> E{(GAS bf16_t*)opq(xb), (GAS float*)opq(ssq), 1.0f / FD_WSCALE, (GAS unsigned char*)nullptr};
                pg8::gemm_phase<EpiResidT<2>, true, true, true>(F.lds, g, S, E);
            } else {
                pg8::Gemm g{opq((const bf16_t*)(ws + AR_FA)), opq((const bf16_t*)(ws + W_FD + L * W_FD_SZ)), M, 1024, DFF}; pg8::StaticOrder S; S.init(M, 1024, F.G, (int)blockIdx.x);
                EpiResid E{(GAS bf16_t*)opq(xb), (GAS float*)opq(ssq), 1.0f, (GAS unsigned char*)nullptr};
                pg8::gemm_phase<EpiResid>(F.lds, g, S, E);
            }
            GRID_BAR(pb + 5);
        }
    }
    if (IN(NPH - 1)) final_phase(F, (const GAS bf16_t*)opq((const bf16_t*)xb), (GAS float*)opq(args.out), (const GAS float*)opq(args.in[3]));
#undef IN
#undef GRID_BAR
}

extern "C" void kernel_launch(void* const* d_in, const int* in_sizes, int n_in, void* d_out, int out_size, void* d_ws, size_t ws_size, hipStream_t stream) {
    static int grid = 0;
    if (grid == 0) {
        if (n_in != 18 || out_size != M * D || ws_size < WS_END) { fprintf(stderr, "kernel_launch: unexpected shapes (n_in %d out %d ws %zu)\n", n_in, out_size, ws_size); grid = -1; return; }
        int dev = 0, cus = 0, per_cu = 0;
        if (hipGetDevice(&dev) != hipSuccess || hipDeviceGetAttribute(&cus, hipDeviceAttributeMultiprocessorCount, dev) != hipSuccess) { grid = -1; return; }
        if (hipFuncSetAttribute((const void*)trunk_fwd, hipFuncAttributeMaxDynamicSharedMemorySize, LDS_BYTES) != hipSuccess) { fprintf(stderr, "kernel_launch: hipFuncSetAttribute failed\n"); grid = -1; return; }
        if (hipOccupancyMaxActiveBlocksPerMultiprocessor(&per_cu, (const void*)trunk_fwd, 512, LDS_BYTES) != hipSuccess || per_cu < 1)
            fprintf(stderr, "kernel_launch: occupancy query reports %d\n", per_cu);
        (void)hipGetLastError();
        grid = cus;
    }
    if (grid < 0) return;
    (void)in_sizes;
    if (hipMemsetAsync((char*)d_ws + WS_CTL, 0, CTL_BYTES, stream) != hipSuccess) return;
    Args a{};
    for (int i = 0; i < 18; ++i) a.in[i] = (const float*)d_in[i];
    a.out = (float*)d_out; a.ws = (unsigned char*)d_ws; a.pad = 0;
#if MK_ONE_LAUNCH
    a.ph_lo = 0; a.ph_hi = NPH; a.li = 0;
    hipLaunchKernelGGL(trunk_fwd, dim3(grid), dim3(512), LDS_BYTES, stream, a);
#else
    int li = 0;
    for (int ph = 0; ph < NPH; ++ph) {
        const int r = (ph - 1) % 6, L = (ph - 1) / 6;
        if (ph >= 1 && ph < NPH - 1 && r == 3 && L != 2) continue;
        a.ph_lo = ph; a.ph_hi = ph + 1; a.li = li++;
        hipLaunchKernelGGL(trunk_fwd, dim3(grid), dim3(512), LDS_BYTES, stream, a);
    }
#endif
}
```

```cpp
#include <hip/hip_runtime.h>
#include <cstdio>
#include <cstdint>

#ifndef MK_ONE_LAUNCH
#define MK_ONE_LAUNCH 1
#endif

#define LAS __attribute__((address_space(3)))
#define GAS __attribute__((address_space(1)))
typedef unsigned short bf16_t;
typedef short bf16x8 __attribute__((ext_vector_type(8)));
typedef short bf16x4 __attribute__((ext_vector_type(4)));
typedef float f32x4 __attribute__((ext_vector_type(4)));
typedef float f32x2 __attribute__((ext_vector_type(2)));
typedef unsigned u32x4 __attribute__((ext_vector_type(4)));
typedef unsigned u32x2 __attribute__((ext_vector_type(2)));
typedef int i32x4 __attribute__((ext_vector_type(4)));
typedef int i32x8 __attribute__((ext_vector_type(8)));

constexpr int D = 1024, NB = 4, SEQ = 8192, M = NB * SEQ, DFF = 2816, NLAYER = 4;
constexpr int RH = 4, RQK = 256, RV = 512, RC = 128;
constexpr float RMS_EPS = 1e-6f, LN_EPS = 1e-5f;
constexpr int F8_LAYERS = 0xC;
constexpr bool I8_RET = true;
constexpr int I8_F1_LAYERS = 0xF;
constexpr int F8_F1_LAYERS = 0x0;
constexpr float FD_WSCALE = 64.0f, FI_WSCALE = 32.0f;
constexpr float WCLIP = 3.5f;
constexpr int CTL_WSS = 131072;

constexpr size_t MiB = 1u << 20;
constexpr size_t WS_CTL = 0, CTL_BYTES = 1 * MiB;
constexpr size_t WS_SSQ = 1 * MiB;
constexpr size_t WS_W = 3 * MiB;
constexpr size_t W_CI = WS_W, W_CI_SZ = (size_t)3072 * 1024 * 2;
constexpr size_t W_CO = W_CI + 2 * W_CI_SZ, W_CO_SZ = (size_t)1024 * 1024 * 2;
constexpr size_t W_SI = W_CO + 2 * W_CO_SZ, W_SI_SZ = (size_t)4096 * 1024 * 2;
constexpr size_t W_SO = W_SI + W_SI_SZ, W_SO_SZ = (size_t)1024 * 2048 * 2;
constexpr size_t W_RQ = W_SO + W_SO_SZ, W_RQ_SZ = (size_t)4096 * 1024 * 2;
constexpr size_t W_RG = W_RQ + W_RQ_SZ, W_RG_SZ = (size_t)2048 * 1024 * 2;
constexpr size_t W_RO = W_RG + W_RG_SZ, W_RO_SZ = (size_t)1024 * 2048 * 2;
constexpr size_t W_FI = W_RO + W_RO_SZ, W_FI_SZ = (size_t)5632 * 1024 * 2;
constexpr size_t W_FD = W_FI + 4 * W_FI_SZ, W_FD_SZ = (size_t)1024 * 2816 * 2;
constexpr size_t W_WS = W_FD + 4 * W_FD_SZ, W_WS_SZ = (size_t)8 * 128 * 128 * 2;
constexpr size_t WS_WEND = W_WS + W_WS_SZ;
static_assert(WS_WEND <= 114 * MiB, "weights");
constexpr size_t WS_ROT = 114 * MiB;
constexpr size_t WS_HSS = WS_ROT;
constexpr size_t WS_XB = 122 * MiB;
constexpr size_t WS_AR = 186 * MiB;
constexpr size_t WS_SA = 491 * MiB;
constexpr size_t WS_X8 = 458 * MiB;
constexpr size_t WS_KT = 442 * MiB;
constexpr size_t WS_LNP = WS_KT;
constexpr size_t WS_END = 506 * MiB;
constexpr size_t AR_CB = WS_AR, AR_CZ = WS_AR + 64 * MiB, AR_CY = WS_AR + 128 * MiB;
constexpr size_t AR_SU = WS_AR, AR_SV = WS_AR + 128 * MiB;
constexpr size_t AR_RQ = WS_AR, AR_RK = WS_AR + 64 * MiB, AR_RV = WS_AR + 128 * MiB;
constexpr size_t AR_FA = WS_AR;

constexpr int NPH = 26;
constexpr int LDS_BYTES = 159744;
constexpr int LDS_MISC = 159232;

#define RLX_AGENT __ATOMIC_RELAXED, __HIP_MEMORY_SCOPE_AGENT
__device__ __forceinline__ unsigned f2bf(float f) { unsigned u = __builtin_bit_cast(unsigned, f); return (u + 0x7fffu + ((u >> 16) & 1u)) >> 16; }
typedef __bf16 bf16v2 __attribute__((ext_vector_type(2)));
__device__ __forceinline__ unsigned pk2(float lo, float hi) { const f32x2 v = {lo, hi}; return __builtin_bit_cast(unsigned, __builtin_convertvector(v, bf16v2)); }
__device__ __forceinline__ float bf_lo(unsigned w) { return __builtin_bit_cast(float, w << 16); }
__device__ __forceinline__ float bf_hi(unsigned w) { return __builtin_bit_cast(float, w & 0xffff0000u); }
__device__ __forceinline__ float wave_max(float v) {
#pragma unroll
    for (int o = 1; o < 64; o <<= 1) v = fmaxf(v, __shfl_xor(v, o));
    return v;
}
__device__ __forceinline__ float wave_sum(float v) {
#pragma unroll
    for (int o = 1; o < 64; o <<= 1) v += __shfl_xor(v, o);
    return v;
}
template <class T> __device__ __forceinline__ T* opq(T* p) { asm volatile("" : "+s"(p)); return p; }
__device__ __forceinline__ int opq_tid() { int t = threadIdx.x; asm volatile("" : "+v"(t)); return t; }
__device__ __forceinline__ float fast_rcp(float x) { return __builtin_amdgcn_rcpf(x); }
__device__ __forceinline__ float silu_f(float x) { return x * fast_rcp(1.0f + __builtin_amdgcn_exp2f(-1.44269504089f * x)); }

#define XB_TMO      128
#define XB_XCNT(j)  (256  + 64 * (j))
#define XB_XSUB(j)  (1280 + 64 * (j))
#define XB_XGEN(j)  (2304 + 64 * (j))
#define XB_TOP      3328
#define XB_TOPGEN   3392
#define XCD_BAR_WORDS 3456
#define XB_SPIN_CAP (1u << 18)
__device__ __forceinline__ unsigned xb_ld(unsigned* p)              { return __hip_atomic_load(p, __ATOMIC_RELAXED, __HIP_MEMORY_SCOPE_AGENT); }
__device__ __forceinline__ unsigned xb_add(unsigned* p, unsigned v) { return __hip_atomic_fetch_add(p, v, __ATOMIC_RELAXED, __HIP_MEMORY_SCOPE_AGENT); }
__device__ __forceinline__ unsigned xb_xcc_id() { return (unsigned)__builtin_amdgcn_s_getreg((3 << 11) | 20) & 0xFu; }
#define XB_SPIN(cond, bar) do { unsigned _sp = 0; while (cond) { __builtin_amdgcn_s_sleep(1); \
    if ((++_sp & 255u) == 0u) { if (xb_ld(&(bar)[XB_TMO])) break; if (_sp > XB_SPIN_CAP) { atomicAdd(&(bar)[XB_TMO], 1u); break; } } } } while (0)
struct XcdBarrier { unsigned* bar; unsigned x; volatile LAS unsigned* st; };
__device__ __forceinline__ XcdBarrier xcd_barrier_post(unsigned* bar, volatile LAS unsigned* st) {
    XcdBarrier b; b.bar = bar; b.x = xb_xcc_id(); b.st = st;
    if (threadIdx.x == 0) (void)xb_add(&bar[XB_XCNT(b.x)], 1u);
    return b;
}
__device__ __forceinline__ void xcd_barrier_complete(unsigned* bar, unsigned x, unsigned& nloc, unsigned& nx) {
    const unsigned G = gridDim.x * gridDim.y * gridDim.z;
    unsigned sum, cnt, mine, sp = 0u;
    for (;;) {
        sum = 0u; cnt = 0u; mine = 0u;
#pragma unroll
        for (unsigned j = 0; j < 16; ++j) { const unsigned c = xb_ld(&bar[XB_XCNT(j)]); sum += c; cnt += (c > 0u) ? 1u : 0u; mine = (j == x) ? c : mine; }
        if (sum == G) break;
        __builtin_amdgcn_s_sleep(1);
        if ((++sp & 255u) == 0u) { if (xb_ld(&bar[XB_TMO])) break; if (sp > XB_SPIN_CAP) { atomicAdd(&bar[XB_TMO], 1u); break; } }
    }
    nloc = mine > 0u ? mine : 1u; nx = cnt > 0u ? cnt : 1u;
}
__device__ __forceinline__ void xcd_barrier(const XcdBarrier& b) {
    asm volatile("s_waitcnt vmcnt(0)" ::: "memory");
    __syncthreads();
    if (threadIdx.x == 0) {
        unsigned* bar = b.bar;
        __builtin_amdgcn_s_waitcnt(0);
        unsigned nloc = b.st[0], nx = b.st[1];
        if (nloc == 0u) { xcd_barrier_complete(bar, b.x, nloc, nx); b.st[0] = nloc; b.st[1] = nx; }
        const unsigned old = xb_add(&bar[XB_XSUB(b.x)], 1u);
        const unsigned gen = old / nloc;
        if (old + 1u == (gen + 1u) * nloc) {
            __builtin_amdgcn_fence(__ATOMIC_RELEASE, "agent");
            asm volatile("s_waitcnt vmcnt(0)" ::: "memory");
            const unsigned og = xb_add(&bar[XB_TOP], 1u);
            const unsigned tg = og / nx;
            if (og + 1u == (tg + 1u) * nx) xb_add(&bar[XB_TOPGEN], 1u);
            else XB_SPIN(xb_ld(&bar[XB_TOPGEN]) == tg, bar);
            __builtin_amdgcn_fence(__ATOMIC_ACQUIRE, "agent");
            xb_add(&bar[XB_XGEN(b.x)], 1u);
            asm volatile("s_waitcnt vmcnt(0)" ::: "memory");
        } else {
            XB_SPIN(xb_ld(&bar[XB_XGEN(b.x)]) == gen, bar);
            __builtin_amdgcn_fence(__ATOMIC_ACQUIRE, "agent");
            asm volatile("s_waitcnt vmcnt(0)" ::: "memory");
        }
    }
    __syncthreads();
}

namespace pg8 {
constexpr int BM = 256, BK = 64, HALF = 128, HTB = HALF * BK * 2, STAGE_BYTES = 8 * HTB, NXCD = 8, WGM = 8;
__host__ __device__ __forceinline__ int lds_byte(int r, int c) { const int st = (r >> 4) * 2 + (c >> 5), rr = r & 15, cc = c & 31, ob = rr * 64 + cc * 2; return st * 1024 + (ob ^ (((ob >> 9) & 1) << 5)); }
__host__ __device__ __forceinline__ void stage_rc(int b, int& R, int& C) { const int st = b / 1024, sb = b % 1024, swz = sb ^ (((sb >> 9) & 1) << 5); R = (st >> 1) * 16 + swz / 64; C = (st & 1) * 32 + (swz % 64) / 2; }
__host__ __device__ __forceinline__ int perm32(int rho) { const int n = rho >> 4, i = rho & 15; return 8 * (i >> 2) + 4 * n + (i & 3); }

struct Unit { int pm, pn; };
struct Gemm { const bf16_t* A; const bf16_t* Bt; int M, N, K; };
struct StaticOrder {
    int nM, nN, nwg, G, c;
    __host__ __device__ void init(int M_, int N_, int G_, int c_) { nM = M_ / BM; nN = N_ / BM; nwg = nM * nN; G = G_; c = c_; }
    __host__ __device__ bool next(int i, Unit& u) const {
        const long L = (long)i * G + c; if (L >= nwg) return false;
        int wgid = (int)L; { const int q = nwg / NXCD, r = nwg % NXCD, xcd = wgid % NXCD, off = wgid / NXCD; wgid = (xcd < r ? xcd * (q + 1) : r * (q + 1) + (xcd - r) * q) + off; }
        const int nig = WGM * nN, gid = wgid / nig, fm = gid * WGM, gsz = (nM - fm) < WGM ? (nM - fm) : WGM;
        u.pm = fm + ((wgid % nig) % gsz); u.pn = (wgid % nig) / gsz; return true;
    }
};

template <class E_> __device__ __forceinline__ auto rowsc_of(const E_& e, int) -> decltype(e.rowsc) { return e.rowsc; }
template <class E_> __device__ __forceinline__ const GAS float* rowsc_of(const E_&, long) { return nullptr; }
template <class E_> __device__ __forceinline__ auto tsc_of(const E_& e, int) -> decltype(e.tsc) { return e.tsc; }
template <class E_> __device__ __forceinline__ float tsc_of(const E_&, long) { return 1.0f; }
template <class Epi, bool ALIGN_EPI = true, bool SP2 = true, bool F8 = false, bool I8 = false, bool CVT = false>
__device__ __forceinline__ void gemm_phase(LAS unsigned char* lds, const Gemm g, const StaticOrder& S, const Epi& E) {
    const int tid = opq_tid(), wid = __builtin_amdgcn_readfirstlane(tid >> 6), lane = tid & 63, wr = wid >> 2, wc = wid & 3, fr = lane & 15, fq = lane >> 4;
    const int K = g.K, nt = K / BK;
    unsigned voffA[2];
#pragma unroll
    for (int i = 0; i < 2; ++i) { int R, C; stage_rc(tid * 16 + i * 8192, R, C); voffA[i] = (unsigned)(R * K + C) * 2u; }
    const size_t kstep = (size_t)(BK * 2);
    const size_t hstep = (size_t)HALF * K * 2;
    const size_t tstep = 2 * hstep;
    const unsigned ldsw = (unsigned)wid * 1024u;
    const int aoff = lds_byte(wr * 64 + fr, fq * 8), boff = lds_byte(wc * 32 + fr, fq * 8);
#define PG8_SA(b, h) (((b) * 2 + (h)) * HTB)
#define PG8_SB(b, h) ((4 + (b) * 2 + (h)) * HTB)
#define PG8_STAGE(bufoff, gbase, voff) do { _Pragma("unroll") for (int _i = 0; _i < 2; ++_i) \
        __builtin_amdgcn_global_load_lds((const unsigned*)((const char*)(gbase) + (voff)[_i]), (LAS unsigned*)(lds + (bufoff) + ldsw + _i * 8192), 16, 0, 0); } while (0)
#define PG8_LDA(dst, b, h) do { _Pragma("unroll") for (int m = 0; m < 4; ++m) _Pragma("unroll") for (int k = 0; k < 2; ++k) dst[m][k] = *(const LAS bf16x8*)(lds + PG8_SA(b, h) + aoff + m * 2048 + k * 1024); } while (0)
#define PG8_LDB(dst, b, h) do { _Pragma("unroll") for (int n = 0; n < 2; ++n) _Pragma("unroll") for (int k = 0; k < 2; ++k) dst[n][k] = *(const LAS bf16x8*)(lds + PG8_SB(b, h) + boff + n * 2048 + k * 1024); } while (0)
#define PG8_CAT8(lo, hi) __builtin_shufflevector(__builtin_bit_cast(i32x4, lo), __builtin_bit_cast(i32x4, hi), 0, 1, 2, 3, 4, 5, 6, 7)
#define PG8_MMA(ai, bj, At, Bt) do { __builtin_amdgcn_s_setprio(1); _Pragma("unroll") for (int m = 0; m < 4; ++m) _Pragma("unroll") for (int n = 0; n < 2; ++n) { \
        if constexpr (F8) { const i32x8 b8_ = PG8_CAT8(Bt[n][0], Bt[n][1]), a8_ = PG8_CAT8(At[m][0], At[m][1]); asm volatile("v_mfma_f32_16x16x128_f8f6f4 %0, %1, %2, %0" : "+v"(acc[ai][bj][m][n]) : "v"(b8_), "v"(a8_)); } \
        else if constexpr (I8) { _Pragma("unroll") for (int k = 0; k < 2; ++k) acc[ai][bj][m][n] = __builtin_bit_cast(f32x4, __builtin_amdgcn_mfma_i32_16x16x64_i8(__builtin_bit_cast(i32x4, Bt[n][k]), __builtin_bit_cast(i32x4, At[m][k]), __builtin_bit_cast(i32x4, acc[ai][bj][m][n]), 0, 0, 0)); } \
        else { _Pragma("unroll") for (int k = 0; k < 2; ++k) acc[ai][bj][m][n] = __builtin_amdgcn_mfma_f32_16x16x32_bf16(Bt[n][k], At[m][k], acc[ai][bj][m][n], 0, 0, 0); } } __builtin_amdgcn_s_setprio(0); } while (0)
#define PG8_WAIT_V(n) asm volatile("s_waitcnt vmcnt(" #n ")" ::: "memory")
#define PG8_WAIT_L(n) asm volatile("s_waitcnt lgkmcnt(" #n ")" ::: "memory")
#define PG8_BAR __builtin_amdgcn_s_barrier()
#define PG8_SCHED __builtin_amdgcn_sched_barrier(0)
    LAS int* utab = (LAS int*)(lds + LDS_MISC + 128);
    if (tid < 16) { Unit tu; tu.pm = 0; tu.pn = 0; const bool ok = S.next(tid, tu); utab[2 * tid] = ok ? tu.pm : -1; utab[2 * tid + 1] = tu.pn; }
    __syncthreads();
#define PG8_NEXT(i, u) ((i) < 16 && ((u).pm = __builtin_amdgcn_readfirstlane(utab[2 * (i)]), (u).pn = __builtin_amdgcn_readfirstlane(utab[2 * (i) + 1]), (u).pm >= 0))
    Unit cur, nxt; int ui = 0;
    if (!PG8_NEXT(0, cur)) return;
    const char* cA = (const char*)g.A + (size_t)cur.pm * tstep; const char* cB = (const char*)g.Bt + (size_t)cur.pn * tstep;
    if constexpr (SP2) {
        PG8_STAGE(PG8_SB(0, 0), cB, voffA); PG8_STAGE(PG8_SB(0, 1), cB + hstep, voffA); PG8_STAGE(PG8_SA(0, 0), cA, voffA); PG8_STAGE(PG8_SA(0, 1), cA + hstep, voffA);
    }
    if constexpr (Epi::NEEDS_RS) {
        LAS float* rst = (LAS float*)(lds + STAGE_BYTES);
        const GAS float* rsc = rowsc_of(E, 0); const float tsc = tsc_of(E, 0);
        for (int q = tid; q < 16 * 256; q += 512) { const int i = q >> 8, r = q & 255, pm = utab[2 * i];
            if (pm >= 0) { const GAS f32x4* p = (const GAS f32x4*)(E.ssq + (size_t)(pm * 256 + r) * 16); const f32x4 a0 = p[0], a1 = p[1], a2 = p[2], a3 = p[3];
                const float xs = (rsc ? rsc[pm * 256 + r] : 1.0f) * tsc;
                rst[q] = xs * rsqrtf((((a0.x + a0.y) + (a0.z + a0.w)) + ((a1.x + a1.y) + (a1.z + a1.w)) + ((a2.x + a2.y) + (a2.z + a2.w)) + ((a3.x + a3.y) + (a3.z + a3.w))) * (1.0f / D) + RMS_EPS); } }
        if constexpr (Epi::NEEDS_RH) {
            LAS float* rht = (LAS float*)(lds + STAGE_BYTES + 16384);
            for (int q = tid; q < 8 * 256; q += 512) { const int i = q >> 8, r = q & 255, pm = utab[2 * i], hh = utab[2 * i + 1] >> 1;
                if (pm >= 0) { const GAS f32x4* p = (const GAS f32x4*)(E.hss + ((size_t)(pm * 256 + r) * RH + hh) * 16); const f32x4 a0 = p[0], a1 = p[1], a2 = p[2], a3 = p[3];
                    rht[q] = rsqrtf((((a0.x + a0.y) + (a0.z + a0.w)) + ((a1.x + a1.y) + (a1.z + a1.w)) + ((a2.x + a2.y) + (a2.z + a2.w)) + ((a3.x + a3.y) + (a3.z + a3.w))) * (1.0f / RV) + RMS_EPS); } }
        }
        __syncthreads();
    }
    f32x4 acc[2][2][4][2];
#define PG8_ZERO_ACC do { bf16x8 z_ = (bf16x8){0, 0, 0, 0, 0, 0, 0, 0}; asm volatile("" : "+v"(z_)); \
        _Pragma("unroll") for (int a = 0; a < 2; ++a) _Pragma("unroll") for (int b = 0; b < 2; ++b) _Pragma("unroll") for (int m = 0; m < 4; ++m) _Pragma("unroll") for (int n = 0; n < 2; ++n) \
            acc[a][b][m][n] = __builtin_amdgcn_mfma_f32_16x16x32_bf16(z_, z_, (f32x4){0.f, 0.f, 0.f, 0.f}, 0, 0, 0); } while (0)
    PG8_ZERO_ACC;
    bf16x8 At[4][2], B0[2][2], B1[2][2];
    if constexpr (SP2) {
        if (wr == 1) PG8_BAR;
        PG8_WAIT_V(2); PG8_BAR;
        PG8_STAGE(PG8_SB(1, 0), cB + kstep, voffA); PG8_STAGE(PG8_SA(1, 0), cA + kstep, voffA); PG8_STAGE(PG8_SB(1, 1), cB + hstep + kstep, voffA);
        PG8_WAIT_V(6); PG8_BAR;
    } else {
        PG8_STAGE(PG8_SB(0, 0), cB, voffA); PG8_STAGE(PG8_SA(0, 0), cA, voffA); PG8_STAGE(PG8_SB(0, 1), cB + hstep, voffA); PG8_STAGE(PG8_SA(0, 1), cA + hstep, voffA);
        if (wr == 1) PG8_BAR;
        PG8_WAIT_V(4); PG8_BAR;
        PG8_STAGE(PG8_SB(1, 0), cB + kstep, voffA); PG8_STAGE(PG8_SA(1, 0), cA + kstep, voffA); PG8_STAGE(PG8_SB(1, 1), cB + hstep + kstep, voffA);
        PG8_WAIT_V(6); PG8_BAR;
    }
    for (;;) {
        const bool has_next = PG8_NEXT(ui + 1, nxt);
        const char* nA = has_next ? (const char*)g.A + (size_t)nxt.pm * tstep : cA; const char* nB = has_next ? (const char*)g.Bt + (size_t)nxt.pn * tstep : cB;
        __builtin_amdgcn_s_waitcnt(0xC07F);
        for (int t = 0; t < nt; t += 2) {
            const bool last = (t == nt - 2);
            const char* a1 = cA + (size_t)(t + 1) * kstep;
            const char* a2 = last ? nA : cA + (size_t)(t + 2) * kstep; const char* b2 = last ? nB : cB + (size_t)(t + 2) * kstep;
            const char* a3 = a2 + kstep; const char* b3 = b2 + kstep;
            if constexpr (SP2) {
            PG8_LDB(B0, 0, 0); PG8_LDB(B1, 0, 1); PG8_SCHED; PG8_LDA(At, 0, 0); PG8_STAGE(PG8_SA(1, 1), a1 + hstep, voffA);
            PG8_WAIT_V(8); PG8_WAIT_L(0); PG8_BAR; PG8_MMA(0, 0, At, B0); PG8_MMA(0, 1, At, B1); PG8_BAR; PG8_SCHED;
            PG8_LDA(At, 0, 1); PG8_STAGE(PG8_SB(0, 0), b2, voffA); PG8_STAGE(PG8_SB(0, 1), b2 + hstep, voffA); PG8_STAGE(PG8_SA(0, 0), a2, voffA);
            PG8_WAIT_V(8); PG8_WAIT_L(0); PG8_BAR; PG8_MMA(1, 0, At, B0); PG8_MMA(1, 1, At, B1); PG8_BAR; PG8_SCHED;
            PG8_LDB(B0, 1, 0); PG8_LDB(B1, 1, 1); PG8_SCHED; PG8_LDA(At, 1, 0); PG8_STAGE(PG8_SA(0, 1), a2 + hstep, voffA);
            PG8_WAIT_V(8); PG8_WAIT_L(0); PG8_BAR; PG8_MMA(0, 0, At, B0); PG8_MMA(0, 1, At, B1); PG8_BAR; PG8_SCHED;
            PG8_LDA(At, 1, 1); PG8_STAGE(PG8_SB(1, 0), b3, voffA); PG8_STAGE(PG8_SB(1, 1), b3 + hstep, voffA); PG8_STAGE(PG8_SA(1, 0), a3, voffA);
            PG8_WAIT_V(8); PG8_WAIT_L(0); PG8_BAR; PG8_MMA(1, 0, At, B0); PG8_MMA(1, 1, At, B1); PG8_BAR; PG8_SCHED;
            } else {
            PG8_LDB(B0, 0, 0); PG8_SCHED; PG8_LDA(At, 0, 0); PG8_STAGE(PG8_SA(1, 1), a1 + hstep, voffA);
            PG8_WAIT_L(8); PG8_BAR; PG8_WAIT_L(0); PG8_MMA(0, 0, At, B0); PG8_BAR; PG8_SCHED;
            PG8_LDB(B1, 0, 1); PG8_STAGE(PG8_SB(0, 0), b2, voffA);
            PG8_BAR; PG8_WAIT_L(0); PG8_MMA(0, 1, At, B1); PG8_BAR;
            PG8_LDA(At, 0, 1); PG8_STAGE(PG8_SA(0, 0), a2, voffA);
            PG8_BAR; PG8_WAIT_L(0); PG8_MMA(1, 0, At, B0); PG8_BAR; PG8_SCHED;
            PG8_STAGE(PG8_SB(0, 1), b2 + hstep, voffA);
            PG8_WAIT_V(6); PG8_BAR; PG8_MMA(1, 1, At, B1); PG8_BAR;
            PG8_LDB(B0, 1, 0); PG8_SCHED; PG8_LDA(At, 1, 0); PG8_STAGE(PG8_SA(0, 1), a2 + hstep, voffA);
            PG8_WAIT_L(8); PG8_BAR; PG8_WAIT_L(0); PG8_MMA(0, 0, At, B0); PG8_BAR; PG8_SCHED;
            PG8_LDB(B1, 1, 1); PG8_STAGE(PG8_SB(1, 0), b3, voffA);
            PG8_BAR; PG8_WAIT_L(0); PG8_MMA(0, 1, At, B1); PG8_BAR;
            PG8_LDA(At, 1, 1); PG8_STAGE(PG8_SA(1, 0), a3, voffA);
            PG8_BAR; PG8_WAIT_L(0); PG8_MMA(1, 0, At, B0); PG8_BAR; PG8_SCHED;
            PG8_STAGE(PG8_SB(1, 1), b3 + hstep, voffA);
            PG8_WAIT_V(6); PG8_BAR; PG8_MMA(1, 1, At, B1); PG8_BAR;
            }
        }
        if constexpr (ALIGN_EPI) { if (wr == 0) PG8_BAR; }
        if constexpr (F8) asm volatile("s_nop 15\n\ts_nop 7" ::: "memory");
        if constexpr (CVT) {
#pragma unroll
            for (int a = 0; a < 2; ++a)
#pragma unroll
                for (int b = 0; b < 2; ++b)
#pragma unroll
                    for (int m = 0; m < 4; ++m)
#pragma unroll
                        for (int n = 0; n < 2; ++n) acc[a][b][m][n] = __builtin_convertvector(__builtin_bit_cast(i32x4, acc[a][b][m][n]), f32x4);
        }
        { int efr = fr, efq = fq; asm volatile("" : "+v"(efr), "+v"(efq));
          E(acc, cur, wr, wc, efr, efq, (const LAS float*)(lds + STAGE_BYTES) + ui * 256 + wr * 64 + efr); }
        if (!has_next) break;
        PG8_ZERO_ACC;
        cur = nxt; cA = nA; cB = nB; ++ui;
        if constexpr (ALIGN_EPI) { if (wr == 1) PG8_BAR; }
    }
    PG8_WAIT_V(0);
    if constexpr (!ALIGN_EPI) { if (wr == 0) PG8_BAR; }
    PG8_BAR;
#undef PG8_NEXT
#undef PG8_SA
#undef PG8_SB
#undef PG8_STAGE
#undef PG8_LDA
#undef PG8_LDB
#undef PG8_MMA
#undef PG8_CAT8
#undef PG8_ZERO_ACC
#undef PG8_WAIT_V
#undef PG8_WAIT_L
#undef PG8_BAR
#undef PG8_SCHED
}
}

typedef f32x4 Acc[2][2][4][2];
__device__ __forceinline__ u32x4 pack8(const f32x4 a, const f32x4 b) { u32x4 w; w.x = pk2(a.x, a.y); w.y = pk2(a.z, a.w); w.z = pk2(b.x, b.y); w.w = pk2(b.z, b.w); return w; }
__device__ __forceinline__ void row_scales(const GAS float* part, size_t stride, int row0, int fq, float inv_n, float eps, float (&sc)[8]) {
    f32x4 v[8];
#pragma unroll
    for (int k = 0; k < 8; ++k) v[k] = *(const GAS f32x4*)(part + (size_t)(row0 + (k >> 2) * 128 + (k & 3) * 16) * stride + 4 * fq);
#pragma unroll
    for (int k = 0; k < 8; ++k) { float t = (v[k].x + v[k].y) + (v[k].z + v[k].w); t += __shfl_xor(t, 16); t += __shfl_xor(t, 32); sc[k] = rsqrtf(t * inv_n + eps); }
}

struct EpiConvIn {
    static constexpr bool NEEDS_RS = true, NEEDS_RH = false;
    const GAS float* ssq; GAS bf16_t* Bo; GAS bf16_t* CZ;
    __device__ __forceinline__ void operator()(const Acc& acc, const pg8::Unit& u, int wr, int wc, int fr, int fq, const LAS float* rst) const {
        const int row0 = u.pm * 256 + wr * 64 + fr;
        float rs[8];
#pragma unroll
        for (int k = 0; k < 8; ++k) rs[k] = rst[(k >> 2) * 128 + (k & 3) * 16];
#pragma unroll
        for (int ai = 0; ai < 2; ++ai)
#pragma unroll
            for (int m = 0; m < 4; ++m) {
                const int row = row0 + ai * 128 + m * 16; const float r1 = rs[4 * ai + m];
                if (u.pn < 4) {
#pragma unroll
                    for (int bj = 0; bj < 2; ++bj)
                        *(GAS u32x4*)(Bo + (size_t)row * D + u.pn * 256 + bj * 128 + wc * 32 + fq * 8) = pack8(acc[ai][bj][m][0] * r1, acc[ai][bj][m][1] * r1);
                } else {
                    const float r2 = r1 * r1;
                    const f32x4 p0 = acc[ai][0][m][0] * acc[ai][0][m][1] * r2, p1 = acc[ai][1][m][0] * acc[ai][1][m][1] * r2;
                    *(GAS u32x4*)(CZ + (size_t)row * D + (u.pn - 4) * 128 + wc * 32 + fq * 8) = pack8(p0, p1);
                }
            }
    }
};
struct EpiFfnIn {
    static constexpr bool NEEDS_RS = true, NEEDS_RH = false;
    const GAS float* ssq; GAS unsigned char* ACT; bool f8; float isc; const GAS float* rowsc; bool i8;
    __device__ __forceinline__ void operator()(const Acc& acc, const pg8::Unit& u, int wr, int wc, int fr, int fq, const LAS float* rst) const {
        const int row0 = u.pm * 256 + wr * 64 + fr;
        float rs[8];
#pragma unroll
        for (int k = 0; k < 8; ++k) rs[k] = rst[(k >> 2) * 128 + (k & 3) * 16];
#pragma unroll
        for (int ai = 0; ai < 2; ++ai)
#pragma unroll
            for (int m = 0; m < 4; ++m) {
                const int row = row0 + ai * 128 + m * 16; const float r1 = rs[4 * ai + m] * isc;
                const float c1 = -1.44269504089f * r1, r2 = r1 * r1;
                f32x2 g[4], p[4], e[4];
#pragma unroll
                for (int bj = 0; bj < 2; ++bj) { f32x4 gt = acc[ai][bj][m][0], up = acc[ai][bj][m][1];
                    if (i8) { gt = __builtin_convertvector(__builtin_bit_cast(i32x4, gt), f32x4); up = __builtin_convertvector(__builtin_bit_cast(i32x4, up), f32x4); }
                    g[2 * bj] = (f32x2){gt.x, gt.y}; g[2 * bj + 1] = (f32x2){gt.z, gt.w};
                    p[2 * bj] = (f32x2){gt.x, gt.y} * (f32x2){up.x, up.y}; p[2 * bj + 1] = (f32x2){gt.z, gt.w} * (f32x2){up.z, up.w}; }
#pragma unroll
                for (int k = 0; k < 4; ++k) { const f32x2 t = g[k] * c1; e[k].x = __builtin_amdgcn_exp2f(t.x); e[k].y = __builtin_amdgcn_exp2f(t.y); }
#pragma unroll
                for (int k = 0; k < 4; ++k) { const f32x2 d = e[k] + 1.0f; e[k].x = __builtin_amdgcn_rcpf(d.x); e[k].y = __builtin_amdgcn_rcpf(d.y); }
#pragma unroll
                for (int k = 0; k < 4; ++k) p[k] = (p[k] * r2) * e[k];
                const size_t eoff = (size_t)row * DFF + u.pn * 128 + wc * 32 + fq * 8;
                if (f8) {
                    u32x2 w;
                    w.x = (unsigned)__builtin_amdgcn_cvt_pk_fp8_f32(p[1].x, p[1].y, __builtin_amdgcn_cvt_pk_fp8_f32(p[0].x, p[0].y, 0, false), true);
                    w.y = (unsigned)__builtin_amdgcn_cvt_pk_fp8_f32(p[3].x, p[3].y, __builtin_amdgcn_cvt_pk_fp8_f32(p[2].x, p[2].y, 0, false), true);
                    __builtin_nontemporal_store(w, (GAS u32x2*)(ACT + eoff));
                } else {
                    u32x4 w; w.x = pk2(p[0].x, p[0].y); w.y = pk2(p[1].x, p[1].y); w.z = pk2(p[2].x, p[2].y); w.w = pk2(p[3].x, p[3].y);
                    __builtin_nontemporal_store(w, (GAS u32x4*)(ACT + 2 * eoff));
                }
            }
    }
};
__device__ __forceinline__ f32x2 gelu_pk(f32x2 v) {
    const f32x2 av = __builtin_elementwise_abs(v), d = av * 0.2316418882f + 1.0f;
    f32x2 t; t.x = __builtin_amdgcn_rcpf(d.x); t.y = __builtin_amdgcn_rcpf(d.y);
    f32x2 q = t * 0.5307027145f + (-0.7265760135f); q = q * t + 0.7107068705f; q = q * t + (-0.142248368f); q = q * t + 0.127414796f; q = q * t;
    const f32x2 s = (v * v) * (-0.72134752044f);
    f32x2 e; e.x = __builtin_amdgcn_exp2f(s.x); e.y = __builtin_amdgcn_exp2f(s.y);
    return v * 0.5f + av * (0.5f - q * e);
}
__device__ __forceinline__ f32x4 gelu4(f32x4 v) { const f32x2 a = gelu_pk((f32x2){v.x, v.y}), b = gelu_pk((f32x2){v.z, v.w}); return (f32x4){a.x, a.y, b.x, b.y}; }
struct EpiSguIn {
    static constexpr bool NEEDS_RS = true, NEEDS_RH = false;
    const GAS float* ssq; GAS bf16_t* U; GAS bf16_t* V; GAS float* lnp;
    __device__ __forceinline__ void operator()(const Acc& acc, const pg8::Unit& u, int wr, int wc, int fr, int fq, const LAS float* rst) const {
        const int row0 = u.pm * 256 + wr * 64 + fr;
        const bool isv = u.pn >= 8;
        GAS bf16_t* dst = isv ? V + (u.pn - 8) * 256 : U + u.pn * 256;
        float rs[8];
#pragma unroll
        for (int k = 0; k < 8; ++k) rs[k] = rst[(k >> 2) * 128 + (k & 3) * 16];
#pragma unroll
        for (int ai = 0; ai < 2; ++ai)
#pragma unroll
            for (int m = 0; m < 4; ++m) {
                const int row = row0 + ai * 128 + m * 16; const float r1 = rs[4 * ai + m];
                float s1 = 0.f, s2 = 0.f;
#pragma unroll
                for (int bj = 0; bj < 2; ++bj) {
                    const f32x4 a = gelu4(acc[ai][bj][m][0] * r1), b = gelu4(acc[ai][bj][m][1] * r1);
                    *(GAS u32x4*)(dst + (size_t)row * 2048 + bj * 128 + wc * 32 + fq * 8) = pack8(a, b);
                    s1 += (a.x + a.y) + (a.z + a.w) + (b.x + b.y) + (b.z + b.w);
                    s2 += (a.x * a.x + a.y * a.y) + (a.z * a.z + a.w * a.w) + (b.x * b.x + b.y * b.y) + (b.z * b.z + b.w * b.w);
                }
                if (isv) {
                    s1 += __shfl_xor(s1, 16); s1 += __shfl_xor(s1, 32); s2 += __shfl_xor(s2, 16); s2 += __shfl_xor(s2, 32);
                    if (fq == 0) *(GAS f32x2*)(lnp + ((size_t)row * 32 + (u.pn - 8) * 4 + wc) * 2) = (f32x2){s1, s2};
                }
            }
    }
};
struct EpiRetQkv {
    static constexpr bool NEEDS_RS = true, NEEDS_RH = false;
    const GAS float* ssq; const GAS float* rcos; const GAS float* rsin; GAS bf16_t* Q; GAS bf16_t* Kn; GAS bf16_t* V; const GAS float* rowsc; float tsc;
    __device__ __forceinline__ void operator()(const Acc& acc, const pg8::Unit& u, int wr, int wc, int fr, int fq, const LAS float* rst) const {
        const int row0 = u.pm * 256 + wr * 64 + fr;
        const int i0 = wc * 32 + fq * 8;
        const bool isk = u.pn >= 4; const int h = u.pn & 3;
        const float l2g = __builtin_amdgcn_logf(1.0f - __builtin_amdgcn_exp2f(-5.0f - (float)h));
        float rs[8];
#pragma unroll
        for (int k = 0; k < 8; ++k) rs[k] = rst[(k >> 2) * 128 + (k & 3) * 16];
        if (u.pn >= 8) {
#pragma unroll
            for (int ai = 0; ai < 2; ++ai)
#pragma unroll
                for (int m = 0; m < 4; ++m) { const int row = row0 + ai * 128 + m * 16; const float r1 = rs[4 * ai + m];
#pragma unroll
                    for (int bj = 0; bj < 2; ++bj)
                        *(GAS u32x4*)(V + (size_t)row * 2048 + (u.pn - 8) * 256 + bj * 128 + i0) = pack8(acc[ai][bj][m][0] * r1, acc[ai][bj][m][1] * r1); }
        } else {
#pragma unroll
            for (int hp = 0; hp < 4; ++hp) {
                const int ai = hp >> 1;
                f32x4 cs[2][2], sn[2][2];
#pragma unroll
                for (int mm = 0; mm < 2; ++mm) { const int pos = (row0 + ai * 128 + (2 * (hp & 1) + mm) * 16) & (SEQ - 1);
#pragma unroll
                    for (int bj = 0; bj < 2; ++bj) { cs[mm][bj] = *(const GAS f32x4*)(rcos + (size_t)pos * 128 + i0 + 4 * bj); sn[mm][bj] = *(const GAS f32x4*)(rsin + (size_t)pos * 128 + i0 + 4 * bj); } }
#pragma unroll
                for (int mm = 0; mm < 2; ++mm) {
                    const int m = 2 * (hp & 1) + mm;
                    const int row = row0 + ai * 128 + m * 16, pos = row & (SEQ - 1); const float r1 = rs[4 * ai + m];
                    const float sc = isk ? r1 * 0.0625f * __builtin_amdgcn_exp2f(l2g * (float)(127 - (pos & 127))) : r1;
                    f32x4 o1[2], o2[2];
#pragma unroll
                    for (int bj = 0; bj < 2; ++bj) { const f32x4 x1 = acc[ai][bj][m][0] * sc, x2 = acc[ai][bj][m][1] * sc;
                        o1[bj] = x1 * cs[mm][bj] - x2 * sn[mm][bj]; o2[bj] = x2 * cs[mm][bj] + x1 * sn[mm][bj]; }
                    GAS bf16_t* dst = (isk ? Kn : Q) + (size_t)row * D + h * 256 + i0;
                    *(GAS u32x4*)dst = pack8(o1[0], o1[1]); *(GAS u32x4*)(dst + 128) = pack8(o2[0], o2[1]);
                }
            }
        }
    }
};
struct EpiRetG {
    static constexpr bool NEEDS_RS = true, NEEDS_RH = true;
    const GAS float* ssq; const GAS float* hss; GAS bf16_t* Y; const GAS float* rowsc; float tsc;
    __device__ __forceinline__ void operator()(const Acc& acc, const pg8::Unit& u, int wr, int wc, int fr, int fq, const LAS float* rst) const {
        const int row0 = u.pm * 256 + wr * 64 + fr; const int h = u.pn >> 1;
        float rs[8], rh[8];
#pragma unroll
        for (int k = 0; k < 8; ++k) { rs[k] = rst[(k >> 2) * 128 + (k & 3) * 16]; rh[k] = rst[4096 + (k >> 2) * 128 + (k & 3) * 16]; }
#pragma unroll
        for (int ai = 0; ai < 2; ++ai) {
            u32x4 ov[4][2];
#pragma unroll
            for (int m = 0; m < 4; ++m)
#pragma unroll
                for (int bj = 0; bj < 2; ++bj) ov[m][bj] = *(const GAS u32x4*)(Y + (size_t)(row0 + ai * 128 + m * 16) * 2048 + u.pn * 256 + bj * 128 + wc * 32 + fq * 8);
#pragma unroll
            for (int m = 0; m < 4; ++m) {
                const int row = row0 + ai * 128 + m * 16; const float r1 = rs[4 * ai + m], r3 = rh[4 * ai + m];
#pragma unroll
                for (int bj = 0; bj < 2; ++bj) {
                    GAS bf16_t* p = Y + (size_t)row * 2048 + u.pn * 256 + bj * 128 + wc * 32 + fq * 8;
                    const u32x4 o = ov[m][bj];
                    const f32x4 g0 = acc[ai][bj][m][0] * r1, g1 = acc[ai][bj][m][1] * r1;
                    const f32x4 a = (f32x4){silu_f(g0.x) * bf_lo(o.x), silu_f(g0.y) * bf_hi(o.x), silu_f(g0.z) * bf_lo(o.y), silu_f(g0.w) * bf_hi(o.y)} * r3;
                    const f32x4 b = (f32x4){silu_f(g1.x) * bf_lo(o.z), silu_f(g1.y) * bf_hi(o.z), silu_f(g1.z) * bf_lo(o.w), silu_f(g1.w) * bf_hi(o.w)} * r3;
                    *(GAS u32x4*)p = pack8(a, b);
                }
            }
        }
    }
};
template <int MB = 4> struct EpiResidT {
    static constexpr bool NEEDS_RS = false, NEEDS_RH = false;
    GAS bf16_t* xb; GAS float* ssq; float osc; GAS unsigned char* x8;
    __device__ __forceinline__ void operator()(const Acc& acc, const pg8::Unit& u, int wr, int wc, int fr, int fq, const LAS float* rst) const {
        const int row0 = u.pm * 256 + wr * 64 + fr, col0 = u.pn * 256 + wc * 32 + fq * 8;
#pragma unroll
        for (int ai = 0; ai < 2; ++ai)
#pragma unroll
        for (int mh = 0; mh < 4; mh += MB) {
            u32x4 bv[4][2];
#pragma unroll
            for (int m = mh; m < mh + MB; ++m)
#pragma unroll
                for (int bj = 0; bj < 2; ++bj) bv[m][bj] = *(const GAS u32x4*)(xb + (size_t)(row0 + ai * 128 + m * 16) * D + col0 + bj * 128);
#pragma unroll
            for (int m = mh; m < mh + MB; ++m) {
                const int row = row0 + ai * 128 + m * 16;
                GAS bf16_t* p = xb + (size_t)row * D + col0;
                float s2 = 0.f;
#pragma unroll
                for (int bj = 0; bj < 2; ++bj) {
                    const u32x4 b = bv[m][bj];
                    const f32x4 x0 = (f32x4){bf_lo(b.x), bf_hi(b.x), bf_lo(b.y), bf_hi(b.y)} + acc[ai][bj][m][0] * osc;
                    const f32x4 x1 = (f32x4){bf_lo(b.z), bf_hi(b.z), bf_lo(b.w), bf_hi(b.w)} + acc[ai][bj][m][1] * osc;
                    *(GAS u32x4*)(p + bj * 128) = pack8(x0, x1);
                    if (x8) { u32x2 w8;
                        w8.x = (unsigned)__builtin_amdgcn_cvt_pk_fp8_f32(x0.z, x0.w, __builtin_amdgcn_cvt_pk_fp8_f32(x0.x, x0.y, 0, false), true);
                        w8.y = (unsigned)__builtin_amdgcn_cvt_pk_fp8_f32(x1.z, x1.w, __builtin_amdgcn_cvt_pk_fp8_f32(x1.x, x1.y, 0, false), true);
                        *(GAS u32x2*)(x8 + (size_t)row * D + col0 + bj * 128) = w8; }
                    s2 += (x0.x * x0.x + x0.y * x0.y) + (x0.z * x0.z + x0.w * x0.w) + (x1.x * x1.x + x1.y * x1.y) + (x1.z * x1.z + x1.w * x1.w);
                }
                s2 += __shfl_xor(s2, 16); s2 += __shfl_xor(s2, 32);
                if (fq == 0) ssq[(size_t)row * 16 + u.pn * 4 + wc] = s2;
            }
        }
    }
};
typedef EpiResidT<4> EpiResid;

struct Args { const float* in[18]; float* out; unsigned char* ws; int ph_lo, ph_hi, li, pad; };

struct Frame {
    LAS unsigned char* lds;
    int tid, lane, wave, vcu, G;
};

enum { MAP_NAT = 0, MAP_P8 = 1, MAP_CONV = 2, MAP_RETQKV = 3, MAP_FFN = 4 };
struct PrepJob { const GAS float* src; const GAS float* src2; const GAS float* gain; GAS bf16_t* dst; int ld, N, K, map; float f8scale, i8scale; };
__device__ __forceinline__ void prep_item(const PrepJob& J, int item, LAS float* scr, int lane) {
    const int nb = J.N / 64, kb = item / nb, r = item % nb, pn = r >> 2, wc = r & 3;
    const int k0 = kb * 64;
    const int sl = 128 * (lane >> 5) + 32 * wc + (lane & 31);
    const int slot = 256 * pn + sl;
    const GAS float* src = J.src; int col;
    {
        const int bj = sl >> 7, n = (sl >> 4) & 1, fq = (sl >> 2) & 3, j = sl & 3, ch = 32 * wc + 8 * fq + 4 * bj + j;
        const int p8 = (slot & ~31) + pg8::perm32(slot & 31);
        if (J.map == MAP_NAT) col = slot;
        else if (J.map == MAP_P8) col = p8;
        else if (J.map == MAP_CONV) col = (pn < 4) ? p8 : (1024 + 1024 * n + 128 * (pn - 4) + ch);
        else if (J.map == MAP_RETQKV) col = (pn < 8) ? (256 * pn + 128 * n + ch) : p8;
        else { col = 128 * pn + ch; if (n) src = J.src2; }
    }
    const GAS float* sp = src + (size_t)k0 * J.ld + col;
#pragma unroll
    for (int hk = 0; hk < 2; ++hk) {
        float wv[32];
#pragma unroll
        for (int k = 0; k < 32; ++k) wv[k] = sp[(size_t)(32 * hk + k) * J.ld];
#pragma unroll
        for (int k = 0; k < 32; ++k) scr[(32 * hk + k) * 65 + lane] = wv[k];
    }
    asm volatile("s_waitcnt lgkmcnt(0)" ::: "memory");
    const int c = lane & 7;
    float gn[8];
#pragma unroll
    for (int e = 0; e < 8; ++e) gn[e] = J.gain ? J.gain[k0 + 8 * c + e] : 1.0f;
#pragma unroll
    for (int it = 0; it < 8; ++it) {
        const int l2 = it * 8 + (lane >> 3);
        const int slot2 = 256 * pn + 128 * (l2 >> 5) + 32 * wc + (l2 & 31);
        const LAS float* s = scr + (8 * c) * 65 + l2;
        if (J.i8scale != 0.f) {
            const float f = J.i8scale; unsigned b8[8];
#pragma unroll
            for (int e = 0; e < 8; ++e) b8[e] = (unsigned)(int)fminf(fmaxf(rintf(s[e * 65] * gn[e] * f), -127.f), 127.f) & 255u;
            u32x2 o8; o8.x = b8[0] | (b8[1] << 8) | (b8[2] << 16) | (b8[3] << 24); o8.y = b8[4] | (b8[5] << 8) | (b8[6] << 16) | (b8[7] << 24);
            *(GAS u32x2*)((GAS unsigned char*)J.dst + (size_t)slot2 * J.K + k0 + 8 * c) = o8;
        } else if (J.f8scale != 0.f) {
            const float f = J.f8scale; u32x2 o8;
            o8.x = (unsigned)__builtin_amdgcn_cvt_pk_fp8_f32(s[2 * 65] * gn[2] * f, s[3 * 65] * gn[3] * f, __builtin_amdgcn_cvt_pk_fp8_f32(s[0] * gn[0] * f, s[65] * gn[1] * f, 0, false), true);
            o8.y = (unsigned)__builtin_amdgcn_cvt_pk_fp8_f32(s[6 * 65] * gn[6] * f, s[7 * 65] * gn[7] * f, __builtin_amdgcn_cvt_pk_fp8_f32(s[4 * 65] * gn[4] * f, s[5 * 65] * gn[5] * f, 0, false), true);
            *(GAS u32x2*)((GAS unsigned char*)J.dst + (size_t)slot2 * J.K + k0 + 8 * c) = o8;
        } else {
        u32x4 o; o.x = pk2(s[0] * gn[0], s[65] * gn[1]); o.y = pk2(s[2 * 65] * gn[2], s[3 * 65] * gn[3]); o.z = pk2(s[4 * 65] * gn[4], s[5 * 65] * gn[5]); o.w = pk2(s[6 * 65] * gn[6], s[7 * 65] * gn[7]);
        *(GAS u32x4*)(J.dst + (size_t)slot2 * J.K + k0 + 8 * c) = o;
        }
    }
    asm volatile("s_waitcnt lgkmcnt(0)" ::: "memory");
}
__device__ __forceinline__ void p0_wabs(const Frame& F, const Args& a) {
    const int tid_ = opq_tid(), lane_ = tid_ & 63, wave_ = __builtin_amdgcn_readfirstlane(tid_ >> 6);
    const int gw = F.vcu * 8 + wave_, NGW = F.G * 8;
#pragma unroll 1
    for (int L = 0; L < NLAYER; ++L) {
        if (!((I8_F1_LAYERS >> L) & 1)) continue;
        float sq = 0.f;
        for (int rr = gw; rr < 2 * 1024; rr += NGW) {
            const int k = rr & 1023; const GAS float* src = (const GAS float*)((rr < 1024 ? a.in[15] : a.in[16]) + ((size_t)L * 1024 + k) * DFF);
            const float gk = ((const GAS float*)a.in[2])[L * D + k];
            float m = 0.f;
#pragma unroll
            for (int j = 0; j < 11; ++j) { const f32x4 v = ((const GAS f32x4*)src)[lane_ + 64 * j]; m += (v.x * v.x + v.y * v.y) + (v.z * v.z + v.w * v.w); }
            sq += m * (gk * gk);
        }
        sq = wave_sum(sq);
        if (lane_ == 0 && gw < 2048) ((GAS float*)(a.ws + WS_CTL))[CTL_WSS + 2048 * L + gw] = sq;
    }
    if (I8_RET) {
        float sq0 = 0.f, sq1 = 0.f;
        for (int k = gw; k < 1024; k += NGW) {
            const GAS f32x4* src = (const GAS f32x4*)(a.in[13] + (size_t)k * 6144);
            const float gk = ((const GAS float*)a.in[1])[2 * D + k];
            float m0 = 0.f, m1 = 0.f;
#pragma unroll
            for (int j = 0; j < 16; ++j) { const f32x4 v = src[lane_ + 64 * j]; m0 += (v.x * v.x + v.y * v.y) + (v.z * v.z + v.w * v.w); }
#pragma unroll
            for (int j = 16; j < 24; ++j) { const f32x4 v = src[lane_ + 64 * j]; m1 += (v.x * v.x + v.y * v.y) + (v.z * v.z + v.w * v.w); }
            sq0 += m0 * (gk * gk); sq1 += m1 * (gk * gk);
        }
        sq0 = wave_sum(sq0); sq1 = wave_sum(sq1);
        if (lane_ == 0 && gw < 2048) { ((GAS float*)(a.ws + WS_CTL))[CTL_WSS + 2048 * 4 + gw] = sq0; ((GAS float*)(a.ws + WS_CTL))[CTL_WSS + 2048 * 5 + gw] = sq1; }
    }
}
__device__ __forceinline__ float i8_wfull(const unsigned char* ws, int L, int lane, float inv_count = 1.0f / (2.0f * 1024.0f * DFF)) {
    const GAS float* p = (const GAS float*)(ws + WS_CTL) + CTL_WSS + 2048 * L;
    float t = 0.f;
#pragma unroll 4
    for (int j = 0; j < 32; ++j) t += p[lane + 64 * j];
    t = wave_sum(t);
    return fmaxf(WCLIP * sqrtf(t * inv_count), 1e-30f);
}
__device__ __forceinline__ void quant_phase(const Frame& F, const GAS bf16_t* xb, GAS unsigned char* x8, GAS float* sa) {
    const int tid_ = opq_tid(), lane_ = tid_ & 63, wave_ = __builtin_amdgcn_readfirstlane(tid_ >> 6);
    const int gw = F.vcu * 8 + wave_, NGW = F.G * 8;
    for (int row = 4 * gw; row < M; row += 4 * NGW) {
        u32x4 v[4][2];
#pragma unroll
        for (int r = 0; r < 4; ++r) { const GAS u32x4* p = (const GAS u32x4*)(xb + (size_t)(row + r) * D) + 2 * lane_; v[r][0] = p[0]; v[r][1] = p[1]; }
#pragma unroll
        for (int r = 0; r < 4; ++r) {
            float x[16];
#pragma unroll
            for (int h = 0; h < 2; ++h)
#pragma unroll
                for (int e = 0; e < 4; ++e) { x[8 * h + 2 * e] = bf_lo(v[r][h][e]); x[8 * h + 2 * e + 1] = bf_hi(v[r][h][e]); }
            float m = 0.f;
#pragma unroll
            for (int e = 0; e < 16; ++e) m = fmaxf(m, fabsf(x[e]));
            m = fmaxf(wave_max(m), 1e-30f);
            const float qs = 127.0f / m;
            unsigned w[4];
#pragma unroll
            for (int d = 0; d < 4; ++d) { unsigned t = 0u;
#pragma unroll
                for (int e = 0; e < 4; ++e) t |= ((unsigned)(int)rintf(x[4 * d + e] * qs) & 255u) << (8 * e);
                w[d] = t; }
            *((GAS u32x4*)(x8 + (size_t)(row + r) * D) + lane_) = (u32x4){w[0], w[1], w[2], w[3]};
            if (lane_ == 0) sa[row + r] = m * (1.0f / 127.0f);
        }
    }
}
__device__ __forceinline__ void p0_prologue(const Frame& F, const Args& a) {
    unsigned char* ws = a.ws;
    const int tid_ = opq_tid(), lane_ = tid_ & 63, wave_ = __builtin_amdgcn_readfirstlane(tid_ >> 6);
    LAS float* scr = (LAS float*)(F.lds + wave_ * 16640);
    const int gw = F.vcu * 8 + wave_, NGW = F.G * 8;
    constexpr int NJOB = 17;
    int start = 0;
#pragma unroll 1
    for (int jb = 0; jb < NJOB; ++jb) {
        PrepJob J; J.f8scale = 0.f; J.i8scale = 0.f;
        if (jb < 2)       { J.src = (const GAS float*)(a.in[4] + (size_t)jb * 1024 * 3072); J.src2 = nullptr; J.gain = (const GAS float*)(a.in[1] + (jb == 0 ? 0 : 3) * D); J.dst = (GAS bf16_t*)(ws + W_CI + jb * W_CI_SZ); J.ld = 3072; J.N = 3072; J.K = 1024; J.map = MAP_CONV; }
        else if (jb < 4)  { const int j = jb - 2; J.src = (const GAS float*)(a.in[6] + (size_t)j * 1024 * 1024); J.src2 = nullptr; J.gain = nullptr; J.dst = (GAS bf16_t*)(ws + W_CO + j * W_CO_SZ); J.ld = 1024; J.N = 1024; J.K = 1024; J.map = MAP_P8; }
        else if (jb == 4) { J.src = (const GAS float*)(a.in[7]); J.src2 = nullptr; J.gain = (const GAS float*)(a.in[1] + 1 * D); J.dst = (GAS bf16_t*)(ws + W_SI); J.ld = 4096; J.N = 4096; J.K = 1024; J.map = MAP_P8; }
        else if (jb == 5) { J.src = (const GAS float*)(a.in[12]); J.src2 = nullptr; J.gain = nullptr; J.dst = (GAS bf16_t*)(ws + W_SO); J.ld = 1024; J.N = 1024; J.K = 2048; J.map = MAP_P8; }
        else if (jb == 6) { J.src = (const GAS float*)(a.in[13]); J.src2 = nullptr; J.gain = (const GAS float*)(a.in[1] + 2 * D); J.dst = (GAS bf16_t*)(ws + W_RQ); J.ld = 6144; J.N = 4096; J.K = 1024; J.map = MAP_RETQKV; if (I8_RET) J.i8scale = 127.0f / i8_wfull(ws, 4, lane_, 1.0f / (1024.0f * 4096.0f)); }
        else if (jb == 7) { J.src = (const GAS float*)(a.in[13] + 4096); J.src2 = nullptr; J.gain = (const GAS float*)(a.in[1] + 2 * D); J.dst = (GAS bf16_t*)(ws + W_RG); J.ld = 6144; J.N = 2048; J.K = 1024; J.map = MAP_P8; if (I8_RET) J.i8scale = 127.0f / i8_wfull(ws, 5, lane_, 1.0f / (1024.0f * 2048.0f)); }
        else if (jb == 8) { J.src = (const GAS float*)(a.in[14]); J.src2 = nullptr; J.gain = nullptr; J.dst = (GAS bf16_t*)(ws + W_RO); J.ld = 1024; J.N = 1024; J.K = 2048; J.map = MAP_P8; }
        else if (jb < 13) { const int L = jb - 9; J.src = (const GAS float*)(a.in[15] + (size_t)L * 1024 * DFF); J.src2 = (const GAS float*)(a.in[16] + (size_t)L * 1024 * DFF); J.gain = (const GAS float*)(a.in[2] + L * D); J.dst = (GAS bf16_t*)(ws + W_FI + L * W_FI_SZ); J.ld = DFF; J.N = 2 * DFF; J.K = 1024; J.map = MAP_FFN; J.f8scale = ((F8_F1_LAYERS >> L) & 1) ? FI_WSCALE : 0.f;
                            if ((I8_F1_LAYERS >> L) & 1) J.i8scale = 127.0f / i8_wfull(ws, L, lane_); }
        else              { const int L = jb - 13; J.src = (const GAS float*)(a.in[17] + (size_t)L * DFF * 1024); J.src2 = nullptr; J.gain = nullptr; J.dst = (GAS bf16_t*)(ws + W_FD + L * W_FD_SZ); J.ld = 1024; J.N = 1024; J.K = DFF; J.map = MAP_P8; J.f8scale = ((F8_LAYERS >> L) & 1) ? FD_WSCALE : 0.f; }
        const int nitems = (J.K / 64) * (J.N / 64);
        int first = (gw - start % NGW + NGW) % NGW;
        for (int it = first; it < nitems; it += NGW) prep_item(J, it, scr, lane_);
        start += nitems;
    }
    {
        const GAS float* x = (const GAS float*)a.in[0]; GAS bf16_t* xb = (GAS bf16_t*)(ws + WS_XB); GAS float* ssq = (GAS float*)(ws + WS_SSQ);
        for (int row = 4 * gw; row < M; row += 4 * NGW) {
            f32x4 v[4][4];
#pragma unroll
            for (int r = 0; r < 4; ++r)
#pragma unroll
                for (int j = 0; j < 4; ++j) v[r][j] = ((const GAS f32x4*)(x + (size_t)(row + r) * D))[lane_ + 64 * j];
#pragma unroll
            for (int r = 0; r < 4; ++r) {
                float sq = 0.f;
#pragma unroll
                for (int j = 0; j < 4; ++j) sq += (v[r][j].x * v[r][j].x + v[r][j].y * v[r][j].y) + (v[r][j].z * v[r][j].z + v[r][j].w * v[r][j].w);
                sq = wave_sum(sq);
                GAS u32x2* o8 = (GAS u32x2*)(xb + (size_t)(row + r) * D) + lane_;
#pragma unroll
                for (int j = 0; j < 4; ++j) { u32x2 w; w.x = pk2(v[r][j].x, v[r][j].y); w.y = pk2(v[r][j].z, v[r][j].w); o8[64 * j] = w; }
                if (lane_ < 16) ssq[(size_t)(row + r) * 16 + lane_] = (lane_ == 0) ? sq : 0.f;
            }
        }
    }
    {
        GAS float* rc = (GAS float*)(ws + WS_ROT); GAS float* rsn = rc + (size_t)SEQ * 128;
        const int gt = F.vcu * 512 + tid_, NGT = F.G * 512;
        for (int idx = gt; idx < SEQ * 128; idx += NGT) {
            const int i = idx & 127, pos = idx >> 7;
            const float inv = __builtin_amdgcn_exp2f(-(float)i * (13.287712379549449f / 128.0f));
            const float ang = (float)pos * inv;
            const double ad = (double)ang;
            const double kq = __builtin_rint(ad * 0.63661977236758134308);
            const double y = __builtin_fma(-kq, 1.57079632679489661923, ad) - kq * 6.123233995736766e-17;
            const double y2 = y * y;
            const double sp = y * (1.0 + y2 * (-1.0 / 6 + y2 * (1.0 / 120 + y2 * (-1.0 / 5040 + y2 * (1.0 / 362880 + y2 * (-1.0 / 39916800))))));
            const double cp = 1.0 + y2 * (-0.5 + y2 * (1.0 / 24 + y2 * (-1.0 / 720 + y2 * (1.0 / 40320 + y2 * (-1.0 / 3628800 + y2 * (1.0 / 479001600))))));
            const int q = ((int)(long long)kq) & 3;
            const double sv = (q == 0) ? sp : (q == 1) ? cp : (q == 2) ? -sp : -cp;
            const double cv = (q == 0) ? cp : (q == 1) ? -sp : (q == 2) ? -cp : sp;
            rc[idx] = (float)cv; rsn[idx] = (float)sv;
        }
        const GAS float* wsp = (const GAS float*)a.in[10]; GAS bf16_t* wd = (GAS bf16_t*)(ws + W_WS);
        for (int idx = gt; idx < 8 * 128 * 128; idx += NGT) { const int s = idx & 127, t = (idx >> 7) & 127; wd[idx] = (bf16_t)f2bf(s <= t ? wsp[idx] : 0.f); }
    }
}

__device__ __forceinline__ void conv_phase(const Frame& F, const GAS bf16_t* Bo, const GAS bf16_t* CZ, const GAS float* cw, GAS bf16_t* Y) {
    constexpr int RB = 16;
    const int nitem = (M / RB) * 128;
    const int tid_ = opq_tid();
    for (int it = F.vcu * 512 + tid_; it < nitem; it += F.G * 512) {
        const int cc = it & 127, rb = it >> 7, r0 = rb * RB, c0 = cc * 8;
        float w0[8], w1[8], w2[8];
#pragma unroll
        for (int e = 0; e < 8; ++e) { w0[e] = cw[c0 + e]; w1[e] = cw[D + c0 + e]; w2[e] = cw[2 * D + c0 + e]; }
        u32x4 p2 = (u32x4){0, 0, 0, 0}, p1 = (u32x4){0, 0, 0, 0};
        if ((r0 & (SEQ - 1)) != 0) { p2 = *(const GAS u32x4*)(CZ + (size_t)(r0 - 2) * D + c0); p1 = *(const GAS u32x4*)(CZ + (size_t)(r0 - 1) * D + c0); }
#pragma unroll
        for (int hb = 0; hb < 2; ++hb) {
            u32x4 pz[8], pb[8];
#pragma unroll
            for (int r = 0; r < 8; ++r) { const size_t off = (size_t)(r0 + 8 * hb + r) * D + c0; pz[r] = *(const GAS u32x4*)(CZ + off); pb[r] = *(const GAS u32x4*)(Bo + off); }
#pragma unroll
            for (int r = 0; r < 8; ++r) {
                const size_t off = (size_t)(r0 + 8 * hb + r) * D + c0;
                const u32x4 p0 = pz[r], bv = pb[r];
                u32x4 o;
#pragma unroll
                for (int q = 0; q < 4; ++q) {
                    const float lo = bf_lo(bv[q]) * (w0[2 * q] * bf_lo(p2[q]) + w1[2 * q] * bf_lo(p1[q]) + w2[2 * q] * bf_lo(p0[q]));
                    const float hi = bf_hi(bv[q]) * (w0[2 * q + 1] * bf_hi(p2[q]) + w1[2 * q + 1] * bf_hi(p1[q]) + w2[2 * q + 1] * bf_hi(p0[q]));
                    o[q] = pk2(lo, hi);
                }
                *(GAS u32x4*)(Y + off) = o;
                p2 = p1; p1 = p0;
            }
        }
    }
}

constexpr int SG_W = 0, SG_WSTR = 272, SG_T = 128 * SG_WSTR, SG_TSTR = 272, SG_ST = SG_T + 256 * SG_TSTR, SG_LG = SG_ST + 1024, SG_END = SG_LG + 2048;
static_assert(SG_END <= LDS_MISC, "sgu lds");
__device__ __forceinline__ void sgu_phase(const Frame& F, GAS bf16_t* U, const GAS bf16_t* V, const GAS float* lnp, const GAS bf16_t* Wt, const GAS float* lng, const GAS float* lnb, const GAS float* bs) {
    LAS unsigned char* lds = F.lds;
    const int tid = opq_tid(), lane = tid & 63, w = __builtin_amdgcn_readfirstlane(tid >> 6), fr = lane & 15, fq = lane >> 4;
    const int s = tid & 127, dg = tid >> 7;
    const int srow = tid >> 2, spart = tid & 3;
    int gcur = -1;
    u32x4 vreg[8]; f32x4 lnv[4];
    int un = F.vcu;
    if (un < 2048) {
        const int g = un & 7, row0 = (un >> 3) * 128;
        const GAS bf16_t* vp = V + (size_t)(row0 + s) * 2048 + g * 256;
#pragma unroll
        for (int i = 0; i < 8; ++i) vreg[i] = *(const GAS u32x4*)(vp + (dg + 4 * i) * 8);
        const GAS f32x4* lp = (const GAS f32x4*)(lnp + (size_t)(row0 + srow) * 64 + spart * 16);
#pragma unroll
        for (int i = 0; i < 4; ++i) lnv[i] = lp[i];
    }
    for (; un < 2048; un += F.G) {
        const int g = un & 7, c = un >> 3, row0 = c * 128;
        __syncthreads();
        if (g != gcur) {
            gcur = g;
            const GAS bf16_t* wg = Wt + (size_t)g * 128 * 128;
#pragma unroll
            for (int i = 0; i < 4; ++i) { const int p = tid + 512 * i, t = p >> 4, c16 = p & 15; *(LAS u32x4*)(lds + SG_W + t * SG_WSTR + c16 * 16) = *(const GAS u32x4*)(wg + t * 128 + c16 * 8); }
            if (tid < 256) { ((LAS float*)(lds + SG_LG))[tid] = lng[g * 256 + tid]; } else { ((LAS float*)(lds + SG_LG))[tid] = lnb[g * 256 + tid - 256]; }
        }
        {
            float s1 = 0.f, s2 = 0.f;
#pragma unroll
            for (int i = 0; i < 4; ++i) { s1 += lnv[i].x + lnv[i].z; s2 += lnv[i].y + lnv[i].w; }
            s1 += __shfl_xor(s1, 1); s2 += __shfl_xor(s2, 1); s1 += __shfl_xor(s1, 2); s2 += __shfl_xor(s2, 2);
            const float mu = s1 * (1.0f / 2048.0f), var = s2 * (1.0f / 2048.0f) - mu * mu;
            if (spart == 0) { ((LAS float*)(lds + SG_ST))[srow] = mu; ((LAS float*)(lds + SG_ST))[128 + srow] = rsqrtf(fmaxf(var, 0.f) + LN_EPS); }
        }
        __syncthreads();
        {
            const float mu = ((LAS float*)(lds + SG_ST))[s], r = ((LAS float*)(lds + SG_ST))[128 + s];
#pragma unroll
            for (int i = 0; i < 8; ++i) {
                const int dc = dg + 4 * i, d0 = dc * 8;
                const u32x4 v = vreg[i];
                const f32x4 g0 = *(const LAS f32x4*)(lds + SG_LG + d0 * 4), g1 = *(const LAS f32x4*)(lds + SG_LG + d0 * 4 + 16);
                const f32x4 b0 = *(const LAS f32x4*)(lds + SG_LG + 1024 + d0 * 4), b1 = *(const LAS f32x4*)(lds + SG_LG + 1024 + d0 * 4 + 16);
                LAS bf16_t* tp = (LAS bf16_t*)(lds + SG_T + d0 * SG_TSTR) + s;
                tp[0 * (SG_TSTR / 2)] = (bf16_t)f2bf((bf_lo(v.x) - mu) * r * g0.x + b0.x);
                tp[1 * (SG_TSTR / 2)] = (bf16_t)f2bf((bf_hi(v.x) - mu) * r * g0.y + b0.y);
                tp[2 * (SG_TSTR / 2)] = (bf16_t)f2bf((bf_lo(v.y) - mu) * r * g0.z + b0.z);
                tp[3 * (SG_TSTR / 2)] = (bf16_t)f2bf((bf_hi(v.y) - mu) * r * g0.w + b0.w);
                tp[4 * (SG_TSTR / 2)] = (bf16_t)f2bf((bf_lo(v.z) - mu) * r * g1.x + b1.x);
                tp[5 * (SG_TSTR / 2)] = (bf16_t)f2bf((bf_hi(v.z) - mu) * r * g1.y + b1.y);
                tp[6 * (SG_TSTR / 2)] = (bf16_t)f2bf((bf_lo(v.w) - mu) * r * g1.z + b1.z);
                tp[7 * (SG_TSTR / 2)] = (bf16_t)f2bf((bf_hi(v.w) - mu) * r * g1.w + b1.w);
            }
        }
        u32x4 uv[8];
#pragma unroll
        for (int tb = 0; tb < 8; ++tb) uv[tb] = *(const GAS u32x4*)(U + (size_t)(row0 + 16 * tb + fr) * 2048 + g * 256 + 32 * w + 8 * fq);
        if (un + F.G < 2048) {
            const int un2 = un + F.G, g2 = un2 & 7, row2 = (un2 >> 3) * 128;
            const GAS bf16_t* vp = V + (size_t)(row2 + s) * 2048 + g2 * 256;
#pragma unroll
            for (int i = 0; i < 8; ++i) vreg[i] = *(const GAS u32x4*)(vp + (dg + 4 * i) * 8);
            const GAS f32x4* lp = (const GAS f32x4*)(lnp + (size_t)(row2 + srow) * 64 + spart * 16);
#pragma unroll
            for (int i = 0; i < 4; ++i) lnv[i] = lp[i];
        }
        __syncthreads();
        f32x4 acc[8][2];
#pragma unroll
        for (int tb = 0; tb < 8; ++tb) { acc[tb][0] = (f32x4){0.f, 0.f, 0.f, 0.f}; acc[tb][1] = (f32x4){0.f, 0.f, 0.f, 0.f}; }
        const int drow0 = 32 * w + 8 * (fr >> 2) + (fr & 3);
#pragma unroll
        for (int ks = 0; ks < 4; ++ks) {
            const bf16x8 t0 = *(const LAS bf16x8*)(lds + SG_T + drow0 * SG_TSTR + ks * 64 + fq * 16);
            const bf16x8 t1 = *(const LAS bf16x8*)(lds + SG_T + (drow0 + 4) * SG_TSTR + ks * 64 + fq * 16);
#pragma unroll
            for (int tb = 2 * ks; tb < 8; ++tb) {
                const bf16x8 wf = *(const LAS bf16x8*)(lds + SG_W + (16 * tb + fr) * SG_WSTR + ks * 64 + fq * 16);
                acc[tb][0] = __builtin_amdgcn_mfma_f32_16x16x32_bf16(t0, wf, acc[tb][0], 0, 0, 0);
                acc[tb][1] = __builtin_amdgcn_mfma_f32_16x16x32_bf16(t1, wf, acc[tb][1], 0, 0, 0);
            }
        }
#pragma unroll
        for (int tb = 0; tb < 8; ++tb) {
            const int t = 16 * tb + fr;
            const float bb = bs[g * 128 + t];
            GAS bf16_t* up = U + (size_t)(row0 + t) * 2048 + g * 256 + 32 * w + 8 * fq;
            const f32x4 a = acc[tb][0] + bb, b = acc[tb][1] + bb;
            const f32x4 ya = (f32x4){a.x * bf_lo(uv[tb].x), a.y * bf_hi(uv[tb].x), a.z * bf_lo(uv[tb].y), a.w * bf_hi(uv[tb].y)};
            const f32x4 yb = (f32x4){b.x * bf_lo(uv[tb].z), b.y * bf_hi(uv[tb].z), b.z * bf_lo(uv[tb].w), b.w * bf_hi(uv[tb].w)};
            *(GAS u32x4*)up = pack8(ya, yb);
        }
    }
    __syncthreads();
}

constexpr int RT_K0 = 0, RT_KB = 65536, RT_ST = 131072, RT_STSTR = 528, RT_VT = RT_ST + 32 * RT_STSTR, RT_VTSTR = 288, RT_END = RT_VT + 32 * RT_VTSTR;
static_assert(RT_END <= LDS_MISC, "ret lds");
typedef short s16x4 __attribute__((ext_vector_type(4)));
__device__ __forceinline__ void ret_phase(const Frame& F, const GAS bf16_t* Q, const GAS bf16_t* Kn, GAS bf16_t* Vb, GAS float* hss) {
    LAS unsigned char* lds = F.lds;
    const int tid = opq_tid(), lane = tid & 63, w = __builtin_amdgcn_readfirstlane(tid >> 6), fr = lane & 15, fq = lane >> 4;
    const int jb = (w < 4) ? w : 11 - w;
    const int srow = tid >> 5, sslot = tid & 31, spiece = ((sslot & 15) ^ (srow & 15)) | (sslot & 16);
    const unsigned voffK = (unsigned)(srow * D + 8 * spiece) * 2u;
    int koffx[4];
#pragma unroll
    for (int k4 = 0; k4 < 4; ++k4) koffx[k4] = fr * 512 + ((((4 * k4 + fq) & 15) ^ fr) << 4);
    int troff[2][2];
#pragma unroll
    for (int db = 0; db < 2; ++db)
#pragma unroll
        for (int t = 0; t < 2; ++t) {
            const int q = fr >> 2, p = fr & 3, m = 8 * fq + 4 * t + q, c = 4 * w + 2 * db + (p >> 1);
            troff[db][t] = m * 512 + ((((c & 15) ^ (m & 15)) | (c & 16)) << 4) + 8 * (p & 1);
        }
    for (int item = F.vcu; item < 256; item += F.G) {
        const int es = item & 15, bh = item >> 4, h = bh & 3, b = bh >> 2;
        const float gam = 1.0f - __builtin_amdgcn_exp2f(-5.0f - (float)h);
        const float l2g = __builtin_amdgcn_logf(gam);
        const float cdec = __builtin_amdgcn_exp2f(128.0f * l2g);
        const size_t rowb = (size_t)b * SEQ;
        const GAS bf16_t* Qh = Q + rowb * D + h * 256;
        const GAS char* Kh = (const GAS char*)(Kn + rowb * D + h * 256);
        GAS bf16_t* Vh = Vb + rowb * 2048 + h * 512 + es * 32;
        GAS float* hs = hss + (rowb * RH + h) * 16 + es;
        __syncthreads();
        for (int i = tid; i < 32 * RT_STSTR / 4; i += 512) ((LAS unsigned*)(lds + RT_ST))[i] = 0u;
        f32x4 sst[2][2];
#pragma unroll
        for (int eb = 0; eb < 2; ++eb)
#pragma unroll
            for (int db = 0; db < 2; ++db) sst[eb][db] = (f32x4){0.f, 0.f, 0.f, 0.f};
#define RT_STAGE_K(buf, ci) do { _Pragma("unroll") for (int _i = 0; _i < 8; ++_i) \
            __builtin_amdgcn_global_load_lds((const GAS unsigned*)(Kh + (size_t)(ci) * 128 * D * 2 + (size_t)_i * 16 * D * 2 + voffK), (LAS unsigned*)(lds + (buf) + _i * 8192 + w * 1024), 16, 0, 0); } while (0)
        RT_STAGE_K(RT_K0, 0);
        const int vm = tid >> 2, vp = tid & 3;
        u32x4 vreg = *(const GAS u32x4*)(Vh + (size_t)vm * 2048 + vp * 8);
        bf16x8 qf[8];
#pragma unroll
        for (int ks = 0; ks < 8; ++ks) qf[ks] = *(const GAS bf16x8*)(Qh + (size_t)(16 * jb + fr) * D + 32 * ks + 8 * fq);
        {
            LAS bf16_t* vt = (LAS bf16_t*)(lds + RT_VT + (8 * vp) * RT_VTSTR) + vm;
#pragma unroll
            for (int q = 0; q < 4; ++q) { vt[(2 * q) * (RT_VTSTR / 2)] = (bf16_t)(vreg[q] & 0xffffu); vt[(2 * q + 1) * (RT_VTSTR / 2)] = (bf16_t)(vreg[q] >> 16); }
        }
        u32x2 pend_ow[2] = {(u32x2){0u, 0u}, (u32x2){0u, 0u}}; float pend_ss = 0.f;
        const int jrow = 16 * jb + fr;
        const float qdec = __builtin_amdgcn_exp2f(l2g * (float)(jrow + 1));
        const float pdec = __builtin_amdgcn_exp2f(l2g * (float)(jrow - 127));
#pragma unroll 1
        for (int ci = 0; ci < SEQ / RC; ++ci) {
            const int kbuf = (ci & 1) ? RT_KB : RT_K0;
            asm volatile("s_waitcnt vmcnt(0) lgkmcnt(0)" ::: "memory"); __builtin_amdgcn_s_barrier(); asm volatile("" ::: "memory");
            const bool more = ci + 1 < SEQ / RC;
#pragma unroll
            for (int ks = 0; ks < 8; ++ks) asm volatile("" : "+v"(qf[ks]));
            if (more) {
                if (ci & 1) RT_STAGE_K(RT_K0, ci + 1); else RT_STAGE_K(RT_KB, ci + 1);
                vreg = *(const GAS u32x4*)(Vh + (size_t)((ci + 1) * 128 + vm) * 2048 + vp * 8);
            }
            if (ci > 0) {
                const size_t row = (size_t)(ci - 1) * 128 + jrow;
#pragma unroll
                for (int eb = 0; eb < 2; ++eb) *(GAS u32x2*)(Vh + row * 2048 + 16 * eb + 4 * fq) = pend_ow[eb];
                if (fq == 0) hs[row * RH * 16] = pend_ss;
            }
            f32x4 oacc[2] = {(f32x4){0.f, 0.f, 0.f, 0.f}, (f32x4){0.f, 0.f, 0.f, 0.f}};
            {
                bf16x8 sf[2][8];
#pragma unroll
                for (int ks = 0; ks < 8; ++ks)
#pragma unroll
                    for (int eb = 0; eb < 2; ++eb) sf[eb][ks] = *(const LAS bf16x8*)(lds + RT_ST + (16 * eb + fr) * RT_STSTR + ks * 64 + fq * 16);
                __builtin_amdgcn_sched_barrier(0);
#pragma unroll
                for (int ks = 0; ks < 8; ++ks)
#pragma unroll
                    for (int eb = 0; eb < 2; ++eb) oacc[eb] = __builtin_amdgcn_mfma_f32_16x16x32_bf16(sf[eb][ks], qf[ks], oacc[eb], 0, 0, 0);
            }
            oacc[0] *= qdec; oacc[1] *= qdec;
#pragma unroll
            for (int kp = 0; kp < 4; ++kp) {
                if (2 * kp <= jb) {
                    const bool two = (2 * kp + 1 <= jb);
                    bf16x8 k0[8], k1[8];
#pragma unroll
                    for (int ks = 0; ks < 8; ++ks) k0[ks] = *(const LAS bf16x8*)(lds + kbuf + (2 * kp) * 8192 + koffx[ks & 3] + (ks >> 2) * 256);
                    if (two) {
#pragma unroll
                        for (int ks = 0; ks < 8; ++ks) k1[ks] = *(const LAS bf16x8*)(lds + kbuf + (2 * kp + 1) * 8192 + koffx[ks & 3] + (ks >> 2) * 256);
                    }
                    u32x2 vlo[2], vhi[2];
#pragma unroll
                    for (int eb = 0; eb < 2; ++eb) { const LAS unsigned char* vb = lds + RT_VT + (16 * eb + fr) * RT_VTSTR + (32 * kp + 4 * fq) * 2; vlo[eb] = *(const LAS u32x2*)vb; vhi[eb] = *(const LAS u32x2*)(vb + 32); }
                    __builtin_amdgcn_sched_barrier(0);
                    f32x4 s0 = (f32x4){0.f, 0.f, 0.f, 0.f}, s1 = (f32x4){0.f, 0.f, 0.f, 0.f};
#pragma unroll
                    for (int ks = 0; ks < 8; ++ks) s0 = __builtin_amdgcn_mfma_f32_16x16x32_bf16(k0[ks], qf[ks], s0, 0, 0, 0);
                    if (two) {
#pragma unroll
                        for (int ks = 0; ks < 8; ++ks) s1 = __builtin_amdgcn_mfma_f32_16x16x32_bf16(k1[ks], qf[ks], s1, 0, 0, 0);
                    }
                    s0 *= pdec; s1 *= pdec;
                    if (2 * kp == jb) {
#pragma unroll
                        for (int r = 0; r < 4; ++r) s0[r] = (4 * fq + r <= fr) ? s0[r] : 0.f;
                    }
                    if (2 * kp + 1 == jb) {
#pragma unroll
                        for (int r = 0; r < 4; ++r) s1[r] = (4 * fq + r <= fr) ? s1[r] : 0.f;
                    }
                    u32x4 pw; pw.x = pk2(s0[0], s0[1]); pw.y = pk2(s0[2], s0[3]); pw.z = pk2(s1[0], s1[1]); pw.w = pk2(s1[2], s1[3]);
                    const bf16x8 pf = __builtin_bit_cast(bf16x8, pw);
#pragma unroll
                    for (int eb = 0; eb < 2; ++eb) {
                        u32x4 vw; vw.x = vlo[eb].x; vw.y = vlo[eb].y; vw.z = vhi[eb].x; vw.w = vhi[eb].y;
                        oacc[eb] = __builtin_amdgcn_mfma_f32_16x16x32_bf16(__builtin_bit_cast(bf16x8, vw), pf, oacc[eb], 0, 0, 0);
                    }
                }
            }
            if (more) {
#pragma unroll
                for (int ks = 0; ks < 8; ++ks) qf[ks] = *(const GAS bf16x8*)(Qh + (size_t)((ci + 1) * 128 + 16 * jb + fr) * D + 32 * ks + 8 * fq);
            }
            {
                float ss = 0.f;
#pragma unroll
                for (int eb = 0; eb < 2; ++eb) {
                    pend_ow[eb].x = pk2(oacc[eb].x, oacc[eb].y); pend_ow[eb].y = pk2(oacc[eb].z, oacc[eb].w);
                    ss += (oacc[eb].x * oacc[eb].x + oacc[eb].y * oacc[eb].y) + (oacc[eb].z * oacc[eb].z + oacc[eb].w * oacc[eb].w);
                }
                ss += __shfl_xor(ss, 16); ss += __shfl_xor(ss, 32);
                pend_ss = ss;
            }
            bf16x8 vtn[2][4]; u32x2 kt[2][4][2];
#pragma unroll
            for (int eb = 0; eb < 2; ++eb)
#pragma unroll
                for (int ks = 0; ks < 4; ++ks) vtn[eb][ks] = *(const LAS bf16x8*)(lds + RT_VT + (16 * eb + fr) * RT_VTSTR + ks * 64 + fq * 16);
            {
                const unsigned a00 = (unsigned)(kbuf + troff[0][0]), a01 = (unsigned)(kbuf + troff[0][1]), a10 = (unsigned)(kbuf + troff[1][0]), a11 = (unsigned)(kbuf + troff[1][1]);
                asm volatile(
                    "ds_read_b64_tr_b16 %0, %16\n\t"  "ds_read_b64_tr_b16 %1, %17\n\t"
                    "ds_read_b64_tr_b16 %2, %16 offset:16384\n\t"  "ds_read_b64_tr_b16 %3, %17 offset:16384\n\t"
                    "ds_read_b64_tr_b16 %4, %16 offset:32768\n\t"  "ds_read_b64_tr_b16 %5, %17 offset:32768\n\t"
                    "ds_read_b64_tr_b16 %6, %16 offset:49152\n\t"  "ds_read_b64_tr_b16 %7, %17 offset:49152\n\t"
                    "ds_read_b64_tr_b16 %8, %18\n\t"  "ds_read_b64_tr_b16 %9, %19\n\t"
                    "ds_read_b64_tr_b16 %10, %18 offset:16384\n\t"  "ds_read_b64_tr_b16 %11, %19 offset:16384\n\t"
                    "ds_read_b64_tr_b16 %12, %18 offset:32768\n\t"  "ds_read_b64_tr_b16 %13, %19 offset:32768\n\t"
                    "ds_read_b64_tr_b16 %14, %18 offset:49152\n\t"  "ds_read_b64_tr_b16 %15, %19 offset:49152\n\t"
                    "s_waitcnt lgkmcnt(0)"
                    : "=&v"(kt[0][0][0]), "=&v"(kt[0][0][1]), "=&v"(kt[0][1][0]), "=&v"(kt[0][1][1]), "=&v"(kt[0][2][0]), "=&v"(kt[0][2][1]), "=&v"(kt[0][3][0]), "=&v"(kt[0][3][1]),
                      "=&v"(kt[1][0][0]), "=&v"(kt[1][0][1]), "=&v"(kt[1][1][0]), "=&v"(kt[1][1][1]), "=&v"(kt[1][2][0]), "=&v"(kt[1][2][1]), "=&v"(kt[1][3][0]), "=&v"(kt[1][3][1])
                    : "v"(a00), "v"(a01), "v"(a10), "v"(a11)
                    : "memory");
            }
            asm volatile("s_waitcnt lgkmcnt(0)" ::: "memory"); __builtin_amdgcn_s_barrier(); asm volatile("" ::: "memory");
#pragma unroll
            for (int eb = 0; eb < 2; ++eb)
#pragma unroll
                for (int db = 0; db < 2; ++db) {
                    sst[eb][db] *= cdec;
#pragma unroll
                    for (int ks = 0; ks < 4; ++ks) {
                        u32x4 kw; kw.x = kt[db][ks][0].x; kw.y = kt[db][ks][0].y; kw.z = kt[db][ks][1].x; kw.w = kt[db][ks][1].y;
                        sst[eb][db] = __builtin_amdgcn_mfma_f32_16x16x32_bf16(__builtin_bit_cast(bf16x8, kw), vtn[eb][ks], sst[eb][db], 0, 0, 0);
                    }
                    u32x2 sw; sw.x = pk2(sst[eb][db].x, sst[eb][db].y); sw.y = pk2(sst[eb][db].z, sst[eb][db].w);
                    *(LAS u32x2*)(lds + RT_ST + (16 * eb + fr) * RT_STSTR + (32 * w + 16 * db + 4 * fq) * 2) = sw;
                }
            __builtin_amdgcn_sched_barrier(0);
            if (more) {
                LAS bf16_t* vt = (LAS bf16_t*)(lds + RT_VT + (8 * vp) * RT_VTSTR) + vm;
#pragma unroll
                for (int q = 0; q < 4; ++q) { vt[(2 * q) * (RT_VTSTR / 2)] = (bf16_t)(vreg[q] & 0xffffu); vt[(2 * q + 1) * (RT_VTSTR / 2)] = (bf16_t)(vreg[q] >> 16); }
            }
        }
        {
            const size_t row = (size_t)(SEQ / RC - 1) * 128 + jrow;
#pragma unroll
            for (int eb = 0; eb < 2; ++eb) *(GAS u32x2*)(Vh + row * 2048 + 16 * eb + 4 * fq) = pend_ow[eb];
            if (fq == 0) hs[row * RH * 16] = pend_ss;
        }
#undef RT_STAGE_K
    }
    __syncthreads();
}

__device__ __forceinline__ void final_phase(const Frame& F, const GAS bf16_t* xb, GAS float* out, const GAS float* g) {
    const int tid_ = opq_tid(), lane_ = tid_ & 63, wave_ = __builtin_amdgcn_readfirstlane(tid_ >> 6);
    const int gw = F.vcu * 8 + wave_, NGW = F.G * 8;
    f32x4 gv[2][2];
#pragma unroll
    for (int j = 0; j < 2; ++j) { gv[j][0] = ((const GAS f32x4*)g)[2 * (lane_ + 64 * j)]; gv[j][1] = ((const GAS f32x4*)g)[2 * (lane_ + 64 * j) + 1]; }
    for (int row = 4 * gw; row < M; row += 4 * NGW) {
        u32x4 w[4][2];
#pragma unroll
        for (int r = 0; r < 4; ++r)
#pragma unroll
            for (int j = 0; j < 2; ++j) w[r][j] = ((const GAS u32x4*)(xb + (size_t)(row + r) * D))[lane_ + 64 * j];
#pragma unroll
        for (int r = 0; r < 4; ++r) {
            f32x4 v[2][2]; float s = 0.f;
#pragma unroll
            for (int j = 0; j < 2; ++j) { const u32x4 ww = w[r][j];
                v[j][0] = (f32x4){bf_lo(ww.x), bf_hi(ww.x), bf_lo(ww.y), bf_hi(ww.y)}; v[j][1] = (f32x4){bf_lo(ww.z), bf_hi(ww.z), bf_lo(ww.w), bf_hi(ww.w)};
                s += (v[j][0].x * v[j][0].x + v[j][0].y * v[j][0].y) + (v[j][0].z * v[j][0].z + v[j][0].w * v[j][0].w) + (v[j][1].x * v[j][1].x + v[j][1].y * v[j][1].y) + (v[j][1].z * v[j][1].z + v[j][1].w * v[j][1].w); }
            const float rs = rsqrtf(wave_sum(s) * (1.0f / D) + RMS_EPS);
            GAS f32x4* o = (GAS f32x4*)(out + (size_t)(row + r) * D) + 2 * lane_;
#pragma unroll
            for (int j = 0; j < 2; ++j) { o[128 * j] = v[j][0] * rs * gv[j][0]; o[128 * j + 1] = v[j][1] * rs * gv[j][1]; }
        }
    }
}

__global__ void __launch_bounds__(512, 2) trunk_fwd(Args args) {
    extern __shared__ __attribute__((aligned(16))) unsigned char lds_raw[];
    Frame F;
    F.lds = (LAS unsigned char*)lds_raw;
    F.tid = threadIdx.x; F.lane = F.tid & 63; F.wave = __builtin_amdgcn_readfirstlane(F.tid >> 6);
    F.G = gridDim.x; { const int bx = blockIdx.x; F.vcu = (F.G % 8 == 0) ? (bx % 8) * (F.G / 8) + bx / 8 : bx; }
    unsigned char* ws = args.ws;
    unsigned* ctl = (unsigned*)(ws + WS_CTL);
    volatile LAS unsigned* MISC = (volatile LAS unsigned*)(F.lds + LDS_MISC);
    for (int u = F.tid; u < (LDS_BYTES - LDS_MISC) / 4; u += 512) ((LAS unsigned*)(F.lds + LDS_MISC))[u] = 0u;
    __syncthreads();
    XcdBarrier bar = xcd_barrier_post(ctl + 4096 + args.li * XCD_BAR_WORDS, MISC + 8);
    const int lo = args.ph_lo, hi = args.ph_hi;
#define IN(k) (lo <= (k) && (k) < hi)
#define GRID_BAR(k) do { if (hi > (k) + 1) xcd_barrier(bar); } while (0)

    bf16_t* xb = (bf16_t*)(ws + WS_XB);
    float* ssq = (float*)(ws + WS_SSQ);

    if (IN(0)) { if (I8_F1_LAYERS || I8_RET) { p0_wabs(F, args); xcd_barrier(bar); } p0_prologue(F, args); GRID_BAR(0); }

#pragma unroll 1
    for (int L = 0; L < NLAYER; ++L) {
        const int pb = 1 + 6 * L;
        const int kind = (L == 1) ? 1 : (L == 2) ? 2 : 0;
        int pmo;
        const bf16_t* moA; const bf16_t* moB; int moK;
        if (kind == 0) {
            const int j = (L == 0) ? 0 : 1;
            bf16_t* Bo = (bf16_t*)(ws + AR_CB); bf16_t* CZ = (bf16_t*)(ws + AR_CZ); bf16_t* CY = (bf16_t*)(ws + AR_CY);
            if (IN(pb)) {
                pg8::Gemm g{opq(xb), opq((const bf16_t*)(ws + W_CI + j * W_CI_SZ)), M, 3072, 1024}; pg8::StaticOrder S; S.init(M, 3072, F.G, (int)blockIdx.x);
                EpiConvIn E{(const GAS float*)opq(ssq), (GAS bf16_t*)opq(Bo), (GAS bf16_t*)opq(CZ)};
                pg8::gemm_phase<EpiConvIn>(F.lds, g, S, E);
                GRID_BAR(pb);
            }
            if (IN(pb + 1)) { conv_phase(F, (const GAS bf16_t*)opq(Bo), (const GAS bf16_t*)opq(CZ), (const GAS float*)opq(args.in[5] + (size_t)j * 3 * D), (GAS bf16_t*)opq(CY)); GRID_BAR(pb + 1); }
            pmo = pb + 2; moA = CY; moB = (const bf16_t*)(ws + W_CO + j * W_CO_SZ); moK = 1024;
        } else if (kind == 1) {
            bf16_t* U = (bf16_t*)(ws + AR_SU); bf16_t* V = (bf16_t*)(ws + AR_SV); float* lnp = (float*)(ws + WS_LNP);
            {
            if (IN(pb)) {
                pg8::Gemm g{opq(xb), opq((const bf16_t*)(ws + W_SI)), M, 4096, 1024}; pg8::StaticOrder S; S.init(M, 4096, F.G, (int)blockIdx.x);
                EpiSguIn E{(const GAS float*)opq(ssq), (GAS bf16_t*)opq(U), (GAS bf16_t*)opq(V), (GAS float*)opq(lnp)};
                pg8::gemm_phase<EpiSguIn>(F.lds, g, S, E);
                GRID_BAR(pb);
            }
            if (IN(pb + 1)) { sgu_phase(F, (GAS bf16_t*)opq(U), (const GAS bf16_t*)opq(V), (const GAS float*)opq(lnp), (const GAS bf16_t*)opq((const bf16_t*)(ws + W_WS)), (const GAS float*)opq(args.in[8]), (const GAS float*)opq(args.in[9]), (const GAS float*)opq(args.in[11])); GRID_BAR(pb + 1); }
            }
            pmo = pb + 2; moA = U; moB = (const bf16_t*)(ws + W_SO); moK = 2048;
        } else {
            bf16_t* Q = (bf16_t*)(ws + AR_RQ); bf16_t* Kn = (bf16_t*)(ws + AR_RK); bf16_t* V = (bf16_t*)(ws + AR_RV);
            float* hss = args.out;
            {
            {
            if (IN(pb)) {
                if constexpr (I8_RET) {
                quant_phase(F, (const GAS bf16_t*)opq((const bf16_t*)xb), (GAS unsigned char*)opq(ws + WS_X8), (GAS float*)opq((float*)(ws + WS_SA)));
                xcd_barrier(bar);
                pg8::Gemm g{opq((const bf16_t*)(ws + WS_X8)), opq((const bf16_t*)(ws + W_RQ)), M, 4096, 1024 / 2}; pg8::StaticOrder S; S.init(M, 4096, F.G, (int)blockIdx.x);
                EpiRetQkv E{(const GAS float*)opq(ssq), (const GAS float*)opq((const float*)(ws + WS_ROT)), (const GAS float*)opq((const float*)(ws + WS_ROT) + (size_t)SEQ * 128), (GAS bf16_t*)opq(Q), (GAS bf16_t*)opq(Kn), (GAS bf16_t*)opq(V),
                            (const GAS float*)opq((const float*)(ws + WS_SA)), i8_wfull(ws, 4, F.lane, 1.0f / (1024.0f * 4096.0f)) * (1.0f / 127.0f)};
                pg8::gemm_phase<EpiRetQkv, true, true, false, true, true>(F.lds, g, S, E);
                } else {
                pg8::Gemm g{opq(xb), opq((const bf16_t*)(ws + W_RQ)), M, 4096, 1024}; pg8::StaticOrder S; S.init(M, 4096, F.G, (int)blockIdx.x);
                EpiRetQkv E{(const GAS float*)opq(ssq), (const GAS float*)opq((const float*)(ws + WS_ROT)), (const GAS float*)opq((const float*)(ws + WS_ROT) + (size_t)SEQ * 128), (GAS bf16_t*)opq(Q), (GAS bf16_t*)opq(Kn), (GAS bf16_t*)opq(V), (const GAS float*)nullptr, 1.0f};
                pg8::gemm_phase<EpiRetQkv>(F.lds, g, S, E);
                }
                GRID_BAR(pb);
            }
            if (IN(pb + 1)) { ret_phase(F, (const GAS bf16_t*)opq(Q), (const GAS bf16_t*)opq(Kn), (GAS bf16_t*)opq(V), (GAS float*)opq(hss)); GRID_BAR(pb + 1); }
            }
            if (IN(pb + 2)) {
                if constexpr (I8_RET) {
                pg8::Gemm g{opq((const bf16_t*)(ws + WS_X8)), opq((const bf16_t*)(ws + W_RG)), M, 2048, 1024 / 2}; pg8::StaticOrder S; S.init(M, 2048, F.G, (int)blockIdx.x);
                EpiRetG E{(const GAS float*)opq(ssq), (const GAS float*)opq(hss), (GAS bf16_t*)opq(V), (const GAS float*)opq((const float*)(ws + WS_SA)), i8_wfull(ws, 5, F.lane, 1.0f / (1024.0f * 2048.0f)) * (1.0f / 127.0f)};
                pg8::gemm_phase<EpiRetG, true, true, false, true, true>(F.lds, g, S, E);
                } else {
                pg8::Gemm g{opq(xb), opq((const bf16_t*)(ws + W_RG)), M, 2048, 1024}; pg8::StaticOrder S; S.init(M, 2048, F.G, (int)blockIdx.x);
                EpiRetG E{(const GAS float*)opq(ssq), (const GAS float*)opq(hss), (GAS bf16_t*)opq(V), (const GAS float*)nullptr, 1.0f};
                pg8::gemm_phase<EpiRetG>(F.lds, g, S, E);
                }
                GRID_BAR(pb + 2);
            }
            }
            pmo = pb + 3; moA = V; moB = (const bf16_t*)(ws + W_RO); moK = 2048;
        }
        if (IN(pmo)) {
            pg8::Gemm g{opq(moA), opq(moB), M, 1024, moK}; pg8::StaticOrder S; S.init(M, 1024, F.G, (int)blockIdx.x);
            EpiResid E{(GAS bf16_t*)opq(xb), (GAS float*)opq(ssq), 1.0f, ((F8_F1_LAYERS >> L) & 1) ? (GAS unsigned char*)opq(ws + WS_X8) : (GAS unsigned char*)nullptr};
            pg8::gemm_phase<EpiResid>(F.lds, g, S, E);
            GRID_BAR(pmo);
        }
        if (IN(pb + 4)) {
            if ((I8_F1_LAYERS >> L) & 1) {
                quant_phase(F, (const GAS bf16_t*)opq((const bf16_t*)xb), (GAS unsigned char*)opq(ws + WS_X8), (GAS float*)opq((float*)(ws + WS_SA)));
                xcd_barrier(bar);
                pg8::Gemm g{opq((const bf16_t*)(ws + WS_X8)), opq((const bf16_t*)(ws + W_FI + L * W_FI_SZ)), M, 2 * DFF, 1024 / 2}; pg8::StaticOrder S; S.init(M, 2 * DFF, F.G, (int)blockIdx.x);
                const float wsc = i8_wfull(ws, L, F.lane) * (1.0f / 127.0f);
                EpiFfnIn E{(const GAS float*)opq(ssq), (GAS unsigned char*)opq(ws + AR_FA), ((F8_LAYERS >> L) & 1) != 0, wsc, (const GAS float*)opq((const float*)(ws + WS_SA)), true};
                pg8::gemm_phase<EpiFfnIn, true, true, false, true>(F.lds, g, S, E);
            } else if ((F8_F1_LAYERS >> L) & 1) {
                pg8::Gemm g{opq((const bf16_t*)(ws + WS_X8)), opq((const bf16_t*)(ws + W_FI + L * W_FI_SZ)), M, 2 * DFF, 1024 / 2}; pg8::StaticOrder S; S.init(M, 2 * DFF, F.G, (int)blockIdx.x);
                EpiFfnIn E{(const GAS float*)opq(ssq), (GAS unsigned char*)opq(ws + AR_FA), ((F8_LAYERS >> L) & 1) != 0, 1.0f / FI_WSCALE, (const GAS float*)nullptr, false};
                pg8::gemm_phase<EpiFfnIn, true, true, true>(F.lds, g, S, E);
            } else {
                pg8::Gemm g{opq(xb), opq((const bf16_t*)(ws + W_FI + L * W_FI_SZ)), M, 2 * DFF, 1024}; pg8::StaticOrder S; S.init(M, 2 * DFF, F.G, (int)blockIdx.x);
                EpiFfnIn E{(const GAS float*)opq(ssq), (GAS unsigned char*)opq(ws + AR_FA), ((F8_LAYERS >> L) & 1) != 0, 1.0f, (const GAS float*)nullptr, false};
                pg8::gemm_phase<EpiFfnIn>(F.lds, g, S, E);
            }
            GRID_BAR(pb + 4);
        }
        if (IN(pb + 5)) {
            if ((F8_LAYERS >> L) & 1) {
                pg8::Gemm g{opq((const bf16_t*)(ws + AR_FA)), opq((const bf16_t*)(ws + W_FD + L * W_FD_SZ)), M, 1024, DFF / 2}; pg8::StaticOrder S; S.init(M, 1024, F.G, (int)blockIdx.x);
                EpiResidT<2> E{(GAS bf16_t*)opq(xb), (GAS float*)opq(ssq), 1.0f / FD_WSCALE, (GAS unsigned char*)nullptr};
                pg8::gemm_phase<EpiResidT<2>, true, true, true>(F.lds, g, S, E);
            } else {
                pg8::Gemm g{opq((const bf16_t*)(ws + AR_FA)), opq((const bf16_t*)(ws + W_FD + L * W_FD_SZ)), M, 1024, DFF}; pg8::StaticOrder S; S.init(M, 1024, F.G, (int)blockIdx.x);
                EpiResid E{(GAS bf16_t*)opq(xb), (GAS float*)opq(ssq), 1.0f, (GAS unsigned char*)nullptr};
                pg8::gemm_phase<EpiResid>(F.lds, g, S, E);
            }
            GRID_BAR(pb + 5);
        }
    }
    if (IN(NPH - 1)) final_phase(F, (const GAS bf16_t*)opq((const bf16_t*)xb), (GAS float*)opq(args.out), (const GAS float*)opq(args.in[3]));
#undef IN
#undef GRID_BAR
}

extern "C" void kernel_launch(void* const* d_in, const int* in_sizes, int n_in, void* d_out, int out_size, void* d_ws, size_t ws_size, hipStream_t stream) {
    static int grid = 0;
    if (grid == 0) {
        if (n_in != 18 || out_size != M * D || ws_size < WS_END) { fprintf(stderr, "kernel_launch: unexpected shapes (n_in %d out %d ws %zu)\n", n_in, out_size, ws_size); grid = -1; return; }
        int dev = 0, cus = 0, per_cu = 0;
        if (hipGetDevice(&dev) != hipSuccess || hipDeviceGetAttribute(&cus, hipDeviceAttributeMultiprocessorCount, dev) != hipSuccess) { grid = -1; return; }
        if (hipFuncSetAttribute((const void*)trunk_fwd, hipFuncAttributeMaxDynamicSharedMemorySize, LDS_BYTES) != hipSuccess) { fprintf(stderr, "kernel_launch: hipFuncSetAttribute failed\n"); grid = -1; return; }
        if (hipOccupancyMaxActiveBlocksPerMultiprocessor(&per_cu, (const void*)trunk_fwd, 512, LDS_BYTES) != hipSuccess || per_cu < 1)
            fprintf(stderr, "kernel_launch: occupancy query reports %d\n", per_cu);
        (void)hipGetLastError();
        grid = cus;
    }
    if (grid < 0) return;
    (void)in_sizes;
    if (hipMemsetAsync((char*)d_ws + WS_CTL, 0, CTL_BYTES, stream) != hipSuccess) return;
    Args a{};
    for (int i = 0; i < 18; ++i) a.in[i] = (const float*)d_in[i];
    a.out = (float*)d_out; a.ws = (unsigned char*)d_ws; a.pad = 0;
#if MK_ONE_LAUNCH
    a.ph_lo = 0; a.ph_hi = NPH; a.li = 0;
    hipLaunchKernelGGL(trunk_fwd, dim3(grid), dim3(512), LDS_BYTES, stream, a);
#else
    int li = 0;
    for (int ph = 0; ph < NPH; ++ph) {
        const int r = (ph - 1) % 6, L = (ph - 1) / 6;
        if (ph >= 1 && ph < NPH - 1 && r == 3 && L != 2) continue;
        a.ph_lo = ph; a.ph_hi = ph + 1; a.li = li++;
        hipLaunchKernelGGL(trunk_fwd, dim3(grid), dim3(512), LDS_BYTES, stream, a);
    }
#endif
}
```

```cpp
#include <hip/hip_runtime.h>
#include <cstdio>
#include <cstdint>

#ifndef MK_ONE_LAUNCH
#define MK_ONE_LAUNCH 1
#endif

#define LAS __attribute__((address_space(3)))
#define GAS __attribute__((address_space(1)))
typedef unsigned short bf16_t;
typedef short bf16x8 __attribute__((ext_vector_type(8)));
typedef short bf16x4 __attribute__((ext_vector_type(4)));
typedef float f32x4 __attribute__((ext_vector_type(4)));
typedef float f32x2 __attribute__((ext_vector_type(2)));
typedef unsigned u32x4 __attribute__((ext_vector_type(4)));
typedef unsigned u32x2 __attribute__((ext_vector_type(2)));
typedef int i32x4 __attribute__((ext_vector_type(4)));
typedef int i32x8 __attribute__((ext_vector_type(8)));

constexpr int D = 1024, NB = 4, SEQ = 8192, M = NB * SEQ, DFF = 2816, NLAYER = 4;
constexpr int RH = 4, RQK = 256, RV = 512, RC = 128;
constexpr float RMS_EPS = 1e-6f, LN_EPS = 1e-5f;
constexpr int F8_LAYERS = 0x8;
constexpr bool I8_SGU = true;
constexpr bool I8_RET = true;
constexpr int I8_F1_LAYERS = 0xF;
constexpr int F8_F1_LAYERS = 0x0;
constexpr float FD_WSCALE = 64.0f, FI_WSCALE = 32.0f;
constexpr float WCLIP = 3.5f;
constexpr int CTL_WSS = 131072;

constexpr size_t MiB = 1u << 20;
constexpr size_t WS_CTL = 0, CTL_BYTES = 1 * MiB;
constexpr size_t WS_SSQ = 1 * MiB;
constexpr size_t WS_W = 3 * MiB;
constexpr size_t W_CI = WS_W, W_CI_SZ = (size_t)3072 * 1024 * 2;
constexpr size_t W_CO = W_CI + 2 * W_CI_SZ, W_CO_SZ = (size_t)1024 * 1024 * 2;
constexpr size_t W_SI = W_CO + 2 * W_CO_SZ, W_SI_SZ = (size_t)4096 * 1024 * 2;
constexpr size_t W_SO = W_SI + W_SI_SZ, W_SO_SZ = (size_t)1024 * 2048 * 2;
constexpr size_t W_RQ = W_SO + W_SO_SZ, W_RQ_SZ = (size_t)4096 * 1024 * 2;
constexpr size_t W_RG = W_RQ + W_RQ_SZ, W_RG_SZ = (size_t)2048 * 1024 * 2;
constexpr size_t W_RO = W_RG + W_RG_SZ, W_RO_SZ = (size_t)1024 * 2048 * 2;
constexpr size_t W_FI = W_RO + W_RO_SZ, W_FI_SZ = (size_t)5632 * 1024 * 2;
constexpr size_t W_FD = W_FI + 4 * W_FI_SZ, W_FD_SZ = (size_t)1024 * 2816 * 2;
constexpr size_t W_WS = W_FD + 4 * W_FD_SZ, W_WS_SZ = (size_t)8 * 128 * 128 * 2;
constexpr size_t WS_WEND = W_WS + W_WS_SZ;
static_assert(WS_WEND <= 114 * MiB, "weights");
constexpr size_t WS_ROT = 114 * MiB;
constexpr size_t WS_HSS = WS_ROT;
constexpr size_t WS_XB = 122 * MiB;
constexpr size_t WS_AR = 186 * MiB;
constexpr size_t WS_SA = 491 * MiB;
constexpr size_t WS_X8 = 458 * MiB;
constexpr size_t WS_KT = 442 * MiB;
constexpr size_t WS_LNP = WS_KT;
constexpr size_t WS_END = 506 * MiB;
constexpr size_t AR_CB = WS_AR, AR_CZ = WS_AR + 64 * MiB, AR_CY = WS_AR + 128 * MiB;
constexpr size_t AR_SU = WS_AR, AR_SV = WS_AR + 128 * MiB;
constexpr size_t AR_RQ = WS_AR, AR_RK = WS_AR + 64 * MiB, AR_RV = WS_AR + 128 * MiB;
constexpr size_t AR_FA = WS_AR;

constexpr int NPH = 26;
constexpr int LDS_BYTES = 159744;
constexpr int LDS_MISC = 159232;

#define RLX_AGENT __ATOMIC_RELAXED, __HIP_MEMORY_SCOPE_AGENT
__device__ __forceinline__ unsigned f2bf(float f) { unsigned u = __builtin_bit_cast(unsigned, f); return (u + 0x7fffu + ((u >> 16) & 1u)) >> 16; }
typedef __bf16 bf16v2 __attribute__((ext_vector_type(2)));
__device__ __forceinline__ unsigned pk2(float lo, float hi) { const f32x2 v = {lo, hi}; return __builtin_bit_cast(unsigned, __builtin_convertvector(v, bf16v2)); }
__device__ __forceinline__ float bf_lo(unsigned w) { return __builtin_bit_cast(float, w << 16); }
__device__ __forceinline__ float bf_hi(unsigned w) { return __builtin_bit_cast(float, w & 0xffff0000u); }
__device__ __forceinline__ float wave_max(float v) {
#pragma unroll
    for (int o = 1; o < 64; o <<= 1) v = fmaxf(v, __shfl_xor(v, o));
    return v;
}
__device__ __forceinline__ float wave_sum(float v) {
#pragma unroll
    for (int o = 1; o < 64; o <<= 1) v += __shfl_xor(v, o);
    return v;
}
template <class T> __device__ __forceinline__ T* opq(T* p) { asm volatile("" : "+s"(p)); return p; }
__device__ __forceinline__ int opq_tid() { int t = threadIdx.x; asm volatile("" : "+v"(t)); return t; }
__device__ __forceinline__ float fast_rcp(float x) { return __builtin_amdgcn_rcpf(x); }
__device__ __forceinline__ float silu_f(float x) { return x * fast_rcp(1.0f + __builtin_amdgcn_exp2f(-1.44269504089f * x)); }

#define XB_TMO      128
#define XB_XCNT(j)  (256  + 64 * (j))
#define XB_XSUB(j)  (1280 + 64 * (j))
#define XB_XGEN(j)  (2304 + 64 * (j))
#define XB_TOP      3328
#define XB_TOPGEN   3392
#define XCD_BAR_WORDS 3456
#define XB_SPIN_CAP (1u << 18)
__device__ __forceinline__ unsigned xb_ld(unsigned* p)              { return __hip_atomic_load(p, __ATOMIC_RELAXED, __HIP_MEMORY_SCOPE_AGENT); }
__device__ __forceinline__ unsigned xb_add(unsigned* p, unsigned v) { return __hip_atomic_fetch_add(p, v, __ATOMIC_RELAXED, __HIP_MEMORY_SCOPE_AGENT); }
__device__ __forceinline__ unsigned xb_xcc_id() { return (unsigned)__builtin_amdgcn_s_getreg((3 << 11) | 20) & 0xFu; }
#define XB_SPIN(cond, bar) do { unsigned _sp = 0; while (cond) { __builtin_amdgcn_s_sleep(1); \
    if ((++_sp & 255u) == 0u) { if (xb_ld(&(bar)[XB_TMO])) break; if (_sp > XB_SPIN_CAP) { atomicAdd(&(bar)[XB_TMO], 1u); break; } } } } while (0)
struct XcdBarrier { unsigned* bar; unsigned x; volatile LAS unsigned* st; };
__device__ __forceinline__ XcdBarrier xcd_barrier_post(unsigned* bar, volatile LAS unsigned* st) {
    XcdBarrier b; b.bar = bar; b.x = xb_xcc_id(); b.st = st;
    if (threadIdx.x == 0) (void)xb_add(&bar[XB_XCNT(b.x)], 1u);
    return b;
}
__device__ __forceinline__ void xcd_barrier_complete(unsigned* bar, unsigned x, unsigned& nloc, unsigned& nx) {
    const unsigned G = gridDim.x * gridDim.y * gridDim.z;
    unsigned sum, cnt, mine, sp = 0u;
    for (;;) {
        sum = 0u; cnt = 0u; mine = 0u;
#pragma unroll
        for (unsigned j = 0; j < 16; ++j) { const unsigned c = xb_ld(&bar[XB_XCNT(j)]); sum += c; cnt += (c > 0u) ? 1u : 0u; mine = (j == x) ? c : mine; }
        if (sum == G) break;
        __builtin_amdgcn_s_sleep(1);
        if ((++sp & 255u) == 0u) { if (xb_ld(&bar[XB_TMO])) break; if (sp > XB_SPIN_CAP) { atomicAdd(&bar[XB_TMO], 1u); break; } }
    }
    nloc = mine > 0u ? mine : 1u; nx = cnt > 0u ? cnt : 1u;
}
__device__ __forceinline__ void xcd_barrier(const XcdBarrier& b) {
    asm volatile("s_waitcnt vmcnt(0)" ::: "memory");
    __syncthreads();
    if (threadIdx.x == 0) {
        unsigned* bar = b.bar;
        __builtin_amdgcn_s_waitcnt(0);
        unsigned nloc = b.st[0], nx = b.st[1];
        if (nloc == 0u) { xcd_barrier_complete(bar, b.x, nloc, nx); b.st[0] = nloc; b.st[1] = nx; }
        const unsigned old = xb_add(&bar[XB_XSUB(b.x)], 1u);
        const unsigned gen = old / nloc;
        if (old + 1u == (gen + 1u) * nloc) {
            __builtin_amdgcn_fence(__ATOMIC_RELEASE, "agent");
            asm volatile("s_waitcnt vmcnt(0)" ::: "memory");
            const unsigned og = xb_add(&bar[XB_TOP], 1u);
            const unsigned tg = og / nx;
            if (og + 1u == (tg + 1u) * nx) xb_add(&bar[XB_TOPGEN], 1u);
            else XB_SPIN(xb_ld(&bar[XB_TOPGEN]) == tg, bar);
            __builtin_amdgcn_fence(__ATOMIC_ACQUIRE, "agent");
            xb_add(&bar[XB_XGEN(b.x)], 1u);
            asm volatile("s_waitcnt vmcnt(0)" ::: "memory");
        } else {
            XB_SPIN(xb_ld(&bar[XB_XGEN(b.x)]) == gen, bar);
            __builtin_amdgcn_fence(__ATOMIC_ACQUIRE, "agent");
            asm volatile("s_waitcnt vmcnt(0)" ::: "memory");
        }
    }
    __syncthreads();
}

namespace pg8 {
constexpr int BM = 256, BK = 64, HALF = 128, HTB = HALF * BK * 2, STAGE_BYTES = 8 * HTB, NXCD = 8, WGM = 8;
__host__ __device__ __forceinline__ int lds_byte(int r, int c) { const int st = (r >> 4) * 2 + (c >> 5), rr = r & 15, cc = c & 31, ob = rr * 64 + cc * 2; return st * 1024 + (ob ^ (((ob >> 9) & 1) << 5)); }
__host__ __device__ __forceinline__ void stage_rc(int b, int& R, int& C) { const int st = b / 1024, sb = b % 1024, swz = sb ^ (((sb >> 9) & 1) << 5); R = (st >> 1) * 16 + swz / 64; C = (st & 1) * 32 + (swz % 64) / 2; }
__host__ __device__ __forceinline__ int perm32(int rho) { const int n = rho >> 4, i = rho & 15; return 8 * (i >> 2) + 4 * n + (i & 3); }

struct Unit { int pm, pn; };
struct Gemm { const bf16_t* A; const bf16_t* Bt; int M, N, K; };
struct StaticOrder {
    int nM, nN, nwg, G, c;
    __host__ __device__ void init(int M_, int N_, int G_, int c_) { nM = M_ / BM; nN = N_ / BM; nwg = nM * nN; G = G_; c = c_; }
    __host__ __device__ bool next(int i, Unit& u) const {
        const long L = (long)i * G + c; if (L >= nwg) return false;
        int wgid = (int)L; { const int q = nwg / NXCD, r = nwg % NXCD, xcd = wgid % NXCD, off = wgid / NXCD; wgid = (xcd < r ? xcd * (q + 1) : r * (q + 1) + (xcd - r) * q) + off; }
        const int nig = WGM * nN, gid = wgid / nig, fm = gid * WGM, gsz = (nM - fm) < WGM ? (nM - fm) : WGM;
        u.pm = fm + ((wgid % nig) % gsz); u.pn = (wgid % nig) / gsz; return true;
    }
};

template <class E_> __device__ __forceinline__ auto rowsc_of(const E_& e, int) -> decltype(e.rowsc) { return e.rowsc; }
template <class E_> __device__ __forceinline__ const GAS float* rowsc_of(const E_&, long) { return nullptr; }
template <class E_> __device__ __forceinline__ auto tsc_of(const E_& e, int) -> decltype(e.tsc) { return e.tsc; }
template <class E_> __device__ __forceinline__ float tsc_of(const E_&, long) { return 1.0f; }
template <class Epi, bool ALIGN_EPI = true, bool SP2 = true, bool F8 = false, bool I8 = false, bool CVT = false>
__device__ __forceinline__ void gemm_phase(LAS unsigned char* lds, const Gemm g, const StaticOrder& S, const Epi& E) {
    const int tid = opq_tid(), wid = __builtin_amdgcn_readfirstlane(tid >> 6), lane = tid & 63, wr = wid >> 2, wc = wid & 3, fr = lane & 15, fq = lane >> 4;
    const int K = g.K, nt = K / BK;
    unsigned voffA[2];
#pragma unroll
    for (int i = 0; i < 2; ++i) { int R, C; stage_rc(tid * 16 + i * 8192, R, C); voffA[i] = (unsigned)(R * K + C) * 2u; }
    const size_t kstep = (size_t)(BK * 2);
    const size_t hstep = (size_t)HALF * K * 2;
    const size_t tstep = 2 * hstep;
    const unsigned ldsw = (unsigned)wid * 1024u;
    const int aoff = lds_byte(wr * 64 + fr, fq * 8), boff = lds_byte(wc * 32 + fr, fq * 8);
#define PG8_SA(b, h) (((b) * 2 + (h)) * HTB)
#define PG8_SB(b, h) ((4 + (b) * 2 + (h)) * HTB)
#define PG8_STAGE(bufoff, gbase, voff) do { _Pragma("unroll") for (int _i = 0; _i < 2; ++_i) \
        __builtin_amdgcn_global_load_lds((const unsigned*)((const char*)(gbase) + (voff)[_i]), (LAS unsigned*)(lds + (bufoff) + ldsw + _i * 8192), 16, 0, 0); } while (0)
#define PG8_LDA(dst, b, h) do { _Pragma("unroll") for (int m = 0; m < 4; ++m) _Pragma("unroll") for (int k = 0; k < 2; ++k) dst[m][k] = *(const LAS bf16x8*)(lds + PG8_SA(b, h) + aoff + m * 2048 + k * 1024); } while (0)
#define PG8_LDB(dst, b, h) do { _Pragma("unroll") for (int n = 0; n < 2; ++n) _Pragma("unroll") for (int k = 0; k < 2; ++k) dst[n][k] = *(const LAS bf16x8*)(lds + PG8_SB(b, h) + boff + n * 2048 + k * 1024); } while (0)
#define PG8_CAT8(lo, hi) __builtin_shufflevector(__builtin_bit_cast(i32x4, lo), __builtin_bit_cast(i32x4, hi), 0, 1, 2, 3, 4, 5, 6, 7)
#define PG8_MMA(ai, bj, At, Bt) do { __builtin_amdgcn_s_setprio(1); _Pragma("unroll") for (int m = 0; m < 4; ++m) _Pragma("unroll") for (int n = 0; n < 2; ++n) { \
        if constexpr (F8) { const i32x8 b8_ = PG8_CAT8(Bt[n][0], Bt[n][1]), a8_ = PG8_CAT8(At[m][0], At[m][1]); asm volatile("v_mfma_f32_16x16x128_f8f6f4 %0, %1, %2, %0" : "+v"(acc[ai][bj][m][n]) : "v"(b8_), "v"(a8_)); } \
        else if constexpr (I8) { _Pragma("unroll") for (int k = 0; k < 2; ++k) acc[ai][bj][m][n] = __builtin_bit_cast(f32x4, __builtin_amdgcn_mfma_i32_16x16x64_i8(__builtin_bit_cast(i32x4, Bt[n][k]), __builtin_bit_cast(i32x4, At[m][k]), __builtin_bit_cast(i32x4, acc[ai][bj][m][n]), 0, 0, 0)); } \
        else { _Pragma("unroll") for (int k = 0; k < 2; ++k) acc[ai][bj][m][n] = __builtin_amdgcn_mfma_f32_16x16x32_bf16(Bt[n][k], At[m][k], acc[ai][bj][m][n], 0, 0, 0); } } __builtin_amdgcn_s_setprio(0); } while (0)
#define PG8_WAIT_V(n) asm volatile("s_waitcnt vmcnt(" #n ")" ::: "memory")
#define PG8_WAIT_L(n) asm volatile("s_waitcnt lgkmcnt(" #n ")" ::: "memory")
#define PG8_BAR __builtin_amdgcn_s_barrier()
#define PG8_SCHED __builtin_amdgcn_sched_barrier(0)
    LAS int* utab = (LAS int*)(lds + LDS_MISC + 128);
    if (tid < 16) { Unit tu; tu.pm = 0; tu.pn = 0; const bool ok = S.next(tid, tu); utab[2 * tid] = ok ? tu.pm : -1; utab[2 * tid + 1] = tu.pn; }
    __syncthreads();
#define PG8_NEXT(i, u) ((i) < 16 && ((u).pm = __builtin_amdgcn_readfirstlane(utab[2 * (i)]), (u).pn = __builtin_amdgcn_readfirstlane(utab[2 * (i) + 1]), (u).pm >= 0))
    Unit cur, nxt; int ui = 0;
    if (!PG8_NEXT(0, cur)) return;
    const char* cA = (const char*)g.A + (size_t)cur.pm * tstep; const char* cB = (const char*)g.Bt + (size_t)cur.pn * tstep;
    if constexpr (SP2) {
        PG8_STAGE(PG8_SB(0, 0), cB, voffA); PG8_STAGE(PG8_SB(0, 1), cB + hstep, voffA); PG8_STAGE(PG8_SA(0, 0), cA, voffA); PG8_STAGE(PG8_SA(0, 1), cA + hstep, voffA);
    }
    if constexpr (Epi::NEEDS_RS) {
        LAS float* rst = (LAS float*)(lds + STAGE_BYTES);
        const GAS float* rsc = rowsc_of(E, 0); const float tsc = tsc_of(E, 0);
        for (int q = tid; q < 16 * 256; q += 512) { const int i = q >> 8, r = q & 255, pm = utab[2 * i];
            if (pm >= 0) { const GAS f32x4* p = (const GAS f32x4*)(E.ssq + (size_t)(pm * 256 + r) * 16); const f32x4 a0 = p[0], a1 = p[1], a2 = p[2], a3 = p[3];
                const float xs = (rsc ? rsc[pm * 256 + r] : 1.0f) * tsc;
                rst[q] = xs * rsqrtf((((a0.x + a0.y) + (a0.z + a0.w)) + ((a1.x + a1.y) + (a1.z + a1.w)) + ((a2.x + a2.y) + (a2.z + a2.w)) + ((a3.x + a3.y) + (a3.z + a3.w))) * (1.0f / D) + RMS_EPS); } }
        if constexpr (Epi::NEEDS_RH) {
            LAS float* rht = (LAS float*)(lds + STAGE_BYTES + 16384);
            for (int q = tid; q < 8 * 256; q += 512) { const int i = q >> 8, r = q & 255, pm = utab[2 * i], hh = utab[2 * i + 1] >> 1;
                if (pm >= 0) { const GAS f32x4* p = (const GAS f32x4*)(E.hss + ((size_t)(pm * 256 + r) * RH + hh) * 16); const f32x4 a0 = p[0], a1 = p[1], a2 = p[2], a3 = p[3];
                    rht[q] = rsqrtf((((a0.x + a0.y) + (a0.z + a0.w)) + ((a1.x + a1.y) + (a1.z + a1.w)) + ((a2.x + a2.y) + (a2.z + a2.w)) + ((a3.x + a3.y) + (a3.z + a3.w))) * (1.0f / RV) + RMS_EPS); } }
        }
        __syncthreads();
    }
    f32x4 acc[2][2][4][2];
#define PG8_ZERO_ACC do { bf16x8 z_ = (bf16x8){0, 0, 0, 0, 0, 0, 0, 0}; asm volatile("" : "+v"(z_)); \
        _Pragma("unroll") for (int a = 0; a < 2; ++a) _Pragma("unroll") for (int b = 0; b < 2; ++b) _Pragma("unroll") for (int m = 0; m < 4; ++m) _Pragma("unroll") for (int n = 0; n < 2; ++n) \
            acc[a][b][m][n] = __builtin_amdgcn_mfma_f32_16x16x32_bf16(z_, z_, (f32x4){0.f, 0.f, 0.f, 0.f}, 0, 0, 0); } while (0)
    PG8_ZERO_ACC;
    bf16x8 At[4][2], B0[2][2], B1[2][2];
    if constexpr (SP2) {
        if (wr == 1) PG8_BAR;
        PG8_WAIT_V(2); PG8_BAR;
        PG8_STAGE(PG8_SB(1, 0), cB + kstep, voffA); PG8_STAGE(PG8_SA(1, 0), cA + kstep, voffA); PG8_STAGE(PG8_SB(1, 1), cB + hstep + kstep, voffA);
        PG8_WAIT_V(6); PG8_BAR;
    } else {
        PG8_STAGE(PG8_SB(0, 0), cB, voffA); PG8_STAGE(PG8_SA(0, 0), cA, voffA); PG8_STAGE(PG8_SB(0, 1), cB + hstep, voffA); PG8_STAGE(PG8_SA(0, 1), cA + hstep, voffA);
        if (wr == 1) PG8_BAR;
        PG8_WAIT_V(4); PG8_BAR;
        PG8_STAGE(PG8_SB(1, 0), cB + kstep, voffA); PG8_STAGE(PG8_SA(1, 0), cA + kstep, voffA); PG8_STAGE(PG8_SB(1, 1), cB + hstep + kstep, voffA);
        PG8_WAIT_V(6); PG8_BAR;
    }
    for (;;) {
        const bool has_next = PG8_NEXT(ui + 1, nxt);
        const char* nA = has_next ? (const char*)g.A + (size_t)nxt.pm * tstep : cA; const char* nB = has_next ? (const char*)g.Bt + (size_t)nxt.pn * tstep : cB;
        __builtin_amdgcn_s_waitcnt(0xC07F);
        for (int t = 0; t < nt; t += 2) {
            const bool last = (t == nt - 2);
            const char* a1 = cA + (size_t)(t + 1) * kstep;
            const char* a2 = last ? nA : cA + (size_t)(t + 2) * kstep; const char* b2 = last ? nB : cB + (size_t)(t + 2) * kstep;
            const char* a3 = a2 + kstep; const char* b3 = b2 + kstep;
            if constexpr (SP2) {
            PG8_LDB(B0, 0, 0); PG8_LDB(B1, 0, 1); PG8_SCHED; PG8_LDA(At, 0, 0); PG8_STAGE(PG8_SA(1, 1), a1 + hstep, voffA);
            PG8_WAIT_V(8); PG8_WAIT_L(0); PG8_BAR; PG8_MMA(0, 0, At, B0); PG8_MMA(0, 1, At, B1); PG8_BAR; PG8_SCHED;
            PG8_LDA(At, 0, 1); PG8_STAGE(PG8_SB(0, 0), b2, voffA); PG8_STAGE(PG8_SB(0, 1), b2 + hstep, voffA); PG8_STAGE(PG8_SA(0, 0), a2, voffA);
            PG8_WAIT_V(8); PG8_WAIT_L(0); PG8_BAR; PG8_MMA(1, 0, At, B0); PG8_MMA(1, 1, At, B1); PG8_BAR; PG8_SCHED;
            PG8_LDB(B0, 1, 0); PG8_LDB(B1, 1, 1); PG8_SCHED; PG8_LDA(At, 1, 0); PG8_STAGE(PG8_SA(0, 1), a2 + hstep, voffA);
            PG8_WAIT_V(8); PG8_WAIT_L(0); PG8_BAR; PG8_MMA(0, 0, At, B0); PG8_MMA(0, 1, At, B1); PG8_BAR; PG8_SCHED;
            PG8_LDA(At, 1, 1); PG8_STAGE(PG8_SB(1, 0), b3, voffA); PG8_STAGE(PG8_SB(1, 1), b3 + hstep, voffA); PG8_STAGE(PG8_SA(1, 0), a3, voffA);
            PG8_WAIT_V(8); PG8_WAIT_L(0); PG8_BAR; PG8_MMA(1, 0, At, B0); PG8_MMA(1, 1, At, B1); PG8_BAR; PG8_SCHED;
            } else {
            PG8_LDB(B0, 0, 0); PG8_SCHED; PG8_LDA(At, 0, 0); PG8_STAGE(PG8_SA(1, 1), a1 + hstep, voffA);
            PG8_WAIT_L(8); PG8_BAR; PG8_WAIT_L(0); PG8_MMA(0, 0, At, B0); PG8_BAR; PG8_SCHED;
            PG8_LDB(B1, 0, 1); PG8_STAGE(PG8_SB(0, 0), b2, voffA);
            PG8_BAR; PG8_WAIT_L(0); PG8_MMA(0, 1, At, B1); PG8_BAR;
            PG8_LDA(At, 0, 1); PG8_STAGE(PG8_SA(0, 0), a2, voffA);
            PG8_BAR; PG8_WAIT_L(0); PG8_MMA(1, 0, At, B0); PG8_BAR; PG8_SCHED;
            PG8_STAGE(PG8_SB(0, 1), b2 + hstep, voffA);
            PG8_WAIT_V(6); PG8_BAR; PG8_MMA(1, 1, At, B1); PG8_BAR;
            PG8_LDB(B0, 1, 0); PG8_SCHED; PG8_LDA(At, 1, 0); PG8_STAGE(PG8_SA(0, 1), a2 + hstep, voffA);
            PG8_WAIT_L(8); PG8_BAR; PG8_WAIT_L(0); PG8_MMA(0, 0, At, B0); PG8_BAR; PG8_SCHED;
            PG8_LDB(B1, 1, 1); PG8_STAGE(PG8_SB(1, 0), b3, voffA);
            PG8_BAR; PG8_WAIT_L(0); PG8_MMA(0, 1, At, B1); PG8_BAR;
            PG8_LDA(At, 1, 1); PG8_STAGE(PG8_SA(1, 0), a3, voffA);
            PG8_BAR; PG8_WAIT_L(0); PG8_MMA(1, 0, At, B0); PG8_BAR; PG8_SCHED;
            PG8_STAGE(PG8_SB(1, 1), b3 + hstep, voffA);
            PG8_WAIT_V(6); PG8_BAR; PG8_MMA(1, 1, At, B1); PG8_BAR;
            }
        }
        if constexpr (ALIGN_EPI) { if (wr == 0) PG8_BAR; }
        if constexpr (F8) asm volatile("s_nop 15\n\ts_nop 7" ::: "memory");
        if constexpr (CVT) {
#pragma unroll
            for (int a = 0; a < 2; ++a)
#pragma unroll
                for (int b = 0; b < 2; ++b)
#pragma unroll
                    for (int m = 0; m < 4; ++m)
#pragma unroll
                        for (int n = 0; n < 2; ++n) acc[a][b][m][n] = __builtin_convertvector(__builtin_bit_cast(i32x4, acc[a][b][m][n]), f32x4);
        }
        { int efr = fr, efq = fq; asm volatile("" : "+v"(efr), "+v"(efq));
          E(acc, cur, wr, wc, efr, efq, (const LAS float*)(lds + STAGE_BYTES) + ui * 256 + wr * 64 + efr); }
        if (!has_next) break;
        PG8_ZERO_ACC;
        cur = nxt; cA = nA; cB = nB; ++ui;
        if constexpr (ALIGN_EPI) { if (wr == 1) PG8_BAR; }
    }
    PG8_WAIT_V(0);
    if constexpr (!ALIGN_EPI) { if (wr == 0) PG8_BAR; }
    PG8_BAR;
#undef PG8_NEXT
#undef PG8_SA
#undef PG8_SB
#undef PG8_STAGE
#undef PG8_LDA
#undef PG8_LDB
#undef PG8_MMA
#undef PG8_CAT8
#undef PG8_ZERO_ACC
#undef PG8_WAIT_V
#undef PG8_WAIT_L
#undef PG8_BAR
#undef PG8_SCHED
}
}

typedef f32x4 Acc[2][2][4][2];
__device__ __forceinline__ u32x4 pack8(const f32x4 a, const f32x4 b) { u32x4 w; w.x = pk2(a.x, a.y); w.y = pk2(a.z, a.w); w.z = pk2(b.x, b.y); w.w = pk2(b.z, b.w); return w; }
__device__ __forceinline__ void row_scales(const GAS float* part, size_t stride, int row0, int fq, float inv_n, float eps, float (&sc)[8]) {
    f32x4 v[8];
#pragma unroll
    for (int k = 0; k < 8; ++k) v[k] = *(const GAS f32x4*)(part + (size_t)(row0 + (k >> 2) * 128 + (k & 3) * 16) * stride + 4 * fq);
#pragma unroll
    for (int k = 0; k < 8; ++k) { float t = (v[k].x + v[k].y) + (v[k].z + v[k].w); t += __shfl_xor(t, 16); t += __shfl_xor(t, 32); sc[k] = rsqrtf(t * inv_n + eps); }
}

struct EpiConvIn {
    static constexpr bool NEEDS_RS = true, NEEDS_RH = false;
    const GAS float* ssq; GAS bf16_t* Bo; GAS bf16_t* CZ;
    __device__ __forceinline__ void operator()(const Acc& acc, const pg8::Unit& u, int wr, int wc, int fr, int fq, const LAS float* rst) const {
        const int row0 = u.pm * 256 + wr * 64 + fr;
        float rs[8];
#pragma unroll
        for (int k = 0; k < 8; ++k) rs[k] = rst[(k >> 2) * 128 + (k & 3) * 16];
#pragma unroll
        for (int ai = 0; ai < 2; ++ai)
#pragma unroll
            for (int m = 0; m < 4; ++m) {
                const int row = row0 + ai * 128 + m * 16; const float r1 = rs[4 * ai + m];
                if (u.pn < 4) {
#pragma unroll
                    for (int bj = 0; bj < 2; ++bj)
                        *(GAS u32x4*)(Bo + (size_t)row * D + u.pn * 256 + bj * 128 + wc * 32 + fq * 8) = pack8(acc[ai][bj][m][0] * r1, acc[ai][bj][m][1] * r1);
                } else {
                    const float r2 = r1 * r1;
                    const f32x4 p0 = acc[ai][0][m][0] * acc[ai][0][m][1] * r2, p1 = acc[ai][1][m][0] * acc[ai][1][m][1] * r2;
                    *(GAS u32x4*)(CZ + (size_t)row * D + (u.pn - 4) * 128 + wc * 32 + fq * 8) = pack8(p0, p1);
                }
            }
    }
};
struct EpiFfnIn {
    static constexpr bool NEEDS_RS = true, NEEDS_RH = false;
    const GAS float* ssq; GAS unsigned char* ACT; bool f8; float isc; const GAS float* rowsc; bool i8;
    __device__ __forceinline__ void operator()(const Acc& acc, const pg8::Unit& u, int wr, int wc, int fr, int fq, const LAS float* rst) const {
        const int row0 = u.pm * 256 + wr * 64 + fr;
        float rs[8];
#pragma unroll
        for (int k = 0; k < 8; ++k) rs[k] = rst[(k >> 2) * 128 + (k & 3) * 16];
#pragma unroll
        for (int ai = 0; ai < 2; ++ai)
#pragma unroll
            for (int m = 0; m < 4; ++m) {
                const int row = row0 + ai * 128 + m * 16; const float r1 = rs[4 * ai + m] * isc;
                const float c1 = -1.44269504089f * r1, r2 = r1 * r1;
                f32x2 g[4], p[4], e[4];
#pragma unroll
                for (int bj = 0; bj < 2; ++bj) { f32x4 gt = acc[ai][bj][m][0], up = acc[ai][bj][m][1];
                    if (i8) { gt = __builtin_convertvector(__builtin_bit_cast(i32x4, gt), f32x4); up = __builtin_convertvector(__builtin_bit_cast(i32x4, up), f32x4); }
                    g[2 * bj] = (f32x2){gt.x, gt.y}; g[2 * bj + 1] = (f32x2){gt.z, gt.w};
                    p[2 * bj] = (f32x2){gt.x, gt.y} * (f32x2){up.x, up.y}; p[2 * bj + 1] = (f32x2){gt.z, gt.w} * (f32x2){up.z, up.w}; }
#pragma unroll
                for (int k = 0; k < 4; ++k) { const f32x2 t = g[k] * c1; e[k].x = __builtin_amdgcn_exp2f(t.x); e[k].y = __builtin_amdgcn_exp2f(t.y); }
#pragma unroll
                for (int k = 0; k < 4; ++k) { const f32x2 d = e[k] + 1.0f; e[k].x = __builtin_amdgcn_rcpf(d.x); e[k].y = __builtin_amdgcn_rcpf(d.y); }
#pragma unroll
                for (int k = 0; k < 4; ++k) p[k] = (p[k] * r2) * e[k];
                const size_t eoff = (size_t)row * DFF + u.pn * 128 + wc * 32 + fq * 8;
                if (f8) {
                    u32x2 w;
                    w.x = (unsigned)__builtin_amdgcn_cvt_pk_fp8_f32(p[1].x, p[1].y, __builtin_amdgcn_cvt_pk_fp8_f32(p[0].x, p[0].y, 0, false), true);
                    w.y = (unsigned)__builtin_amdgcn_cvt_pk_fp8_f32(p[3].x, p[3].y, __builtin_amdgcn_cvt_pk_fp8_f32(p[2].x, p[2].y, 0, false), true);
                    __builtin_nontemporal_store(w, (GAS u32x2*)(ACT + eoff));
                } else {
                    u32x4 w; w.x = pk2(p[0].x, p[0].y); w.y = pk2(p[1].x, p[1].y); w.z = pk2(p[2].x, p[2].y); w.w = pk2(p[3].x, p[3].y);
                    __builtin_nontemporal_store(w, (GAS u32x4*)(ACT + 2 * eoff));
                }
            }
    }
};
__device__ __forceinline__ f32x2 gelu_pk(f32x2 v) {
    const f32x2 av = __builtin_elementwise_abs(v), d = av * 0.2316418882f + 1.0f;
    f32x2 t; t.x = __builtin_amdgcn_rcpf(d.x); t.y = __builtin_amdgcn_rcpf(d.y);
    f32x2 q = t * 0.5307027145f + (-0.7265760135f); q = q * t + 0.7107068705f; q = q * t + (-0.142248368f); q = q * t + 0.127414796f; q = q * t;
    const f32x2 s = (v * v) * (-0.72134752044f);
    f32x2 e; e.x = __builtin_amdgcn_exp2f(s.x); e.y = __builtin_amdgcn_exp2f(s.y);
    return v * 0.5f + av * (0.5f - q * e);
}
__device__ __forceinline__ f32x4 gelu4(f32x4 v) { const f32x2 a = gelu_pk((f32x2){v.x, v.y}), b = gelu_pk((f32x2){v.z, v.w}); return (f32x4){a.x, a.y, b.x, b.y}; }
struct EpiSguIn {
    static constexpr bool NEEDS_RS = true, NEEDS_RH = false;
    const GAS float* ssq; GAS bf16_t* U; GAS bf16_t* V; GAS float* lnp; const GAS float* rowsc; float tsc;
    __device__ __forceinline__ void operator()(const Acc& acc, const pg8::Unit& u, int wr, int wc, int fr, int fq, const LAS float* rst) const {
        const int row0 = u.pm * 256 + wr * 64 + fr;
        const bool isv = u.pn >= 8;
        GAS bf16_t* dst = isv ? V + (u.pn - 8) * 256 : U + u.pn * 256;
        float rs[8];
#pragma unroll
        for (int k = 0; k < 8; ++k) rs[k] = rst[(k >> 2) * 128 + (k & 3) * 16];
#pragma unroll
        for (int ai = 0; ai < 2; ++ai)
#pragma unroll
            for (int m = 0; m < 4; ++m) {
                const int row = row0 + ai * 128 + m * 16; const float r1 = rs[4 * ai + m];
                float s1 = 0.f, s2 = 0.f;
#pragma unroll
                for (int bj = 0; bj < 2; ++bj) {
                    const f32x4 a = gelu4(acc[ai][bj][m][0] * r1), b = gelu4(acc[ai][bj][m][1] * r1);
                    *(GAS u32x4*)(dst + (size_t)row * 2048 + bj * 128 + wc * 32 + fq * 8) = pack8(a, b);
                    s1 += (a.x + a.y) + (a.z + a.w) + (b.x + b.y) + (b.z + b.w);
                    s2 += (a.x * a.x + a.y * a.y) + (a.z * a.z + a.w * a.w) + (b.x * b.x + b.y * b.y) + (b.z * b.z + b.w * b.w);
                }
                if (isv) {
                    s1 += __shfl_xor(s1, 16); s1 += __shfl_xor(s1, 32); s2 += __shfl_xor(s2, 16); s2 += __shfl_xor(s2, 32);
                    if (fq == 0) *(GAS f32x2*)(lnp + ((size_t)row * 32 + (u.pn - 8) * 4 + wc) * 2) = (f32x2){s1, s2};
                }
            }
    }
};
struct EpiRetQkv {
    static constexpr bool NEEDS_RS = true, NEEDS_RH = false;
    const GAS float* ssq; const GAS float* rcos; const GAS float* rsin; GAS bf16_t* Q; GAS bf16_t* Kn; GAS bf16_t* V; const GAS float* rowsc; float tsc;
    __device__ __forceinline__ void operator()(const Acc& acc, const pg8::Unit& u, int wr, int wc, int fr, int fq, const LAS float* rst) const {
        const int row0 = u.pm * 256 + wr * 64 + fr;
        const int i0 = wc * 32 + fq * 8;
        const bool isk = u.pn >= 4; const int h = u.pn & 3;
        const float l2g = __builtin_amdgcn_logf(1.0f - __builtin_amdgcn_exp2f(-5.0f - (float)h));
        float rs[8];
#pragma unroll
        for (int k = 0; k < 8; ++k) rs[k] = rst[(k >> 2) * 128 + (k & 3) * 16];
        if (u.pn >= 8) {
#pragma unroll
            for (int ai = 0; ai < 2; ++ai)
#pragma unroll
                for (int m = 0; m < 4; ++m) { const int row = row0 + ai * 128 + m * 16; const float r1 = rs[4 * ai + m];
#pragma unroll
                    for (int bj = 0; bj < 2; ++bj)
                        *(GAS u32x4*)(V + (size_t)row * 2048 + (u.pn - 8) * 256 + bj * 128 + i0) = pack8(acc[ai][bj][m][0] * r1, acc[ai][bj][m][1] * r1); }
        } else {
#pragma unroll
            for (int hp = 0; hp < 4; ++hp) {
                const int ai = hp >> 1;
                f32x4 cs[2][2], sn[2][2];
#pragma unroll
                for (int mm = 0; mm < 2; ++mm) { const int pos = (row0 + ai * 128 + (2 * (hp & 1) + mm) * 16) & (SEQ - 1);
#pragma unroll
                    for (int bj = 0; bj < 2; ++bj) { cs[mm][bj] = *(const GAS f32x4*)(rcos + (size_t)pos * 128 + i0 + 4 * bj); sn[mm][bj] = *(const GAS f32x4*)(rsin + (size_t)pos * 128 + i0 + 4 * bj); } }
#pragma unroll
                for (int mm = 0; mm < 2; ++mm) {
                    const int m = 2 * (hp & 1) + mm;
                    const int row = row0 + ai * 128 + m * 16, pos = row & (SEQ - 1); const float r1 = rs[4 * ai + m];
                    const float sc = isk ? r1 * 0.0625f * __builtin_amdgcn_exp2f(l2g * (float)(127 - (pos & 127))) : r1;
                    f32x4 o1[2], o2[2];
#pragma unroll
                    for (int bj = 0; bj < 2; ++bj) { const f32x4 x1 = acc[ai][bj][m][0] * sc, x2 = acc[ai][bj][m][1] * sc;
                        o1[bj] = x1 * cs[mm][bj] - x2 * sn[mm][bj]; o2[bj] = x2 * cs[mm][bj] + x1 * sn[mm][bj]; }
                    GAS bf16_t* dst = (isk ? Kn : Q) + (size_t)row * D + h * 256 + i0;
                    *(GAS u32x4*)dst = pack8(o1[0], o1[1]); *(GAS u32x4*)(dst + 128) = pack8(o2[0], o2[1]);
                }
            }
        }
    }
};
struct EpiRetG {
    static constexpr bool NEEDS_RS = true, NEEDS_RH = true;
    const GAS float* ssq; const GAS float* hss; GAS bf16_t* Y; const GAS float* rowsc; float tsc;
    __device__ __forceinline__ void operator()(const Acc& acc, const pg8::Unit& u, int wr, int wc, int fr, int fq, const LAS float* rst) const {
        const int row0 = u.pm * 256 + wr * 64 + fr; const int h = u.pn >> 1;
        float rs[8], rh[8];
#pragma unroll
        for (int k = 0; k < 8; ++k) { rs[k] = rst[(k >> 2) * 128 + (k & 3) * 16]; rh[k] = rst[4096 + (k >> 2) * 128 + (k & 3) * 16]; }
#pragma unroll
        for (int ai = 0; ai < 2; ++ai) {
            u32x4 ov[4][2];
#pragma unroll
            for (int m = 0; m < 4; ++m)
#pragma unroll
                for (int bj = 0; bj < 2; ++bj) ov[m][bj] = *(const GAS u32x4*)(Y + (size_t)(row0 + ai * 128 + m * 16) * 2048 + u.pn * 256 + bj * 128 + wc * 32 + fq * 8);
#pragma unroll
            for (int m = 0; m < 4; ++m) {
                const int row = row0 + ai * 128 + m * 16; const float r1 = rs[4 * ai + m], r3 = rh[4 * ai + m];
#pragma unroll
                for (int bj = 0; bj < 2; ++bj) {
                    GAS bf16_t* p = Y + (size_t)row * 2048 + u.pn * 256 + bj * 128 + wc * 32 + fq * 8;
                    const u32x4 o = ov[m][bj];
                    const f32x4 g0 = acc[ai][bj][m][0] * r1, g1 = acc[ai][bj][m][1] * r1;
                    const f32x4 a = (f32x4){silu_f(g0.x) * bf_lo(o.x), silu_f(g0.y) * bf_hi(o.x), silu_f(g0.z) * bf_lo(o.y), silu_f(g0.w) * bf_hi(o.y)} * r3;
                    const f32x4 b = (f32x4){silu_f(g1.x) * bf_lo(o.z), silu_f(g1.y) * bf_hi(o.z), silu_f(g1.z) * bf_lo(o.w), silu_f(g1.w) * bf_hi(o.w)} * r3;
                    *(GAS u32x4*)p = pack8(a, b);
                }
            }
        }
    }
};
template <int MB = 4> struct EpiResidT {
    static constexpr bool NEEDS_RS = false, NEEDS_RH = false;
    GAS bf16_t* xb; GAS float* ssq; float osc; GAS unsigned char* x8;
    __device__ __forceinline__ void operator()(const Acc& acc, const pg8::Unit& u, int wr, int wc, int fr, int fq, const LAS float* rst) const {
        const int row0 = u.pm * 256 + wr * 64 + fr, col0 = u.pn * 256 + wc * 32 + fq * 8;
#pragma unroll
        for (int ai = 0; ai < 2; ++ai)
#pragma unroll
        for (int mh = 0; mh < 4; mh += MB) {
            u32x4 bv[4][2];
#pragma unroll
            for (int m = mh; m < mh + MB; ++m)
#pragma unroll
                for (int bj = 0; bj < 2; ++bj) bv[m][bj] = *(const GAS u32x4*)(xb + (size_t)(row0 + ai * 128 + m * 16) * D + col0 + bj * 128);
#pragma unroll
            for (int m = mh; m < mh + MB; ++m) {
                const int row = row0 + ai * 128 + m * 16;
                GAS bf16_t* p = xb + (size_t)row * D + col0;
                float s2 = 0.f;
#pragma unroll
                for (int bj = 0; bj < 2; ++bj) {
                    const u32x4 b = bv[m][bj];
                    const f32x4 x0 = (f32x4){bf_lo(b.x), bf_hi(b.x), bf_lo(b.y), bf_hi(b.y)} + acc[ai][bj][m][0] * osc;
                    const f32x4 x1 = (f32x4){bf_lo(b.z), bf_hi(b.z), bf_lo(b.w), bf_hi(b.w)} + acc[ai][bj][m][1] * osc;
                    *(GAS u32x4*)(p + bj * 128) = pack8(x0, x1);
                    if (x8) { u32x2 w8;
                        w8.x = (unsigned)__builtin_amdgcn_cvt_pk_fp8_f32(x0.z, x0.w, __builtin_amdgcn_cvt_pk_fp8_f32(x0.x, x0.y, 0, false), true);
                        w8.y = (unsigned)__builtin_amdgcn_cvt_pk_fp8_f32(x1.z, x1.w, __builtin_amdgcn_cvt_pk_fp8_f32(x1.x, x1.y, 0, false), true);
                        *(GAS u32x2*)(x8 + (size_t)row * D + col0 + bj * 128) = w8; }
                    s2 += (x0.x * x0.x + x0.y * x0.y) + (x0.z * x0.z + x0.w * x0.w) + (x1.x * x1.x + x1.y * x1.y) + (x1.z * x1.z + x1.w * x1.w);
                }
                s2 += __shfl_xor(s2, 16); s2 += __shfl_xor(s2, 32);
                if (fq == 0) ssq[(size_t)row * 16 + u.pn * 4 + wc] = s2;
            }
        }
    }
};
typedef EpiResidT<4> EpiResid;

struct Args { const float* in[18]; float* out; unsigned char* ws; int ph_lo, ph_hi, li, pad; };

struct Frame {
    LAS unsigned char* lds;
    int tid, lane, wave, vcu, G;
};

enum { MAP_NAT = 0, MAP_P8 = 1, MAP_CONV = 2, MAP_RETQKV = 3, MAP_FFN = 4 };
struct PrepJob { const GAS float* src; const GAS float* src2; const GAS float* gain; GAS bf16_t* dst; int ld, N, K, map; float f8scale, i8scale; };
__device__ __forceinline__ void prep_item(const PrepJob& J, int item, LAS float* scr, int lane) {
    const int nb = J.N / 64, kb = item / nb, r = item % nb, pn = r >> 2, wc = r & 3;
    const int k0 = kb * 64;
    const int sl = 128 * (lane >> 5) + 32 * wc + (lane & 31);
    const int slot = 256 * pn + sl;
    const GAS float* src = J.src; int col;
    {
        const int bj = sl >> 7, n = (sl >> 4) & 1, fq = (sl >> 2) & 3, j = sl & 3, ch = 32 * wc + 8 * fq + 4 * bj + j;
        const int p8 = (slot & ~31) + pg8::perm32(slot & 31);
        if (J.map == MAP_NAT) col = slot;
        else if (J.map == MAP_P8) col = p8;
        else if (J.map == MAP_CONV) col = (pn < 4) ? p8 : (1024 + 1024 * n + 128 * (pn - 4) + ch);
        else if (J.map == MAP_RETQKV) col = (pn < 8) ? (256 * pn + 128 * n + ch) : p8;
        else { col = 128 * pn + ch; if (n) src = J.src2; }
    }
    const GAS float* sp = src + (size_t)k0 * J.ld + col;
#pragma unroll
    for (int hk = 0; hk < 2; ++hk) {
        float wv[32];
#pragma unroll
        for (int k = 0; k < 32; ++k) wv[k] = sp[(size_t)(32 * hk + k) * J.ld];
#pragma unroll
        for (int k = 0; k < 32; ++k) scr[(32 * hk + k) * 65 + lane] = wv[k];
    }
    asm volatile("s_waitcnt lgkmcnt(0)" ::: "memory");
    const int c = lane & 7;
    float gn[8];
#pragma unroll
    for (int e = 0; e < 8; ++e) gn[e] = J.gain ? J.gain[k0 + 8 * c + e] : 1.0f;
#pragma unroll
    for (int it = 0; it < 8; ++it) {
        const int l2 = it * 8 + (lane >> 3);
        const int slot2 = 256 * pn + 128 * (l2 >> 5) + 32 * wc + (l2 & 31);
        const LAS float* s = scr + (8 * c) * 65 + l2;
        if (J.i8scale != 0.f) {
            const float f = J.i8scale; unsigned b8[8];
#pragma unroll
            for (int e = 0; e < 8; ++e) b8[e] = (unsigned)(int)fminf(fmaxf(rintf(s[e * 65] * gn[e] * f), -127.f), 127.f) & 255u;
            u32x2 o8; o8.x = b8[0] | (b8[1] << 8) | (b8[2] << 16) | (b8[3] << 24); o8.y = b8[4] | (b8[5] << 8) | (b8[6] << 16) | (b8[7] << 24);
            *(GAS u32x2*)((GAS unsigned char*)J.dst + (size_t)slot2 * J.K + k0 + 8 * c) = o8;
        } else if (J.f8scale != 0.f) {
            const float f = J.f8scale; u32x2 o8;
            o8.x = (unsigned)__builtin_amdgcn_cvt_pk_fp8_f32(s[2 * 65] * gn[2] * f, s[3 * 65] * gn[3] * f, __builtin_amdgcn_cvt_pk_fp8_f32(s[0] * gn[0] * f, s[65] * gn[1] * f, 0, false), true);
            o8.y = (unsigned)__builtin_amdgcn_cvt_pk_fp8_f32(s[6 * 65] * gn[6] * f, s[7 * 65] * gn[7] * f, __builtin_amdgcn_cvt_pk_fp8_f32(s[4 * 65] * gn[4] * f, s[5 * 65] * gn[5] * f, 0, false), true);
            *(GAS u32x2*)((GAS unsigned char*)J.dst + (size_t)slot2 * J.K + k0 + 8 * c) = o8;
        } else {
        u32x4 o; o.x = pk2(s[0] * gn[0], s[65] * gn[1]); o.y = pk2(s[2 * 65] * gn[2], s[3 * 65] * gn[3]); o.z = pk2(s[4 * 65] * gn[4], s[5 * 65] * gn[5]); o.w = pk2(s[6 * 65] * gn[6], s[7 * 65] * gn[7]);
        *(GAS u32x4*)(J.dst + (size_t)slot2 * J.K + k0 + 8 * c) = o;
        }
    }
    asm volatile("s_waitcnt lgkmcnt(0)" ::: "memory");
}
__device__ __forceinline__ void p0_wabs(const Frame& F, const Args& a) {
    const int tid_ = opq_tid(), lane_ = tid_ & 63, wave_ = __builtin_amdgcn_readfirstlane(tid_ >> 6);
    const int gw = F.vcu * 8 + wave_, NGW = F.G * 8;
#pragma unroll 1
    for (int L = 0; L < NLAYER; ++L) {
        if (!((I8_F1_LAYERS >> L) & 1)) continue;
        float sq = 0.f;
        for (int rr = gw; rr < 2 * 1024; rr += NGW) {
            const int k = rr & 1023; const GAS float* src = (const GAS float*)((rr < 1024 ? a.in[15] : a.in[16]) + ((size_t)L * 1024 + k) * DFF);
            const float gk = ((const GAS float*)a.in[2])[L * D + k];
            float m = 0.f;
#pragma unroll
            for (int j = 0; j < 11; ++j) { const f32x4 v = ((const GAS f32x4*)src)[lane_ + 64 * j]; m += (v.x * v.x + v.y * v.y) + (v.z * v.z + v.w * v.w); }
            sq += m * (gk * gk);
        }
        sq = wave_sum(sq);
        if (lane_ == 0 && gw < 2048) ((GAS float*)(a.ws + WS_CTL))[CTL_WSS + 2048 * L + gw] = sq;
    }
    if (I8_SGU) {
        float sq0 = 0.f;
        for (int k = gw; k < 1024; k += NGW) {
            const GAS f32x4* src = (const GAS f32x4*)(a.in[7] + (size_t)k * 4096);
            const float gk = ((const GAS float*)a.in[1])[1 * D + k];
            float m0 = 0.f;
#pragma unroll
            for (int j = 0; j < 16; ++j) { const f32x4 v = src[lane_ + 64 * j]; m0 += (v.x * v.x + v.y * v.y) + (v.z * v.z + v.w * v.w); }
            sq0 += m0 * (gk * gk);
        }
        sq0 = wave_sum(sq0);
        if (lane_ == 0 && gw < 2048) ((GAS float*)(a.ws + WS_CTL))[CTL_WSS + 2048 * 6 + gw] = sq0;
    }
    if (I8_RET) {
        float sq0 = 0.f, sq1 = 0.f;
        for (int k = gw; k < 1024; k += NGW) {
            const GAS f32x4* src = (const GAS f32x4*)(a.in[13] + (size_t)k * 6144);
            const float gk = ((const GAS float*)a.in[1])[2 * D + k];
            float m0 = 0.f, m1 = 0.f;
#pragma unroll
            for (int j = 0; j < 16; ++j) { const f32x4 v = src[lane_ + 64 * j]; m0 += (v.x * v.x + v.y * v.y) + (v.z * v.z + v.w * v.w); }
#pragma unroll
            for (int j = 16; j < 24; ++j) { const f32x4 v = src[lane_ + 64 * j]; m1 += (v.x * v.x + v.y * v.y) + (v.z * v.z + v.w * v.w); }
            sq0 += m0 * (gk * gk); sq1 += m1 * (gk * gk);
        }
        sq0 = wave_sum(sq0); sq1 = wave_sum(sq1);
        if (lane_ == 0 && gw < 2048) { ((GAS float*)(a.ws + WS_CTL))[CTL_WSS + 2048 * 4 + gw] = sq0; ((GAS float*)(a.ws + WS_CTL))[CTL_WSS + 2048 * 5 + gw] = sq1; }
    }
}
__device__ __forceinline__ float i8_wfull(const unsigned char* ws, int L, int lane, float inv_count = 1.0f / (2.0f * 1024.0f * DFF)) {
    const GAS float* p = (const GAS float*)(ws + WS_CTL) + CTL_WSS + 2048 * L;
    float t = 0.f;
#pragma unroll 4
    for (int j = 0; j < 32; ++j) t += p[lane + 64 * j];
    t = wave_sum(t);
    return fmaxf(WCLIP * sqrtf(t * inv_count), 1e-30f);
}
__device__ __forceinline__ void quant_phase(const Frame& F, const GAS bf16_t* xb, GAS unsigned char* x8, GAS float* sa) {
    const int tid_ = opq_tid(), lane_ = tid_ & 63, wave_ = __builtin_amdgcn_readfirstlane(tid_ >> 6);
    const int gw = F.vcu * 8 + wave_, NGW = F.G * 8;
    for (int row = 4 * gw; row < M; row += 4 * NGW) {
        u32x4 v[4][2];
#pragma unroll
        for (int r = 0; r < 4; ++r) { const GAS u32x4* p = (const GAS u32x4*)(xb + (size_t)(row + r) * D) + 2 * lane_; v[r][0] = p[0]; v[r][1] = p[1]; }
#pragma unroll
        for (int r = 0; r < 4; ++r) {
            float x[16];
#pragma unroll
            for (int h = 0; h < 2; ++h)
#pragma unroll
                for (int e = 0; e < 4; ++e) { x[8 * h + 2 * e] = bf_lo(v[r][h][e]); x[8 * h + 2 * e + 1] = bf_hi(v[r][h][e]); }
            float m = 0.f;
#pragma unroll
            for (int e = 0; e < 16; ++e) m = fmaxf(m, fabsf(x[e]));
            m = fmaxf(wave_max(m), 1e-30f);
            const float qs = 127.0f / m;
            unsigned w[4];
#pragma unroll
            for (int d = 0; d < 4; ++d) { unsigned t = 0u;
#pragma unroll
                for (int e = 0; e < 4; ++e) t |= ((unsigned)(int)rintf(x[4 * d + e] * qs) & 255u) << (8 * e);
                w[d] = t; }
            *((GAS u32x4*)(x8 + (size_t)(row + r) * D) + lane_) = (u32x4){w[0], w[1], w[2], w[3]};
            if (lane_ == 0) sa[row + r] = m * (1.0f / 127.0f);
        }
    }
}
__device__ __forceinline__ void p0_prologue(const Frame& F, const Args& a) {
    unsigned char* ws = a.ws;
    const int tid_ = opq_tid(), lane_ = tid_ & 63, wave_ = __builtin_amdgcn_readfirstlane(tid_ >> 6);
    LAS float* scr = (LAS float*)(F.lds + wave_ * 16640);
    const int gw = F.vcu * 8 + wave_, NGW = F.G * 8;
    constexpr int NJOB = 17;
    int start = 0;
#pragma unroll 1
    for (int jb = 0; jb < NJOB; ++jb) {
        PrepJob J; J.f8scale = 0.f; J.i8scale = 0.f;
        if (jb < 2)       { J.src = (const GAS float*)(a.in[4] + (size_t)jb * 1024 * 3072); J.src2 = nullptr; J.gain = (const GAS float*)(a.in[1] + (jb == 0 ? 0 : 3) * D); J.dst = (GAS bf16_t*)(ws + W_CI + jb * W_CI_SZ); J.ld = 3072; J.N = 3072; J.K = 1024; J.map = MAP_CONV; }
        else if (jb < 4)  { const int j = jb - 2; J.src = (const GAS float*)(a.in[6] + (size_t)j * 1024 * 1024); J.src2 = nullptr; J.gain = nullptr; J.dst = (GAS bf16_t*)(ws + W_CO + j * W_CO_SZ); J.ld = 1024; J.N = 1024; J.K = 1024; J.map = MAP_P8; }
        else if (jb == 4) { J.src = (const GAS float*)(a.in[7]); J.src2 = nullptr; J.gain = (const GAS float*)(a.in[1] + 1 * D); J.dst = (GAS bf16_t*)(ws + W_SI); J.ld = 4096; J.N = 4096; J.K = 1024; J.map = MAP_P8; if (I8_SGU) J.i8scale = 127.0f / i8_wfull(ws, 6, lane_, 1.0f / (1024.0f * 4096.0f)); }
        else if (jb == 5) { J.src = (const GAS float*)(a.in[12]); J.src2 = nullptr; J.gain = nullptr; J.dst = (GAS bf16_t*)(ws + W_SO); J.ld = 1024; J.N = 1024; J.K = 2048; J.map = MAP_P8; }
        else if (jb == 6) { J.src = (const GAS float*)(a.in[13]); J.src2 = nullptr; J.gain = (const GAS float*)(a.in[1] + 2 * D); J.dst = (GAS bf16_t*)(ws + W_RQ); J.ld = 6144; J.N = 4096; J.K = 1024; J.map = MAP_RETQKV; if (I8_RET) J.i8scale = 127.0f / i8_wfull(ws, 4, lane_, 1.0f / (1024.0f * 4096.0f)); }
        else if (jb == 7) { J.src = (const GAS float*)(a.in[13] + 4096); J.src2 = nullptr; J.gain = (const GAS float*)(a.in[1] + 2 * D); J.dst = (GAS bf16_t*)(ws + W_RG); J.ld = 6144; J.N = 2048; J.K = 1024; J.map = MAP_P8; if (I8_RET) J.i8scale = 127.0f / i8_wfull(ws, 5, lane_, 1.0f / (1024.0f * 2048.0f)); }
        else if (jb == 8) { J.src = (const GAS float*)(a.in[14]); J.src2 = nullptr; J.gain = nullptr; J.dst = (GAS bf16_t*)(ws + W_RO); J.ld = 1024; J.N = 1024; J.K = 2048; J.map = MAP_P8; }
        else if (jb < 13) { const int L = jb - 9; J.src = (const GAS float*)(a.in[15] + (size_t)L * 1024 * DFF); J.src2 = (const GAS float*)(a.in[16] + (size_t)L * 1024 * DFF); J.gain = (const GAS float*)(a.in[2] + L * D); J.dst = (GAS bf16_t*)(ws + W_FI + L * W_FI_SZ); J.ld = DFF; J.N = 2 * DFF; J.K = 1024; J.map = MAP_FFN; J.f8scale = ((F8_F1_LAYERS >> L) & 1) ? FI_WSCALE : 0.f;
                            if ((I8_F1_LAYERS >> L) & 1) J.i8scale = 127.0f / i8_wfull(ws, L, lane_); }
        else              { const int L = jb - 13; J.src = (const GAS float*)(a.in[17] + (size_t)L * DFF * 1024); J.src2 = nullptr; J.gain = nullptr; J.dst = (GAS bf16_t*)(ws + W_FD + L * W_FD_SZ); J.ld = 1024; J.N = 1024; J.K = DFF; J.map = MAP_P8; J.f8scale = ((F8_LAYERS >> L) & 1) ? FD_WSCALE : 0.f; }
        const int nitems = (J.K / 64) * (J.N / 64);
        int first = (gw - start % NGW + NGW) % NGW;
        for (int it = first; it < nitems; it += NGW) prep_item(J, it, scr, lane_);
        start += nitems;
    }
    {
        const GAS float* x = (const GAS float*)a.in[0]; GAS bf16_t* xb = (GAS bf16_t*)(ws + WS_XB); GAS float* ssq = (GAS float*)(ws + WS_SSQ);
        for (int row = 4 * gw; row < M; row += 4 * NGW) {
            f32x4 v[4][4];
#pragma unroll
            for (int r = 0; r < 4; ++r)
#pragma unroll
                for (int j = 0; j < 4; ++j) v[r][j] = ((const GAS f32x4*)(x + (size_t)(row + r) * D))[lane_ + 64 * j];
#pragma unroll
            for (int r = 0; r < 4; ++r) {
                float sq = 0.f;
#pragma unroll
                for (int j = 0; j < 4; ++j) sq += (v[r][j].x * v[r][j].x + v[r][j].y * v[r][j].y) + (v[r][j].z * v[r][j].z + v[r][j].w * v[r][j].w);
                sq = wave_sum(sq);
                GAS u32x2* o8 = (GAS u32x2*)(xb + (size_t)(row + r) * D) + lane_;
#pragma unroll
                for (int j = 0; j < 4; ++j) { u32x2 w; w.x = pk2(v[r][j].x, v[r][j].y); w.y = pk2(v[r][j].z, v[r][j].w); o8[64 * j] = w; }
                if (lane_ < 16) ssq[(size_t)(row + r) * 16 + lane_] = (lane_ == 0) ? sq : 0.f;
            }
        }
    }
    {
        GAS float* rc = (GAS float*)(ws + WS_ROT); GAS float* rsn = rc + (size_t)SEQ * 128;
        const int gt = F.vcu * 512 + tid_, NGT = F.G * 512;
        for (int idx = gt; idx < SEQ * 128; idx += NGT) {
            const int i = idx & 127, pos = idx >> 7;
            const float inv = __builtin_amdgcn_exp2f(-(float)i * (13.287712379549449f / 128.0f));
            const float ang = (float)pos * inv;
            const double ad = (double)ang;
            const double kq = __builtin_rint(ad * 0.63661977236758134308);
            const double y = __builtin_fma(-kq, 1.57079632679489661923, ad) - kq * 6.123233995736766e-17;
            const double y2 = y * y;
            const double sp = y * (1.0 + y2 * (-1.0 / 6 + y2 * (1.0 / 120 + y2 * (-1.0 / 5040 + y2 * (1.0 / 362880 + y2 * (-1.0 / 39916800))))));
            const double cp = 1.0 + y2 * (-0.5 + y2 * (1.0 / 24 + y2 * (-1.0 / 720 + y2 * (1.0 / 40320 + y2 * (-1.0 / 3628800 + y2 * (1.0 / 479001600))))));
            const int q = ((int)(long long)kq) & 3;
            const double sv = (q == 0) ? sp : (q == 1) ? cp : (q == 2) ? -sp : -cp;
            const double cv = (q == 0) ? cp : (q == 1) ? -sp : (q == 2) ? -cp : sp;
            rc[idx] = (float)cv; rsn[idx] = (float)sv;
        }
        const GAS float* wsp = (const GAS float*)a.in[10]; GAS bf16_t* wd = (GAS bf16_t*)(ws + W_WS);
        for (int idx = gt; idx < 8 * 128 * 128; idx += NGT) { const int s = idx & 127, t = (idx >> 7) & 127; wd[idx] = (bf16_t)f2bf(s <= t ? wsp[idx] : 0.f); }
    }
}

__device__ __forceinline__ void conv_phase(const Frame& F, const GAS bf16_t* Bo, const GAS bf16_t* CZ, const GAS float* cw, GAS bf16_t* Y) {
    constexpr int RB = 16;
    const int nitem = (M / RB) * 128;
    const int tid_ = opq_tid();
    for (int it = F.vcu * 512 + tid_; it < nitem; it += F.G * 512) {
        const int cc = it & 127, rb = it >> 7, r0 = rb * RB, c0 = cc * 8;
        float w0[8], w1[8], w2[8];
#pragma unroll
        for (int e = 0; e < 8; ++e) { w0[e] = cw[c0 + e]; w1[e] = cw[D + c0 + e]; w2[e] = cw[2 * D + c0 + e]; }
        u32x4 p2 = (u32x4){0, 0, 0, 0}, p1 = (u32x4){0, 0, 0, 0};
        if ((r0 & (SEQ - 1)) != 0) { p2 = *(const GAS u32x4*)(CZ + (size_t)(r0 - 2) * D + c0); p1 = *(const GAS u32x4*)(CZ + (size_t)(r0 - 1) * D + c0); }
#pragma unroll
        for (int hb = 0; hb < 2; ++hb) {
            u32x4 pz[8], pb[8];
#pragma unroll
            for (int r = 0; r < 8; ++r) { const size_t off = (size_t)(r0 + 8 * hb + r) * D + c0; pz[r] = *(const GAS u32x4*)(CZ + off); pb[r] = *(const GAS u32x4*)(Bo + off); }
#pragma unroll
            for (int r = 0; r < 8; ++r) {
                const size_t off = (size_t)(r0 + 8 * hb + r) * D + c0;
                const u32x4 p0 = pz[r], bv = pb[r];
                u32x4 o;
#pragma unroll
                for (int q = 0; q < 4; ++q) {
                    const float lo = bf_lo(bv[q]) * (w0[2 * q] * bf_lo(p2[q]) + w1[2 * q] * bf_lo(p1[q]) + w2[2 * q] * bf_lo(p0[q]));
                    const float hi = bf_hi(bv[q]) * (w0[2 * q + 1] * bf_hi(p2[q]) + w1[2 * q + 1] * bf_hi(p1[q]) + w2[2 * q + 1] * bf_hi(p0[q]));
                    o[q] = pk2(lo, hi);
                }
                *(GAS u32x4*)(Y + off) = o;
                p2 = p1; p1 = p0;
            }
        }
    }
}

constexpr int SG_W = 0, SG_WSTR = 272, SG_T = 128 * SG_WSTR, SG_TSTR = 272, SG_ST = SG_T + 256 * SG_TSTR, SG_LG = SG_ST + 1024, SG_END = SG_LG + 2048;
static_assert(SG_END <= LDS_MISC, "sgu lds");
__device__ __forceinline__ void sgu_phase(const Frame& F, GAS bf16_t* U, const GAS bf16_t* V, const GAS float* lnp, const GAS bf16_t* Wt, const GAS float* lng, const GAS float* lnb, const GAS float* bs) {
    LAS unsigned char* lds = F.lds;
    const int tid = opq_tid(), lane = tid & 63, w = __builtin_amdgcn_readfirstlane(tid >> 6), fr = lane & 15, fq = lane >> 4;
    const int s = tid & 127, dg = tid >> 7;
    const int srow = tid >> 2, spart = tid & 3;
    int gcur = -1;
    u32x4 vreg[8]; f32x4 lnv[4];
    int un = F.vcu;
    if (un < 2048) {
        const int g = un & 7, row0 = (un >> 3) * 128;
        const GAS bf16_t* vp = V + (size_t)(row0 + s) * 2048 + g * 256;
#pragma unroll
        for (int i = 0; i < 8; ++i) vreg[i] = *(const GAS u32x4*)(vp + (dg + 4 * i) * 8);
        const GAS f32x4* lp = (const GAS f32x4*)(lnp + (size_t)(row0 + srow) * 64 + spart * 16);
#pragma unroll
        for (int i = 0; i < 4; ++i) lnv[i] = lp[i];
    }
    for (; un < 2048; un += F.G) {
        const int g = un & 7, c = un >> 3, row0 = c * 128;
        __syncthreads();
        if (g != gcur) {
            gcur = g;
            const GAS bf16_t* wg = Wt + (size_t)g * 128 * 128;
#pragma unroll
            for (int i = 0; i < 4; ++i) { const int p = tid + 512 * i, t = p >> 4, c16 = p & 15; *(LAS u32x4*)(lds + SG_W + t * SG_WSTR + c16 * 16) = *(const GAS u32x4*)(wg + t * 128 + c16 * 8); }
            if (tid < 256) { ((LAS float*)(lds + SG_LG))[tid] = lng[g * 256 + tid]; } else { ((LAS float*)(lds + SG_LG))[tid] = lnb[g * 256 + tid - 256]; }
        }
        {
            float s1 = 0.f, s2 = 0.f;
#pragma unroll
            for (int i = 0; i < 4; ++i) { s1 += lnv[i].x + lnv[i].z; s2 += lnv[i].y + lnv[i].w; }
            s1 += __shfl_xor(s1, 1); s2 += __shfl_xor(s2, 1); s1 += __shfl_xor(s1, 2); s2 += __shfl_xor(s2, 2);
            const float mu = s1 * (1.0f / 2048.0f), var = s2 * (1.0f / 2048.0f) - mu * mu;
            if (spart == 0) { ((LAS float*)(lds + SG_ST))[srow] = mu; ((LAS float*)(lds + SG_ST))[128 + srow] = rsqrtf(fmaxf(var, 0.f) + LN_EPS); }
        }
        __syncthreads();
        {
            const float mu = ((LAS float*)(lds + SG_ST))[s], r = ((LAS float*)(lds + SG_ST))[128 + s];
#pragma unroll
            for (int i = 0; i < 8; ++i) {
                const int dc = dg + 4 * i, d0 = dc * 8;
                const u32x4 v = vreg[i];
                const f32x4 g0 = *(const LAS f32x4*)(lds + SG_LG + d0 * 4), g1 = *(const LAS f32x4*)(lds + SG_LG + d0 * 4 + 16);
                const f32x4 b0 = *(const LAS f32x4*)(lds + SG_LG + 1024 + d0 * 4), b1 = *(const LAS f32x4*)(lds + SG_LG + 1024 + d0 * 4 + 16);
                LAS bf16_t* tp = (LAS bf16_t*)(lds + SG_T + d0 * SG_TSTR) + s;
                tp[0 * (SG_TSTR / 2)] = (bf16_t)f2bf((bf_lo(v.x) - mu) * r * g0.x + b0.x);
                tp[1 * (SG_TSTR / 2)] = (bf16_t)f2bf((bf_hi(v.x) - mu) * r * g0.y + b0.y);
                tp[2 * (SG_TSTR / 2)] = (bf16_t)f2bf((bf_lo(v.y) - mu) * r * g0.z + b0.z);
                tp[3 * (SG_TSTR / 2)] = (bf16_t)f2bf((bf_hi(v.y) - mu) * r * g0.w + b0.w);
                tp[4 * (SG_TSTR / 2)] = (bf16_t)f2bf((bf_lo(v.z) - mu) * r * g1.x + b1.x);
                tp[5 * (SG_TSTR / 2)] = (bf16_t)f2bf((bf_hi(v.z) - mu) * r * g1.y + b1.y);
                tp[6 * (SG_TSTR / 2)] = (bf16_t)f2bf((bf_lo(v.w) - mu) * r * g1.z + b1.z);
                tp[7 * (SG_TSTR / 2)] = (bf16_t)f2bf((bf_hi(v.w) - mu) * r * g1.w + b1.w);
            }
        }
        u32x4 uv[8];
#pragma unroll
        for (int tb = 0; tb < 8; ++tb) uv[tb] = *(const GAS u32x4*)(U + (size_t)(row0 + 16 * tb + fr) * 2048 + g * 256 + 32 * w + 8 * fq);
        if (un + F.G < 2048) {
            const int un2 = un + F.G, g2 = un2 & 7, row2 = (un2 >> 3) * 128;
            const GAS bf16_t* vp = V + (size_t)(row2 + s) * 2048 + g2 * 256;
#pragma unroll
            for (int i = 0; i < 8; ++i) vreg[i] = *(const GAS u32x4*)(vp + (dg + 4 * i) * 8);
            const GAS f32x4* lp = (const GAS f32x4*)(lnp + (size_t)(row2 + srow) * 64 + spart * 16);
#pragma unroll
            for (int i = 0; i < 4; ++i) lnv[i] = lp[i];
        }
        __syncthreads();
        f32x4 acc[8][2];
#pragma unroll
        for (int tb = 0; tb < 8; ++tb) { acc[tb][0] = (f32x4){0.f, 0.f, 0.f, 0.f}; acc[tb][1] = (f32x4){0.f, 0.f, 0.f, 0.f}; }
        const int drow0 = 32 * w + 8 * (fr >> 2) + (fr & 3);
#pragma unroll
        for (int ks = 0; ks < 4; ++ks) {
            const bf16x8 t0 = *(const LAS bf16x8*)(lds + SG_T + drow0 * SG_TSTR + ks * 64 + fq * 16);
            const bf16x8 t1 = *(const LAS bf16x8*)(lds + SG_T + (drow0 + 4) * SG_TSTR + ks * 64 + fq * 16);
#pragma unroll
            for (int tb = 2 * ks; tb < 8; ++tb) {
                const bf16x8 wf = *(const LAS bf16x8*)(lds + SG_W + (16 * tb + fr) * SG_WSTR + ks * 64 + fq * 16);
                acc[tb][0] = __builtin_amdgcn_mfma_f32_16x16x32_bf16(t0, wf, acc[tb][0], 0, 0, 0);
                acc[tb][1] = __builtin_amdgcn_mfma_f32_16x16x32_bf16(t1, wf, acc[tb][1], 0, 0, 0);
            }
        }
#pragma unroll
        for (int tb = 0; tb < 8; ++tb) {
            const int t = 16 * tb + fr;
            const float bb = bs[g * 128 + t];
            GAS bf16_t* up = U + (size_t)(row0 + t) * 2048 + g * 256 + 32 * w + 8 * fq;
            const f32x4 a = acc[tb][0] + bb, b = acc[tb][1] + bb;
            const f32x4 ya = (f32x4){a.x * bf_lo(uv[tb].x), a.y * bf_hi(uv[tb].x), a.z * bf_lo(uv[tb].y), a.w * bf_hi(uv[tb].y)};
            const f32x4 yb = (f32x4){b.x * bf_lo(uv[tb].z), b.y * bf_hi(uv[tb].z), b.z * bf_lo(uv[tb].w), b.w * bf_hi(uv[tb].w)};
            *(GAS u32x4*)up = pack8(ya, yb);
        }
    }
    __syncthreads();
}

constexpr int RT_K0 = 0, RT_KB = 65536, RT_ST = 131072, RT_STSTR = 528, RT_VT = RT_ST + 32 * RT_STSTR, RT_VTSTR = 288, RT_END = RT_VT + 32 * RT_VTSTR;
static_assert(RT_END <= LDS_MISC, "ret lds");
typedef short s16x4 __attribute__((ext_vector_type(4)));
__device__ __forceinline__ void ret_phase(const Frame& F, const GAS bf16_t* Q, const GAS bf16_t* Kn, GAS bf16_t* Vb, GAS float* hss) {
    LAS unsigned char* lds = F.lds;
    const int tid = opq_tid(), lane = tid & 63, w = __builtin_amdgcn_readfirstlane(tid >> 6), fr = lane & 15, fq = lane >> 4;
    const int jb = (w < 4) ? w : 11 - w;
    const int srow = tid >> 5, sslot = tid & 31, spiece = ((sslot & 15) ^ (srow & 15)) | (sslot & 16);
    const unsigned voffK = (unsigned)(srow * D + 8 * spiece) * 2u;
    int koffx[4];
#pragma unroll
    for (int k4 = 0; k4 < 4; ++k4) koffx[k4] = fr * 512 + ((((4 * k4 + fq) & 15) ^ fr) << 4);
    int troff[2][2];
#pragma unroll
    for (int db = 0; db < 2; ++db)
#pragma unroll
        for (int t = 0; t < 2; ++t) {
            const int q = fr >> 2, p = fr & 3, m = 8 * fq + 4 * t + q, c = 4 * w + 2 * db + (p >> 1);
            troff[db][t] = m * 512 + ((((c & 15) ^ (m & 15)) | (c & 16)) << 4) + 8 * (p & 1);
        }
    for (int item = F.vcu; item < 256; item += F.G) {
        const int es = item & 15, bh = item >> 4, h = bh & 3, b = bh >> 2;
        const float gam = 1.0f - __builtin_amdgcn_exp2f(-5.0f - (float)h);
        const float l2g = __builtin_amdgcn_logf(gam);
        const float cdec = __builtin_amdgcn_exp2f(128.0f * l2g);
        const size_t rowb = (size_t)b * SEQ;
        const GAS bf16_t* Qh = Q + rowb * D + h * 256;
        const GAS char* Kh = (const GAS char*)(Kn + rowb * D + h * 256);
        GAS bf16_t* Vh = Vb + rowb * 2048 + h * 512 + es * 32;
        GAS float* hs = hss + (rowb * RH + h) * 16 + es;
        __syncthreads();
        for (int i = tid; i < 32 * RT_STSTR / 4; i += 512) ((LAS unsigned*)(lds + RT_ST))[i] = 0u;
        f32x4 sst[2][2];
#pragma unroll
        for (int eb = 0; eb < 2; ++eb)
#pragma unroll
            for (int db = 0; db < 2; ++db) sst[eb][db] = (f32x4){0.f, 0.f, 0.f, 0.f};
#define RT_STAGE_K(buf, ci) do { _Pragma("unroll") for (int _i = 0; _i < 8; ++_i) \
            __builtin_amdgcn_global_load_lds((const GAS unsigned*)(Kh + (size_t)(ci) * 128 * D * 2 + (size_t)_i * 16 * D * 2 + voffK), (LAS unsigned*)(lds + (buf) + _i * 8192 + w * 1024), 16, 0, 0); } while (0)
        RT_STAGE_K(RT_K0, 0);
        const int vm = tid >> 2, vp = tid & 3;
        u32x4 vreg = *(const GAS u32x4*)(Vh + (size_t)vm * 2048 + vp * 8);
        bf16x8 qf[8];
#pragma unroll
        for (int ks = 0; ks < 8; ++ks) qf[ks] = *(const GAS bf16x8*)(Qh + (size_t)(16 * jb + fr) * D + 32 * ks + 8 * fq);
        {
            LAS bf16_t* vt = (LAS bf16_t*)(lds + RT_VT + (8 * vp) * RT_VTSTR) + vm;
#pragma unroll
            for (int q = 0; q < 4; ++q) { vt[(2 * q) * (RT_VTSTR / 2)] = (bf16_t)(vreg[q] & 0xffffu); vt[(2 * q + 1) * (RT_VTSTR / 2)] = (bf16_t)(vreg[q] >> 16); }
        }
        u32x2 pend_ow[2] = {(u32x2){0u, 0u}, (u32x2){0u, 0u}}; float pend_ss = 0.f;
        const int jrow = 16 * jb + fr;
        const float qdec = __builtin_amdgcn_exp2f(l2g * (float)(jrow + 1));
        const float pdec = __builtin_amdgcn_exp2f(l2g * (float)(jrow - 127));
#pragma unroll 1
        for (int ci = 0; ci < SEQ / RC; ++ci) {
            const int kbuf = (ci & 1) ? RT_KB : RT_K0;
            asm volatile("s_waitcnt vmcnt(0) lgkmcnt(0)" ::: "memory"); __builtin_amdgcn_s_barrier(); asm volatile("" ::: "memory");
            const bool more = ci + 1 < SEQ / RC;
#pragma unroll
            for (int ks = 0; ks < 8; ++ks) asm volatile("" : "+v"(qf[ks]));
            if (more) {
                if (ci & 1) RT_STAGE_K(RT_K0, ci + 1); else RT_STAGE_K(RT_KB, ci + 1);
                vreg = *(const GAS u32x4*)(Vh + (size_t)((ci + 1) * 128 + vm) * 2048 + vp * 8);
            }
            if (ci > 0) {
                const size_t row = (size_t)(ci - 1) * 128 + jrow;
#pragma unroll
                for (int eb = 0; eb < 2; ++eb) *(GAS u32x2*)(Vh + row * 2048 + 16 * eb + 4 * fq) = pend_ow[eb];
                if (fq == 0) hs[row * RH * 16] = pend_ss;
            }
            f32x4 oacc[2] = {(f32x4){0.f, 0.f, 0.f, 0.f}, (f32x4){0.f, 0.f, 0.f, 0.f}};
            {
                bf16x8 sf[2][8];
#pragma unroll
                for (int ks = 0; ks < 8; ++ks)
#pragma unroll
                    for (int eb = 0; eb < 2; ++eb) sf[eb][ks] = *(const LAS bf16x8*)(lds + RT_ST + (16 * eb + fr) * RT_STSTR + ks * 64 + fq * 16);
                __builtin_amdgcn_sched_barrier(0);
#pragma unroll
                for (int ks = 0; ks < 8; ++ks)
#pragma unroll
                    for (int eb = 0; eb < 2; ++eb) oacc[eb] = __builtin_amdgcn_mfma_f32_16x16x32_bf16(sf[eb][ks], qf[ks], oacc[eb], 0, 0, 0);
            }
            oacc[0] *= qdec; oacc[1] *= qdec;
#pragma unroll
            for (int kp = 0; kp < 4; ++kp) {
                if (2 * kp <= jb) {
                    const bool two = (2 * kp + 1 <= jb);
                    bf16x8 k0[8], k1[8];
#pragma unroll
                    for (int ks = 0; ks < 8; ++ks) k0[ks] = *(const LAS bf16x8*)(lds + kbuf + (2 * kp) * 8192 + koffx[ks & 3] + (ks >> 2) * 256);
                    if (two) {
#pragma unroll
                        for (int ks = 0; ks < 8; ++ks) k1[ks] = *(const LAS bf16x8*)(lds + kbuf + (2 * kp + 1) * 8192 + koffx[ks & 3] + (ks >> 2) * 256);
                    }
                    u32x2 vlo[2], vhi[2];
#pragma unroll
                    for (int eb = 0; eb < 2; ++eb) { const LAS unsigned char* vb = lds + RT_VT + (16 * eb + fr) * RT_VTSTR + (32 * kp + 4 * fq) * 2; vlo[eb] = *(const LAS u32x2*)vb; vhi[eb] = *(const LAS u32x2*)(vb + 32); }
                    __builtin_amdgcn_sched_barrier(0);
                    f32x4 s0 = (f32x4){0.f, 0.f, 0.f, 0.f}, s1 = (f32x4){0.f, 0.f, 0.f, 0.f};
#pragma unroll
                    for (int ks = 0; ks < 8; ++ks) s0 = __builtin_amdgcn_mfma_f32_16x16x32_bf16(k0[ks], qf[ks], s0, 0, 0, 0);
                    if (two) {
#pragma unroll
                        for (int ks = 0; ks < 8; ++ks) s1 = __builtin_amdgcn_mfma_f32_16x16x32_bf16(k1[ks], qf[ks], s1, 0, 0, 0);
                    }
                    s0 *= pdec; s1 *= pdec;
                    if (2 * kp == jb) {
#pragma unroll
                        for (int r = 0; r < 4; ++r) s0[r] = (4 * fq + r <= fr) ? s0[r] : 0.f;
                    }
                    if (2 * kp + 1 == jb) {
#pragma unroll
                        for (int r = 0; r < 4; ++r) s1[r] = (4 * fq + r <= fr) ? s1[r] : 0.f;
                    }
                    u32x4 pw; pw.x = pk2(s0[0], s0[1]); pw.y = pk2(s0[2], s0[3]); pw.z = pk2(s1[0], s1[1]); pw.w = pk2(s1[2], s1[3]);
                    const bf16x8 pf = __builtin_bit_cast(bf16x8, pw);
#pragma unroll
                    for (int eb = 0; eb < 2; ++eb) {
                        u32x4 vw; vw.x = vlo[eb].x; vw.y = vlo[eb].y; vw.z = vhi[eb].x; vw.w = vhi[eb].y;
                        oacc[eb] = __builtin_amdgcn_mfma_f32_16x16x32_bf16(__builtin_bit_cast(bf16x8, vw), pf, oacc[eb], 0, 0, 0);
                    }
                }
            }
            if (more) {
#pragma unroll
                for (int ks = 0; ks < 8; ++ks) qf[ks] = *(const GAS bf16x8*)(Qh + (size_t)((ci + 1) * 128 + 16 * jb + fr) * D + 32 * ks + 8 * fq);
            }
            {
                float ss = 0.f;
#pragma unroll
                for (int eb = 0; eb < 2; ++eb) {
                    pend_ow[eb].x = pk2(oacc[eb].x, oacc[eb].y); pend_ow[eb].y = pk2(oacc[eb].z, oacc[eb].w);
                    ss += (oacc[eb].x * oacc[eb].x + oacc[eb].y * oacc[eb].y) + (oacc[eb].z * oacc[eb].z + oacc[eb].w * oacc[eb].w);
                }
                ss += __shfl_xor(ss, 16); ss += __shfl_xor(ss, 32);
                pend_ss = ss;
            }
            bf16x8 vtn[2][4]; u32x2 kt[2][4][2];
#pragma unroll
            for (int eb = 0; eb < 2; ++eb)
#pragma unroll
                for (int ks = 0; ks < 4; ++ks) vtn[eb][ks] = *(const LAS bf16x8*)(lds + RT_VT + (16 * eb + fr) * RT_VTSTR + ks * 64 + fq * 16);
            {
                const unsigned a00 = (unsigned)(kbuf + troff[0][0]), a01 = (unsigned)(kbuf + troff[0][1]), a10 = (unsigned)(kbuf + troff[1][0]), a11 = (unsigned)(kbuf + troff[1][1]);
                asm volatile(
                    "ds_read_b64_tr_b16 %0, %16\n\t"  "ds_read_b64_tr_b16 %1, %17\n\t"
                    "ds_read_b64_tr_b16 %2, %16 offset:16384\n\t"  "ds_read_b64_tr_b16 %3, %17 offset:16384\n\t"
                    "ds_read_b64_tr_b16 %4, %16 offset:32768\n\t"  "ds_read_b64_tr_b16 %5, %17 offset:32768\n\t"
                    "ds_read_b64_tr_b16 %6, %16 offset:49152\n\t"  "ds_read_b64_tr_b16 %7, %17 offset:49152\n\t"
                    "ds_read_b64_tr_b16 %8, %18\n\t"  "ds_read_b64_tr_b16 %9, %19\n\t"
                    "ds_read_b64_tr_b16 %10, %18 offset:16384\n\t"  "ds_read_b64_tr_b16 %11, %19 offset:16384\n\t"
                    "ds_read_b64_tr_b16 %12, %18 offset:32768\n\t"  "ds_read_b64_tr_b16 %13, %19 offset:32768\n\t"
                    "ds_read_b64_tr_b16 %14, %18 offset:49152\n\t"  "ds_read_b64_tr_b16 %15, %19 offset:49152\n\t"
                    "s_waitcnt lgkmcnt(0)"
                    : "=&v"(kt[0][0][0]), "=&v"(kt[0][0][1]), "=&v"(kt[0][1][0]), "=&v"(kt[0][1][1]), "=&v"(kt[0][2][0]), "=&v"(kt[0][2][1]), "=&v"(kt[0][3][0]), "=&v"(kt[0][3][1]),
                      "=&v"(kt[1][0][0]), "=&v"(kt[1][0][1]), "=&v"(kt[1][1][0]), "=&v"(kt[1][1][1]), "=&v"(kt[1][2][0]), "=&v"(kt[1][2][1]), "=&v"(kt[1][3][0]), "=&v"(kt[1][3][1])
                    : "v"(a00), "v"(a01), "v"(a10), "v"(a11)
                    : "memory");
            }
            asm volatile("s_waitcnt lgkmcnt(0)" ::: "memory"); __builtin_amdgcn_s_barrier(); asm volatile("" ::: "memory");
#pragma unroll
            for (int eb = 0; eb < 2; ++eb)
#pragma unroll
                for (int db = 0; db < 2; ++db) {
                    sst[eb][db] *= cdec;
#pragma unroll
                    for (int ks = 0; ks < 4; ++ks) {
                        u32x4 kw; kw.x = kt[db][ks][0].x; kw.y = kt[db][ks][0].y; kw.z = kt[db][ks][1].x; kw.w = kt[db][ks][1].y;
                        sst[eb][db] = __builtin_amdgcn_mfma_f32_16x16x32_bf16(__builtin_bit_cast(bf16x8, kw), vtn[eb][ks], sst[eb][db], 0, 0, 0);
                    }
                    u32x2 sw; sw.x = pk2(sst[eb][db].x, sst[eb][db].y); sw.y = pk2(sst[eb][db].z, sst[eb][db].w);
                    *(LAS u32x2*)(lds + RT_ST + (16 * eb + fr) * RT_STSTR + (32 * w + 16 * db + 4 * fq) * 2) = sw;
                }
            __builtin_amdgcn_sched_barrier(0);
            if (more) {
                LAS bf16_t* vt = (LAS bf16_t*)(lds + RT_VT + (8 * vp) * RT_VTSTR) + vm;
#pragma unroll
                for (int q = 0; q < 4; ++q) { vt[(2 * q) * (RT_VTSTR / 2)] = (bf16_t)(vreg[q] & 0xffffu); vt[(2 * q + 1) * (RT_VTSTR / 2)] = (bf16_t)(vreg[q] >> 16); }
            }
        }
        {
            const size_t row = (size_t)(SEQ / RC - 1) * 128 + jrow;
#pragma unroll
            for (int eb = 0; eb < 2; ++eb) *(GAS u32x2*)(Vh + row * 2048 + 16 * eb + 4 * fq) = pend_ow[eb];
            if (fq == 0) hs[row * RH * 16] = pend_ss;
        }
#undef RT_STAGE_K
    }
    __syncthreads();
}

__device__ __forceinline__ void final_phase(const Frame& F, const GAS bf16_t* xb, GAS float* out, const GAS float* g) {
    const int tid_ = opq_tid(), lane_ = tid_ & 63, wave_ = __builtin_amdgcn_readfirstlane(tid_ >> 6);
    const int gw = F.vcu * 8 + wave_, NGW = F.G * 8;
    f32x4 gv[2][2];
#pragma unroll
    for (int j = 0; j < 2; ++j) { gv[j][0] = ((const GAS f32x4*)g)[2 * (lane_ + 64 * j)]; gv[j][1] = ((const GAS f32x4*)g)[2 * (lane_ + 64 * j) + 1]; }
    for (int row = 4 * gw; row < M; row += 4 * NGW) {
        u32x4 w[4][2];
#pragma unroll
        for (int r = 0; r < 4; ++r)
#pragma unroll
            for (int j = 0; j < 2; ++j) w[r][j] = ((const GAS u32x4*)(xb + (size_t)(row + r) * D))[lane_ + 64 * j];
#pragma unroll
        for (int r = 0; r < 4; ++r) {
            f32x4 v[2][2]; float s = 0.f;
#pragma unroll
            for (int j = 0; j < 2; ++j) { const u32x4 ww = w[r][j];
                v[j][0] = (f32x4){bf_lo(ww.x), bf_hi(ww.x), bf_lo(ww.y), bf_hi(ww.y)}; v[j][1] = (f32x4){bf_lo(ww.z), bf_hi(ww.z), bf_lo(ww.w), bf_hi(ww.w)};
                s += (v[j][0].x * v[j][0].x + v[j][0].y * v[j][0].y) + (v[j][0].z * v[j][0].z + v[j][0].w * v[j][0].w) + (v[j][1].x * v[j][1].x + v[j][1].y * v[j][1].y) + (v[j][1].z * v[j][1].z + v[j][1].w * v[j][1].w); }
            const float rs = rsqrtf(wave_sum(s) * (1.0f / D) + RMS_EPS);
            GAS f32x4* o = (GAS f32x4*)(out + (size_t)(row + r) * D) + 2 * lane_;
#pragma unroll
            for (int j = 0; j < 2; ++j) { o[128 * j] = v[j][0] * rs * gv[j][0]; o[128 * j + 1] = v[j][1] * rs * gv[j][1]; }
        }
    }
}

__global__ void __launch_bounds__(512, 2) trunk_fwd(Args args) {
    extern __shared__ __attribute__((aligned(16))) unsigned char lds_raw[];
    Frame F;
    F.lds = (LAS unsigned char*)lds_raw;
    F.tid = threadIdx.x; F.lane = F.tid & 63; F.wave = __builtin_amdgcn_readfirstlane(F.tid >> 6);
    F.G = gridDim.x; { const int bx = blockIdx.x; F.vcu = (F.G % 8 == 0) ? (bx % 8) * (F.G / 8) + bx / 8 : bx; }
    unsigned char* ws = args.ws;
    unsigned* ctl = (unsigned*)(ws + WS_CTL);
    volatile LAS unsigned* MISC = (volatile LAS unsigned*)(F.lds + LDS_MISC);
    for (int u = F.tid; u < (LDS_BYTES - LDS_MISC) / 4; u += 512) ((LAS unsigned*)(F.lds + LDS_MISC))[u] = 0u;
    __syncthreads();
    XcdBarrier bar = xcd_barrier_post(ctl + 4096 + args.li * XCD_BAR_WORDS, MISC + 8);
    const int lo = args.ph_lo, hi = args.ph_hi;
#define IN(k) (lo <= (k) && (k) < hi)
#define GRID_BAR(k) do { if (hi > (k) + 1) xcd_barrier(bar); } while (0)

    bf16_t* xb = (bf16_t*)(ws + WS_XB);
    float* ssq = (float*)(ws + WS_SSQ);

    if (IN(0)) { if (I8_F1_LAYERS || I8_RET || I8_SGU) { p0_wabs(F, args); xcd_barrier(bar); } p0_prologue(F, args); GRID_BAR(0); }

#pragma unroll 1
    for (int L = 0; L < NLAYER; ++L) {
        const int pb = 1 + 6 * L;
        const int kind = (L == 1) ? 1 : (L == 2) ? 2 : 0;
        int pmo;
        const bf16_t* moA; const bf16_t* moB; int moK;
        if (kind == 0) {
            const int j = (L == 0) ? 0 : 1;
            bf16_t* Bo = (bf16_t*)(ws + AR_CB); bf16_t* CZ = (bf16_t*)(ws + AR_CZ); bf16_t* CY = (bf16_t*)(ws + AR_CY);
            if (IN(pb)) {
                pg8::Gemm g{opq(xb), opq((const bf16_t*)(ws + W_CI + j * W_CI_SZ)), M, 3072, 1024}; pg8::StaticOrder S; S.init(M, 3072, F.G, (int)blockIdx.x);
                EpiConvIn E{(const GAS float*)opq(ssq), (GAS bf16_t*)opq(Bo), (GAS bf16_t*)opq(CZ)};
                pg8::gemm_phase<EpiConvIn>(F.lds, g, S, E);
                GRID_BAR(pb);
            }
            if (IN(pb + 1)) { conv_phase(F, (const GAS bf16_t*)opq(Bo), (const GAS bf16_t*)opq(CZ), (const GAS float*)opq(args.in[5] + (size_t)j * 3 * D), (GAS bf16_t*)opq(CY)); GRID_BAR(pb + 1); }
            pmo = pb + 2; moA = CY; moB = (const bf16_t*)(ws + W_CO + j * W_CO_SZ); moK = 1024;
        } else if (kind == 1) {
            bf16_t* U = (bf16_t*)(ws + AR_SU); bf16_t* V = (bf16_t*)(ws + AR_SV); float* lnp = (float*)(ws + WS_LNP);
            {
            if (IN(pb)) {
                if constexpr (I8_SGU) {
                quant_phase(F, (const GAS bf16_t*)opq((const bf16_t*)xb), (GAS unsigned char*)opq(ws + WS_X8), (GAS float*)opq((float*)(ws + WS_SA)));
                xcd_barrier(bar);
                pg8::Gemm g{opq((const bf16_t*)(ws + WS_X8)), opq((const bf16_t*)(ws + W_SI)), M, 4096, 1024 / 2}; pg8::StaticOrder S; S.init(M, 4096, F.G, (int)blockIdx.x);
                EpiSguIn E{(const GAS float*)opq(ssq), (GAS bf16_t*)opq(U), (GAS bf16_t*)opq(V), (GAS float*)opq(lnp), (const GAS float*)opq((const float*)(ws + WS_SA)), i8_wfull(ws, 6, F.lane, 1.0f / (1024.0f * 4096.0f)) * (1.0f / 127.0f)};
                pg8::gemm_phase<EpiSguIn, true, true, false, true, true>(F.lds, g, S, E);
                } else {
                pg8::Gemm g{opq(xb), opq((const bf16_t*)(ws + W_SI)), M, 4096, 1024}; pg8::StaticOrder S; S.init(M, 4096, F.G, (int)blockIdx.x);
                EpiSguIn E{(const GAS float*)opq(ssq), (GAS bf16_t*)opq(U), (GAS bf16_t*)opq(V), (GAS float*)opq(lnp), (const GAS float*)nullptr, 1.0f};
                pg8::gemm_phase<EpiSguIn>(F.lds, g, S, E);
                }
                GRID_BAR(pb);
            }
            if (IN(pb + 1)) { sgu_phase(F, (GAS bf16_t*)opq(U), (const GAS bf16_t*)opq(V), (const GAS float*)opq(lnp), (const GAS bf16_t*)opq((const bf16_t*)(ws + W_WS)), (const GAS float*)opq(args.in[8]), (const GAS float*)opq(args.in[9]), (const GAS float*)opq(args.in[11])); GRID_BAR(pb + 1); }
            }
            pmo = pb + 2; moA = U; moB = (const bf16_t*)(ws + W_SO); moK = 2048;
        } else {
            bf16_t* Q = (bf16_t*)(ws + AR_RQ); bf16_t* Kn = (bf16_t*)(ws + AR_RK); bf16_t* V = (bf16_t*)(ws + AR_RV);
            float* hss = args.out;
            {
            {
            if (IN(pb)) {
                if constexpr (I8_RET) {
                quant_phase(F, (const GAS bf16_t*)opq((const bf16_t*)xb), (GAS unsigned char*)opq(ws + WS_X8), (GAS float*)opq((float*)(ws + WS_SA)));
                xcd_barrier(bar);
                pg8::Gemm g{opq((const bf16_t*)(ws + WS_X8)), opq((const bf16_t*)(ws + W_RQ)), M, 4096, 1024 / 2}; pg8::StaticOrder S; S.init(M, 4096, F.G, (int)blockIdx.x);
                EpiRetQkv E{(const GAS float*)opq(ssq), (const GAS float*)opq((const float*)(ws + WS_ROT)), (const GAS float*)opq((const float*)(ws + WS_ROT) + (size_t)SEQ * 128), (GAS bf16_t*)opq(Q), (GAS bf16_t*)opq(Kn), (GAS bf16_t*)opq(V),
                            (const GAS float*)opq((const float*)(ws + WS_SA)), i8_wfull(ws, 4, F.lane, 1.0f / (1024.0f * 4096.0f)) * (1.0f / 127.0f)};
                pg8::gemm_phase<EpiRetQkv, true, true, false, true, true>(F.lds, g, S, E);
                } else {
                pg8::Gemm g{opq(xb), opq((const bf16_t*)(ws + W_RQ)), M, 4096, 1024}; pg8::StaticOrder S; S.init(M, 4096, F.G, (int)blockIdx.x);
                EpiRetQkv E{(const GAS float*)opq(ssq), (const GAS float*)opq((const float*)(ws + WS_ROT)), (const GAS float*)opq((const float*)(ws + WS_ROT) + (size_t)SEQ * 128), (GAS bf16_t*)opq(Q), (GAS bf16_t*)opq(Kn), (GAS bf16_t*)opq(V), (const GAS float*)nullptr, 1.0f};
                pg8::gemm_phase<EpiRetQkv>(F.lds, g, S, E);
                }
                GRID_BAR(pb);
            }
            if (IN(pb + 1)) { ret_phase(F, (const GAS bf16_t*)opq(Q), (const GAS bf16_t*)opq(Kn), (GAS bf16_t*)opq(V), (GAS float*)opq(hss)); GRID_BAR(pb + 1); }
            }
            if (IN(pb + 2)) {
                if constexpr (I8_RET) {
                pg8::Gemm g{opq((const bf16_t*)(ws + WS_X8)), opq((const bf16_t*)(ws + W_RG)), M, 2048, 1024 / 2}; pg8::StaticOrder S; S.init(M, 2048, F.G, (int)blockIdx.x);
                EpiRetG E{(const GAS float*)opq(ssq), (const GAS float*)opq(hss), (GAS bf16_t*)opq(V), (const GAS float*)opq((const float*)(ws + WS_SA)), i8_wfull(ws, 5, F.lane, 1.0f / (1024.0f * 2048.0f)) * (1.0f / 127.0f)};
                pg8::gemm_phase<EpiRetG, true, true, false, true, true>(F.lds, g, S, E);
                } else {
                pg8::Gemm g{opq(xb), opq((const bf16_t*)(ws + W_RG)), M, 2048, 1024}; pg8::StaticOrder S; S.init(M, 2048, F.G, (int)blockIdx.x);
                EpiRetG E{(const GAS float*)opq(ssq), (const GAS float*)opq(hss), (GAS bf16_t*)opq(V), (const GAS float*)nullptr, 1.0f};
                pg8::gemm_phase<EpiRetG>(F.lds, g, S, E);
                }
                GRID_BAR(pb + 2);
            }
            }
            pmo = pb + 3; moA = V; moB = (const bf16_t*)(ws + W_RO); moK = 2048;
        }
        if (IN(pmo)) {
            pg8::Gemm g{opq(moA), opq(moB), M, 1024, moK}; pg8::StaticOrder S; S.init(M, 1024, F.G, (int)blockIdx.x);
            EpiResid E{(GAS bf16_t*)opq(xb), (GAS float*)opq(ssq), 1.0f, ((F8_F1_LAYERS >> L) & 1) ? (GAS unsigned char*)opq(ws + WS_X8) : (GAS unsigned char*)nullptr};
            pg8::gemm_phase<EpiResid>(F.lds, g, S, E);
            GRID_BAR(pmo);
        }
        if (IN(pb + 4)) {
            if ((I8_F1_LAYERS >> L) & 1) {
                quant_phase(F, (const GAS bf16_t*)opq((const bf16_t*)xb), (GAS unsigned char*)opq(ws + WS_X8), (GAS float*)opq((float*)(ws + WS_SA)));
                xcd_barrier(bar);
                pg8::Gemm g{opq((const bf16_t*)(ws + WS_X8)), opq((const bf16_t*)(ws + W_FI + L * W_FI_SZ)), M, 2 * DFF, 1024 / 2}; pg8::StaticOrder S; S.init(M, 2 * DFF, F.G, (int)blockIdx.x);
                const float wsc = i8_wfull(ws, L, F.lane) * (1.0f / 127.0f);
                EpiFfnIn E{(const GAS float*)opq(ssq), (GAS unsigned char*)opq(ws + AR_FA), ((F8_LAYERS >> L) & 1) != 0, wsc, (const GAS float*)opq((const float*)(ws + WS_SA)), true};
                pg8::gemm_phase<EpiFfnIn, true, true, false, true>(F.lds, g, S, E);
            } else if ((F8_F1_LAYERS >> L) & 1) {
                pg8::Gemm g{opq((const bf16_t*)(ws + WS_X8)), opq((const bf16_t*)(ws + W_FI + L * W_FI_SZ)), M, 2 * DFF, 1024 / 2}; pg8::StaticOrder S; S.init(M, 2 * DFF, F.G, (int)blockIdx.x);
                EpiFfnIn E{(const GAS float*)opq(ssq), (GAS unsigned char*)opq(ws + AR_FA), ((F8_LAYERS >> L) & 1) != 0, 1.0f / FI_WSCALE, (const GAS float*)nullptr, false};
                pg8::gemm_phase<EpiFfnIn, true, true, true>(F.lds, g, S, E);
            } else {
                pg8::Gemm g{opq(xb), opq((const bf16_t*)(ws + W_FI + L * W_FI_SZ)), M, 2 * DFF, 1024}; pg8::StaticOrder S; S.init(M, 2 * DFF, F.G, (int)blockIdx.x);
                EpiFfnIn E{(const GAS float*)opq(ssq), (GAS unsigned char*)opq(ws + AR_FA), ((F8_LAYERS >> L) & 1) != 0, 1.0f, (const GAS float*)nullptr, false};
                pg8::gemm_phase<EpiFfnIn>(F.lds, g, S, E);
            }
            GRID_BAR(pb + 4);
        }
        if (IN(pb + 5)) {
            if ((F8_LAYERS >> L) & 1) {
                pg8::Gemm g{opq((const bf16_t*)(ws + AR_FA)), opq((const bf16_t*)(ws + W_FD + L * W_FD_SZ)), M, 1024, DFF / 2}; pg8::StaticOrder S; S.init(M, 1024, F.G, (int)blockIdx.x);
                EpiResidT<2> E{(GAS bf16_t*)opq(xb), (GAS float*)opq(ssq), 1.0f / FD_WSCALE, (GAS unsigned char*)nullptr};
                pg8::gemm_phase<EpiResidT<2>, true, true, true>(F.lds, g, S, E);
            } else {
                pg8::Gemm g{opq((const bf16_t*)(ws + AR_FA)), opq((const bf16_t*)(ws + W_FD + L * W_FD_SZ)), M, 1024, DFF}; pg8::StaticOrder S; S.init(M, 1024, F.G, (int)blockIdx.x);
                EpiResid E{(GAS bf16_t*)opq(xb), (GAS float*)opq(ssq), 1.0f, (GAS unsigned char*)nullptr};
                pg8::gemm_phase<EpiResid>(F.lds, g, S, E);
            }
            GRID_BAR(pb + 5);
        }
    }
    if (IN(NPH - 1)) final_phase(F, (const GAS bf16_t*)opq((const bf16_t*)xb), (GAS float*)opq(args.out), (const GAS float*)opq(args.in[3]));
#undef IN
#undef GRID_BAR
}

extern "C" void kernel_launch(void* const* d_in, const int* in_sizes, int n_in, void* d_out, int out_size, void* d_ws, size_t ws_size, hipStream_t stream) {
    static int grid = 0;
    if (grid == 0) {
        if (n_in != 18 || out_size != M * D || ws_size < WS_END) { fprintf(stderr, "kernel_launch: unexpected shapes (n_in %d out %d ws %zu)\n", n_in, out_size, ws_size); grid = -1; return; }
        int dev = 0, cus = 0, per_cu = 0;
        if (hipGetDevice(&dev) != hipSuccess || hipDeviceGetAttribute(&cus, hipDeviceAttributeMultiprocessorCount, dev) != hipSuccess) { grid = -1; return; }
        if (hipFuncSetAttribute((const void*)trunk_fwd, hipFuncAttributeMaxDynamicSharedMemorySize, LDS_BYTES) != hipSuccess) { fprintf(stderr, "kernel_launch: hipFuncSetAttribute failed\n"); grid = -1; return; }
        if (hipOccupancyMaxActiveBlocksPerMultiprocessor(&per_cu, (const void*)trunk_fwd, 512, LDS_BYTES) != hipSuccess || per_cu < 1)
            fprintf(stderr, "kernel_launch: occupancy query reports %d\n", per_cu);
        (void)hipGetLastError();
        grid = cus;
    }
    if (grid < 0) return;
    (void)in_sizes;
    if (hipMemsetAsync((char*)d_ws + WS_CTL, 0, CTL_BYTES, stream) != hipSuccess) return;
    Args a{};
    for (int i = 0; i < 18; ++i) a.in[i] = (const float*)d_in[i];
    a.out = (float*)d_out; a.ws = (unsigned char*)d_ws; a.pad = 0;
#if MK_ONE_LAUNCH
    a.ph_lo = 0; a.ph_hi = NPH; a.li = 0;
    hipLaunchKernelGGL(trunk_fwd, dim3(grid), dim3(512), LDS_BYTES, stream, a);
#else
    int li = 0;
    for (int ph = 0; ph < NPH; ++ph) {
        const int r = (ph - 1) % 6, L = (ph - 1) / 6;
        if (ph >= 1 && ph < NPH - 1 && r == 3 && L != 2) continue;
        a.ph_lo = ph; a.ph_hi = ph + 1; a.li = li++;
        hipLaunchKernelGGL(trunk_fwd, dim3(grid), dim3(512), LDS_BYTES, stream, a);
    }
#endif
}
```

```cpp
#include <hip/hip_runtime.h>
#include <cstdio>
#include <cstdint>

#ifndef MK_ONE_LAUNCH
#define MK_ONE_LAUNCH 1
#endif

#define LAS __attribute__((address_space(3)))
#define GAS __attribute__((address_space(1)))
typedef unsigned short bf16_t;
typedef short bf16x8 __attribute__((ext_vector_type(8)));
typedef short bf16x4 __attribute__((ext_vector_type(4)));
typedef float f32x4 __attribute__((ext_vector_type(4)));
typedef float f32x2 __attribute__((ext_vector_type(2)));
typedef unsigned u32x4 __attribute__((ext_vector_type(4)));
typedef unsigned u32x2 __attribute__((ext_vector_type(2)));
typedef int i32x4 __attribute__((ext_vector_type(4)));
typedef int i32x8 __attribute__((ext_vector_type(8)));

constexpr int D = 1024, NB = 4, SEQ = 8192, M = NB * SEQ, DFF = 2816, NLAYER = 4;
constexpr int RH = 4, RQK = 256, RV = 512, RC = 128;
constexpr float RMS_EPS = 1e-6f, LN_EPS = 1e-5f;
constexpr int F8_LAYERS = 0x8;
constexpr bool I8_CONV3 = true;
constexpr bool I8_SGU = true;
constexpr bool I8_RET = true;
constexpr int I8_F1_LAYERS = 0xF;
constexpr int F8_F1_LAYERS = 0x0;
constexpr float FD_WSCALE = 64.0f, FI_WSCALE = 32.0f;
constexpr float WCLIP = 3.5f;
constexpr int CTL_WSS = 131072;

constexpr size_t MiB = 1u << 20;
constexpr size_t WS_CTL = 0, CTL_BYTES = 1 * MiB;
constexpr size_t WS_SSQ = 1 * MiB;
constexpr size_t WS_W = 3 * MiB;
constexpr size_t W_CI = WS_W, W_CI_SZ = (size_t)3072 * 1024 * 2;
constexpr size_t W_CO = W_CI + 2 * W_CI_SZ, W_CO_SZ = (size_t)1024 * 1024 * 2;
constexpr size_t W_SI = W_CO + 2 * W_CO_SZ, W_SI_SZ = (size_t)4096 * 1024 * 2;
constexpr size_t W_SO = W_SI + W_SI_SZ, W_SO_SZ = (size_t)1024 * 2048 * 2;
constexpr size_t W_RQ = W_SO + W_SO_SZ, W_RQ_SZ = (size_t)4096 * 1024 * 2;
constexpr size_t W_RG = W_RQ + W_RQ_SZ, W_RG_SZ = (size_t)2048 * 1024 * 2;
constexpr size_t W_RO = W_RG + W_RG_SZ, W_RO_SZ = (size_t)1024 * 2048 * 2;
constexpr size_t W_FI = W_RO + W_RO_SZ, W_FI_SZ = (size_t)5632 * 1024 * 2;
constexpr size_t W_FD = W_FI + 4 * W_FI_SZ, W_FD_SZ = (size_t)1024 * 2816 * 2;
constexpr size_t W_WS = W_FD + 4 * W_FD_SZ, W_WS_SZ = (size_t)8 * 128 * 128 * 2;
constexpr size_t WS_WEND = W_WS + W_WS_SZ;
static_assert(WS_WEND <= 114 * MiB, "weights");
constexpr size_t WS_ROT = 114 * MiB;
constexpr size_t WS_HSS = WS_ROT;
constexpr size_t WS_XB = 122 * MiB;
constexpr size_t WS_AR = 186 * MiB;
constexpr size_t WS_SA = 491 * MiB;
constexpr size_t WS_X8 = 458 * MiB;
constexpr size_t WS_KT = 442 * MiB;
constexpr size_t WS_LNP = WS_KT;
constexpr size_t WS_END = 506 * MiB;
constexpr size_t AR_CB = WS_AR, AR_CZ = WS_AR + 64 * MiB, AR_CY = WS_AR + 128 * MiB;
constexpr size_t AR_SU = WS_AR, AR_SV = WS_AR + 128 * MiB;
constexpr size_t AR_RQ = WS_AR, AR_RK = WS_AR + 64 * MiB, AR_RV = WS_AR + 128 * MiB;
constexpr size_t AR_FA = WS_AR;

constexpr int NPH = 26;
constexpr int LDS_BYTES = 159744;
constexpr int LDS_MISC = 159232;

#define RLX_AGENT __ATOMIC_RELAXED, __HIP_MEMORY_SCOPE_AGENT
__device__ __forceinline__ unsigned f2bf(float f) { unsigned u = __builtin_bit_cast(unsigned, f); return (u + 0x7fffu + ((u >> 16) & 1u)) >> 16; }
typedef __bf16 bf16v2 __attribute__((ext_vector_type(2)));
__device__ __forceinline__ unsigned pk2(float lo, float hi) { const f32x2 v = {lo, hi}; return __builtin_bit_cast(unsigned, __builtin_convertvector(v, bf16v2)); }
__device__ __forceinline__ float bf_lo(unsigned w) { return __builtin_bit_cast(float, w << 16); }
__device__ __forceinline__ float bf_hi(unsigned w) { return __builtin_bit_cast(float, w & 0xffff0000u); }
__device__ __forceinline__ float wave_max(float v) {
#pragma unroll
    for (int o = 1; o < 64; o <<= 1) v = fmaxf(v, __shfl_xor(v, o));
    return v;
}
__device__ __forceinline__ float wave_sum(float v) {
#pragma unroll
    for (int o = 1; o < 64; o <<= 1) v += __shfl_xor(v, o);
    return v;
}
template <class T> __device__ __forceinline__ T* opq(T* p) { asm volatile("" : "+s"(p)); return p; }
__device__ __forceinline__ int opq_tid() { int t = threadIdx.x; asm volatile("" : "+v"(t)); return t; }
__device__ __forceinline__ float fast_rcp(float x) { return __builtin_amdgcn_rcpf(x); }
__device__ __forceinline__ float silu_f(float x) { return x * fast_rcp(1.0f + __builtin_amdgcn_exp2f(-1.44269504089f * x)); }

#define XB_TMO      128
#define XB_XCNT(j)  (256  + 64 * (j))
#define XB_XSUB(j)  (1280 + 64 * (j))
#define XB_XGEN(j)  (2304 + 64 * (j))
#define XB_TOP      3328
#define XB_TOPGEN   3392
#define XCD_BAR_WORDS 3456
#define XB_SPIN_CAP (1u << 18)
__device__ __forceinline__ unsigned xb_ld(unsigned* p)              { return __hip_atomic_load(p, __ATOMIC_RELAXED, __HIP_MEMORY_SCOPE_AGENT); }
__device__ __forceinline__ unsigned xb_add(unsigned* p, unsigned v) { return __hip_atomic_fetch_add(p, v, __ATOMIC_RELAXED, __HIP_MEMORY_SCOPE_AGENT); }
__device__ __forceinline__ unsigned xb_xcc_id() { return (unsigned)__builtin_amdgcn_s_getreg((3 << 11) | 20) & 0xFu; }
#define XB_SPIN(cond, bar) do { unsigned _sp = 0; while (cond) { __builtin_amdgcn_s_sleep(1); \
    if ((++_sp & 255u) == 0u) { if (xb_ld(&(bar)[XB_TMO])) break; if (_sp > XB_SPIN_CAP) { atomicAdd(&(bar)[XB_TMO], 1u); break; } } } } while (0)
struct XcdBarrier { unsigned* bar; unsigned x; volatile LAS unsigned* st; };
__device__ __forceinline__ XcdBarrier xcd_barrier_post(unsigned* bar, volatile LAS unsigned* st) {
    XcdBarrier b; b.bar = bar; b.x = xb_xcc_id(); b.st = st;
    if (threadIdx.x == 0) (void)xb_add(&bar[XB_XCNT(b.x)], 1u);
    return b;
}
__device__ __forceinline__ void xcd_barrier_complete(unsigned* bar, unsigned x, unsigned& nloc, unsigned& nx) {
    const unsigned G = gridDim.x * gridDim.y * gridDim.z;
    unsigned sum, cnt, mine, sp = 0u;
    for (;;) {
        sum = 0u; cnt = 0u; mine = 0u;
#pragma unroll
        for (unsigned j = 0; j < 16; ++j) { const unsigned c = xb_ld(&bar[XB_XCNT(j)]); sum += c; cnt += (c > 0u) ? 1u : 0u; mine = (j == x) ? c : mine; }
        if (sum == G) break;
        __builtin_amdgcn_s_sleep(1);
        if ((++sp & 255u) == 0u) { if (xb_ld(&bar[XB_TMO])) break; if (sp > XB_SPIN_CAP) { atomicAdd(&bar[XB_TMO], 1u); break; } }
    }
    nloc = mine > 0u ? mine : 1u; nx = cnt > 0u ? cnt : 1u;
}
__device__ __forceinline__ void xcd_barrier(const XcdBarrier& b) {
    asm volatile("s_waitcnt vmcnt(0)" ::: "memory");
    __syncthreads();
    if (threadIdx.x == 0) {
        unsigned* bar = b.bar;
        __builtin_amdgcn_s_waitcnt(0);
        unsigned nloc = b.st[0], nx = b.st[1];
        if (nloc == 0u) { xcd_barrier_complete(bar, b.x, nloc, nx); b.st[0] = nloc; b.st[1] = nx; }
        const unsigned old = xb_add(&bar[XB_XSUB(b.x)], 1u);
        const unsigned gen = old / nloc;
        if (old + 1u == (gen + 1u) * nloc) {
            __builtin_amdgcn_fence(__ATOMIC_RELEASE, "agent");
            asm volatile("s_waitcnt vmcnt(0)" ::: "memory");
            const unsigned og = xb_add(&bar[XB_TOP], 1u);
            const unsigned tg = og / nx;
            if (og + 1u == (tg + 1u) * nx) xb_add(&bar[XB_TOPGEN], 1u);
            else XB_SPIN(xb_ld(&bar[XB_TOPGEN]) == tg, bar);
            __builtin_amdgcn_fence(__ATOMIC_ACQUIRE, "agent");
            xb_add(&bar[XB_XGEN(b.x)], 1u);
            asm volatile("s_waitcnt vmcnt(0)" ::: "memory");
        } else {
            XB_SPIN(xb_ld(&bar[XB_XGEN(b.x)]) == gen, bar);
            __builtin_amdgcn_fence(__ATOMIC_ACQUIRE, "agent");
            asm volatile("s_waitcnt vmcnt(0)" ::: "memory");
        }
    }
    __syncthreads();
}

namespace pg8 {
constexpr int BM = 256, BK = 64, HALF = 128, HTB = HALF * BK * 2, STAGE_BYTES = 8 * HTB, NXCD = 8, WGM = 8;
__host__ __device__ __forceinline__ int lds_byte(int r, int c) { const int st = (r >> 4) * 2 + (c >> 5), rr = r & 15, cc = c & 31, ob = rr * 64 + cc * 2; return st * 1024 + (ob ^ (((ob >> 9) & 1) << 5)); }
__host__ __device__ __forceinline__ void stage_rc(int b, int& R, int& C) { const int st = b / 1024, sb = b % 1024, swz = sb ^ (((sb >> 9) & 1) << 5); R = (st >> 1) * 16 + swz / 64; C = (st & 1) * 32 + (swz % 64) / 2; }
__host__ __device__ __forceinline__ int perm32(int rho) { const int n = rho >> 4, i = rho & 15; return 8 * (i >> 2) + 4 * n + (i & 3); }

struct Unit { int pm, pn; };
struct Gemm { const bf16_t* A; const bf16_t* Bt; int M, N, K; };
struct StaticOrder {
    int nM, nN, nwg, G, c;
    __host__ __device__ void init(int M_, int N_, int G_, int c_) { nM = M_ / BM; nN = N_ / BM; nwg = nM * nN; G = G_; c = c_; }
    __host__ __device__ bool next(int i, Unit& u) const {
        const long L = (long)i * G + c; if (L >= nwg) return false;
        int wgid = (int)L; { const int q = nwg / NXCD, r = nwg % NXCD, xcd = wgid % NXCD, off = wgid / NXCD; wgid = (xcd < r ? xcd * (q + 1) : r * (q + 1) + (xcd - r) * q) + off; }
        const int nig = WGM * nN, gid = wgid / nig, fm = gid * WGM, gsz = (nM - fm) < WGM ? (nM - fm) : WGM;
        u.pm = fm + ((wgid % nig) % gsz); u.pn = (wgid % nig) / gsz; return true;
    }
};

template <class E_> __device__ __forceinline__ auto rowsc_of(const E_& e, int) -> decltype(e.rowsc) { return e.rowsc; }
template <class E_> __device__ __forceinline__ const GAS float* rowsc_of(const E_&, long) { return nullptr; }
template <class E_> __device__ __forceinline__ auto tsc_of(const E_& e, int) -> decltype(e.tsc) { return e.tsc; }
template <class E_> __device__ __forceinline__ float tsc_of(const E_&, long) { return 1.0f; }
template <class Epi, bool ALIGN_EPI = true, bool SP2 = true, bool F8 = false, bool I8 = false, bool CVT = false>
__device__ __forceinline__ void gemm_phase(LAS unsigned char* lds, const Gemm g, const StaticOrder& S, const Epi& E) {
    const int tid = opq_tid(), wid = __builtin_amdgcn_readfirstlane(tid >> 6), lane = tid & 63, wr = wid >> 2, wc = wid & 3, fr = lane & 15, fq = lane >> 4;
    const int K = g.K, nt = K / BK;
    unsigned voffA[2];
#pragma unroll
    for (int i = 0; i < 2; ++i) { int R, C; stage_rc(tid * 16 + i * 8192, R, C); voffA[i] = (unsigned)(R * K + C) * 2u; }
    const size_t kstep = (size_t)(BK * 2);
    const size_t hstep = (size_t)HALF * K * 2;
    const size_t tstep = 2 * hstep;
    const unsigned ldsw = (unsigned)wid * 1024u;
    const int aoff = lds_byte(wr * 64 + fr, fq * 8), boff = lds_byte(wc * 32 + fr, fq * 8);
#define PG8_SA(b, h) (((b) * 2 + (h)) * HTB)
#define PG8_SB(b, h) ((4 + (b) * 2 + (h)) * HTB)
#define PG8_STAGE(bufoff, gbase, voff) do { _Pragma("unroll") for (int _i = 0; _i < 2; ++_i) \
        __builtin_amdgcn_global_load_lds((const unsigned*)((const char*)(gbase) + (voff)[_i]), (LAS unsigned*)(lds + (bufoff) + ldsw + _i * 8192), 16, 0, 0); } while (0)
#define PG8_LDA(dst, b, h) do { _Pragma("unroll") for (int m = 0; m < 4; ++m) _Pragma("unroll") for (int k = 0; k < 2; ++k) dst[m][k] = *(const LAS bf16x8*)(lds + PG8_SA(b, h) + aoff + m * 2048 + k * 1024); } while (0)
#define PG8_LDB(dst, b, h) do { _Pragma("unroll") for (int n = 0; n < 2; ++n) _Pragma("unroll") for (int k = 0; k < 2; ++k) dst[n][k] = *(const LAS bf16x8*)(lds + PG8_SB(b, h) + boff + n * 2048 + k * 1024); } while (0)
#define PG8_CAT8(lo, hi) __builtin_shufflevector(__builtin_bit_cast(i32x4, lo), __builtin_bit_cast(i32x4, hi), 0, 1, 2, 3, 4, 5, 6, 7)
#define PG8_MMA(ai, bj, At, Bt) do { __builtin_amdgcn_s_setprio(1); _Pragma("unroll") for (int m = 0; m < 4; ++m) _Pragma("unroll") for (int n = 0; n < 2; ++n) { \
        if constexpr (F8) { const i32x8 b8_ = PG8_CAT8(Bt[n][0], Bt[n][1]), a8_ = PG8_CAT8(At[m][0], At[m][1]); asm volatile("v_mfma_f32_16x16x128_f8f6f4 %0, %1, %2, %0" : "+v"(acc[ai][bj][m][n]) : "v"(b8_), "v"(a8_)); } \
        else if constexpr (I8) { _Pragma("unroll") for (int k = 0; k < 2; ++k) acc[ai][bj][m][n] = __builtin_bit_cast(f32x4, __builtin_amdgcn_mfma_i32_16x16x64_i8(__builtin_bit_cast(i32x4, Bt[n][k]), __builtin_bit_cast(i32x4, At[m][k]), __builtin_bit_cast(i32x4, acc[ai][bj][m][n]), 0, 0, 0)); } \
        else { _Pragma("unroll") for (int k = 0; k < 2; ++k) acc[ai][bj][m][n] = __builtin_amdgcn_mfma_f32_16x16x32_bf16(Bt[n][k], At[m][k], acc[ai][bj][m][n], 0, 0, 0); } } __builtin_amdgcn_s_setprio(0); } while (0)
#define PG8_WAIT_V(n) asm volatile("s_waitcnt vmcnt(" #n ")" ::: "memory")
#define PG8_WAIT_L(n) asm volatile("s_waitcnt lgkmcnt(" #n ")" ::: "memory")
#define PG8_BAR __builtin_amdgcn_s_barrier()
#define PG8_SCHED __builtin_amdgcn_sched_barrier(0)
    LAS int* utab = (LAS int*)(lds + LDS_MISC + 128);
    if (tid < 16) { Unit tu; tu.pm = 0; tu.pn = 0; const bool ok = S.next(tid, tu); utab[2 * tid] = ok ? tu.pm : -1; utab[2 * tid + 1] = tu.pn; }
    __syncthreads();
#define PG8_NEXT(i, u) ((i) < 16 && ((u).pm = __builtin_amdgcn_readfirstlane(utab[2 * (i)]), (u).pn = __builtin_amdgcn_readfirstlane(utab[2 * (i) + 1]), (u).pm >= 0))
    Unit cur, nxt; int ui = 0;
    if (!PG8_NEXT(0, cur)) return;
    const char* cA = (const char*)g.A + (size_t)cur.pm * tstep; const char* cB = (const char*)g.Bt + (size_t)cur.pn * tstep;
    if constexpr (SP2) {
        PG8_STAGE(PG8_SB(0, 0), cB, voffA); PG8_STAGE(PG8_SB(0, 1), cB + hstep, voffA); PG8_STAGE(PG8_SA(0, 0), cA, voffA); PG8_STAGE(PG8_SA(0, 1), cA + hstep, voffA);
    }
    if constexpr (Epi::NEEDS_RS) {
        LAS float* rst = (LAS float*)(lds + STAGE_BYTES);
        const GAS float* rsc = rowsc_of(E, 0); const float tsc = tsc_of(E, 0);
        for (int q = tid; q < 16 * 256; q += 512) { const int i = q >> 8, r = q & 255, pm = utab[2 * i];
            if (pm >= 0) { const GAS f32x4* p = (const GAS f32x4*)(E.ssq + (size_t)(pm * 256 + r) * 16); const f32x4 a0 = p[0], a1 = p[1], a2 = p[2], a3 = p[3];
                const float xs = (rsc ? rsc[pm * 256 + r] : 1.0f) * tsc;
                rst[q] = xs * rsqrtf((((a0.x + a0.y) + (a0.z + a0.w)) + ((a1.x + a1.y) + (a1.z + a1.w)) + ((a2.x + a2.y) + (a2.z + a2.w)) + ((a3.x + a3.y) + (a3.z + a3.w))) * (1.0f / D) + RMS_EPS); } }
        if constexpr (Epi::NEEDS_RH) {
            LAS float* rht = (LAS float*)(lds + STAGE_BYTES + 16384);
            for (int q = tid; q < 8 * 256; q += 512) { const int i = q >> 8, r = q & 255, pm = utab[2 * i], hh = utab[2 * i + 1] >> 1;
                if (pm >= 0) { const GAS f32x4* p = (const GAS f32x4*)(E.hss + ((size_t)(pm * 256 + r) * RH + hh) * 16); const f32x4 a0 = p[0], a1 = p[1], a2 = p[2], a3 = p[3];
                    rht[q] = rsqrtf((((a0.x + a0.y) + (a0.z + a0.w)) + ((a1.x + a1.y) + (a1.z + a1.w)) + ((a2.x + a2.y) + (a2.z + a2.w)) + ((a3.x + a3.y) + (a3.z + a3.w))) * (1.0f / RV) + RMS_EPS); } }
        }
        __syncthreads();
    }
    f32x4 acc[2][2][4][2];
#define PG8_ZERO_ACC do { bf16x8 z_ = (bf16x8){0, 0, 0, 0, 0, 0, 0, 0}; asm volatile("" : "+v"(z_)); \
        _Pragma("unroll") for (int a = 0; a < 2; ++a) _Pragma("unroll") for (int b = 0; b < 2; ++b) _Pragma("unroll") for (int m = 0; m < 4; ++m) _Pragma("unroll") for (int n = 0; n < 2; ++n) \
            acc[a][b][m][n] = __builtin_amdgcn_mfma_f32_16x16x32_bf16(z_, z_, (f32x4){0.f, 0.f, 0.f, 0.f}, 0, 0, 0); } while (0)
    PG8_ZERO_ACC;
    bf16x8 At[4][2], B0[2][2], B1[2][2];
    if constexpr (SP2) {
        if (wr == 1) PG8_BAR;
        PG8_WAIT_V(2); PG8_BAR;
        PG8_STAGE(PG8_SB(1, 0), cB + kstep, voffA); PG8_STAGE(PG8_SA(1, 0), cA + kstep, voffA); PG8_STAGE(PG8_SB(1, 1), cB + hstep + kstep, voffA);
        PG8_WAIT_V(6); PG8_BAR;
    } else {
        PG8_STAGE(PG8_SB(0, 0), cB, voffA); PG8_STAGE(PG8_SA(0, 0), cA, voffA); PG8_STAGE(PG8_SB(0, 1), cB + hstep, voffA); PG8_STAGE(PG8_SA(0, 1), cA + hstep, voffA);
        if (wr == 1) PG8_BAR;
        PG8_WAIT_V(4); PG8_BAR;
        PG8_STAGE(PG8_SB(1, 0), cB + kstep, voffA); PG8_STAGE(PG8_SA(1, 0), cA + kstep, voffA); PG8_STAGE(PG8_SB(1, 1), cB + hstep + kstep, voffA);
        PG8_WAIT_V(6); PG8_BAR;
    }
    for (;;) {
        const bool has_next = PG8_NEXT(ui + 1, nxt);
        const char* nA = has_next ? (const char*)g.A + (size_t)nxt.pm * tstep : cA; const char* nB = has_next ? (const char*)g.Bt + (size_t)nxt.pn * tstep : cB;
        __builtin_amdgcn_s_waitcnt(0xC07F);
        for (int t = 0; t < nt; t += 2) {
            const bool last = (t == nt - 2);
            const char* a1 = cA + (size_t)(t + 1) * kstep;
            const char* a2 = last ? nA : cA + (size_t)(t + 2) * kstep; const char* b2 = last ? nB : cB + (size_t)(t + 2) * kstep;
            const char* a3 = a2 + kstep; const char* b3 = b2 + kstep;
            if constexpr (SP2) {
            PG8_LDB(B0, 0, 0); PG8_LDB(B1, 0, 1); PG8_SCHED; PG8_LDA(At, 0, 0); PG8_STAGE(PG8_SA(1, 1), a1 + hstep, voffA);
            PG8_WAIT_V(8); PG8_WAIT_L(0); PG8_BAR; PG8_MMA(0, 0, At, B0); PG8_MMA(0, 1, At, B1); PG8_BAR; PG8_SCHED;
            PG8_LDA(At, 0, 1); PG8_STAGE(PG8_SB(0, 0), b2, voffA); PG8_STAGE(PG8_SB(0, 1), b2 + hstep, voffA); PG8_STAGE(PG8_SA(0, 0), a2, voffA);
            PG8_WAIT_V(8); PG8_WAIT_L(0); PG8_BAR; PG8_MMA(1, 0, At, B0); PG8_MMA(1, 1, At, B1); PG8_BAR; PG8_SCHED;
            PG8_LDB(B0, 1, 0); PG8_LDB(B1, 1, 1); PG8_SCHED; PG8_LDA(At, 1, 0); PG8_STAGE(PG8_SA(0, 1), a2 + hstep, voffA);
            PG8_WAIT_V(8); PG8_WAIT_L(0); PG8_BAR; PG8_MMA(0, 0, At, B0); PG8_MMA(0, 1, At, B1); PG8_BAR; PG8_SCHED;
            PG8_LDA(At, 1, 1); PG8_STAGE(PG8_SB(1, 0), b3, voffA); PG8_STAGE(PG8_SB(1, 1), b3 + hstep, voffA); PG8_STAGE(PG8_SA(1, 0), a3, voffA);
            PG8_WAIT_V(8); PG8_WAIT_L(0); PG8_BAR; PG8_MMA(1, 0, At, B0); PG8_MMA(1, 1, At, B1); PG8_BAR; PG8_SCHED;
            } else {
            PG8_LDB(B0, 0, 0); PG8_SCHED; PG8_LDA(At, 0, 0); PG8_STAGE(PG8_SA(1, 1), a1 + hstep, voffA);
            PG8_WAIT_L(8); PG8_BAR; PG8_WAIT_L(0); PG8_MMA(0, 0, At, B0); PG8_BAR; PG8_SCHED;
            PG8_LDB(B1, 0, 1); PG8_STAGE(PG8_SB(0, 0), b2, voffA);
            PG8_BAR; PG8_WAIT_L(0); PG8_MMA(0, 1, At, B1); PG8_BAR;
            PG8_LDA(At, 0, 1); PG8_STAGE(PG8_SA(0, 0), a2, voffA);
            PG8_BAR; PG8_WAIT_L(0); PG8_MMA(1, 0, At, B0); PG8_BAR; PG8_SCHED;
            PG8_STAGE(PG8_SB(0, 1), b2 + hstep, voffA);
            PG8_WAIT_V(6); PG8_BAR; PG8_MMA(1, 1, At, B1); PG8_BAR;
            PG8_LDB(B0, 1, 0); PG8_SCHED; PG8_LDA(At, 1, 0); PG8_STAGE(PG8_SA(0, 1), a2 + hstep, voffA);
            PG8_WAIT_L(8); PG8_BAR; PG8_WAIT_L(0); PG8_MMA(0, 0, At, B0); PG8_BAR; PG8_SCHED;
            PG8_LDB(B1, 1, 1); PG8_STAGE(PG8_SB(1, 0), b3, voffA);
            PG8_BAR; PG8_WAIT_L(0); PG8_MMA(0, 1, At, B1); PG8_BAR;
            PG8_LDA(At, 1, 1); PG8_STAGE(PG8_SA(1, 0), a3, voffA);
            PG8_BAR; PG8_WAIT_L(0); PG8_MMA(1, 0, At, B0); PG8_BAR; PG8_SCHED;
            PG8_STAGE(PG8_SB(1, 1), b3 + hstep, voffA);
            PG8_WAIT_V(6); PG8_BAR; PG8_MMA(1, 1, At, B1); PG8_BAR;
            }
        }
        if constexpr (ALIGN_EPI) { if (wr == 0) PG8_BAR; }
        if constexpr (F8) asm volatile("s_nop 15\n\ts_nop 7" ::: "memory");
        if constexpr (CVT) {
#pragma unroll
            for (int a = 0; a < 2; ++a)
#pragma unroll
                for (int b = 0; b < 2; ++b)
#pragma unroll
                    for (int m = 0; m < 4; ++m)
#pragma unroll
                        for (int n = 0; n < 2; ++n) acc[a][b][m][n] = __builtin_convertvector(__builtin_bit_cast(i32x4, acc[a][b][m][n]), f32x4);
        }
        { int efr = fr, efq = fq; asm volatile("" : "+v"(efr), "+v"(efq));
          E(acc, cur, wr, wc, efr, efq, (const LAS float*)(lds + STAGE_BYTES) + ui * 256 + wr * 64 + efr); }
        if (!has_next) break;
        PG8_ZERO_ACC;
        cur = nxt; cA = nA; cB = nB; ++ui;
        if constexpr (ALIGN_EPI) { if (wr == 1) PG8_BAR; }
    }
    PG8_WAIT_V(0);
    if constexpr (!ALIGN_EPI) { if (wr == 0) PG8_BAR; }
    PG8_BAR;
#undef PG8_NEXT
#undef PG8_SA
#undef PG8_SB
#undef PG8_STAGE
#undef PG8_LDA
#undef PG8_LDB
#undef PG8_MMA
#undef PG8_CAT8
#undef PG8_ZERO_ACC
#undef PG8_WAIT_V
#undef PG8_WAIT_L
#undef PG8_BAR
#undef PG8_SCHED
}
}

typedef f32x4 Acc[2][2][4][2];
__device__ __forceinline__ u32x4 pack8(const f32x4 a, const f32x4 b) { u32x4 w; w.x = pk2(a.x, a.y); w.y = pk2(a.z, a.w); w.z = pk2(b.x, b.y); w.w = pk2(b.z, b.w); return w; }
__device__ __forceinline__ void row_scales(const GAS float* part, size_t stride, int row0, int fq, float inv_n, float eps, float (&sc)[8]) {
    f32x4 v[8];
#pragma unroll
    for (int k = 0; k < 8; ++k) v[k] = *(const GAS f32x4*)(part + (size_t)(row0 + (k >> 2) * 128 + (k & 3) * 16) * stride + 4 * fq);
#pragma unroll
    for (int k = 0; k < 8; ++k) { float t = (v[k].x + v[k].y) + (v[k].z + v[k].w); t += __shfl_xor(t, 16); t += __shfl_xor(t, 32); sc[k] = rsqrtf(t * inv_n + eps); }
}

struct EpiConvIn {
    static constexpr bool NEEDS_RS = true, NEEDS_RH = false;
    const GAS float* ssq; GAS bf16_t* Bo; GAS bf16_t* CZ; const GAS float* rowsc; float tsc;
    __device__ __forceinline__ void operator()(const Acc& acc, const pg8::Unit& u, int wr, int wc, int fr, int fq, const LAS float* rst) const {
        const int row0 = u.pm * 256 + wr * 64 + fr;
        float rs[8];
#pragma unroll
        for (int k = 0; k < 8; ++k) rs[k] = rst[(k >> 2) * 128 + (k & 3) * 16];
#pragma unroll
        for (int ai = 0; ai < 2; ++ai)
#pragma unroll
            for (int m = 0; m < 4; ++m) {
                const int row = row0 + ai * 128 + m * 16; const float r1 = rs[4 * ai + m];
                if (u.pn < 4) {
#pragma unroll
                    for (int bj = 0; bj < 2; ++bj)
                        *(GAS u32x4*)(Bo + (size_t)row * D + u.pn * 256 + bj * 128 + wc * 32 + fq * 8) = pack8(acc[ai][bj][m][0] * r1, acc[ai][bj][m][1] * r1);
                } else {
                    const float r2 = r1 * r1;
                    const f32x4 p0 = acc[ai][0][m][0] * acc[ai][0][m][1] * r2, p1 = acc[ai][1][m][0] * acc[ai][1][m][1] * r2;
                    *(GAS u32x4*)(CZ + (size_t)row * D + (u.pn - 4) * 128 + wc * 32 + fq * 8) = pack8(p0, p1);
                }
            }
    }
};
struct EpiFfnIn {
    static constexpr bool NEEDS_RS = true, NEEDS_RH = false;
    const GAS float* ssq; GAS unsigned char* ACT; bool f8; float isc; const GAS float* rowsc; bool i8;
    __device__ __forceinline__ void operator()(const Acc& acc, const pg8::Unit& u, int wr, int wc, int fr, int fq, const LAS float* rst) const {
        const int row0 = u.pm * 256 + wr * 64 + fr;
        float rs[8];
#pragma unroll
        for (int k = 0; k < 8; ++k) rs[k] = rst[(k >> 2) * 128 + (k & 3) * 16];
#pragma unroll
        for (int ai = 0; ai < 2; ++ai)
#pragma unroll
            for (int m = 0; m < 4; ++m) {
                const int row = row0 + ai * 128 + m * 16; const float r1 = rs[4 * ai + m] * isc;
                const float c1 = -1.44269504089f * r1, r2 = r1 * r1;
                f32x2 g[4], p[4], e[4];
#pragma unroll
                for (int bj = 0; bj < 2; ++bj) { f32x4 gt = acc[ai][bj][m][0], up = acc[ai][bj][m][1];
                    if (i8) { gt = __builtin_convertvector(__builtin_bit_cast(i32x4, gt), f32x4); up = __builtin_convertvector(__builtin_bit_cast(i32x4, up), f32x4); }
                    g[2 * bj] = (f32x2){gt.x, gt.y}; g[2 * bj + 1] = (f32x2){gt.z, gt.w};
                    p[2 * bj] = (f32x2){gt.x, gt.y} * (f32x2){up.x, up.y}; p[2 * bj + 1] = (f32x2){gt.z, gt.w} * (f32x2){up.z, up.w}; }
#pragma unroll
                for (int k = 0; k < 4; ++k) { const f32x2 t = g[k] * c1; e[k].x = __builtin_amdgcn_exp2f(t.x); e[k].y = __builtin_amdgcn_exp2f(t.y); }
#pragma unroll
                for (int k = 0; k < 4; ++k) { const f32x2 d = e[k] + 1.0f; e[k].x = __builtin_amdgcn_rcpf(d.x); e[k].y = __builtin_amdgcn_rcpf(d.y); }
#pragma unroll
                for (int k = 0; k < 4; ++k) p[k] = (p[k] * r2) * e[k];
                const size_t eoff = (size_t)row * DFF + u.pn * 128 + wc * 32 + fq * 8;
                if (f8) {
                    u32x2 w;
                    w.x = (unsigned)__builtin_amdgcn_cvt_pk_fp8_f32(p[1].x, p[1].y, __builtin_amdgcn_cvt_pk_fp8_f32(p[0].x, p[0].y, 0, false), true);
                    w.y = (unsigned)__builtin_amdgcn_cvt_pk_fp8_f32(p[3].x, p[3].y, __builtin_amdgcn_cvt_pk_fp8_f32(p[2].x, p[2].y, 0, false), true);
                    __builtin_nontemporal_store(w, (GAS u32x2*)(ACT + eoff));
                } else {
                    u32x4 w; w.x = pk2(p[0].x, p[0].y); w.y = pk2(p[1].x, p[1].y); w.z = pk2(p[2].x, p[2].y); w.w = pk2(p[3].x, p[3].y);
                    __builtin_nontemporal_store(w, (GAS u32x4*)(ACT + 2 * eoff));
                }
            }
    }
};
__device__ __forceinline__ f32x2 gelu_pk(f32x2 v) {
    const f32x2 av = __builtin_elementwise_abs(v), d = av * 0.2316418882f + 1.0f;
    f32x2 t; t.x = __builtin_amdgcn_rcpf(d.x); t.y = __builtin_amdgcn_rcpf(d.y);
    f32x2 q = t * 0.5307027145f + (-0.7265760135f); q = q * t + 0.7107068705f; q = q * t + (-0.142248368f); q = q * t + 0.127414796f; q = q * t;
    const f32x2 s = (v * v) * (-0.72134752044f);
    f32x2 e; e.x = __builtin_amdgcn_exp2f(s.x); e.y = __builtin_amdgcn_exp2f(s.y);
    return v * 0.5f + av * (0.5f - q * e);
}
__device__ __forceinline__ f32x4 gelu4(f32x4 v) { const f32x2 a = gelu_pk((f32x2){v.x, v.y}), b = gelu_pk((f32x2){v.z, v.w}); return (f32x4){a.x, a.y, b.x, b.y}; }
struct EpiSguIn {
    static constexpr bool NEEDS_RS = true, NEEDS_RH = false;
    const GAS float* ssq; GAS bf16_t* U; GAS bf16_t* V; GAS float* lnp; const GAS float* rowsc; float tsc;
    __device__ __forceinline__ void operator()(const Acc& acc, const pg8::Unit& u, int wr, int wc, int fr, int fq, const LAS float* rst) const {
        const int row0 = u.pm * 256 + wr * 64 + fr;
        const bool isv = u.pn >= 8;
        GAS bf16_t* dst = isv ? V + (u.pn - 8) * 256 : U + u.pn * 256;
        float rs[8];
#pragma unroll
        for (int k = 0; k < 8; ++k) rs[k] = rst[(k >> 2) * 128 + (k & 3) * 16];
#pragma unroll
        for (int ai = 0; ai < 2; ++ai)
#pragma unroll
            for (int m = 0; m < 4; ++m) {
                const int row = row0 + ai * 128 + m * 16; const float r1 = rs[4 * ai + m];
                float s1 = 0.f, s2 = 0.f;
#pragma unroll
                for (int bj = 0; bj < 2; ++bj) {
                    const f32x4 a = gelu4(acc[ai][bj][m][0] * r1), b = gelu4(acc[ai][bj][m][1] * r1);
                    *(GAS u32x4*)(dst + (size_t)row * 2048 + bj * 128 + wc * 32 + fq * 8) = pack8(a, b);
                    s1 += (a.x + a.y) + (a.z + a.w) + (b.x + b.y) + (b.z + b.w);
                    s2 += (a.x * a.x + a.y * a.y) + (a.z * a.z + a.w * a.w) + (b.x * b.x + b.y * b.y) + (b.z * b.z + b.w * b.w);
                }
                if (isv) {
                    s1 += __shfl_xor(s1, 16); s1 += __shfl_xor(s1, 32); s2 += __shfl_xor(s2, 16); s2 += __shfl_xor(s2, 32);
                    if (fq == 0) *(GAS f32x2*)(lnp + ((size_t)row * 32 + (u.pn - 8) * 4 + wc) * 2) = (f32x2){s1, s2};
                }
            }
    }
};
struct EpiRetQkv {
    static constexpr bool NEEDS_RS = true, NEEDS_RH = false;
    const GAS float* ssq; const GAS float* rcos; const GAS float* rsin; GAS bf16_t* Q; GAS bf16_t* Kn; GAS bf16_t* V; const GAS float* rowsc; float tsc;
    __device__ __forceinline__ void operator()(const Acc& acc, const pg8::Unit& u, int wr, int wc, int fr, int fq, const LAS float* rst) const {
        const int row0 = u.pm * 256 + wr * 64 + fr;
        const int i0 = wc * 32 + fq * 8;
        const bool isk = u.pn >= 4; const int h = u.pn & 3;
        const float l2g = __builtin_amdgcn_logf(1.0f - __builtin_amdgcn_exp2f(-5.0f - (float)h));
        float rs[8];
#pragma unroll
        for (int k = 0; k < 8; ++k) rs[k] = rst[(k >> 2) * 128 + (k & 3) * 16];
        if (u.pn >= 8) {
#pragma unroll
            for (int ai = 0; ai < 2; ++ai)
#pragma unroll
                for (int m = 0; m < 4; ++m) { const int row = row0 + ai * 128 + m * 16; const float r1 = rs[4 * ai + m];
#pragma unroll
                    for (int bj = 0; bj < 2; ++bj)
                        *(GAS u32x4*)(V + (size_t)row * 2048 + (u.pn - 8) * 256 + bj * 128 + i0) = pack8(acc[ai][bj][m][0] * r1, acc[ai][bj][m][1] * r1); }
        } else {
#pragma unroll
            for (int hp = 0; hp < 4; ++hp) {
                const int ai = hp >> 1;
                f32x4 cs[2][2], sn[2][2];
#pragma unroll
                for (int mm = 0; mm < 2; ++mm) { const int pos = (row0 + ai * 128 + (2 * (hp & 1) + mm) * 16) & (SEQ - 1);
#pragma unroll
                    for (int bj = 0; bj < 2; ++bj) { cs[mm][bj] = *(const GAS f32x4*)(rcos + (size_t)pos * 128 + i0 + 4 * bj); sn[mm][bj] = *(const GAS f32x4*)(rsin + (size_t)pos * 128 + i0 + 4 * bj); } }
#pragma unroll
                for (int mm = 0; mm < 2; ++mm) {
                    const int m = 2 * (hp & 1) + mm;
                    const int row = row0 + ai * 128 + m * 16, pos = row & (SEQ - 1); const float r1 = rs[4 * ai + m];
                    const float sc = isk ? r1 * 0.0625f * __builtin_amdgcn_exp2f(l2g * (float)(127 - (pos & 127))) : r1;
                    f32x4 o1[2], o2[2];
#pragma unroll
                    for (int bj = 0; bj < 2; ++bj) { const f32x4 x1 = acc[ai][bj][m][0] * sc, x2 = acc[ai][bj][m][1] * sc;
                        o1[bj] = x1 * cs[mm][bj] - x2 * sn[mm][bj]; o2[bj] = x2 * cs[mm][bj] + x1 * sn[mm][bj]; }
                    GAS bf16_t* dst = (isk ? Kn : Q) + (size_t)row * D + h * 256 + i0;
                    *(GAS u32x4*)dst = pack8(o1[0], o1[1]); *(GAS u32x4*)(dst + 128) = pack8(o2[0], o2[1]);
                }
            }
        }
    }
};
struct EpiRetG {
    static constexpr bool NEEDS_RS = true, NEEDS_RH = true;
    const GAS float* ssq; const GAS float* hss; GAS bf16_t* Y; const GAS float* rowsc; float tsc;
    __device__ __forceinline__ void operator()(const Acc& acc, const pg8::Unit& u, int wr, int wc, int fr, int fq, const LAS float* rst) const {
        const int row0 = u.pm * 256 + wr * 64 + fr; const int h = u.pn >> 1;
        float rs[8], rh[8];
#pragma unroll
        for (int k = 0; k < 8; ++k) { rs[k] = rst[(k >> 2) * 128 + (k & 3) * 16]; rh[k] = rst[4096 + (k >> 2) * 128 + (k & 3) * 16]; }
#pragma unroll
        for (int ai = 0; ai < 2; ++ai) {
            u32x4 ov[4][2];
#pragma unroll
            for (int m = 0; m < 4; ++m)
#pragma unroll
                for (int bj = 0; bj < 2; ++bj) ov[m][bj] = *(const GAS u32x4*)(Y + (size_t)(row0 + ai * 128 + m * 16) * 2048 + u.pn * 256 + bj * 128 + wc * 32 + fq * 8);
#pragma unroll
            for (int m = 0; m < 4; ++m) {
                const int row = row0 + ai * 128 + m * 16; const float r1 = rs[4 * ai + m], r3 = rh[4 * ai + m];
#pragma unroll
                for (int bj = 0; bj < 2; ++bj) {
                    GAS bf16_t* p = Y + (size_t)row * 2048 + u.pn * 256 + bj * 128 + wc * 32 + fq * 8;
                    const u32x4 o = ov[m][bj];
                    const f32x4 g0 = acc[ai][bj][m][0] * r1, g1 = acc[ai][bj][m][1] * r1;
                    const f32x4 a = (f32x4){silu_f(g0.x) * bf_lo(o.x), silu_f(g0.y) * bf_hi(o.x), silu_f(g0.z) * bf_lo(o.y), silu_f(g0.w) * bf_hi(o.y)} * r3;
                    const f32x4 b = (f32x4){silu_f(g1.x) * bf_lo(o.z), silu_f(g1.y) * bf_hi(o.z), silu_f(g1.z) * bf_lo(o.w), silu_f(g1.w) * bf_hi(o.w)} * r3;
                    *(GAS u32x4*)p = pack8(a, b);
                }
            }
        }
    }
};
template <int MB = 4> struct EpiResidT {
    static constexpr bool NEEDS_RS = false, NEEDS_RH = false;
    GAS bf16_t* xb; GAS float* ssq; float osc; GAS unsigned char* x8;
    __device__ __forceinline__ void operator()(const Acc& acc, const pg8::Unit& u, int wr, int wc, int fr, int fq, const LAS float* rst) const {
        const int row0 = u.pm * 256 + wr * 64 + fr, col0 = u.pn * 256 + wc * 32 + fq * 8;
#pragma unroll
        for (int ai = 0; ai < 2; ++ai)
#pragma unroll
        for (int mh = 0; mh < 4; mh += MB) {
            u32x4 bv[4][2];
#pragma unroll
            for (int m = mh; m < mh + MB; ++m)
#pragma unroll
                for (int bj = 0; bj < 2; ++bj) bv[m][bj] = *(const GAS u32x4*)(xb + (size_t)(row0 + ai * 128 + m * 16) * D + col0 + bj * 128);
#pragma unroll
            for (int m = mh; m < mh + MB; ++m) {
                const int row = row0 + ai * 128 + m * 16;
                GAS bf16_t* p = xb + (size_t)row * D + col0;
                float s2 = 0.f;
#pragma unroll
                for (int bj = 0; bj < 2; ++bj) {
                    const u32x4 b = bv[m][bj];
                    const f32x4 x0 = (f32x4){bf_lo(b.x), bf_hi(b.x), bf_lo(b.y), bf_hi(b.y)} + acc[ai][bj][m][0] * osc;
                    const f32x4 x1 = (f32x4){bf_lo(b.z), bf_hi(b.z), bf_lo(b.w), bf_hi(b.w)} + acc[ai][bj][m][1] * osc;
                    *(GAS u32x4*)(p + bj * 128) = pack8(x0, x1);
                    if (x8) { u32x2 w8;
                        w8.x = (unsigned)__builtin_amdgcn_cvt_pk_fp8_f32(x0.z, x0.w, __builtin_amdgcn_cvt_pk_fp8_f32(x0.x, x0.y, 0, false), true);
                        w8.y = (unsigned)__builtin_amdgcn_cvt_pk_fp8_f32(x1.z, x1.w, __builtin_amdgcn_cvt_pk_fp8_f32(x1.x, x1.y, 0, false), true);
                        *(GAS u32x2*)(x8 + (size_t)row * D + col0 + bj * 128) = w8; }
                    s2 += (x0.x * x0.x + x0.y * x0.y) + (x0.z * x0.z + x0.w * x0.w) + (x1.x * x1.x + x1.y * x1.y) + (x1.z * x1.z + x1.w * x1.w);
                }
                s2 += __shfl_xor(s2, 16); s2 += __shfl_xor(s2, 32);
                if (fq == 0) ssq[(size_t)row * 16 + u.pn * 4 + wc] = s2;
            }
        }
    }
};
typedef EpiResidT<4> EpiResid;

struct Args { const float* in[18]; float* out; unsigned char* ws; int ph_lo, ph_hi, li, pad; };

struct Frame {
    LAS unsigned char* lds;
    int tid, lane, wave, vcu, G;
};

enum { MAP_NAT = 0, MAP_P8 = 1, MAP_CONV = 2, MAP_RETQKV = 3, MAP_FFN = 4 };
struct PrepJob { const GAS float* src; const GAS float* src2; const GAS float* gain; GAS bf16_t* dst; int ld, N, K, map; float f8scale, i8scale; };
__device__ __forceinline__ void prep_item(const PrepJob& J, int item, LAS float* scr, int lane) {
    const int nb = J.N / 64, kb = item / nb, r = item % nb, pn = r >> 2, wc = r & 3;
    const int k0 = kb * 64;
    const int sl = 128 * (lane >> 5) + 32 * wc + (lane & 31);
    const int slot = 256 * pn + sl;
    const GAS float* src = J.src; int col;
    {
        const int bj = sl >> 7, n = (sl >> 4) & 1, fq = (sl >> 2) & 3, j = sl & 3, ch = 32 * wc + 8 * fq + 4 * bj + j;
        const int p8 = (slot & ~31) + pg8::perm32(slot & 31);
        if (J.map == MAP_NAT) col = slot;
        else if (J.map == MAP_P8) col = p8;
        else if (J.map == MAP_CONV) col = (pn < 4) ? p8 : (1024 + 1024 * n + 128 * (pn - 4) + ch);
        else if (J.map == MAP_RETQKV) col = (pn < 8) ? (256 * pn + 128 * n + ch) : p8;
        else { col = 128 * pn + ch; if (n) src = J.src2; }
    }
    const GAS float* sp = src + (size_t)k0 * J.ld + col;
#pragma unroll
    for (int hk = 0; hk < 2; ++hk) {
        float wv[32];
#pragma unroll
        for (int k = 0; k < 32; ++k) wv[k] = sp[(size_t)(32 * hk + k) * J.ld];
#pragma unroll
        for (int k = 0; k < 32; ++k) scr[(32 * hk + k) * 65 + lane] = wv[k];
    }
    asm volatile("s_waitcnt lgkmcnt(0)" ::: "memory");
    const int c = lane & 7;
    float gn[8];
#pragma unroll
    for (int e = 0; e < 8; ++e) gn[e] = J.gain ? J.gain[k0 + 8 * c + e] : 1.0f;
#pragma unroll
    for (int it = 0; it < 8; ++it) {
        const int l2 = it * 8 + (lane >> 3);
        const int slot2 = 256 * pn + 128 * (l2 >> 5) + 32 * wc + (l2 & 31);
        const LAS float* s = scr + (8 * c) * 65 + l2;
        if (J.i8scale != 0.f) {
            const float f = J.i8scale; unsigned b8[8];
#pragma unroll
            for (int e = 0; e < 8; ++e) b8[e] = (unsigned)(int)fminf(fmaxf(rintf(s[e * 65] * gn[e] * f), -127.f), 127.f) & 255u;
            u32x2 o8; o8.x = b8[0] | (b8[1] << 8) | (b8[2] << 16) | (b8[3] << 24); o8.y = b8[4] | (b8[5] << 8) | (b8[6] << 16) | (b8[7] << 24);
            *(GAS u32x2*)((GAS unsigned char*)J.dst + (size_t)slot2 * J.K + k0 + 8 * c) = o8;
        } else if (J.f8scale != 0.f) {
            const float f = J.f8scale; u32x2 o8;
            o8.x = (unsigned)__builtin_amdgcn_cvt_pk_fp8_f32(s[2 * 65] * gn[2] * f, s[3 * 65] * gn[3] * f, __builtin_amdgcn_cvt_pk_fp8_f32(s[0] * gn[0] * f, s[65] * gn[1] * f, 0, false), true);
            o8.y = (unsigned)__builtin_amdgcn_cvt_pk_fp8_f32(s[6 * 65] * gn[6] * f, s[7 * 65] * gn[7] * f, __builtin_amdgcn_cvt_pk_fp8_f32(s[4 * 65] * gn[4] * f, s[5 * 65] * gn[5] * f, 0, false), true);
            *(GAS u32x2*)((GAS unsigned char*)J.dst + (size_t)slot2 * J.K + k0 + 8 * c) = o8;
        } else {
        u32x4 o; o.x = pk2(s[0] * gn[0], s[65] * gn[1]); o.y = pk2(s[2 * 65] * gn[2], s[3 * 65] * gn[3]); o.z = pk2(s[4 * 65] * gn[4], s[5 * 65] * gn[5]); o.w = pk2(s[6 * 65] * gn[6], s[7 * 65] * gn[7]);
        *(GAS u32x4*)(J.dst + (size_t)slot2 * J.K + k0 + 8 * c) = o;
        }
    }
    asm volatile("s_waitcnt lgkmcnt(0)" ::: "memory");
}
__device__ __forceinline__ void p0_wabs(const Frame& F, const Args& a) {
    const int tid_ = opq_tid(), lane_ = tid_ & 63, wave_ = __builtin_amdgcn_readfirstlane(tid_ >> 6);
    const int gw = F.vcu * 8 + wave_, NGW = F.G * 8;
#pragma unroll 1
    for (int L = 0; L < NLAYER; ++L) {
        if (!((I8_F1_LAYERS >> L) & 1)) continue;
        float sq = 0.f;
        for (int rr = gw; rr < 2 * 1024; rr += NGW) {
            const int k = rr & 1023; const GAS float* src = (const GAS float*)((rr < 1024 ? a.in[15] : a.in[16]) + ((size_t)L * 1024 + k) * DFF);
            const float gk = ((const GAS float*)a.in[2])[L * D + k];
            float m = 0.f;
#pragma unroll
            for (int j = 0; j < 11; ++j) { const f32x4 v = ((const GAS f32x4*)src)[lane_ + 64 * j]; m += (v.x * v.x + v.y * v.y) + (v.z * v.z + v.w * v.w); }
            sq += m * (gk * gk);
        }
        sq = wave_sum(sq);
        if (lane_ == 0 && gw < 2048) ((GAS float*)(a.ws + WS_CTL))[CTL_WSS + 2048 * L + gw] = sq;
    }
    if (I8_CONV3) {
        float sq0 = 0.f;
        for (int k = gw; k < 1024; k += NGW) {
            const GAS f32x4* src = (const GAS f32x4*)(a.in[4] + ((size_t)1024 + k) * 3072);
            const float gk = ((const GAS float*)a.in[1])[3 * D + k];
            float m0 = 0.f;
#pragma unroll
            for (int j = 0; j < 12; ++j) { const f32x4 v = src[lane_ + 64 * j]; m0 += (v.x * v.x + v.y * v.y) + (v.z * v.z + v.w * v.w); }
            sq0 += m0 * (gk * gk);
        }
        sq0 = wave_sum(sq0);
        if (lane_ == 0 && gw < 2048) ((GAS float*)(a.ws + WS_CTL))[CTL_WSS + 2048 * 7 + gw] = sq0;
    }
    if (I8_SGU) {
        float sq0 = 0.f;
        for (int k = gw; k < 1024; k += NGW) {
            const GAS f32x4* src = (const GAS f32x4*)(a.in[7] + (size_t)k * 4096);
            const float gk = ((const GAS float*)a.in[1])[1 * D + k];
            float m0 = 0.f;
#pragma unroll
            for (int j = 0; j < 16; ++j) { const f32x4 v = src[lane_ + 64 * j]; m0 += (v.x * v.x + v.y * v.y) + (v.z * v.z + v.w * v.w); }
            sq0 += m0 * (gk * gk);
        }
        sq0 = wave_sum(sq0);
        if (lane_ == 0 && gw < 2048) ((GAS float*)(a.ws + WS_CTL))[CTL_WSS + 2048 * 6 + gw] = sq0;
    }
    if (I8_RET) {
        float sq0 = 0.f, sq1 = 0.f;
        for (int k = gw; k < 1024; k += NGW) {
            const GAS f32x4* src = (const GAS f32x4*)(a.in[13] + (size_t)k * 6144);
            const float gk = ((const GAS float*)a.in[1])[2 * D + k];
            float m0 = 0.f, m1 = 0.f;
#pragma unroll
            for (int j = 0; j < 16; ++j) { const f32x4 v = src[lane_ + 64 * j]; m0 += (v.x * v.x + v.y * v.y) + (v.z * v.z + v.w * v.w); }
#pragma unroll
            for (int j = 16; j < 24; ++j) { const f32x4 v = src[lane_ + 64 * j]; m1 += (v.x * v.x + v.y * v.y) + (v.z * v.z + v.w * v.w); }
            sq0 += m0 * (gk * gk); sq1 += m1 * (gk * gk);
        }
        sq0 = wave_sum(sq0); sq1 = wave_sum(sq1);
        if (lane_ == 0 && gw < 2048) { ((GAS float*)(a.ws + WS_CTL))[CTL_WSS + 2048 * 4 + gw] = sq0; ((GAS float*)(a.ws + WS_CTL))[CTL_WSS + 2048 * 5 + gw] = sq1; }
    }
}
__device__ __forceinline__ float i8_wfull(const unsigned char* ws, int L, int lane, float inv_count = 1.0f / (2.0f * 1024.0f * DFF)) {
    const GAS float* p = (const GAS float*)(ws + WS_CTL) + CTL_WSS + 2048 * L;
    float t = 0.f;
#pragma unroll 4
    for (int j = 0; j < 32; ++j) t += p[lane + 64 * j];
    t = wave_sum(t);
    return fmaxf(WCLIP * sqrtf(t * inv_count), 1e-30f);
}
__device__ __forceinline__ void quant_phase(const Frame& F, const GAS bf16_t* xb, GAS unsigned char* x8, GAS float* sa) {
    const int tid_ = opq_tid(), lane_ = tid_ & 63, wave_ = __builtin_amdgcn_readfirstlane(tid_ >> 6);
    const int gw = F.vcu * 8 + wave_, NGW = F.G * 8;
    for (int row = 4 * gw; row < M; row += 4 * NGW) {
        u32x4 v[4][2];
#pragma unroll
        for (int r = 0; r < 4; ++r) { const GAS u32x4* p = (const GAS u32x4*)(xb + (size_t)(row + r) * D) + 2 * lane_; v[r][0] = p[0]; v[r][1] = p[1]; }
#pragma unroll
        for (int r = 0; r < 4; ++r) {
            float x[16];
#pragma unroll
            for (int h = 0; h < 2; ++h)
#pragma unroll
                for (int e = 0; e < 4; ++e) { x[8 * h + 2 * e] = bf_lo(v[r][h][e]); x[8 * h + 2 * e + 1] = bf_hi(v[r][h][e]); }
            float m = 0.f;
#pragma unroll
            for (int e = 0; e < 16; ++e) m = fmaxf(m, fabsf(x[e]));
            m = fmaxf(wave_max(m), 1e-30f);
            const float qs = 127.0f / m;
            unsigned w[4];
#pragma unroll
            for (int d = 0; d < 4; ++d) { unsigned t = 0u;
#pragma unroll
                for (int e = 0; e < 4; ++e) t |= ((unsigned)(int)rintf(x[4 * d + e] * qs) & 255u) << (8 * e);
                w[d] = t; }
            *((GAS u32x4*)(x8 + (size_t)(row + r) * D) + lane_) = (u32x4){w[0], w[1], w[2], w[3]};
            if (lane_ == 0) sa[row + r] = m * (1.0f / 127.0f);
        }
    }
}
__device__ __forceinline__ void p0_prologue(const Frame& F, const Args& a) {
    unsigned char* ws = a.ws;
    const int tid_ = opq_tid(), lane_ = tid_ & 63, wave_ = __builtin_amdgcn_readfirstlane(tid_ >> 6);
    LAS float* scr = (LAS float*)(F.lds + wave_ * 16640);
    const int gw = F.vcu * 8 + wave_, NGW = F.G * 8;
    constexpr int NJOB = 17;
    int start = 0;
#pragma unroll 1
    for (int jb = 0; jb < NJOB; ++jb) {
        PrepJob J; J.f8scale = 0.f; J.i8scale = 0.f;
        if (jb < 2)       { J.src = (const GAS float*)(a.in[4] + (size_t)jb * 1024 * 3072); J.src2 = nullptr; J.gain = (const GAS float*)(a.in[1] + (jb == 0 ? 0 : 3) * D); J.dst = (GAS bf16_t*)(ws + W_CI + jb * W_CI_SZ); J.ld = 3072; J.N = 3072; J.K = 1024; J.map = MAP_CONV; if (I8_CONV3 && jb == 1) J.i8scale = 127.0f / i8_wfull(ws, 7, lane_, 1.0f / (1024.0f * 3072.0f)); }
        else if (jb < 4)  { const int j = jb - 2; J.src = (const GAS float*)(a.in[6] + (size_t)j * 1024 * 1024); J.src2 = nullptr; J.gain = nullptr; J.dst = (GAS bf16_t*)(ws + W_CO + j * W_CO_SZ); J.ld = 1024; J.N = 1024; J.K = 1024; J.map = MAP_P8; }
        else if (jb == 4) { J.src = (const GAS float*)(a.in[7]); J.src2 = nullptr; J.gain = (const GAS float*)(a.in[1] + 1 * D); J.dst = (GAS bf16_t*)(ws + W_SI); J.ld = 4096; J.N = 4096; J.K = 1024; J.map = MAP_P8; if (I8_SGU) J.i8scale = 127.0f / i8_wfull(ws, 6, lane_, 1.0f / (1024.0f * 4096.0f)); }
        else if (jb == 5) { J.src = (const GAS float*)(a.in[12]); J.src2 = nullptr; J.gain = nullptr; J.dst = (GAS bf16_t*)(ws + W_SO); J.ld = 1024; J.N = 1024; J.K = 2048; J.map = MAP_P8; }
        else if (jb == 6) { J.src = (const GAS float*)(a.in[13]); J.src2 = nullptr; J.gain = (const GAS float*)(a.in[1] + 2 * D); J.dst = (GAS bf16_t*)(ws + W_RQ); J.ld = 6144; J.N = 4096; J.K = 1024; J.map = MAP_RETQKV; if (I8_RET) J.i8scale = 127.0f / i8_wfull(ws, 4, lane_, 1.0f / (1024.0f * 4096.0f)); }
        else if (jb == 7) { J.src = (const GAS float*)(a.in[13] + 4096); J.src2 = nullptr; J.gain = (const GAS float*)(a.in[1] + 2 * D); J.dst = (GAS bf16_t*)(ws + W_RG); J.ld = 6144; J.N = 2048; J.K = 1024; J.map = MAP_P8; if (I8_RET) J.i8scale = 127.0f / i8_wfull(ws, 5, lane_, 1.0f / (1024.0f * 2048.0f)); }
        else if (jb == 8) { J.src = (const GAS float*)(a.in[14]); J.src2 = nullptr; J.gain = nullptr; J.dst = (GAS bf16_t*)(ws + W_RO); J.ld = 1024; J.N = 1024; J.K = 2048; J.map = MAP_P8; }
        else if (jb < 13) { const int L = jb - 9; J.src = (const GAS float*)(a.in[15] + (size_t)L * 1024 * DFF); J.src2 = (const GAS float*)(a.in[16] + (size_t)L * 1024 * DFF); J.gain = (const GAS float*)(a.in[2] + L * D); J.dst = (GAS bf16_t*)(ws + W_FI + L * W_FI_SZ); J.ld = DFF; J.N = 2 * DFF; J.K = 1024; J.map = MAP_FFN; J.f8scale = ((F8_F1_LAYERS >> L) & 1) ? FI_WSCALE : 0.f;
                            if ((I8_F1_LAYERS >> L) & 1) J.i8scale = 127.0f / i8_wfull(ws, L, lane_); }
        else              { const int L = jb - 13; J.src = (const GAS float*)(a.in[17] + (size_t)L * DFF * 1024); J.src2 = nullptr; J.gain = nullptr; J.dst = (GAS bf16_t*)(ws + W_FD + L * W_FD_SZ); J.ld = 1024; J.N = 1024; J.K = DFF; J.map = MAP_P8; J.f8scale = ((F8_LAYERS >> L) & 1) ? FD_WSCALE : 0.f; }
        const int nitems = (J.K / 64) * (J.N / 64);
        int first = (gw - start % NGW + NGW) % NGW;
        for (int it = first; it < nitems; it += NGW) prep_item(J, it, scr, lane_);
        start += nitems;
    }
    {
        const GAS float* x = (const GAS float*)a.in[0]; GAS bf16_t* xb = (GAS bf16_t*)(ws + WS_XB); GAS float* ssq = (GAS float*)(ws + WS_SSQ);
        for (int row = 4 * gw; row < M; row += 4 * NGW) {
            f32x4 v[4][4];
#pragma unroll
            for (int r = 0; r < 4; ++r)
#pragma unroll
                for (int j = 0; j < 4; ++j) v[r][j] = ((const GAS f32x4*)(x + (size_t)(row + r) * D))[lane_ + 64 * j];
#pragma unroll
            for (int r = 0; r < 4; ++r) {
                float sq = 0.f;
#pragma unroll
                for (int j = 0; j < 4; ++j) sq += (v[r][j].x * v[r][j].x + v[r][j].y * v[r][j].y) + (v[r][j].z * v[r][j].z + v[r][j].w * v[r][j].w);
                sq = wave_sum(sq);
                GAS u32x2* o8 = (GAS u32x2*)(xb + (size_t)(row + r) * D) + lane_;
#pragma unroll
                for (int j = 0; j < 4; ++j) { u32x2 w; w.x = pk2(v[r][j].x, v[r][j].y); w.y = pk2(v[r][j].z, v[r][j].w); o8[64 * j] = w; }
                if (lane_ < 16) ssq[(size_t)(row + r) * 16 + lane_] = (lane_ == 0) ? sq : 0.f;
            }
        }
    }
    {
        GAS float* rc = (GAS float*)(ws + WS_ROT); GAS float* rsn = rc + (size_t)SEQ * 128;
        const int gt = F.vcu * 512 + tid_, NGT = F.G * 512;
        for (int idx = gt; idx < SEQ * 128; idx += NGT) {
            const int i = idx & 127, pos = idx >> 7;
            const float inv = __builtin_amdgcn_exp2f(-(float)i * (13.287712379549449f / 128.0f));
            const float ang = (float)pos * inv;
            const double ad = (double)ang;
            const double kq = __builtin_rint(ad * 0.63661977236758134308);
            const double y = __builtin_fma(-kq, 1.57079632679489661923, ad) - kq * 6.123233995736766e-17;
            const double y2 = y * y;
            const double sp = y * (1.0 + y2 * (-1.0 / 6 + y2 * (1.0 / 120 + y2 * (-1.0 / 5040 + y2 * (1.0 / 362880 + y2 * (-1.0 / 39916800))))));
            const double cp = 1.0 + y2 * (-0.5 + y2 * (1.0 / 24 + y2 * (-1.0 / 720 + y2 * (1.0 / 40320 + y2 * (-1.0 / 3628800 + y2 * (1.0 / 479001600))))));
            const int q = ((int)(long long)kq) & 3;
            const double sv = (q == 0) ? sp : (q == 1) ? cp : (q == 2) ? -sp : -cp;
            const double cv = (q == 0) ? cp : (q == 1) ? -sp : (q == 2) ? -cp : sp;
            rc[idx] = (float)cv; rsn[idx] = (float)sv;
        }
        const GAS float* wsp = (const GAS float*)a.in[10]; GAS bf16_t* wd = (GAS bf16_t*)(ws + W_WS);
        for (int idx = gt; idx < 8 * 128 * 128; idx += NGT) { const int s = idx & 127, t = (idx >> 7) & 127; wd[idx] = (bf16_t)f2bf(s <= t ? wsp[idx] : 0.f); }
    }
}

__device__ __forceinline__ void conv_phase(const Frame& F, const GAS bf16_t* Bo, const GAS bf16_t* CZ, const GAS float* cw, GAS bf16_t* Y) {
    constexpr int RB = 16;
    const int nitem = (M / RB) * 128;
    const int tid_ = opq_tid();
    for (int it = F.vcu * 512 + tid_; it < nitem; it += F.G * 512) {
        const int cc = it & 127, rb = it >> 7, r0 = rb * RB, c0 = cc * 8;
        float w0[8], w1[8], w2[8];
#pragma unroll
        for (int e = 0; e < 8; ++e) { w0[e] = cw[c0 + e]; w1[e] = cw[D + c0 + e]; w2[e] = cw[2 * D + c0 + e]; }
        u32x4 p2 = (u32x4){0, 0, 0, 0}, p1 = (u32x4){0, 0, 0, 0};
        if ((r0 & (SEQ - 1)) != 0) { p2 = *(const GAS u32x4*)(CZ + (size_t)(r0 - 2) * D + c0); p1 = *(const GAS u32x4*)(CZ + (size_t)(r0 - 1) * D + c0); }
#pragma unroll
        for (int hb = 0; hb < 2; ++hb) {
            u32x4 pz[8], pb[8];
#pragma unroll
            for (int r = 0; r < 8; ++r) { const size_t off = (size_t)(r0 + 8 * hb + r) * D + c0; pz[r] = *(const GAS u32x4*)(CZ + off); pb[r] = *(const GAS u32x4*)(Bo + off); }
#pragma unroll
            for (int r = 0; r < 8; ++r) {
                const size_t off = (size_t)(r0 + 8 * hb + r) * D + c0;
                const u32x4 p0 = pz[r], bv = pb[r];
                u32x4 o;
#pragma unroll
                for (int q = 0; q < 4; ++q) {
                    const float lo = bf_lo(bv[q]) * (w0[2 * q] * bf_lo(p2[q]) + w1[2 * q] * bf_lo(p1[q]) + w2[2 * q] * bf_lo(p0[q]));
                    const float hi = bf_hi(bv[q]) * (w0[2 * q + 1] * bf_hi(p2[q]) + w1[2 * q + 1] * bf_hi(p1[q]) + w2[2 * q + 1] * bf_hi(p0[q]));
                    o[q] = pk2(lo, hi);
                }
                *(GAS u32x4*)(Y + off) = o;
                p2 = p1; p1 = p0;
            }
        }
    }
}

constexpr int SG_W = 0, SG_WSTR = 272, SG_T = 128 * SG_WSTR, SG_TSTR = 272, SG_ST = SG_T + 256 * SG_TSTR, SG_LG = SG_ST + 1024, SG_END = SG_LG + 2048;
static_assert(SG_END <= LDS_MISC, "sgu lds");
__device__ __forceinline__ void sgu_phase(const Frame& F, GAS bf16_t* U, const GAS bf16_t* V, const GAS float* lnp, const GAS bf16_t* Wt, const GAS float* lng, const GAS float* lnb, const GAS float* bs) {
    LAS unsigned char* lds = F.lds;
    const int tid = opq_tid(), lane = tid & 63, w = __builtin_amdgcn_readfirstlane(tid >> 6), fr = lane & 15, fq = lane >> 4;
    const int s = tid & 127, dg = tid >> 7;
    const int srow = tid >> 2, spart = tid & 3;
    int gcur = -1;
    u32x4 vreg[8]; f32x4 lnv[4];
    int un = F.vcu;
    if (un < 2048) {
        const int g = un & 7, row0 = (un >> 3) * 128;
        const GAS bf16_t* vp = V + (size_t)(row0 + s) * 2048 + g * 256;
#pragma unroll
        for (int i = 0; i < 8; ++i) vreg[i] = *(const GAS u32x4*)(vp + (dg + 4 * i) * 8);
        const GAS f32x4* lp = (const GAS f32x4*)(lnp + (size_t)(row0 + srow) * 64 + spart * 16);
#pragma unroll
        for (int i = 0; i < 4; ++i) lnv[i] = lp[i];
    }
    for (; un < 2048; un += F.G) {
        const int g = un & 7, c = un >> 3, row0 = c * 128;
        __syncthreads();
        if (g != gcur) {
            gcur = g;
            const GAS bf16_t* wg = Wt + (size_t)g * 128 * 128;
#pragma unroll
            for (int i = 0; i < 4; ++i) { const int p = tid + 512 * i, t = p >> 4, c16 = p & 15; *(LAS u32x4*)(lds + SG_W + t * SG_WSTR + c16 * 16) = *(const GAS u32x4*)(wg + t * 128 + c16 * 8); }
            if (tid < 256) { ((LAS float*)(lds + SG_LG))[tid] = lng[g * 256 + tid]; } else { ((LAS float*)(lds + SG_LG))[tid] = lnb[g * 256 + tid - 256]; }
        }
        {
            float s1 = 0.f, s2 = 0.f;
#pragma unroll
            for (int i = 0; i < 4; ++i) { s1 += lnv[i].x + lnv[i].z; s2 += lnv[i].y + lnv[i].w; }
            s1 += __shfl_xor(s1, 1); s2 += __shfl_xor(s2, 1); s1 += __shfl_xor(s1, 2); s2 += __shfl_xor(s2, 2);
            const float mu = s1 * (1.0f / 2048.0f), var = s2 * (1.0f / 2048.0f) - mu * mu;
            if (spart == 0) { ((LAS float*)(lds + SG_ST))[srow] = mu; ((LAS float*)(lds + SG_ST))[128 + srow] = rsqrtf(fmaxf(var, 0.f) + LN_EPS); }
        }
        __syncthreads();
        {
            const float mu = ((LAS float*)(lds + SG_ST))[s], r = ((LAS float*)(lds + SG_ST))[128 + s];
#pragma unroll
            for (int i = 0; i < 8; ++i) {
                const int dc = dg + 4 * i, d0 = dc * 8;
                const u32x4 v = vreg[i];
                const f32x4 g0 = *(const LAS f32x4*)(lds + SG_LG + d0 * 4), g1 = *(const LAS f32x4*)(lds + SG_LG + d0 * 4 + 16);
                const f32x4 b0 = *(const LAS f32x4*)(lds + SG_LG + 1024 + d0 * 4), b1 = *(const LAS f32x4*)(lds + SG_LG + 1024 + d0 * 4 + 16);
                LAS bf16_t* tp = (LAS bf16_t*)(lds + SG_T + d0 * SG_TSTR) + s;
                tp[0 * (SG_TSTR / 2)] = (bf16_t)f2bf((bf_lo(v.x) - mu) * r * g0.x + b0.x);
                tp[1 * (SG_TSTR / 2)] = (bf16_t)f2bf((bf_hi(v.x) - mu) * r * g0.y + b0.y);
                tp[2 * (SG_TSTR / 2)] = (bf16_t)f2bf((bf_lo(v.y) - mu) * r * g0.z + b0.z);
                tp[3 * (SG_TSTR / 2)] = (bf16_t)f2bf((bf_hi(v.y) - mu) * r * g0.w + b0.w);
                tp[4 * (SG_TSTR / 2)] = (bf16_t)f2bf((bf_lo(v.z) - mu) * r * g1.x + b1.x);
                tp[5 * (SG_TSTR / 2)] = (bf16_t)f2bf((bf_hi(v.z) - mu) * r * g1.y + b1.y);
                tp[6 * (SG_TSTR / 2)] = (bf16_t)f2bf((bf_lo(v.w) - mu) * r * g1.z + b1.z);
                tp[7 * (SG_TSTR / 2)] = (bf16_t)f2bf((bf_hi(v.w) - mu) * r * g1.w + b1.w);
            }
        }
        u32x4 uv[8];
#pragma unroll
        for (int tb = 0; tb < 8; ++tb) uv[tb] = *(const GAS u32x4*)(U + (size_t)(row0 + 16 * tb + fr) * 2048 + g * 256 + 32 * w + 8 * fq);
        if (un + F.G < 2048) {
            const int un2 = un + F.G, g2 = un2 & 7, row2 = (un2 >> 3) * 128;
            const GAS bf16_t* vp = V + (size_t)(row2 + s) * 2048 + g2 * 256;
#pragma unroll
            for (int i = 0; i < 8; ++i) vreg[i] = *(const GAS u32x4*)(vp + (dg + 4 * i) * 8);
            const GAS f32x4* lp = (const GAS f32x4*)(lnp + (size_t)(row2 + srow) * 64 + spart * 16);
#pragma unroll
            for (int i = 0; i < 4; ++i) lnv[i] = lp[i];
        }
        __syncthreads();
        f32x4 acc[8][2];
#pragma unroll
        for (int tb = 0; tb < 8; ++tb) { acc[tb][0] = (f32x4){0.f, 0.f, 0.f, 0.f}; acc[tb][1] = (f32x4){0.f, 0.f, 0.f, 0.f}; }
        const int drow0 = 32 * w + 8 * (fr >> 2) + (fr & 3);
#pragma unroll
        for (int ks = 0; ks < 4; ++ks) {
            const bf16x8 t0 = *(const LAS bf16x8*)(lds + SG_T + drow0 * SG_TSTR + ks * 64 + fq * 16);
            const bf16x8 t1 = *(const LAS bf16x8*)(lds + SG_T + (drow0 + 4) * SG_TSTR + ks * 64 + fq * 16);
#pragma unroll
            for (int tb = 2 * ks; tb < 8; ++tb) {
                const bf16x8 wf = *(const LAS bf16x8*)(lds + SG_W + (16 * tb + fr) * SG_WSTR + ks * 64 + fq * 16);
                acc[tb][0] = __builtin_amdgcn_mfma_f32_16x16x32_bf16(t0, wf, acc[tb][0], 0, 0, 0);
                acc[tb][1] = __builtin_amdgcn_mfma_f32_16x16x32_bf16(t1, wf, acc[tb][1], 0, 0, 0);
            }
        }
#pragma unroll
        for (int tb = 0; tb < 8; ++tb) {
            const int t = 16 * tb + fr;
            const float bb = bs[g * 128 + t];
            GAS bf16_t* up = U + (size_t)(row0 + t) * 2048 + g * 256 + 32 * w + 8 * fq;
            const f32x4 a = acc[tb][0] + bb, b = acc[tb][1] + bb;
            const f32x4 ya = (f32x4){a.x * bf_lo(uv[tb].x), a.y * bf_hi(uv[tb].x), a.z * bf_lo(uv[tb].y), a.w * bf_hi(uv[tb].y)};
            const f32x4 yb = (f32x4){b.x * bf_lo(uv[tb].z), b.y * bf_hi(uv[tb].z), b.z * bf_lo(uv[tb].w), b.w * bf_hi(uv[tb].w)};
            *(GAS u32x4*)up = pack8(ya, yb);
        }
    }
    __syncthreads();
}

constexpr int RT_K0 = 0, RT_KB = 65536, RT_ST = 131072, RT_STSTR = 528, RT_VT = RT_ST + 32 * RT_STSTR, RT_VTSTR = 288, RT_END = RT_VT + 32 * RT_VTSTR;
static_assert(RT_END <= LDS_MISC, "ret lds");
typedef short s16x4 __attribute__((ext_vector_type(4)));
__device__ __forceinline__ void ret_phase(const Frame& F, const GAS bf16_t* Q, const GAS bf16_t* Kn, GAS bf16_t* Vb, GAS float* hss) {
    LAS unsigned char* lds = F.lds;
    const int tid = opq_tid(), lane = tid & 63, w = __builtin_amdgcn_readfirstlane(tid >> 6), fr = lane & 15, fq = lane >> 4;
    const int jb = (w < 4) ? w : 11 - w;
    const int srow = tid >> 5, sslot = tid & 31, spiece = ((sslot & 15) ^ (srow & 15)) | (sslot & 16);
    const unsigned voffK = (unsigned)(srow * D + 8 * spiece) * 2u;
    int koffx[4];
#pragma unroll
    for (int k4 = 0; k4 < 4; ++k4) koffx[k4] = fr * 512 + ((((4 * k4 + fq) & 15) ^ fr) << 4);
    int troff[2][2];
#pragma unroll
    for (int db = 0; db < 2; ++db)
#pragma unroll
        for (int t = 0; t < 2; ++t) {
            const int q = fr >> 2, p = fr & 3, m = 8 * fq + 4 * t + q, c = 4 * w + 2 * db + (p >> 1);
            troff[db][t] = m * 512 + ((((c & 15) ^ (m & 15)) | (c & 16)) << 4) + 8 * (p & 1);
        }
    for (int item = F.vcu; item < 256; item += F.G) {
        const int es = item & 15, bh = item >> 4, h = bh & 3, b = bh >> 2;
        const float gam = 1.0f - __builtin_amdgcn_exp2f(-5.0f - (float)h);
        const float l2g = __builtin_amdgcn_logf(gam);
        const float cdec = __builtin_amdgcn_exp2f(128.0f * l2g);
        const size_t rowb = (size_t)b * SEQ;
        const GAS bf16_t* Qh = Q + rowb * D + h * 256;
        const GAS char* Kh = (const GAS char*)(Kn + rowb * D + h * 256);
        GAS bf16_t* Vh = Vb + rowb * 2048 + h * 512 + es * 32;
        GAS float* hs = hss + (rowb * RH + h) * 16 + es;
        __syncthreads();
        for (int i = tid; i < 32 * RT_STSTR / 4; i += 512) ((LAS unsigned*)(lds + RT_ST))[i] = 0u;
        f32x4 sst[2][2];
#pragma unroll
        for (int eb = 0; eb < 2; ++eb)
#pragma unroll
            for (int db = 0; db < 2; ++db) sst[eb][db] = (f32x4){0.f, 0.f, 0.f, 0.f};
#define RT_STAGE_K(buf, ci) do { _Pragma("unroll") for (int _i = 0; _i < 8; ++_i) \
            __builtin_amdgcn_global_load_lds((const GAS unsigned*)(Kh + (size_t)(ci) * 128 * D * 2 + (size_t)_i * 16 * D * 2 + voffK), (LAS unsigned*)(lds + (buf) + _i * 8192 + w * 1024), 16, 0, 0); } while (0)
        RT_STAGE_K(RT_K0, 0);
        const int vm = tid >> 2, vp = tid & 3;
        u32x4 vreg = *(const GAS u32x4*)(Vh + (size_t)vm * 2048 + vp * 8);
        bf16x8 qf[8];
#pragma unroll
        for (int ks = 0; ks < 8; ++ks) qf[ks] = *(const GAS bf16x8*)(Qh + (size_t)(16 * jb + fr) * D + 32 * ks + 8 * fq);
        {
            LAS bf16_t* vt = (LAS bf16_t*)(lds + RT_VT + (8 * vp) * RT_VTSTR) + vm;
#pragma unroll
            for (int q = 0; q < 4; ++q) { vt[(2 * q) * (RT_VTSTR / 2)] = (bf16_t)(vreg[q] & 0xffffu); vt[(2 * q + 1) * (RT_VTSTR / 2)] = (bf16_t)(vreg[q] >> 16); }
        }
        u32x2 pend_ow[2] = {(u32x2){0u, 0u}, (u32x2){0u, 0u}}; float pend_ss = 0.f;
        const int jrow = 16 * jb + fr;
        const float qdec = __builtin_amdgcn_exp2f(l2g * (float)(jrow + 1));
        const float pdec = __builtin_amdgcn_exp2f(l2g * (float)(jrow - 127));
#pragma unroll 1
        for (int ci = 0; ci < SEQ / RC; ++ci) {
            const int kbuf = (ci & 1) ? RT_KB : RT_K0;
            asm volatile("s_waitcnt vmcnt(0) lgkmcnt(0)" ::: "memory"); __builtin_amdgcn_s_barrier(); asm volatile("" ::: "memory");
            const bool more = ci + 1 < SEQ / RC;
#pragma unroll
            for (int ks = 0; ks < 8; ++ks) asm volatile("" : "+v"(qf[ks]));
            if (more) {
                if (ci & 1) RT_STAGE_K(RT_K0, ci + 1); else RT_STAGE_K(RT_KB, ci + 1);
                vreg = *(const GAS u32x4*)(Vh + (size_t)((ci + 1) * 128 + vm) * 2048 + vp * 8);
            }
            if (ci > 0) {
                const size_t row = (size_t)(ci - 1) * 128 + jrow;
#pragma unroll
                for (int eb = 0; eb < 2; ++eb) *(GAS u32x2*)(Vh + row * 2048 + 16 * eb + 4 * fq) = pend_ow[eb];
                if (fq == 0) hs[row * RH * 16] = pend_ss;
            }
            f32x4 oacc[2] = {(f32x4){0.f, 0.f, 0.f, 0.f}, (f32x4){0.f, 0.f, 0.f, 0.f}};
            {
                bf16x8 sf[2][8];
#pragma unroll
                for (int ks = 0; ks < 8; ++ks)
#pragma unroll
                    for (int eb = 0; eb < 2; ++eb) sf[eb][ks] = *(const LAS bf16x8*)(lds + RT_ST + (16 * eb + fr) * RT_STSTR + ks * 64 + fq * 16);
                __builtin_amdgcn_sched_barrier(0);
#pragma unroll
                for (int ks = 0; ks < 8; ++ks)
#pragma unroll
                    for (int eb = 0; eb < 2; ++eb) oacc[eb] = __builtin_amdgcn_mfma_f32_16x16x32_bf16(sf[eb][ks], qf[ks], oacc[eb], 0, 0, 0);
            }
            oacc[0] *= qdec; oacc[1] *= qdec;
#pragma unroll
            for (int kp = 0; kp < 4; ++kp) {
                if (2 * kp <= jb) {
                    const bool two = (2 * kp + 1 <= jb);
                    bf16x8 k0[8], k1[8];
#pragma unroll
                    for (int ks = 0; ks < 8; ++ks) k0[ks] = *(const LAS bf16x8*)(lds + kbuf + (2 * kp) * 8192 + koffx[ks & 3] + (ks >> 2) * 256);
                    if (two) {
#pragma unroll
                        for (int ks = 0; ks < 8; ++ks) k1[ks] = *(const LAS bf16x8*)(lds + kbuf + (2 * kp + 1) * 8192 + koffx[ks & 3] + (ks >> 2) * 256);
                    }
                    u32x2 vlo[2], vhi[2];
#pragma unroll
                    for (int eb = 0; eb < 2; ++eb) { const LAS unsigned char* vb = lds + RT_VT + (16 * eb + fr) * RT_VTSTR + (32 * kp + 4 * fq) * 2; vlo[eb] = *(const LAS u32x2*)vb; vhi[eb] = *(const LAS u32x2*)(vb + 32); }
                    __builtin_amdgcn_sched_barrier(0);
                    f32x4 s0 = (f32x4){0.f, 0.f, 0.f, 0.f}, s1 = (f32x4){0.f, 0.f, 0.f, 0.f};
#pragma unroll
                    for (int ks = 0; ks < 8; ++ks) s0 = __builtin_amdgcn_mfma_f32_16x16x32_bf16(k0[ks], qf[ks], s0, 0, 0, 0);
                    if (two) {
#pragma unroll
                        for (int ks = 0; ks < 8; ++ks) s1 = __builtin_amdgcn_mfma_f32_16x16x32_bf16(k1[ks], qf[ks], s1, 0, 0, 0);
                    }
                    s0 *= pdec; s1 *= pdec;
                    if (2 * kp == jb) {
#pragma unroll
                        for (int r = 0; r < 4; ++r) s0[r] = (4 * fq + r <= fr) ? s0[r] : 0.f;
                    }
                    if (2 * kp + 1 == jb) {
#pragma unroll
                        for (int r = 0; r < 4; ++r) s1[r] = (4 * fq + r <= fr) ? s1[r] : 0.f;
                    }
                    u32x4 pw; pw.x = pk2(s0[0], s0[1]); pw.y = pk2(s0[2], s0[3]); pw.z = pk2(s1[0], s1[1]); pw.w = pk2(s1[2], s1[3]);
                    const bf16x8 pf = __builtin_bit_cast(bf16x8, pw);
#pragma unroll
                    for (int eb = 0; eb < 2; ++eb) {
                        u32x4 vw; vw.x = vlo[eb].x; vw.y = vlo[eb].y; vw.z = vhi[eb].x; vw.w = vhi[eb].y;
                        oacc[eb] = __builtin_amdgcn_mfma_f32_16x16x32_bf16(__builtin_bit_cast(bf16x8, vw), pf, oacc[eb], 0, 0, 0);
                    }
                }
            }
            if (more) {
#pragma unroll
                for (int ks = 0; ks < 8; ++ks) qf[ks] = *(const GAS bf16x8*)(Qh + (size_t)((ci + 1) * 128 + 16 * jb + fr) * D + 32 * ks + 8 * fq);
            }
            {
                float ss = 0.f;
#pragma unroll
                for (int eb = 0; eb < 2; ++eb) {
                    pend_ow[eb].x = pk2(oacc[eb].x, oacc[eb].y); pend_ow[eb].y = pk2(oacc[eb].z, oacc[eb].w);
                    ss += (oacc[eb].x * oacc[eb].x + oacc[eb].y * oacc[eb].y) + (oacc[eb].z * oacc[eb].z + oacc[eb].w * oacc[eb].w);
                }
                ss += __shfl_xor(ss, 16); ss += __shfl_xor(ss, 32);
                pend_ss = ss;
            }
            bf16x8 vtn[2][4]; u32x2 kt[2][4][2];
#pragma unroll
            for (int eb = 0; eb < 2; ++eb)
#pragma unroll
                for (int ks = 0; ks < 4; ++ks) vtn[eb][ks] = *(const LAS bf16x8*)(lds + RT_VT + (16 * eb + fr) * RT_VTSTR + ks * 64 + fq * 16);
            {
                const unsigned a00 = (unsigned)(kbuf + troff[0][0]), a01 = (unsigned)(kbuf + troff[0][1]), a10 = (unsigned)(kbuf + troff[1][0]), a11 = (unsigned)(kbuf + troff[1][1]);
                asm volatile(
                    "ds_read_b64_tr_b16 %0, %16\n\t"  "ds_read_b64_tr_b16 %1, %17\n\t"
                    "ds_read_b64_tr_b16 %2, %16 offset:16384\n\t"  "ds_read_b64_tr_b16 %3, %17 offset:16384\n\t"
                    "ds_read_b64_tr_b16 %4, %16 offset:32768\n\t"  "ds_read_b64_tr_b16 %5, %17 offset:32768\n\t"
                    "ds_read_b64_tr_b16 %6, %16 offset:49152\n\t"  "ds_read_b64_tr_b16 %7, %17 offset:49152\n\t"
                    "ds_read_b64_tr_b16 %8, %18\n\t"  "ds_read_b64_tr_b16 %9, %19\n\t"
                    "ds_read_b64_tr_b16 %10, %18 offset:16384\n\t"  "ds_read_b64_tr_b16 %11, %19 offset:16384\n\t"
                    "ds_read_b64_tr_b16 %12, %18 offset:32768\n\t"  "ds_read_b64_tr_b16 %13, %19 offset:32768\n\t"
                    "ds_read_b64_tr_b16 %14, %18 offset:49152\n\t"  "ds_read_b64_tr_b16 %15, %19 offset:49152\n\t"
                    "s_waitcnt lgkmcnt(0)"
                    : "=&v"(kt[0][0][0]), "=&v"(kt[0][0][1]), "=&v"(kt[0][1][0]), "=&v"(kt[0][1][1]), "=&v"(kt[0][2][0]), "=&v"(kt[0][2][1]), "=&v"(kt[0][3][0]), "=&v"(kt[0][3][1]),
                      "=&v"(kt[1][0][0]), "=&v"(kt[1][0][1]), "=&v"(kt[1][1][0]), "=&v"(kt[1][1][1]), "=&v"(kt[1][2][0]), "=&v"(kt[1][2][1]), "=&v"(kt[1][3][0]), "=&v"(kt[1][3][1])
                    : "v"(a00), "v"(a01), "v"(a10), "v"(a11)
                    : "memory");
            }
            asm volatile("s_waitcnt lgkmcnt(0)" ::: "memory"); __builtin_amdgcn_s_barrier(); asm volatile("" ::: "memory");
#pragma unroll
            for (int eb = 0; eb < 2; ++eb)
#pragma unroll
                for (int db = 0; db < 2; ++db) {
                    sst[eb][db] *= cdec;
#pragma unroll
                    for (int ks = 0; ks < 4; ++ks) {
                        u32x4 kw; kw.x = kt[db][ks][0].x; kw.y = kt[db][ks][0].y; kw.z = kt[db][ks][1].x; kw.w = kt[db][ks][1].y;
                        sst[eb][db] = __builtin_amdgcn_mfma_f32_16x16x32_bf16(__builtin_bit_cast(bf16x8, kw), vtn[eb][ks], sst[eb][db], 0, 0, 0);
                    }
                    u32x2 sw; sw.x = pk2(sst[eb][db].x, sst[eb][db].y); sw.y = pk2(sst[eb][db].z, sst[eb][db].w);
                    *(LAS u32x2*)(lds + RT_ST + (16 * eb + fr) * RT_STSTR + (32 * w + 16 * db + 4 * fq) * 2) = sw;
                }
            __builtin_amdgcn_sched_barrier(0);
            if (more) {
                LAS bf16_t* vt = (LAS bf16_t*)(lds + RT_VT + (8 * vp) * RT_VTSTR) + vm;
#pragma unroll
                for (int q = 0; q < 4; ++q) { vt[(2 * q) * (RT_VTSTR / 2)] = (bf16_t)(vreg[q] & 0xffffu); vt[(2 * q + 1) * (RT_VTSTR / 2)] = (bf16_t)(vreg[q] >> 16); }
            }
        }
        {
            const size_t row = (size_t)(SEQ / RC - 1) * 128 + jrow;
#pragma unroll
            for (int eb = 0; eb < 2; ++eb) *(GAS u32x2*)(Vh + row * 2048 + 16 * eb + 4 * fq) = pend_ow[eb];
            if (fq == 0) hs[row * RH * 16] = pend_ss;
        }
#undef RT_STAGE_K
    }
    __syncthreads();
}

__device__ __forceinline__ void final_phase(const Frame& F, const GAS bf16_t* xb, GAS float* out, const GAS float* g) {
    const int tid_ = opq_tid(), lane_ = tid_ & 63, wave_ = __builtin_amdgcn_readfirstlane(tid_ >> 6);
    const int gw = F.vcu * 8 + wave_, NGW = F.G * 8;
    f32x4 gv[2][2];
#pragma unroll
    for (int j = 0; j < 2; ++j) { gv[j][0] = ((const GAS f32x4*)g)[2 * (lane_ + 64 * j)]; gv[j][1] = ((const GAS f32x4*)g)[2 * (lane_ + 64 * j) + 1]; }
    for (int row = 4 * gw; row < M; row += 4 * NGW) {
        u32x4 w[4][2];
#pragma unroll
        for (int r = 0; r < 4; ++r)
#pragma unroll
            for (int j = 0; j < 2; ++j) w[r][j] = ((const GAS u32x4*)(xb + (size_t)(row + r) * D))[lane_ + 64 * j];
#pragma unroll
        for (int r = 0; r < 4; ++r) {
            f32x4 v[2][2]; float s = 0.f;
#pragma unroll
            for (int j = 0; j < 2; ++j) { const u32x4 ww = w[r][j];
                v[j][0] = (f32x4){bf_lo(ww.x), bf_hi(ww.x), bf_lo(ww.y), bf_hi(ww.y)}; v[j][1] = (f32x4){bf_lo(ww.z), bf_hi(ww.z), bf_lo(ww.w), bf_hi(ww.w)};
                s += (v[j][0].x * v[j][0].x + v[j][0].y * v[j][0].y) + (v[j][0].z * v[j][0].z + v[j][0].w * v[j][0].w) + (v[j][1].x * v[j][1].x + v[j][1].y * v[j][1].y) + (v[j][1].z * v[j][1].z + v[j][1].w * v[j][1].w); }
            const float rs = rsqrtf(wave_sum(s) * (1.0f / D) + RMS_EPS);
            GAS f32x4* o = (GAS f32x4*)(out + (size_t)(row + r) * D) + 2 * lane_;
#pragma unroll
            for (int j = 0; j < 2; ++j) { o[128 * j] = v[j][0] * rs * gv[j][0]; o[128 * j + 1] = v[j][1] * rs * gv[j][1]; }
        }
    }
}

__global__ void __launch_bounds__(512, 2) trunk_fwd(Args args) {
    extern __shared__ __attribute__((aligned(16))) unsigned char lds_raw[];
    Frame F;
    F.lds = (LAS unsigned char*)lds_raw;
    F.tid = threadIdx.x; F.lane = F.tid & 63; F.wave = __builtin_amdgcn_readfirstlane(F.tid >> 6);
    F.G = gridDim.x; { const int bx = blockIdx.x; F.vcu = (F.G % 8 == 0) ? (bx % 8) * (F.G / 8) + bx / 8 : bx; }
    unsigned char* ws = args.ws;
    unsigned* ctl = (unsigned*)(ws + WS_CTL);
    volatile LAS unsigned* MISC = (volatile LAS unsigned*)(F.lds + LDS_MISC);
    for (int u = F.tid; u < (LDS_BYTES - LDS_MISC) / 4; u += 512) ((LAS unsigned*)(F.lds + LDS_MISC))[u] = 0u;
    __syncthreads();
    XcdBarrier bar = xcd_barrier_post(ctl + 4096 + args.li * XCD_BAR_WORDS, MISC + 8);
    const int lo = args.ph_lo, hi = args.ph_hi;
#define IN(k) (lo <= (k) && (k) < hi)
#define GRID_BAR(k) do { if (hi > (k) + 1) xcd_barrier(bar); } while (0)

    bf16_t* xb = (bf16_t*)(ws + WS_XB);
    float* ssq = (float*)(ws + WS_SSQ);

    if (IN(0)) { if (I8_F1_LAYERS || I8_RET || I8_SGU || I8_CONV3) { p0_wabs(F, args); xcd_barrier(bar); } p0_prologue(F, args); GRID_BAR(0); }

#pragma unroll 1
    for (int L = 0; L < NLAYER; ++L) {
        const int pb = 1 + 6 * L;
        const int kind = (L == 1) ? 1 : (L == 2) ? 2 : 0;
        int pmo;
        const bf16_t* moA; const bf16_t* moB; int moK;
        if (kind == 0) {
            const int j = (L == 0) ? 0 : 1;
            bf16_t* Bo = (bf16_t*)(ws + AR_CB); bf16_t* CZ = (bf16_t*)(ws + AR_CZ); bf16_t* CY = (bf16_t*)(ws + AR_CY);
            if (IN(pb)) {
                if (I8_CONV3 && j == 1) {
                quant_phase(F, (const GAS bf16_t*)opq((const bf16_t*)xb), (GAS unsigned char*)opq(ws + WS_X8), (GAS float*)opq((float*)(ws + WS_SA)));
                xcd_barrier(bar);
                pg8::Gemm g{opq((const bf16_t*)(ws + WS_X8)), opq((const bf16_t*)(ws + W_CI + j * W_CI_SZ)), M, 3072, 1024 / 2}; pg8::StaticOrder S; S.init(M, 3072, F.G, (int)blockIdx.x);
                EpiConvIn E{(const GAS float*)opq(ssq), (GAS bf16_t*)opq(Bo), (GAS bf16_t*)opq(CZ), (const GAS float*)opq((const float*)(ws + WS_SA)), i8_wfull(ws, 7, F.lane, 1.0f / (1024.0f * 3072.0f)) * (1.0f / 127.0f)};
                pg8::gemm_phase<EpiConvIn, true, true, false, true, true>(F.lds, g, S, E);
                } else {
                pg8::Gemm g{opq(xb), opq((const bf16_t*)(ws + W_CI + j * W_CI_SZ)), M, 3072, 1024}; pg8::StaticOrder S; S.init(M, 3072, F.G, (int)blockIdx.x);
                EpiConvIn E{(const GAS float*)opq(ssq), (GAS bf16_t*)opq(Bo), (GAS bf16_t*)opq(CZ), (const GAS float*)nullptr, 1.0f};
                pg8::gemm_phase<EpiConvIn>(F.lds, g, S, E);
                }
                GRID_BAR(pb);
            }
            if (IN(pb + 1)) { conv_phase(F, (const GAS bf16_t*)opq(Bo), (const GAS bf16_t*)opq(CZ), (const GAS float*)opq(args.in[5] + (size_t)j * 3 * D), (GAS bf16_t*)opq(CY)); GRID_BAR(pb + 1); }
            pmo = pb + 2; moA = CY; moB = (const bf16_t*)(ws + W_CO + j * W_CO_SZ); moK = 1024;
        } else if (kind == 1) {
            bf16_t* U = (bf16_t*)(ws + AR_SU); bf16_t* V = (bf16_t*)(ws + AR_SV); float* lnp = (float*)(ws + WS_LNP);
            {
            if (IN(pb)) {
                if constexpr (I8_SGU) {
                quant_phase(F, (const GAS bf16_t*)opq((const bf16_t*)xb), (GAS unsigned char*)opq(ws + WS_X8), (GAS float*)opq((float*)(ws + WS_SA)));
                xcd_barrier(bar);
                pg8::Gemm g{opq((const bf16_t*)(ws + WS_X8)), opq((const bf16_t*)(ws + W_SI)), M, 4096, 1024 / 2}; pg8::StaticOrder S; S.init(M, 4096, F.G, (int)blockIdx.x);
                EpiSguIn E{(const GAS float*)opq(ssq), (GAS bf16_t*)opq(U), (GAS bf16_t*)opq(V), (GAS float*)opq(lnp), (const GAS float*)opq((const float*)(ws + WS_SA)), i8_wfull(ws, 6, F.lane, 1.0f / (1024.0f * 4096.0f)) * (1.0f / 127.0f)};
                pg8::gemm_phase<EpiSguIn, true, true, false, true, true>(F.lds, g, S, E);
                } else {
                pg8::Gemm g{opq(xb), opq((const bf16_t*)(ws + W_SI)), M, 4096, 1024}; pg8::StaticOrder S; S.init(M, 4096, F.G, (int)blockIdx.x);
                EpiSguIn E{(const GAS float*)opq(ssq), (GAS bf16_t*)opq(U), (GAS bf16_t*)opq(V), (GAS float*)opq(lnp), (const GAS float*)nullptr, 1.0f};
                pg8::gemm_phase<EpiSguIn>(F.lds, g, S, E);
                }
                GRID_BAR(pb);
            }
            if (IN(pb + 1)) { sgu_phase(F, (GAS bf16_t*)opq(U), (const GAS bf16_t*)opq(V), (const GAS float*)opq(lnp), (const GAS bf16_t*)opq((const bf16_t*)(ws + W_WS)), (const GAS float*)opq(args.in[8]), (const GAS float*)opq(args.in[9]), (const GAS float*)opq(args.in[11])); GRID_BAR(pb + 1); }
            }
            pmo = pb + 2; moA = U; moB = (const bf16_t*)(ws + W_SO); moK = 2048;
        } else {
            bf16_t* Q = (bf16_t*)(ws + AR_RQ); bf16_t* Kn = (bf16_t*)(ws + AR_RK); bf16_t* V = (bf16_t*)(ws + AR_RV);
            float* hss = args.out;
            {
            {
            if (IN(pb)) {
                if constexpr (I8_RET) {
                quant_phase(F, (const GAS bf16_t*)opq((const bf16_t*)xb), (GAS unsigned char*)opq(ws + WS_X8), (GAS float*)opq((float*)(ws + WS_SA)));
                xcd_barrier(bar);
                pg8::Gemm g{opq((const bf16_t*)(ws + WS_X8)), opq((const bf16_t*)(ws + W_RQ)), M, 4096, 1024 / 2}; pg8::StaticOrder S; S.init(M, 4096, F.G, (int)blockIdx.x);
                EpiRetQkv E{(const GAS float*)opq(ssq), (const GAS float*)opq((const float*)(ws + WS_ROT)), (const GAS float*)opq((const float*)(ws + WS_ROT) + (size_t)SEQ * 128), (GAS bf16_t*)opq(Q), (GAS bf16_t*)opq(Kn), (GAS bf16_t*)opq(V),
                            (const GAS float*)opq((const float*)(ws + WS_SA)), i8_wfull(ws, 4, F.lane, 1.0f / (1024.0f * 4096.0f)) * (1.0f / 127.0f)};
                pg8::gemm_phase<EpiRetQkv, true, true, false, true, true>(F.lds, g, S, E);
                } else {
                pg8::Gemm g{opq(xb), opq((const bf16_t*)(ws + W_RQ)), M, 4096, 1024}; pg8::StaticOrder S; S.init(M, 4096, F.G, (int)blockIdx.x);
                EpiRetQkv E{(const GAS float*)opq(ssq), (const GAS float*)opq((const float*)(ws + WS_ROT)), (const GAS float*)opq((const float*)(ws + WS_ROT) + (size_t)SEQ * 128), (GAS bf16_t*)opq(Q), (GAS bf16_t*)opq(Kn), (GAS bf16_t*)opq(V), (const GAS float*)nullptr, 1.0f};
                pg8::gemm_phase<EpiRetQkv>(F.lds, g, S, E);
                }
                GRID_BAR(pb);
            }
            if (IN(pb + 1)) { ret_phase(F, (const GAS bf16_t*)opq(Q), (const GAS bf16_t*)opq(Kn), (GAS bf16_t*)opq(V), (GAS float*)opq(hss)); GRID_BAR(pb + 1); }
            }
            if (IN(pb + 2)) {
                if constexpr (I8_RET) {
                pg8::Gemm g{opq((const bf16_t*)(ws + WS_X8)), opq((const bf16_t*)(ws + W_RG)), M, 2048, 1024 / 2}; pg8::StaticOrder S; S.init(M, 2048, F.G, (int)blockIdx.x);
                EpiRetG E{(const GAS float*)opq(ssq), (const GAS float*)opq(hss), (GAS bf16_t*)opq(V), (const GAS float*)opq((const float*)(ws + WS_SA)), i8_wfull(ws, 5, F.lane, 1.0f / (1024.0f * 2048.0f)) * (1.0f / 127.0f)};
                pg8::gemm_phase<EpiRetG, true, true, false, true, true>(F.lds, g, S, E);
                } else {
                pg8::Gemm g{opq(xb), opq((const bf16_t*)(ws + W_RG)), M, 2048, 1024}; pg8::StaticOrder S; S.init(M, 2048, F.G, (int)blockIdx.x);
                EpiRetG E{(const GAS float*)opq(ssq), (const GAS float*)opq(hss), (GAS bf16_t*)opq(V), (const GAS float*)nullptr, 1.0f};
                pg8::gemm_phase<EpiRetG>(F.lds, g, S, E);
                }
                GRID_BAR(pb + 2);
            }
            }
            pmo = pb + 3; moA = V; moB = (const bf16_t*)(ws + W_RO); moK = 2048;
        }
        if (IN(pmo)) {
            pg8::Gemm g{opq(moA), opq(moB), M, 1024, moK}; pg8::StaticOrder S; S.init(M, 1024, F.G, (int)blockIdx.x);
            EpiResid E{(GAS bf16_t*)opq(xb), (GAS float*)opq(ssq), 1.0f, ((F8_F1_LAYERS >> L) & 1) ? (GAS unsigned char*)opq(ws + WS_X8) : (GAS unsigned char*)nullptr};
            pg8::gemm_phase<EpiResid>(F.lds, g, S, E);
            GRID_BAR(pmo);
        }
        if (IN(pb + 4)) {
            if ((I8_F1_LAYERS >> L) & 1) {
                quant_phase(F, (const GAS bf16_t*)opq((const bf16_t*)xb), (GAS unsigned char*)opq(ws + WS_X8), (GAS float*)opq((float*)(ws + WS_SA)));
                xcd_barrier(bar);
                pg8::Gemm g{opq((const bf16_t*)(ws + WS_X8)), opq((const bf16_t*)(ws + W_FI + L * W_FI_SZ)), M, 2 * DFF, 1024 / 2}; pg8::StaticOrder S; S.init(M, 2 * DFF, F.G, (int)blockIdx.x);
                const float wsc = i8_wfull(ws, L, F.lane) * (1.0f / 127.0f);
                EpiFfnIn E{(const GAS float*)opq(ssq), (GAS unsigned char*)opq(ws + AR_FA), ((F8_LAYERS >> L) & 1) != 0, wsc, (const GAS float*)opq((const float*)(ws + WS_SA)), true};
                pg8::gemm_phase<EpiFfnIn, true, true, false, true>(F.lds, g, S, E);
            } else if ((F8_F1_LAYERS >> L) & 1) {
                pg8::Gemm g{opq((const bf16_t*)(ws + WS_X8)), opq((const bf16_t*)(ws + W_FI + L * W_FI_SZ)), M, 2 * DFF, 1024 / 2}; pg8::StaticOrder S; S.init(M, 2 * DFF, F.G, (int)blockIdx.x);
                EpiFfnIn E{(const GAS float*)opq(ssq), (GAS unsigned char*)opq(ws + AR_FA), ((F8_LAYERS >> L) & 1) != 0, 1.0f / FI_WSCALE, (const GAS float*)nullptr, false};
                pg8::gemm_phase<EpiFfnIn, true, true, true>(F.lds, g, S, E);
            } else {
                pg8::Gemm g{opq(xb), opq((const bf16_t*)(ws + W_FI + L * W_FI_SZ)), M, 2 * DFF, 1024}; pg8::StaticOrder S; S.init(M, 2 * DFF, F.G, (int)blockIdx.x);
                EpiFfnIn E{(const GAS float*)opq(ssq), (GAS unsigned char*)opq(ws + AR_FA), ((F8_LAYERS >> L) & 1) != 0, 1.0f, (const GAS float*)nullptr, false};
                pg8::gemm_phase<EpiFfnIn>(F.lds, g, S, E);
            }
            GRID_BAR(pb + 4);
        }
        if (IN(pb + 5)) {
            if ((F8_LAYERS >> L) & 1) {
                pg8::Gemm g{opq((const bf16_t*)(ws + AR_FA)), opq((const bf16_t*)(ws + W_FD + L * W_FD_SZ)), M, 1024, DFF / 2}; pg8::StaticOrder S; S.init(M, 1024, F.G, (int)blockIdx.x);
                EpiResidT<2> E{(GAS bf16_t*)opq(xb), (GAS float*)opq(ssq), 1.0f / FD_WSCALE, (GAS unsigned char*)nullptr};
                pg8::gemm_phase<EpiResidT<2>, true, true, true>(F.lds, g, S, E);
            } else {
                pg8::Gemm g{opq((const bf16_t*)(ws + AR_FA)), opq((const bf16_t*)(ws + W_FD + L * W_FD_SZ)), M, 1024, DFF}; pg8::StaticOrder S; S.init(M, 1024, F.G, (int)blockIdx.x);
                EpiResid E{(GAS bf16_t*)opq(xb), (GAS float*)opq(ssq), 1.0f, (GAS unsigned char*)nullptr};
                pg8::gemm_phase<EpiResid>(F.lds, g, S, E);
            }
            GRID_BAR(pb + 5);
        }
    }
    if (IN(NPH - 1)) final_phase(F, (const GAS bf16_t*)opq((const bf16_t*)xb), (GAS float*)opq(args.out), (const GAS float*)opq(args.in[3]));
#undef IN
#undef GRID_BAR
}

extern "C" void kernel_launch(void* const* d_in, const int* in_sizes, int n_in, void* d_out, int out_size, void* d_ws, size_t ws_size, hipStream_t stream) {
    static int grid = 0;
    if (grid == 0) {
        if (n_in != 18 || out_size != M * D || ws_size < WS_END) { fprintf(stderr, "kernel_launch: unexpected shapes (n_in %d out %d ws %zu)\n", n_in, out_size, ws_size); grid = -1; return; }
        int dev = 0, cus = 0, per_cu = 0;
        if (hipGetDevice(&dev) != hipSuccess || hipDeviceGetAttribute(&cus, hipDeviceAttributeMultiprocessorCount, dev) != hipSuccess) { grid = -1; return; }
        if (hipFuncSetAttribute((const void*)trunk_fwd, hipFuncAttributeMaxDynamicSharedMemorySize, LDS_BYTES) != hipSuccess) { fprintf(stderr, "kernel_launch: hipFuncSetAttribute failed\n"); grid = -1; return; }
        if (hipOccupancyMaxActiveBlocksPerMultiprocessor(&per_cu, (const void*)trunk_fwd, 512, LDS_BYTES) != hipSuccess || per_cu < 1)
            fprintf(stderr, "kernel_launch: occupancy query reports %d\n", per_cu);
        (void)hipGetLastError();
        grid = cus;
    }
    if (grid < 0) return;
    (void)in_sizes;
    if (hipMemsetAsync((char*)d_ws + WS_CTL, 0, CTL_BYTES, stream) != hipSuccess) return;
    Args a{};
    for (int i = 0; i < 18; ++i) a.in[i] = (const float*)d_in[i];
    a.out = (float*)d_out; a.ws = (unsigned char*)d_ws; a.pad = 0;
#if MK_ONE_LAUNCH
    a.ph_lo = 0; a.ph_hi = NPH; a.li = 0;
    hipLaunchKernelGGL(trunk_fwd, dim3(grid), dim3(512), LDS_BYTES, stream, a);
#else
    int li = 0;
    for (int ph = 0; ph < NPH; ++ph) {
        const int r = (ph - 1) % 6, L = (ph - 1) / 6;
        if (ph >= 1 && ph < NPH - 1 && r == 3 && L != 2) continue;
        a.ph_lo = ph; a.ph_hi = ph + 1; a.li = li++;
        hipLaunchKernelGGL(trunk_fwd, dim3(grid), dim3(512), LDS_BYTES, stream, a);
    }
#endif
}
```

```cpp
#include <hip/hip_runtime.h>
#include <cstdio>
#include <cstdint>

#ifndef MK_ONE_LAUNCH
#define MK_ONE_LAUNCH 1
#endif

#define LAS __attribute__((address_space(3)))
#define GAS __attribute__((address_space(1)))
typedef unsigned short bf16_t;
typedef short bf16x8 __attribute__((ext_vector_type(8)));
typedef short bf16x4 __attribute__((ext_vector_type(4)));
typedef float f32x4 __attribute__((ext_vector_type(4)));
typedef float f32x2 __attribute__((ext_vector_type(2)));
typedef unsigned u32x4 __attribute__((ext_vector_type(4)));
typedef unsigned u32x2 __attribute__((ext_vector_type(2)));
typedef int i32x4 __attribute__((ext_vector_type(4)));
typedef int i32x8 __attribute__((ext_vector_type(8)));

constexpr int D = 1024, NB = 4, SEQ = 8192, M = NB * SEQ, DFF = 2816, NLAYER = 4;
constexpr int RH = 4, RQK = 256, RV = 512, RC = 128;
constexpr float RMS_EPS = 1e-6f, LN_EPS = 1e-5f;
constexpr int F8_LAYERS = 0x8;
constexpr bool I8_CONV3 = true;
constexpr bool I8_SGU = true;
constexpr bool I8_RET = true;
constexpr int I8_F1_LAYERS = 0xF;
constexpr int F8_F1_LAYERS = 0x0;
constexpr float FD_WSCALE = 64.0f, FI_WSCALE = 32.0f;
constexpr float WCLIP = 4.0f;
constexpr int CTL_WSS = 131072;

constexpr size_t MiB = 1u << 20;
constexpr size_t WS_CTL = 0, CTL_BYTES = 1 * MiB;
constexpr size_t WS_SSQ = 1 * MiB;
constexpr size_t WS_W = 3 * MiB;
constexpr size_t W_CI = WS_W, W_CI_SZ = (size_t)3072 * 1024 * 2;
constexpr size_t W_CO = W_CI + 2 * W_CI_SZ, W_CO_SZ = (size_t)1024 * 1024 * 2;
constexpr size_t W_SI = W_CO + 2 * W_CO_SZ, W_SI_SZ = (size_t)4096 * 1024 * 2;
constexpr size_t W_SO = W_SI + W_SI_SZ, W_SO_SZ = (size_t)1024 * 2048 * 2;
constexpr size_t W_RQ = W_SO + W_SO_SZ, W_RQ_SZ = (size_t)4096 * 1024 * 2;
constexpr size_t W_RG = W_RQ + W_RQ_SZ, W_RG_SZ = (size_t)2048 * 1024 * 2;
constexpr size_t W_RO = W_RG + W_RG_SZ, W_RO_SZ = (size_t)1024 * 2048 * 2;
constexpr size_t W_FI = W_RO + W_RO_SZ, W_FI_SZ = (size_t)5632 * 1024 * 2;
constexpr size_t W_FD = W_FI + 4 * W_FI_SZ, W_FD_SZ = (size_t)1024 * 2816 * 2;
constexpr size_t W_WS = W_FD + 4 * W_FD_SZ, W_WS_SZ = (size_t)8 * 128 * 128 * 2;
constexpr size_t WS_WEND = W_WS + W_WS_SZ;
static_assert(WS_WEND <= 114 * MiB, "weights");
constexpr size_t WS_ROT = 114 * MiB;
constexpr size_t WS_HSS = WS_ROT;
constexpr size_t WS_XB = 122 * MiB;
constexpr size_t WS_AR = 186 * MiB;
constexpr size_t WS_SA = 491 * MiB;
constexpr size_t WS_X8 = 458 * MiB;
constexpr size_t WS_KT = 442 * MiB;
constexpr size_t WS_LNP = WS_KT;
constexpr size_t WS_END = 506 * MiB;
constexpr size_t AR_CB = WS_AR, AR_CZ = WS_AR + 64 * MiB, AR_CY = WS_AR + 128 * MiB;
constexpr size_t AR_SU = WS_AR, AR_SV = WS_AR + 128 * MiB;
constexpr size_t AR_RQ = WS_AR, AR_RK = WS_AR + 64 * MiB, AR_RV = WS_AR + 128 * MiB;
constexpr size_t AR_FA = WS_AR;

constexpr int NPH = 26;
constexpr int LDS_BYTES = 159744;
constexpr int LDS_MISC = 159232;

#define RLX_AGENT __ATOMIC_RELAXED, __HIP_MEMORY_SCOPE_AGENT
__device__ __forceinline__ unsigned f2bf(float f) { unsigned u = __builtin_bit_cast(unsigned, f); return (u + 0x7fffu + ((u >> 16) & 1u)) >> 16; }
typedef __bf16 bf16v2 __attribute__((ext_vector_type(2)));
__device__ __forceinline__ unsigned pk2(float lo, float hi) { const f32x2 v = {lo, hi}; return __builtin_bit_cast(unsigned, __builtin_convertvector(v, bf16v2)); }
__device__ __forceinline__ float bf_lo(unsigned w) { return __builtin_bit_cast(float, w << 16); }
__device__ __forceinline__ float bf_hi(unsigned w) { return __builtin_bit_cast(float, w & 0xffff0000u); }
__device__ __forceinline__ float wave_max(float v) {
#pragma unroll
    for (int o = 1; o < 64; o <<= 1) v = fmaxf(v, __shfl_xor(v, o));
    return v;
}
__device__ __forceinline__ float wave_sum(float v) {
#pragma unroll
    for (int o = 1; o < 64; o <<= 1) v += __shfl_xor(v, o);
    return v;
}
template <class T> __device__ __forceinline__ T* opq(T* p) { asm volatile("" : "+s"(p)); return p; }
__device__ __forceinline__ int opq_tid() { int t = threadIdx.x; asm volatile("" : "+v"(t)); return t; }
__device__ __forceinline__ float fast_rcp(float x) { return __builtin_amdgcn_rcpf(x); }
__device__ __forceinline__ float silu_f(float x) { return x * fast_rcp(1.0f + __builtin_amdgcn_exp2f(-1.44269504089f * x)); }

#define XB_TMO      128
#define XB_XCNT(j)  (256  + 64 * (j))
#define XB_XSUB(j)  (1280 + 64 * (j))
#define XB_XGEN(j)  (2304 + 64 * (j))
#define XB_TOP      3328
#define XB_TOPGEN   3392
#define XCD_BAR_WORDS 3456
#define XB_SPIN_CAP (1u << 18)
__device__ __forceinline__ unsigned xb_ld(unsigned* p)              { return __hip_atomic_load(p, __ATOMIC_RELAXED, __HIP_MEMORY_SCOPE_AGENT); }
__device__ __forceinline__ unsigned xb_add(unsigned* p, unsigned v) { return __hip_atomic_fetch_add(p, v, __ATOMIC_RELAXED, __HIP_MEMORY_SCOPE_AGENT); }
__device__ __forceinline__ unsigned xb_xcc_id() { return (unsigned)__builtin_amdgcn_s_getreg((3 << 11) | 20) & 0xFu; }
#define XB_SPIN(cond, bar) do { unsigned _sp = 0; while (cond) { __builtin_amdgcn_s_sleep(1); \
    if ((++_sp & 255u) == 0u) { if (xb_ld(&(bar)[XB_TMO])) break; if (_sp > XB_SPIN_CAP) { atomicAdd(&(bar)[XB_TMO], 1u); break; } } } } while (0)
struct XcdBarrier { unsigned* bar; unsigned x; volatile LAS unsigned* st; };
__device__ __forceinline__ XcdBarrier xcd_barrier_post(unsigned* bar, volatile LAS unsigned* st) {
    XcdBarrier b; b.bar = bar; b.x = xb_xcc_id(); b.st = st;
    if (threadIdx.x == 0) (void)xb_add(&bar[XB_XCNT(b.x)], 1u);
    return b;
}
__device__ __forceinline__ void xcd_barrier_complete(unsigned* bar, unsigned x, unsigned& nloc, unsigned& nx) {
    const unsigned G = gridDim.x * gridDim.y * gridDim.z;
    unsigned sum, cnt, mine, sp = 0u;
    for (;;) {
        sum = 0u; cnt = 0u; mine = 0u;
#pragma unroll
        for (unsigned j = 0; j < 16; ++j) { const unsigned c = xb_ld(&bar[XB_XCNT(j)]); sum += c; cnt += (c > 0u) ? 1u : 0u; mine = (j == x) ? c : mine; }
        if (sum == G) break;
        __builtin_amdgcn_s_sleep(1);
        if ((++sp & 255u) == 0u) { if (xb_ld(&bar[XB_TMO])) break; if (sp > XB_SPIN_CAP) { atomicAdd(&bar[XB_TMO], 1u); break; } }
    }
    nloc = mine > 0u ? mine : 1u; nx = cnt > 0u ? cnt : 1u;
}
__device__ __forceinline__ void xcd_barrier(const XcdBarrier& b) {
    asm volatile("s_waitcnt vmcnt(0)" ::: "memory");
    __syncthreads();
    if (threadIdx.x == 0) {
        unsigned* bar = b.bar;
        __builtin_amdgcn_s_waitcnt(0);
        unsigned nloc = b.st[0], nx = b.st[1];
        if (nloc == 0u) { xcd_barrier_complete(bar, b.x, nloc, nx); b.st[0] = nloc; b.st[1] = nx; }
        const unsigned old = xb_add(&bar[XB_XSUB(b.x)], 1u);
        const unsigned gen = old / nloc;
        if (old + 1u == (gen + 1u) * nloc) {
            __builtin_amdgcn_fence(__ATOMIC_RELEASE, "agent");
            asm volatile("s_waitcnt vmcnt(0)" ::: "memory");
            const unsigned og = xb_add(&bar[XB_TOP], 1u);
            const unsigned tg = og / nx;
            if (og + 1u == (tg + 1u) * nx) xb_add(&bar[XB_TOPGEN], 1u);
            else XB_SPIN(xb_ld(&bar[XB_TOPGEN]) == tg, bar);
            __builtin_amdgcn_fence(__ATOMIC_ACQUIRE, "agent");
            xb_add(&bar[XB_XGEN(b.x)], 1u);
            asm volatile("s_waitcnt vmcnt(0)" ::: "memory");
        } else {
            XB_SPIN(xb_ld(&bar[XB_XGEN(b.x)]) == gen, bar);
            __builtin_amdgcn_fence(__ATOMIC_ACQUIRE, "agent");
            asm volatile("s_waitcnt vmcnt(0)" ::: "memory");
        }
    }
    __syncthreads();
}

namespace pg8 {
constexpr int BM = 256, BK = 64, HALF = 128, HTB = HALF * BK * 2, STAGE_BYTES = 8 * HTB, NXCD = 8, WGM = 8;
__host__ __device__ __forceinline__ int lds_byte(int r, int c) { const int st = (r >> 4) * 2 + (c >> 5), rr = r & 15, cc = c & 31, ob = rr * 64 + cc * 2; return st * 1024 + (ob ^ (((ob >> 9) & 1) << 5)); }
__host__ __device__ __forceinline__ void stage_rc(int b, int& R, int& C) { const int st = b / 1024, sb = b % 1024, swz = sb ^ (((sb >> 9) & 1) << 5); R = (st >> 1) * 16 + swz / 64; C = (st & 1) * 32 + (swz % 64) / 2; }
__host__ __device__ __forceinline__ int perm32(int rho) { const int n = rho >> 4, i = rho & 15; return 8 * (i >> 2) + 4 * n + (i & 3); }

struct Unit { int pm, pn; };
struct Gemm { const bf16_t* A; const bf16_t* Bt; int M, N, K; };
struct StaticOrder {
    int nM, nN, nwg, G, c;
    __host__ __device__ void init(int M_, int N_, int G_, int c_) { nM = M_ / BM; nN = N_ / BM; nwg = nM * nN; G = G_; c = c_; }
    __host__ __device__ bool next(int i, Unit& u) const {
        const long L = (long)i * G + c; if (L >= nwg) return false;
        int wgid = (int)L; { const int q = nwg / NXCD, r = nwg % NXCD, xcd = wgid % NXCD, off = wgid / NXCD; wgid = (xcd < r ? xcd * (q + 1) : r * (q + 1) + (xcd - r) * q) + off; }
        const int nig = WGM * nN, gid = wgid / nig, fm = gid * WGM, gsz = (nM - fm) < WGM ? (nM - fm) : WGM;
        u.pm = fm + ((wgid % nig) % gsz); u.pn = (wgid % nig) / gsz; return true;
    }
};

template <class E_> __device__ __forceinline__ auto rowsc_of(const E_& e, int) -> decltype(e.rowsc) { return e.rowsc; }
template <class E_> __device__ __forceinline__ const GAS float* rowsc_of(const E_&, long) { return nullptr; }
template <class E_> __device__ __forceinline__ auto tsc_of(const E_& e, int) -> decltype(e.tsc) { return e.tsc; }
template <class E_> __device__ __forceinline__ float tsc_of(const E_&, long) { return 1.0f; }
template <class Epi, bool ALIGN_EPI = true, bool SP2 = true, bool F8 = false, bool I8 = false, bool CVT = false>
__device__ __forceinline__ void gemm_phase(LAS unsigned char* lds, const Gemm g, const StaticOrder& S, const Epi& E) {
    const int tid = opq_tid(), wid = __builtin_amdgcn_readfirstlane(tid >> 6), lane = tid & 63, wr = wid >> 2, wc = wid & 3, fr = lane & 15, fq = lane >> 4;
    const int K = g.K, nt = K / BK;
    unsigned voffA[2];
#pragma unroll
    for (int i = 0; i < 2; ++i) { int R, C; stage_rc(tid * 16 + i * 8192, R, C); voffA[i] = (unsigned)(R * K + C) * 2u; }
    const size_t kstep = (size_t)(BK * 2);
    const size_t hstep = (size_t)HALF * K * 2;
    const size_t tstep = 2 * hstep;
    const unsigned ldsw = (unsigned)wid * 1024u;
    const int aoff = lds_byte(wr * 64 + fr, fq * 8), boff = lds_byte(wc * 32 + fr, fq * 8);
#define PG8_SA(b, h) (((b) * 2 + (h)) * HTB)
#define PG8_SB(b, h) ((4 + (b) * 2 + (h)) * HTB)
#define PG8_STAGE(bufoff, gbase, voff) do { _Pragma("unroll") for (int _i = 0; _i < 2; ++_i) \
        __builtin_amdgcn_global_load_lds((const unsigned*)((const char*)(gbase) + (voff)[_i]), (LAS unsigned*)(lds + (bufoff) + ldsw + _i * 8192), 16, 0, 0); } while (0)
#define PG8_LDA(dst, b, h) do { _Pragma("unroll") for (int m = 0; m < 4; ++m) _Pragma("unroll") for (int k = 0; k < 2; ++k) dst[m][k] = *(const LAS bf16x8*)(lds + PG8_SA(b, h) + aoff + m * 2048 + k * 1024); } while (0)
#define PG8_LDB(dst, b, h) do { _Pragma("unroll") for (int n = 0; n < 2; ++n) _Pragma("unroll") for (int k = 0; k < 2; ++k) dst[n][k] = *(const LAS bf16x8*)(lds + PG8_SB(b, h) + boff + n * 2048 + k * 1024); } while (0)
#define PG8_CAT8(lo, hi) __builtin_shufflevector(__builtin_bit_cast(i32x4, lo), __builtin_bit_cast(i32x4, hi), 0, 1, 2, 3, 4, 5, 6, 7)
#define PG8_MMA(ai, bj, At, Bt) do { __builtin_amdgcn_s_setprio(1); _Pragma("unroll") for (int m = 0; m < 4; ++m) _Pragma("unroll") for (int n = 0; n < 2; ++n) { \
        if constexpr (F8) { const i32x8 b8_ = PG8_CAT8(Bt[n][0], Bt[n][1]), a8_ = PG8_CAT8(At[m][0], At[m][1]); asm volatile("v_mfma_f32_16x16x128_f8f6f4 %0, %1, %2, %0" : "+v"(acc[ai][bj][m][n]) : "v"(b8_), "v"(a8_)); } \
        else if constexpr (I8) { _Pragma("unroll") for (int k = 0; k < 2; ++k) acc[ai][bj][m][n] = __builtin_bit_cast(f32x4, __builtin_amdgcn_mfma_i32_16x16x64_i8(__builtin_bit_cast(i32x4, Bt[n][k]), __builtin_bit_cast(i32x4, At[m][k]), __builtin_bit_cast(i32x4, acc[ai][bj][m][n]), 0, 0, 0)); } \
        else { _Pragma("unroll") for (int k = 0; k < 2; ++k) acc[ai][bj][m][n] = __builtin_amdgcn_mfma_f32_16x16x32_bf16(Bt[n][k], At[m][k], acc[ai][bj][m][n], 0, 0, 0); } } __builtin_amdgcn_s_setprio(0); } while (0)
#define PG8_WAIT_V(n) asm volatile("s_waitcnt vmcnt(" #n ")" ::: "memory")
#define PG8_WAIT_L(n) asm volatile("s_waitcnt lgkmcnt(" #n ")" ::: "memory")
#define PG8_BAR __builtin_amdgcn_s_barrier()
#define PG8_SCHED __builtin_amdgcn_sched_barrier(0)
    LAS int* utab = (LAS int*)(lds + LDS_MISC + 128);
    if (tid < 16) { Unit tu; tu.pm = 0; tu.pn = 0; const bool ok = S.next(tid, tu); utab[2 * tid] = ok ? tu.pm : -1; utab[2 * tid + 1] = tu.pn; }
    __syncthreads();
#define PG8_NEXT(i, u) ((i) < 16 && ((u).pm = __builtin_amdgcn_readfirstlane(utab[2 * (i)]), (u).pn = __builtin_amdgcn_readfirstlane(utab[2 * (i) + 1]), (u).pm >= 0))
    Unit cur, nxt; int ui = 0;
    if (!PG8_NEXT(0, cur)) return;
    const char* cA = (const char*)g.A + (size_t)cur.pm * tstep; const char* cB = (const char*)g.Bt + (size_t)cur.pn * tstep;
    if constexpr (SP2) {
        PG8_STAGE(PG8_SB(0, 0), cB, voffA); PG8_STAGE(PG8_SB(0, 1), cB + hstep, voffA); PG8_STAGE(PG8_SA(0, 0), cA, voffA); PG8_STAGE(PG8_SA(0, 1), cA + hstep, voffA);
    }
    if constexpr (Epi::NEEDS_RS) {
        LAS float* rst = (LAS float*)(lds + STAGE_BYTES);
        const GAS float* rsc = rowsc_of(E, 0); const float tsc = tsc_of(E, 0);
        for (int q = tid; q < 16 * 256; q += 512) { const int i = q >> 8, r = q & 255, pm = utab[2 * i];
            if (pm >= 0) { const GAS f32x4* p = (const GAS f32x4*)(E.ssq + (size_t)(pm * 256 + r) * 16); const f32x4 a0 = p[0], a1 = p[1], a2 = p[2], a3 = p[3];
                const float xs = (rsc ? rsc[pm * 256 + r] : 1.0f) * tsc;
                rst[q] = xs * rsqrtf((((a0.x + a0.y) + (a0.z + a0.w)) + ((a1.x + a1.y) + (a1.z + a1.w)) + ((a2.x + a2.y) + (a2.z + a2.w)) + ((a3.x + a3.y) + (a3.z + a3.w))) * (1.0f / D) + RMS_EPS); } }
        if constexpr (Epi::NEEDS_RH) {
            LAS float* rht = (LAS float*)(lds + STAGE_BYTES + 16384);
            for (int q = tid; q < 8 * 256; q += 512) { const int i = q >> 8, r = q & 255, pm = utab[2 * i], hh = utab[2 * i + 1] >> 1;
                if (pm >= 0) { const GAS f32x4* p = (const GAS f32x4*)(E.hss + ((size_t)(pm * 256 + r) * RH + hh) * 16); const f32x4 a0 = p[0], a1 = p[1], a2 = p[2], a3 = p[3];
                    rht[q] = rsqrtf((((a0.x + a0.y) + (a0.z + a0.w)) + ((a1.x + a1.y) + (a1.z + a1.w)) + ((a2.x + a2.y) + (a2.z + a2.w)) + ((a3.x + a3.y) + (a3.z + a3.w))) * (1.0f / RV) + RMS_EPS); } }
        }
        __syncthreads();
    }
    f32x4 acc[2][2][4][2];
#define PG8_ZERO_ACC do { bf16x8 z_ = (bf16x8){0, 0, 0, 0, 0, 0, 0, 0}; asm volatile("" : "+v"(z_)); \
        _Pragma("unroll") for (int a = 0; a < 2; ++a) _Pragma("unroll") for (int b = 0; b < 2; ++b) _Pragma("unroll") for (int m = 0; m < 4; ++m) _Pragma("unroll") for (int n = 0; n < 2; ++n) \
            acc[a][b][m][n] = __builtin_amdgcn_mfma_f32_16x16x32_bf16(z_, z_, (f32x4){0.f, 0.f, 0.f, 0.f}, 0, 0, 0); } while (0)
    PG8_ZERO_ACC;
    bf16x8 At[4][2], B0[2][2], B1[2][2];
    if constexpr (SP2) {
        if (wr == 1) PG8_BAR;
        PG8_WAIT_V(2); PG8_BAR;
        PG8_STAGE(PG8_SB(1, 0), cB + kstep, voffA); PG8_STAGE(PG8_SA(1, 0), cA + kstep, voffA); PG8_STAGE(PG8_SB(1, 1), cB + hstep + kstep, voffA);
        PG8_WAIT_V(6); PG8_BAR;
    } else {
        PG8_STAGE(PG8_SB(0, 0), cB, voffA); PG8_STAGE(PG8_SA(0, 0), cA, voffA); PG8_STAGE(PG8_SB(0, 1), cB + hstep, voffA); PG8_STAGE(PG8_SA(0, 1), cA + hstep, voffA);
        if (wr == 1) PG8_BAR;
        PG8_WAIT_V(4); PG8_BAR;
        PG8_STAGE(PG8_SB(1, 0), cB + kstep, voffA); PG8_STAGE(PG8_SA(1, 0), cA + kstep, voffA); PG8_STAGE(PG8_SB(1, 1), cB + hstep + kstep, voffA);
        PG8_WAIT_V(6); PG8_BAR;
    }
    for (;;) {
        const bool has_next = PG8_NEXT(ui + 1, nxt);
        const char* nA = has_next ? (const char*)g.A + (size_t)nxt.pm * tstep : cA; const char* nB = has_next ? (const char*)g.Bt + (size_t)nxt.pn * tstep : cB;
        __builtin_amdgcn_s_waitcnt(0xC07F);
        for (int t = 0; t < nt; t += 2) {
            const bool last = (t == nt - 2);
            const char* a1 = cA + (size_t)(t + 1) * kstep;
            const char* a2 = last ? nA : cA + (size_t)(t + 2) * kstep; const char* b2 = last ? nB : cB + (size_t)(t + 2) * kstep;
            const char* a3 = a2 + kstep; const char* b3 = b2 + kstep;
            if constexpr (SP2) {
            PG8_LDB(B0, 0, 0); PG8_LDB(B1, 0, 1); PG8_SCHED; PG8_LDA(At, 0, 0); PG8_STAGE(PG8_SA(1, 1), a1 + hstep, voffA);
            PG8_WAIT_V(8); PG8_WAIT_L(0); PG8_BAR; PG8_MMA(0, 0, At, B0); PG8_MMA(0, 1, At, B1); PG8_BAR; PG8_SCHED;
            PG8_LDA(At, 0, 1); PG8_STAGE(PG8_SB(0, 0), b2, voffA); PG8_STAGE(PG8_SB(0, 1), b2 + hstep, voffA); PG8_STAGE(PG8_SA(0, 0), a2, voffA);
            PG8_WAIT_V(8); PG8_WAIT_L(0); PG8_BAR; PG8_MMA(1, 0, At, B0); PG8_MMA(1, 1, At, B1); PG8_BAR; PG8_SCHED;
            PG8_LDB(B0, 1, 0); PG8_LDB(B1, 1, 1); PG8_SCHED; PG8_LDA(At, 1, 0); PG8_STAGE(PG8_SA(0, 1), a2 + hstep, voffA);
            PG8_WAIT_V(8); PG8_WAIT_L(0); PG8_BAR; PG8_MMA(0, 0, At, B0); PG8_MMA(0, 1, At, B1); PG8_BAR; PG8_SCHED;
            PG8_LDA(At, 1, 1); PG8_STAGE(PG8_SB(1, 0), b3, voffA); PG8_STAGE(PG8_SB(1, 1), b3 + hstep, voffA); PG8_STAGE(PG8_SA(1, 0), a3, voffA);
            PG8_WAIT_V(8); PG8_WAIT_L(0); PG8_BAR; PG8_MMA(1, 0, At, B0); PG8_MMA(1, 1, At, B1); PG8_BAR; PG8_SCHED;
            } else {
            PG8_LDB(B0, 0, 0); PG8_SCHED; PG8_LDA(At, 0, 0); PG8_STAGE(PG8_SA(1, 1), a1 + hstep, voffA);
            PG8_WAIT_L(8); PG8_BAR; PG8_WAIT_L(0); PG8_MMA(0, 0, At, B0); PG8_BAR; PG8_SCHED;
            PG8_LDB(B1, 0, 1); PG8_STAGE(PG8_SB(0, 0), b2, voffA);
            PG8_BAR; PG8_WAIT_L(0); PG8_MMA(0, 1, At, B1); PG8_BAR;
            PG8_LDA(At, 0, 1); PG8_STAGE(PG8_SA(0, 0), a2, voffA);
            PG8_BAR; PG8_WAIT_L(0); PG8_MMA(1, 0, At, B0); PG8_BAR; PG8_SCHED;
            PG8_STAGE(PG8_SB(0, 1), b2 + hstep, voffA);
            PG8_WAIT_V(6); PG8_BAR; PG8_MMA(1, 1, At, B1); PG8_BAR;
            PG8_LDB(B0, 1, 0); PG8_SCHED; PG8_LDA(At, 1, 0); PG8_STAGE(PG8_SA(0, 1), a2 + hstep, voffA);
            PG8_WAIT_L(8); PG8_BAR; PG8_WAIT_L(0); PG8_MMA(0, 0, At, B0); PG8_BAR; PG8_SCHED;
            PG8_LDB(B1, 1, 1); PG8_STAGE(PG8_SB(1, 0), b3, voffA);
            PG8_BAR; PG8_WAIT_L(0); PG8_MMA(0, 1, At, B1); PG8_BAR;
            PG8_LDA(At, 1, 1); PG8_STAGE(PG8_SA(1, 0), a3, voffA);
            PG8_BAR; PG8_WAIT_L(0); PG8_MMA(1, 0, At, B0); PG8_BAR; PG8_SCHED;
            PG8_STAGE(PG8_SB(1, 1), b3 + hstep, voffA);
            PG8_WAIT_V(6); PG8_BAR; PG8_MMA(1, 1, At, B1); PG8_BAR;
            }
        }
        if constexpr (ALIGN_EPI) { if (wr == 0) PG8_BAR; }
        if constexpr (F8) asm volatile("s_nop 15\n\ts_nop 7" ::: "memory");
        if constexpr (CVT) {
#pragma unroll
            for (int a = 0; a < 2; ++a)
#pragma unroll
                for (int b = 0; b < 2; ++b)
#pragma unroll
                    for (int m = 0; m < 4; ++m)
#pragma unroll
                        for (int n = 0; n < 2; ++n) acc[a][b][m][n] = __builtin_convertvector(__builtin_bit_cast(i32x4, acc[a][b][m][n]), f32x4);
        }
        { int efr = fr, efq = fq; asm volatile("" : "+v"(efr), "+v"(efq));
          E(acc, cur, wr, wc, efr, efq, (const LAS float*)(lds + STAGE_BYTES) + ui * 256 + wr * 64 + efr); }
        if (!has_next) break;
        PG8_ZERO_ACC;
        cur = nxt; cA = nA; cB = nB; ++ui;
        if constexpr (ALIGN_EPI) { if (wr == 1) PG8_BAR; }
    }
    PG8_WAIT_V(0);
    if constexpr (!ALIGN_EPI) { if (wr == 0) PG8_BAR; }
    PG8_BAR;
#undef PG8_NEXT
#undef PG8_SA
#undef PG8_SB
#undef PG8_STAGE
#undef PG8_LDA
#undef PG8_LDB
#undef PG8_MMA
#undef PG8_CAT8
#undef PG8_ZERO_ACC
#undef PG8_WAIT_V
#undef PG8_WAIT_L
#undef PG8_BAR
#undef PG8_SCHED
}
}

typedef f32x4 Acc[2][2][4][2];
__device__ __forceinline__ u32x4 pack8(const f32x4 a, const f32x4 b) { u32x4 w; w.x = pk2(a.x, a.y); w.y = pk2(a.z, a.w); w.z = pk2(b.x, b.y); w.w = pk2(b.z, b.w); return w; }
__device__ __forceinline__ void row_scales(const GAS float* part, size_t stride, int row0, int fq, float inv_n, float eps, float (&sc)[8]) {
    f32x4 v[8];
#pragma unroll
    for (int k = 0; k < 8; ++k) v[k] = *(const GAS f32x4*)(part + (size_t)(row0 + (k >> 2) * 128 + (k & 3) * 16) * stride + 4 * fq);
#pragma unroll
    for (int k = 0; k < 8; ++k) { float t = (v[k].x + v[k].y) + (v[k].z + v[k].w); t += __shfl_xor(t, 16); t += __shfl_xor(t, 32); sc[k] = rsqrtf(t * inv_n + eps); }
}

struct EpiConvIn {
    static constexpr bool NEEDS_RS = true, NEEDS_RH = false;
    const GAS float* ssq; GAS bf16_t* Bo; GAS bf16_t* CZ; const GAS float* rowsc; float tsc;
    __device__ __forceinline__ void operator()(const Acc& acc, const pg8::Unit& u, int wr, int wc, int fr, int fq, const LAS float* rst) const {
        const int row0 = u.pm * 256 + wr * 64 + fr;
        float rs[8];
#pragma unroll
        for (int k = 0; k < 8; ++k) rs[k] = rst[(k >> 2) * 128 + (k & 3) * 16];
#pragma unroll
        for (int ai = 0; ai < 2; ++ai)
#pragma unroll
            for (int m = 0; m < 4; ++m) {
                const int row = row0 + ai * 128 + m * 16; const float r1 = rs[4 * ai + m];
                if (u.pn < 4) {
#pragma unroll
                    for (int bj = 0; bj < 2; ++bj)
                        *(GAS u32x4*)(Bo + (size_t)row * D + u.pn * 256 + bj * 128 + wc * 32 + fq * 8) = pack8(acc[ai][bj][m][0] * r1, acc[ai][bj][m][1] * r1);
                } else {
                    const float r2 = r1 * r1;
                    const f32x4 p0 = acc[ai][0][m][0] * acc[ai][0][m][1] * r2, p1 = acc[ai][1][m][0] * acc[ai][1][m][1] * r2;
                    *(GAS u32x4*)(CZ + (size_t)row * D + (u.pn - 4) * 128 + wc * 32 + fq * 8) = pack8(p0, p1);
                }
            }
    }
};
struct EpiFfnIn {
    static constexpr bool NEEDS_RS = true, NEEDS_RH = false;
    const GAS float* ssq; GAS unsigned char* ACT; bool f8; float isc; const GAS float* rowsc; bool i8;
    __device__ __forceinline__ void operator()(const Acc& acc, const pg8::Unit& u, int wr, int wc, int fr, int fq, const LAS float* rst) const {
        const int row0 = u.pm * 256 + wr * 64 + fr;
        float rs[8];
#pragma unroll
        for (int k = 0; k < 8; ++k) rs[k] = rst[(k >> 2) * 128 + (k & 3) * 16];
#pragma unroll
        for (int ai = 0; ai < 2; ++ai)
#pragma unroll
            for (int m = 0; m < 4; ++m) {
                const int row = row0 + ai * 128 + m * 16; const float r1 = rs[4 * ai + m] * isc;
                const float c1 = -1.44269504089f * r1, r2 = r1 * r1;
                f32x2 g[4], p[4], e[4];
#pragma unroll
                for (int bj = 0; bj < 2; ++bj) { f32x4 gt = acc[ai][bj][m][0], up = acc[ai][bj][m][1];
                    if (i8) { gt = __builtin_convertvector(__builtin_bit_cast(i32x4, gt), f32x4); up = __builtin_convertvector(__builtin_bit_cast(i32x4, up), f32x4); }
                    g[2 * bj] = (f32x2){gt.x, gt.y}; g[2 * bj + 1] = (f32x2){gt.z, gt.w};
                    p[2 * bj] = (f32x2){gt.x, gt.y} * (f32x2){up.x, up.y}; p[2 * bj + 1] = (f32x2){gt.z, gt.w} * (f32x2){up.z, up.w}; }
#pragma unroll
                for (int k = 0; k < 4; ++k) { const f32x2 t = g[k] * c1; e[k].x = __builtin_amdgcn_exp2f(t.x); e[k].y = __builtin_amdgcn_exp2f(t.y); }
#pragma unroll
                for (int k = 0; k < 4; ++k) { const f32x2 d = e[k] + 1.0f; e[k].x = __builtin_amdgcn_rcpf(d.x); e[k].y = __builtin_amdgcn_rcpf(d.y); }
#pragma unroll
                for (int k = 0; k < 4; ++k) p[k] = (p[k] * r2) * e[k];
                const size_t eoff = (size_t)row * DFF + u.pn * 128 + wc * 32 + fq * 8;
                if (f8) {
                    u32x2 w;
                    w.x = (unsigned)__builtin_amdgcn_cvt_pk_fp8_f32(p[1].x, p[1].y, __builtin_amdgcn_cvt_pk_fp8_f32(p[0].x, p[0].y, 0, false), true);
                    w.y = (unsigned)__builtin_amdgcn_cvt_pk_fp8_f32(p[3].x, p[3].y, __builtin_amdgcn_cvt_pk_fp8_f32(p[2].x, p[2].y, 0, false), true);
                    __builtin_nontemporal_store(w, (GAS u32x2*)(ACT + eoff));
                } else {
                    u32x4 w; w.x = pk2(p[0].x, p[0].y); w.y = pk2(p[1].x, p[1].y); w.z = pk2(p[2].x, p[2].y); w.w = pk2(p[3].x, p[3].y);
                    __builtin_nontemporal_store(w, (GAS u32x4*)(ACT + 2 * eoff));
                }
            }
    }
};
__device__ __forceinline__ f32x2 gelu_pk(f32x2 v) {
    const f32x2 av = __builtin_elementwise_abs(v), d = av * 0.2316418882f + 1.0f;
    f32x2 t; t.x = __builtin_amdgcn_rcpf(d.x); t.y = __builtin_amdgcn_rcpf(d.y);
    f32x2 q = t * 0.5307027145f + (-0.7265760135f); q = q * t + 0.7107068705f; q = q * t + (-0.142248368f); q = q * t + 0.127414796f; q = q * t;
    const f32x2 s = (v * v) * (-0.72134752044f);
    f32x2 e; e.x = __builtin_amdgcn_exp2f(s.x); e.y = __builtin_amdgcn_exp2f(s.y);
    return v * 0.5f + av * (0.5f - q * e);
}
__device__ __forceinline__ f32x4 gelu4(f32x4 v) { const f32x2 a = gelu_pk((f32x2){v.x, v.y}), b = gelu_pk((f32x2){v.z, v.w}); return (f32x4){a.x, a.y, b.x, b.y}; }
struct EpiSguIn {
    static constexpr bool NEEDS_RS = true, NEEDS_RH = false;
    const GAS float* ssq; GAS bf16_t* U; GAS bf16_t* V; GAS float* lnp; const GAS float* rowsc; float tsc;
    __device__ __forceinline__ void operator()(const Acc& acc, const pg8::Unit& u, int wr, int wc, int fr, int fq, const LAS float* rst) const {
        const int row0 = u.pm * 256 + wr * 64 + fr;
        const bool isv = u.pn >= 8;
        GAS bf16_t* dst = isv ? V + (u.pn - 8) * 256 : U + u.pn * 256;
        float rs[8];
#pragma unroll
        for (int k = 0; k < 8; ++k) rs[k] = rst[(k >> 2) * 128 + (k & 3) * 16];
#pragma unroll
        for (int ai = 0; ai < 2; ++ai)
#pragma unroll
            for (int m = 0; m < 4; ++m) {
                const int row = row0 + ai * 128 + m * 16; const float r1 = rs[4 * ai + m];
                float s1 = 0.f, s2 = 0.f;
#pragma unroll
                for (int bj = 0; bj < 2; ++bj) {
                    const f32x4 a = gelu4(acc[ai][bj][m][0] * r1), b = gelu4(acc[ai][bj][m][1] * r1);
                    *(GAS u32x4*)(dst + (size_t)row * 2048 + bj * 128 + wc * 32 + fq * 8) = pack8(a, b);
                    s1 += (a.x + a.y) + (a.z + a.w) + (b.x + b.y) + (b.z + b.w);
                    s2 += (a.x * a.x + a.y * a.y) + (a.z * a.z + a.w * a.w) + (b.x * b.x + b.y * b.y) + (b.z * b.z + b.w * b.w);
                }
                if (isv) {
                    s1 += __shfl_xor(s1, 16); s1 += __shfl_xor(s1, 32); s2 += __shfl_xor(s2, 16); s2 += __shfl_xor(s2, 32);
                    if (fq == 0) *(GAS f32x2*)(lnp + ((size_t)row * 32 + (u.pn - 8) * 4 + wc) * 2) = (f32x2){s1, s2};
                }
            }
    }
};
struct EpiRetQkv {
    static constexpr bool NEEDS_RS = true, NEEDS_RH = false;
    const GAS float* ssq; const GAS float* rcos; const GAS float* rsin; GAS bf16_t* Q; GAS bf16_t* Kn; GAS bf16_t* V; const GAS float* rowsc; float tsc;
    __device__ __forceinline__ void operator()(const Acc& acc, const pg8::Unit& u, int wr, int wc, int fr, int fq, const LAS float* rst) const {
        const int row0 = u.pm * 256 + wr * 64 + fr;
        const int i0 = wc * 32 + fq * 8;
        const bool isk = u.pn >= 4; const int h = u.pn & 3;
        const float l2g = __builtin_amdgcn_logf(1.0f - __builtin_amdgcn_exp2f(-5.0f - (float)h));
        float rs[8];
#pragma unroll
        for (int k = 0; k < 8; ++k) rs[k] = rst[(k >> 2) * 128 + (k & 3) * 16];
        if (u.pn >= 8) {
#pragma unroll
            for (int ai = 0; ai < 2; ++ai)
#pragma unroll
                for (int m = 0; m < 4; ++m) { const int row = row0 + ai * 128 + m * 16; const float r1 = rs[4 * ai + m];
#pragma unroll
                    for (int bj = 0; bj < 2; ++bj)
                        *(GAS u32x4*)(V + (size_t)row * 2048 + (u.pn - 8) * 256 + bj * 128 + i0) = pack8(acc[ai][bj][m][0] * r1, acc[ai][bj][m][1] * r1); }
        } else {
#pragma unroll
            for (int hp = 0; hp < 4; ++hp) {
                const int ai = hp >> 1;
                f32x4 cs[2][2], sn[2][2];
#pragma unroll
                for (int mm = 0; mm < 2; ++mm) { const int pos = (row0 + ai * 128 + (2 * (hp & 1) + mm) * 16) & (SEQ - 1);
#pragma unroll
                    for (int bj = 0; bj < 2; ++bj) { cs[mm][bj] = *(const GAS f32x4*)(rcos + (size_t)pos * 128 + i0 + 4 * bj); sn[mm][bj] = *(const GAS f32x4*)(rsin + (size_t)pos * 128 + i0 + 4 * bj); } }
#pragma unroll
                for (int mm = 0; mm < 2; ++mm) {
                    const int m = 2 * (hp & 1) + mm;
                    const int row = row0 + ai * 128 + m * 16, pos = row & (SEQ - 1); const float r1 = rs[4 * ai + m];
                    const float sc = isk ? r1 * 0.0625f * __builtin_amdgcn_exp2f(l2g * (float)(127 - (pos & 127))) : r1;
                    f32x4 o1[2], o2[2];
#pragma unroll
                    for (int bj = 0; bj < 2; ++bj) { const f32x4 x1 = acc[ai][bj][m][0] * sc, x2 = acc[ai][bj][m][1] * sc;
                        o1[bj] = x1 * cs[mm][bj] - x2 * sn[mm][bj]; o2[bj] = x2 * cs[mm][bj] + x1 * sn[mm][bj]; }
                    GAS bf16_t* dst = (isk ? Kn : Q) + (size_t)row * D + h * 256 + i0;
                    *(GAS u32x4*)dst = pack8(o1[0], o1[1]); *(GAS u32x4*)(dst + 128) = pack8(o2[0], o2[1]);
                }
            }
        }
    }
};
struct EpiRetG {
    static constexpr bool NEEDS_RS = true, NEEDS_RH = true;
    const GAS float* ssq; const GAS float* hss; GAS bf16_t* Y; const GAS float* rowsc; float tsc;
    __device__ __forceinline__ void operator()(const Acc& acc, const pg8::Unit& u, int wr, int wc, int fr, int fq, const LAS float* rst) const {
        const int row0 = u.pm * 256 + wr * 64 + fr; const int h = u.pn >> 1;
        float rs[8], rh[8];
#pragma unroll
        for (int k = 0; k < 8; ++k) { rs[k] = rst[(k >> 2) * 128 + (k & 3) * 16]; rh[k] = rst[4096 + (k >> 2) * 128 + (k & 3) * 16]; }
#pragma unroll
        for (int ai = 0; ai < 2; ++ai) {
            u32x4 ov[4][2];
#pragma unroll
            for (int m = 0; m < 4; ++m)
#pragma unroll
                for (int bj = 0; bj < 2; ++bj) ov[m][bj] = *(const GAS u32x4*)(Y + (size_t)(row0 + ai * 128 + m * 16) * 2048 + u.pn * 256 + bj * 128 + wc * 32 + fq * 8);
#pragma unroll
            for (int m = 0; m < 4; ++m) {
                const int row = row0 + ai * 128 + m * 16; const float r1 = rs[4 * ai + m], r3 = rh[4 * ai + m];
#pragma unroll
                for (int bj = 0; bj < 2; ++bj) {
                    GAS bf16_t* p = Y + (size_t)row * 2048 + u.pn * 256 + bj * 128 + wc * 32 + fq * 8;
                    const u32x4 o = ov[m][bj];
                    const f32x4 g0 = acc[ai][bj][m][0] * r1, g1 = acc[ai][bj][m][1] * r1;
                    const f32x4 a = (f32x4){silu_f(g0.x) * bf_lo(o.x), silu_f(g0.y) * bf_hi(o.x), silu_f(g0.z) * bf_lo(o.y), silu_f(g0.w) * bf_hi(o.y)} * r3;
                    const f32x4 b = (f32x4){silu_f(g1.x) * bf_lo(o.z), silu_f(g1.y) * bf_hi(o.z), silu_f(g1.z) * bf_lo(o.w), silu_f(g1.w) * bf_hi(o.w)} * r3;
                    *(GAS u32x4*)p = pack8(a, b);
                }
            }
        }
    }
};
template <int MB = 4> struct EpiResidT {
    static constexpr bool NEEDS_RS = false, NEEDS_RH = false;
    GAS bf16_t* xb; GAS float* ssq; float osc; GAS unsigned char* x8;
    __device__ __forceinline__ void operator()(const Acc& acc, const pg8::Unit& u, int wr, int wc, int fr, int fq, const LAS float* rst) const {
        const int row0 = u.pm * 256 + wr * 64 + fr, col0 = u.pn * 256 + wc * 32 + fq * 8;
#pragma unroll
        for (int ai = 0; ai < 2; ++ai)
#pragma unroll
        for (int mh = 0; mh < 4; mh += MB) {
            u32x4 bv[4][2];
#pragma unroll
            for (int m = mh; m < mh + MB; ++m)
#pragma unroll
                for (int bj = 0; bj < 2; ++bj) bv[m][bj] = *(const GAS u32x4*)(xb + (size_t)(row0 + ai * 128 + m * 16) * D + col0 + bj * 128);
#pragma unroll
            for (int m = mh; m < mh + MB; ++m) {
                const int row = row0 + ai * 128 + m * 16;
                GAS bf16_t* p = xb + (size_t)row * D + col0;
                float s2 = 0.f;
#pragma unroll
                for (int bj = 0; bj < 2; ++bj) {
                    const u32x4 b = bv[m][bj];
                    const f32x4 x0 = (f32x4){bf_lo(b.x), bf_hi(b.x), bf_lo(b.y), bf_hi(b.y)} + acc[ai][bj][m][0] * osc;
                    const f32x4 x1 = (f32x4){bf_lo(b.z), bf_hi(b.z), bf_lo(b.w), bf_hi(b.w)} + acc[ai][bj][m][1] * osc;
                    *(GAS u32x4*)(p + bj * 128) = pack8(x0, x1);
                    if (x8) { u32x2 w8;
                        w8.x = (unsigned)__builtin_amdgcn_cvt_pk_fp8_f32(x0.z, x0.w, __builtin_amdgcn_cvt_pk_fp8_f32(x0.x, x0.y, 0, false), true);
                        w8.y = (unsigned)__builtin_amdgcn_cvt_pk_fp8_f32(x1.z, x1.w, __builtin_amdgcn_cvt_pk_fp8_f32(x1.x, x1.y, 0, false), true);
                        *(GAS u32x2*)(x8 + (size_t)row * D + col0 + bj * 128) = w8; }
                    s2 += (x0.x * x0.x + x0.y * x0.y) + (x0.z * x0.z + x0.w * x0.w) + (x1.x * x1.x + x1.y * x1.y) + (x1.z * x1.z + x1.w * x1.w);
                }
                s2 += __shfl_xor(s2, 16); s2 += __shfl_xor(s2, 32);
                if (fq == 0) ssq[(size_t)row * 16 + u.pn * 4 + wc] = s2;
            }
        }
    }
};
typedef EpiResidT<4> EpiResid;

struct Args { const float* in[18]; float* out; unsigned char* ws; int ph_lo, ph_hi, li, pad; };

struct Frame {
    LAS unsigned char* lds;
    int tid, lane, wave, vcu, G;
};

enum { MAP_NAT = 0, MAP_P8 = 1, MAP_CONV = 2, MAP_RETQKV = 3, MAP_FFN = 4 };
struct PrepJob { const GAS float* src; const GAS float* src2; const GAS float* gain; GAS bf16_t* dst; int ld, N, K, map; float f8scale, i8scale; };
__device__ __forceinline__ void prep_item(const PrepJob& J, int item, LAS float* scr, int lane) {
    const int nb = J.N / 64, kb = item / nb, r = item % nb, pn = r >> 2, wc = r & 3;
    const int k0 = kb * 64;
    const int sl = 128 * (lane >> 5) + 32 * wc + (lane & 31);
    const int slot = 256 * pn + sl;
    const GAS float* src = J.src; int col;
    {
        const int bj = sl >> 7, n = (sl >> 4) & 1, fq = (sl >> 2) & 3, j = sl & 3, ch = 32 * wc + 8 * fq + 4 * bj + j;
        const int p8 = (slot & ~31) + pg8::perm32(slot & 31);
        if (J.map == MAP_NAT) col = slot;
        else if (J.map == MAP_P8) col = p8;
        else if (J.map == MAP_CONV) col = (pn < 4) ? p8 : (1024 + 1024 * n + 128 * (pn - 4) + ch);
        else if (J.map == MAP_RETQKV) col = (pn < 8) ? (256 * pn + 128 * n + ch) : p8;
        else { col = 128 * pn + ch; if (n) src = J.src2; }
    }
    const GAS float* sp = src + (size_t)k0 * J.ld + col;
#pragma unroll
    for (int hk = 0; hk < 2; ++hk) {
        float wv[32];
#pragma unroll
        for (int k = 0; k < 32; ++k) wv[k] = sp[(size_t)(32 * hk + k) * J.ld];
#pragma unroll
        for (int k = 0; k < 32; ++k) scr[(32 * hk + k) * 65 + lane] = wv[k];
    }
    asm volatile("s_waitcnt lgkmcnt(0)" ::: "memory");
    const int c = lane & 7;
    float gn[8];
#pragma unroll
    for (int e = 0; e < 8; ++e) gn[e] = J.gain ? J.gain[k0 + 8 * c + e] : 1.0f;
#pragma unroll
    for (int it = 0; it < 8; ++it) {
        const int l2 = it * 8 + (lane >> 3);
        const int slot2 = 256 * pn + 128 * (l2 >> 5) + 32 * wc + (l2 & 31);
        const LAS float* s = scr + (8 * c) * 65 + l2;
        if (J.i8scale != 0.f) {
            const float f = J.i8scale; unsigned b8[8];
#pragma unroll
            for (int e = 0; e < 8; ++e) b8[e] = (unsigned)(int)fminf(fmaxf(rintf(s[e * 65] * gn[e] * f), -127.f), 127.f) & 255u;
            u32x2 o8; o8.x = b8[0] | (b8[1] << 8) | (b8[2] << 16) | (b8[3] << 24); o8.y = b8[4] | (b8[5] << 8) | (b8[6] << 16) | (b8[7] << 24);
            *(GAS u32x2*)((GAS unsigned char*)J.dst + (size_t)slot2 * J.K + k0 + 8 * c) = o8;
        } else if (J.f8scale != 0.f) {
            const float f = J.f8scale; u32x2 o8;
            o8.x = (unsigned)__builtin_amdgcn_cvt_pk_fp8_f32(s[2 * 65] * gn[2] * f, s[3 * 65] * gn[3] * f, __builtin_amdgcn_cvt_pk_fp8_f32(s[0] * gn[0] * f, s[65] * gn[1] * f, 0, false), true);
            o8.y = (unsigned)__builtin_amdgcn_cvt_pk_fp8_f32(s[6 * 65] * gn[6] * f, s[7 * 65] * gn[7] * f, __builtin_amdgcn_cvt_pk_fp8_f32(s[4 * 65] * gn[4] * f, s[5 * 65] * gn[5] * f, 0, false), true);
            *(GAS u32x2*)((GAS unsigned char*)J.dst + (size_t)slot2 * J.K + k0 + 8 * c) = o8;
        } else {
        u32x4 o; o.x = pk2(s[0] * gn[0], s[65] * gn[1]); o.y = pk2(s[2 * 65] * gn[2], s[3 * 65] * gn[3]); o.z = pk2(s[4 * 65] * gn[4], s[5 * 65] * gn[5]); o.w = pk2(s[6 * 65] * gn[6], s[7 * 65] * gn[7]);
        *(GAS u32x4*)(J.dst + (size_t)slot2 * J.K + k0 + 8 * c) = o;
        }
    }
    asm volatile("s_waitcnt lgkmcnt(0)" ::: "memory");
}
__device__ __forceinline__ void p0_wabs(const Frame& F, const Args& a) {
    const int tid_ = opq_tid(), lane_ = tid_ & 63, wave_ = __builtin_amdgcn_readfirstlane(tid_ >> 6);
    const int gw = F.vcu * 8 + wave_, NGW = F.G * 8;
#pragma unroll 1
    for (int L = 0; L < NLAYER; ++L) {
        if (!((I8_F1_LAYERS >> L) & 1)) continue;
        float sq = 0.f;
        for (int rr = gw; rr < 2 * 1024; rr += NGW) {
            const int k = rr & 1023; const GAS float* src = (const GAS float*)((rr < 1024 ? a.in[15] : a.in[16]) + ((size_t)L * 1024 + k) * DFF);
            const float gk = ((const GAS float*)a.in[2])[L * D + k];
            float m = 0.f;
#pragma unroll
            for (int j = 0; j < 11; ++j) { const f32x4 v = ((const GAS f32x4*)src)[lane_ + 64 * j]; m += (v.x * v.x + v.y * v.y) + (v.z * v.z + v.w * v.w); }
            sq += m * (gk * gk);
        }
        sq = wave_sum(sq);
        if (lane_ == 0 && gw < 2048) ((GAS float*)(a.ws + WS_CTL))[CTL_WSS + 2048 * L + gw] = sq;
    }
    if (I8_CONV3) {
        float sq0 = 0.f;
        for (int k = gw; k < 1024; k += NGW) {
            const GAS f32x4* src = (const GAS f32x4*)(a.in[4] + ((size_t)1024 + k) * 3072);
            const float gk = ((const GAS float*)a.in[1])[3 * D + k];
            float m0 = 0.f;
#pragma unroll
            for (int j = 0; j < 12; ++j) { const f32x4 v = src[lane_ + 64 * j]; m0 += (v.x * v.x + v.y * v.y) + (v.z * v.z + v.w * v.w); }
            sq0 += m0 * (gk * gk);
        }
        sq0 = wave_sum(sq0);
        if (lane_ == 0 && gw < 2048) ((GAS float*)(a.ws + WS_CTL))[CTL_WSS + 2048 * 7 + gw] = sq0;
    }
    if (I8_SGU) {
        float sq0 = 0.f;
        for (int k = gw; k < 1024; k += NGW) {
            const GAS f32x4* src = (const GAS f32x4*)(a.in[7] + (size_t)k * 4096);
            const float gk = ((const GAS float*)a.in[1])[1 * D + k];
            float m0 = 0.f;
#pragma unroll
            for (int j = 0; j < 16; ++j) { const f32x4 v = src[lane_ + 64 * j]; m0 += (v.x * v.x + v.y * v.y) + (v.z * v.z + v.w * v.w); }
            sq0 += m0 * (gk * gk);
        }
        sq0 = wave_sum(sq0);
        if (lane_ == 0 && gw < 2048) ((GAS float*)(a.ws + WS_CTL))[CTL_WSS + 2048 * 6 + gw] = sq0;
    }
    if (I8_RET) {
        float sq0 = 0.f, sq1 = 0.f;
        for (int k = gw; k < 1024; k += NGW) {
            const GAS f32x4* src = (const GAS f32x4*)(a.in[13] + (size_t)k * 6144);
            const float gk = ((const GAS float*)a.in[1])[2 * D + k];
            float m0 = 0.f, m1 = 0.f;
#pragma unroll
            for (int j = 0; j < 16; ++j) { const f32x4 v = src[lane_ + 64 * j]; m0 += (v.x * v.x + v.y * v.y) + (v.z * v.z + v.w * v.w); }
#pragma unroll
            for (int j = 16; j < 24; ++j) { const f32x4 v = src[lane_ + 64 * j]; m1 += (v.x * v.x + v.y * v.y) + (v.z * v.z + v.w * v.w); }
            sq0 += m0 * (gk * gk); sq1 += m1 * (gk * gk);
        }
        sq0 = wave_sum(sq0); sq1 = wave_sum(sq1);
        if (lane_ == 0 && gw < 2048) { ((GAS float*)(a.ws + WS_CTL))[CTL_WSS + 2048 * 4 + gw] = sq0; ((GAS float*)(a.ws + WS_CTL))[CTL_WSS + 2048 * 5 + gw] = sq1; }
    }
}
__device__ __forceinline__ float i8_wfull(const unsigned char* ws, int L, int lane, float inv_count = 1.0f / (2.0f * 1024.0f * DFF)) {
    const GAS float* p = (const GAS float*)(ws + WS_CTL) + CTL_WSS + 2048 * L;
    float t = 0.f;
#pragma unroll 4
    for (int j = 0; j < 32; ++j) t += p[lane + 64 * j];
    t = wave_sum(t);
    return fmaxf(WCLIP * sqrtf(t * inv_count), 1e-30f);
}
__device__ __forceinline__ void quant_phase(const Frame& F, const GAS bf16_t* xb, GAS unsigned char* x8, GAS float* sa) {
    const int tid_ = opq_tid(), lane_ = tid_ & 63, wave_ = __builtin_amdgcn_readfirstlane(tid_ >> 6);
    const int gw = F.vcu * 8 + wave_, NGW = F.G * 8;
    for (int row = 4 * gw; row < M; row += 4 * NGW) {
        u32x4 v[4][2];
#pragma unroll
        for (int r = 0; r < 4; ++r) { const GAS u32x4* p = (const GAS u32x4*)(xb + (size_t)(row + r) * D) + 2 * lane_; v[r][0] = p[0]; v[r][1] = p[1]; }
#pragma unroll
        for (int r = 0; r < 4; ++r) {
            float x[16];
#pragma unroll
            for (int h = 0; h < 2; ++h)
#pragma unroll
                for (int e = 0; e < 4; ++e) { x[8 * h + 2 * e] = bf_lo(v[r][h][e]); x[8 * h + 2 * e + 1] = bf_hi(v[r][h][e]); }
            float m = 0.f;
#pragma unroll
            for (int e = 0; e < 16; ++e) m = fmaxf(m, fabsf(x[e]));
            m = fmaxf(wave_max(m), 1e-30f);
            const float qs = 127.0f / m;
            unsigned w[4];
#pragma unroll
            for (int d = 0; d < 4; ++d) { unsigned t = 0u;
#pragma unroll
                for (int e = 0; e < 4; ++e) t |= ((unsigned)(int)rintf(x[4 * d + e] * qs) & 255u) << (8 * e);
                w[d] = t; }
            *((GAS u32x4*)(x8 + (size_t)(row + r) * D) + lane_) = (u32x4){w[0], w[1], w[2], w[3]};
            if (lane_ == 0) sa[row + r] = m * (1.0f / 127.0f);
        }
    }
}
__device__ __forceinline__ void p0_prologue(const Frame& F, const Args& a) {
    unsigned char* ws = a.ws;
    const int tid_ = opq_tid(), lane_ = tid_ & 63, wave_ = __builtin_amdgcn_readfirstlane(tid_ >> 6);
    LAS float* scr = (LAS float*)(F.lds + wave_ * 16640);
    const int gw = F.vcu * 8 + wave_, NGW = F.G * 8;
    constexpr int NJOB = 17;
    int start = 0;
#pragma unroll 1
    for (int jb = 0; jb < NJOB; ++jb) {
        PrepJob J; J.f8scale = 0.f; J.i8scale = 0.f;
        if (jb < 2)       { J.src = (const GAS float*)(a.in[4] + (size_t)jb * 1024 * 3072); J.src2 = nullptr; J.gain = (const GAS float*)(a.in[1] + (jb == 0 ? 0 : 3) * D); J.dst = (GAS bf16_t*)(ws + W_CI + jb * W_CI_SZ); J.ld = 3072; J.N = 3072; J.K = 1024; J.map = MAP_CONV; if (I8_CONV3 && jb == 1) J.i8scale = 127.0f / i8_wfull(ws, 7, lane_, 1.0f / (1024.0f * 3072.0f)); }
        else if (jb < 4)  { const int j = jb - 2; J.src = (const GAS float*)(a.in[6] + (size_t)j * 1024 * 1024); J.src2 = nullptr; J.gain = nullptr; J.dst = (GAS bf16_t*)(ws + W_CO + j * W_CO_SZ); J.ld = 1024; J.N = 1024; J.K = 1024; J.map = MAP_P8; }
        else if (jb == 4) { J.src = (const GAS float*)(a.in[7]); J.src2 = nullptr; J.gain = (const GAS float*)(a.in[1] + 1 * D); J.dst = (GAS bf16_t*)(ws + W_SI); J.ld = 4096; J.N = 4096; J.K = 1024; J.map = MAP_P8; if (I8_SGU) J.i8scale = 127.0f / i8_wfull(ws, 6, lane_, 1.0f / (1024.0f * 4096.0f)); }
        else if (jb == 5) { J.src = (const GAS float*)(a.in[12]); J.src2 = nullptr; J.gain = nullptr; J.dst = (GAS bf16_t*)(ws + W_SO); J.ld = 1024; J.N = 1024; J.K = 2048; J.map = MAP_P8; }
        else if (jb == 6) { J.src = (const GAS float*)(a.in[13]); J.src2 = nullptr; J.gain = (const GAS float*)(a.in[1] + 2 * D); J.dst = (GAS bf16_t*)(ws + W_RQ); J.ld = 6144; J.N = 4096; J.K = 1024; J.map = MAP_RETQKV; if (I8_RET) J.i8scale = 127.0f / i8_wfull(ws, 4, lane_, 1.0f / (1024.0f * 4096.0f)); }
        else if (jb == 7) { J.src = (const GAS float*)(a.in[13] + 4096); J.src2 = nullptr; J.gain = (const GAS float*)(a.in[1] + 2 * D); J.dst = (GAS bf16_t*)(ws + W_RG); J.ld = 6144; J.N = 2048; J.K = 1024; J.map = MAP_P8; if (I8_RET) J.i8scale = 127.0f / i8_wfull(ws, 5, lane_, 1.0f / (1024.0f * 2048.0f)); }
        else if (jb == 8) { J.src = (const GAS float*)(a.in[14]); J.src2 = nullptr; J.gain = nullptr; J.dst = (GAS bf16_t*)(ws + W_RO); J.ld = 1024; J.N = 1024; J.K = 2048; J.map = MAP_P8; }
        else if (jb < 13) { const int L = jb - 9; J.src = (const GAS float*)(a.in[15] + (size_t)L * 1024 * DFF); J.src2 = (const GAS float*)(a.in[16] + (size_t)L * 1024 * DFF); J.gain = (const GAS float*)(a.in[2] + L * D); J.dst = (GAS bf16_t*)(ws + W_FI + L * W_FI_SZ); J.ld = DFF; J.N = 2 * DFF; J.K = 1024; J.map = MAP_FFN; J.f8scale = ((F8_F1_LAYERS >> L) & 1) ? FI_WSCALE : 0.f;
                            if ((I8_F1_LAYERS >> L) & 1) J.i8scale = 127.0f / i8_wfull(ws, L, lane_); }
        else              { const int L = jb - 13; J.src = (const GAS float*)(a.in[17] + (size_t)L * DFF * 1024); J.src2 = nullptr; J.gain = nullptr; J.dst = (GAS bf16_t*)(ws + W_FD + L * W_FD_SZ); J.ld = 1024; J.N = 1024; J.K = DFF; J.map = MAP_P8; J.f8scale = ((F8_LAYERS >> L) & 1) ? FD_WSCALE : 0.f; }
        const int nitems = (J.K / 64) * (J.N / 64);
        int first = (gw - start % NGW + NGW) % NGW;
        for (int it = first; it < nitems; it += NGW) prep_item(J, it, scr, lane_);
        start += nitems;
    }
    {
        const GAS float* x = (const GAS float*)a.in[0]; GAS bf16_t* xb = (GAS bf16_t*)(ws + WS_XB); GAS float* ssq = (GAS float*)(ws + WS_SSQ);
        for (int row = 4 * gw; row < M; row += 4 * NGW) {
            f32x4 v[4][4];
#pragma unroll
            for (int r = 0; r < 4; ++r)
#pragma unroll
                for (int j = 0; j < 4; ++j) v[r][j] = ((const GAS f32x4*)(x + (size_t)(row + r) * D))[lane_ + 64 * j];
#pragma unroll
            for (int r = 0; r < 4; ++r) {
                float sq = 0.f;
#pragma unroll
                for (int j = 0; j < 4; ++j) sq += (v[r][j].x * v[r][j].x + v[r][j].y * v[r][j].y) + (v[r][j].z * v[r][j].z + v[r][j].w * v[r][j].w);
                sq = wave_sum(sq);
                GAS u32x2* o8 = (GAS u32x2*)(xb + (size_t)(row + r) * D) + lane_;
#pragma unroll
                for (int j = 0; j < 4; ++j) { u32x2 w; w.x = pk2(v[r][j].x, v[r][j].y); w.y = pk2(v[r][j].z, v[r][j].w); o8[64 * j] = w; }
                if (lane_ < 16) ssq[(size_t)(row + r) * 16 + lane_] = (lane_ == 0) ? sq : 0.f;
            }
        }
    }
    {
        GAS float* rc = (GAS float*)(ws + WS_ROT); GAS float* rsn = rc + (size_t)SEQ * 128;
        const int gt = F.vcu * 512 + tid_, NGT = F.G * 512;
        for (int idx = gt; idx < SEQ * 128; idx += NGT) {
            const int i = idx & 127, pos = idx >> 7;
            const float inv = __builtin_amdgcn_exp2f(-(float)i * (13.287712379549449f / 128.0f));
            const float ang = (float)pos * inv;
            const double ad = (double)ang;
            const double kq = __builtin_rint(ad * 0.63661977236758134308);
            const double y = __builtin_fma(-kq, 1.57079632679489661923, ad) - kq * 6.123233995736766e-17;
            const double y2 = y * y;
            const double sp = y * (1.0 + y2 * (-1.0 / 6 + y2 * (1.0 / 120 + y2 * (-1.0 / 5040 + y2 * (1.0 / 362880 + y2 * (-1.0 / 39916800))))));
            const double cp = 1.0 + y2 * (-0.5 + y2 * (1.0 / 24 + y2 * (-1.0 / 720 + y2 * (1.0 / 40320 + y2 * (-1.0 / 3628800 + y2 * (1.0 / 479001600))))));
            const int q = ((int)(long long)kq) & 3;
            const double sv = (q == 0) ? sp : (q == 1) ? cp : (q == 2) ? -sp : -cp;
            const double cv = (q == 0) ? cp : (q == 1) ? -sp : (q == 2) ? -cp : sp;
            rc[idx] = (float)cv; rsn[idx] = (float)sv;
        }
        const GAS float* wsp = (const GAS float*)a.in[10]; GAS bf16_t* wd = (GAS bf16_t*)(ws + W_WS);
        for (int idx = gt; idx < 8 * 128 * 128; idx += NGT) { const int s = idx & 127, t = (idx >> 7) & 127; wd[idx] = (bf16_t)f2bf(s <= t ? wsp[idx] : 0.f); }
    }
}

__device__ __forceinline__ void conv_phase(const Frame& F, const GAS bf16_t* Bo, const GAS bf16_t* CZ, const GAS float* cw, GAS bf16_t* Y) {
    constexpr int RB = 16;
    const int nitem = (M / RB) * 128;
    const int tid_ = opq_tid();
    for (int it = F.vcu * 512 + tid_; it < nitem; it += F.G * 512) {
        const int cc = it & 127, rb = it >> 7, r0 = rb * RB, c0 = cc * 8;
        float w0[8], w1[8], w2[8];
#pragma unroll
        for (int e = 0; e < 8; ++e) { w0[e] = cw[c0 + e]; w1[e] = cw[D + c0 + e]; w2[e] = cw[2 * D + c0 + e]; }
        u32x4 p2 = (u32x4){0, 0, 0, 0}, p1 = (u32x4){0, 0, 0, 0};
        if ((r0 & (SEQ - 1)) != 0) { p2 = *(const GAS u32x4*)(CZ + (size_t)(r0 - 2) * D + c0); p1 = *(const GAS u32x4*)(CZ + (size_t)(r0 - 1) * D + c0); }
#pragma unroll
        for (int hb = 0; hb < 2; ++hb) {
            u32x4 pz[8], pb[8];
#pragma unroll
            for (int r = 0; r < 8; ++r) { const size_t off = (size_t)(r0 + 8 * hb + r) * D + c0; pz[r] = *(const GAS u32x4*)(CZ + off); pb[r] = *(const GAS u32x4*)(Bo + off); }
#pragma unroll
            for (int r = 0; r < 8; ++r) {
                const size_t off = (size_t)(r0 + 8 * hb + r) * D + c0;
                const u32x4 p0 = pz[r], bv = pb[r];
                u32x4 o;
#pragma unroll
                for (int q = 0; q < 4; ++q) {
                    const float lo = bf_lo(bv[q]) * (w0[2 * q] * bf_lo(p2[q]) + w1[2 * q] * bf_lo(p1[q]) + w2[2 * q] * bf_lo(p0[q]));
                    const float hi = bf_hi(bv[q]) * (w0[2 * q + 1] * bf_hi(p2[q]) + w1[2 * q + 1] * bf_hi(p1[q]) + w2[2 * q + 1] * bf_hi(p0[q]));
                    o[q] = pk2(lo, hi);
                }
                *(GAS u32x4*)(Y + off) = o;
                p2 = p1; p1 = p0;
            }
        }
    }
}

constexpr int SG_W = 0, SG_WSTR = 272, SG_T = 128 * SG_WSTR, SG_TSTR = 272, SG_ST = SG_T + 256 * SG_TSTR, SG_LG = SG_ST + 1024, SG_END = SG_LG + 2048;
static_assert(SG_END <= LDS_MISC, "sgu lds");
__device__ __forceinline__ void sgu_phase(const Frame& F, GAS bf16_t* U, const GAS bf16_t* V, const GAS float* lnp, const GAS bf16_t* Wt, const GAS float* lng, const GAS float* lnb, const GAS float* bs) {
    LAS unsigned char* lds = F.lds;
    const int tid = opq_tid(), lane = tid & 63, w = __builtin_amdgcn_readfirstlane(tid >> 6), fr = lane & 15, fq = lane >> 4;
    const int s = tid & 127, dg = tid >> 7;
    const int srow = tid >> 2, spart = tid & 3;
    int gcur = -1;
    u32x4 vreg[8]; f32x4 lnv[4];
    int un = F.vcu;
    if (un < 2048) {
        const int g = un & 7, row0 = (un >> 3) * 128;
        const GAS bf16_t* vp = V + (size_t)(row0 + s) * 2048 + g * 256;
#pragma unroll
        for (int i = 0; i < 8; ++i) vreg[i] = *(const GAS u32x4*)(vp + (dg + 4 * i) * 8);
        const GAS f32x4* lp = (const GAS f32x4*)(lnp + (size_t)(row0 + srow) * 64 + spart * 16);
#pragma unroll
        for (int i = 0; i < 4; ++i) lnv[i] = lp[i];
    }
    for (; un < 2048; un += F.G) {
        const int g = un & 7, c = un >> 3, row0 = c * 128;
        __syncthreads();
        if (g != gcur) {
            gcur = g;
            const GAS bf16_t* wg = Wt + (size_t)g * 128 * 128;
#pragma unroll
            for (int i = 0; i < 4; ++i) { const int p = tid + 512 * i, t = p >> 4, c16 = p & 15; *(LAS u32x4*)(lds + SG_W + t * SG_WSTR + c16 * 16) = *(const GAS u32x4*)(wg + t * 128 + c16 * 8); }
            if (tid < 256) { ((LAS float*)(lds + SG_LG))[tid] = lng[g * 256 + tid]; } else { ((LAS float*)(lds + SG_LG))[tid] = lnb[g * 256 + tid - 256]; }
        }
        {
            float s1 = 0.f, s2 = 0.f;
#pragma unroll
            for (int i = 0; i < 4; ++i) { s1 += lnv[i].x + lnv[i].z; s2 += lnv[i].y + lnv[i].w; }
            s1 += __shfl_xor(s1, 1); s2 += __shfl_xor(s2, 1); s1 += __shfl_xor(s1, 2); s2 += __shfl_xor(s2, 2);
            const float mu = s1 * (1.0f / 2048.0f), var = s2 * (1.0f / 2048.0f) - mu * mu;
            if (spart == 0) { ((LAS float*)(lds + SG_ST))[srow] = mu; ((LAS float*)(lds + SG_ST))[128 + srow] = rsqrtf(fmaxf(var, 0.f) + LN_EPS); }
        }
        __syncthreads();
        {
            const float mu = ((LAS float*)(lds + SG_ST))[s], r = ((LAS float*)(lds + SG_ST))[128 + s];
#pragma unroll
            for (int i = 0; i < 8; ++i) {
                const int dc = dg + 4 * i, d0 = dc * 8;
                const u32x4 v = vreg[i];
                const f32x4 g0 = *(const LAS f32x4*)(lds + SG_LG + d0 * 4), g1 = *(const LAS f32x4*)(lds + SG_LG + d0 * 4 + 16);
                const f32x4 b0 = *(const LAS f32x4*)(lds + SG_LG + 1024 + d0 * 4), b1 = *(const LAS f32x4*)(lds + SG_LG + 1024 + d0 * 4 + 16);
                LAS bf16_t* tp = (LAS bf16_t*)(lds + SG_T + d0 * SG_TSTR) + s;
                tp[0 * (SG_TSTR / 2)] = (bf16_t)f2bf((bf_lo(v.x) - mu) * r * g0.x + b0.x);
                tp[1 * (SG_TSTR / 2)] = (bf16_t)f2bf((bf_hi(v.x) - mu) * r * g0.y + b0.y);
                tp[2 * (SG_TSTR / 2)] = (bf16_t)f2bf((bf_lo(v.y) - mu) * r * g0.z + b0.z);
                tp[3 * (SG_TSTR / 2)] = (bf16_t)f2bf((bf_hi(v.y) - mu) * r * g0.w + b0.w);
                tp[4 * (SG_TSTR / 2)] = (bf16_t)f2bf((bf_lo(v.z) - mu) * r * g1.x + b1.x);
                tp[5 * (SG_TSTR / 2)] = (bf16_t)f2bf((bf_hi(v.z) - mu) * r * g1.y + b1.y);
                tp[6 * (SG_TSTR / 2)] = (bf16_t)f2bf((bf_lo(v.w) - mu) * r * g1.z + b1.z);
                tp[7 * (SG_TSTR / 2)] = (bf16_t)f2bf((bf_hi(v.w) - mu) * r * g1.w + b1.w);
            }
        }
        u32x4 uv[8];
#pragma unroll
        for (int tb = 0; tb < 8; ++tb) uv[tb] = *(const GAS u32x4*)(U + (size_t)(row0 + 16 * tb + fr) * 2048 + g * 256 + 32 * w + 8 * fq);
        if (un + F.G < 2048) {
            const int un2 = un + F.G, g2 = un2 & 7, row2 = (un2 >> 3) * 128;
            const GAS bf16_t* vp = V + (size_t)(row2 + s) * 2048 + g2 * 256;
#pragma unroll
            for (int i = 0; i < 8; ++i) vreg[i] = *(const GAS u32x4*)(vp + (dg + 4 * i) * 8);
            const GAS f32x4* lp = (const GAS f32x4*)(lnp + (size_t)(row2 + srow) * 64 + spart * 16);
#pragma unroll
            for (int i = 0; i < 4; ++i) lnv[i] = lp[i];
        }
        __syncthreads();
        f32x4 acc[8][2];
#pragma unroll
        for (int tb = 0; tb < 8; ++tb) { acc[tb][0] = (f32x4){0.f, 0.f, 0.f, 0.f}; acc[tb][1] = (f32x4){0.f, 0.f, 0.f, 0.f}; }
        const int drow0 = 32 * w + 8 * (fr >> 2) + (fr & 3);
#pragma unroll
        for (int ks = 0; ks < 4; ++ks) {
            const bf16x8 t0 = *(const LAS bf16x8*)(lds + SG_T + drow0 * SG_TSTR + ks * 64 + fq * 16);
            const bf16x8 t1 = *(const LAS bf16x8*)(lds + SG_T + (drow0 + 4) * SG_TSTR + ks * 64 + fq * 16);
#pragma unroll
            for (int tb = 2 * ks; tb < 8; ++tb) {
                const bf16x8 wf = *(const LAS bf16x8*)(lds + SG_W + (16 * tb + fr) * SG_WSTR + ks * 64 + fq * 16);
                acc[tb][0] = __builtin_amdgcn_mfma_f32_16x16x32_bf16(t0, wf, acc[tb][0], 0, 0, 0);
                acc[tb][1] = __builtin_amdgcn_mfma_f32_16x16x32_bf16(t1, wf, acc[tb][1], 0, 0, 0);
            }
        }
#pragma unroll
        for (int tb = 0; tb < 8; ++tb) {
            const int t = 16 * tb + fr;
            const float bb = bs[g * 128 + t];
            GAS bf16_t* up = U + (size_t)(row0 + t) * 2048 + g * 256 + 32 * w + 8 * fq;
            const f32x4 a = acc[tb][0] + bb, b = acc[tb][1] + bb;
            const f32x4 ya = (f32x4){a.x * bf_lo(uv[tb].x), a.y * bf_hi(uv[tb].x), a.z * bf_lo(uv[tb].y), a.w * bf_hi(uv[tb].y)};
            const f32x4 yb = (f32x4){b.x * bf_lo(uv[tb].z), b.y * bf_hi(uv[tb].z), b.z * bf_lo(uv[tb].w), b.w * bf_hi(uv[tb].w)};
            *(GAS u32x4*)up = pack8(ya, yb);
        }
    }
    __syncthreads();
}

constexpr int RT_K0 = 0, RT_KB = 65536, RT_ST = 131072, RT_STSTR = 528, RT_VT = RT_ST + 32 * RT_STSTR, RT_VTSTR = 288, RT_END = RT_VT + 32 * RT_VTSTR;
static_assert(RT_END <= LDS_MISC, "ret lds");
typedef short s16x4 __attribute__((ext_vector_type(4)));
__device__ __forceinline__ void ret_phase(const Frame& F, const GAS bf16_t* Q, const GAS bf16_t* Kn, GAS bf16_t* Vb, GAS float* hss) {
    LAS unsigned char* lds = F.lds;
    const int tid = opq_tid(), lane = tid & 63, w = __builtin_amdgcn_readfirstlane(tid >> 6), fr = lane & 15, fq = lane >> 4;
    const int jb = (w < 4) ? w : 11 - w;
    const int srow = tid >> 5, sslot = tid & 31, spiece = ((sslot & 15) ^ (srow & 15)) | (sslot & 16);
    const unsigned voffK = (unsigned)(srow * D + 8 * spiece) * 2u;
    int koffx[4];
#pragma unroll
    for (int k4 = 0; k4 < 4; ++k4) koffx[k4] = fr * 512 + ((((4 * k4 + fq) & 15) ^ fr) << 4);
    int troff[2][2];
#pragma unroll
    for (int db = 0; db < 2; ++db)
#pragma unroll
        for (int t = 0; t < 2; ++t) {
            const int q = fr >> 2, p = fr & 3, m = 8 * fq + 4 * t + q, c = 4 * w + 2 * db + (p >> 1);
            troff[db][t] = m * 512 + ((((c & 15) ^ (m & 15)) | (c & 16)) << 4) + 8 * (p & 1);
        }
    for (int item = F.vcu; item < 256; item += F.G) {
        const int es = item & 15, bh = item >> 4, h = bh & 3, b = bh >> 2;
        const float gam = 1.0f - __builtin_amdgcn_exp2f(-5.0f - (float)h);
        const float l2g = __builtin_amdgcn_logf(gam);
        const float cdec = __builtin_amdgcn_exp2f(128.0f * l2g);
        const size_t rowb = (size_t)b * SEQ;
        const GAS bf16_t* Qh = Q + rowb * D + h * 256;
        const GAS char* Kh = (const GAS char*)(Kn + rowb * D + h * 256);
        GAS bf16_t* Vh = Vb + rowb * 2048 + h * 512 + es * 32;
        GAS float* hs = hss + (rowb * RH + h) * 16 + es;
        __syncthreads();
        for (int i = tid; i < 32 * RT_STSTR / 4; i += 512) ((LAS unsigned*)(lds + RT_ST))[i] = 0u;
        f32x4 sst[2][2];
#pragma unroll
        for (int eb = 0; eb < 2; ++eb)
#pragma unroll
            for (int db = 0; db < 2; ++db) sst[eb][db] = (f32x4){0.f, 0.f, 0.f, 0.f};
#define RT_STAGE_K(buf, ci) do { _Pragma("unroll") for (int _i = 0; _i < 8; ++_i) \
            __builtin_amdgcn_global_load_lds((const GAS unsigned*)(Kh + (size_t)(ci) * 128 * D * 2 + (size_t)_i * 16 * D * 2 + voffK), (LAS unsigned*)(lds + (buf) + _i * 8192 + w * 1024), 16, 0, 0); } while (0)
        RT_STAGE_K(RT_K0, 0);
        const int vm = tid >> 2, vp = tid & 3;
        u32x4 vreg = *(const GAS u32x4*)(Vh + (size_t)vm * 2048 + vp * 8);
        bf16x8 qf[8];
#pragma unroll
        for (int ks = 0; ks < 8; ++ks) qf[ks] = *(const GAS bf16x8*)(Qh + (size_t)(16 * jb + fr) * D + 32 * ks + 8 * fq);
        {
            LAS bf16_t* vt = (LAS bf16_t*)(lds + RT_VT + (8 * vp) * RT_VTSTR) + vm;
#pragma unroll
            for (int q = 0; q < 4; ++q) { vt[(2 * q) * (RT_VTSTR / 2)] = (bf16_t)(vreg[q] & 0xffffu); vt[(2 * q + 1) * (RT_VTSTR / 2)] = (bf16_t)(vreg[q] >> 16); }
        }
        u32x2 pend_ow[2] = {(u32x2){0u, 0u}, (u32x2){0u, 0u}}; float pend_ss = 0.f;
        const int jrow = 16 * jb + fr;
        const float qdec = __builtin_amdgcn_exp2f(l2g * (float)(jrow + 1));
        const float pdec = __builtin_amdgcn_exp2f(l2g * (float)(jrow - 127));
#pragma unroll 1
        for (int ci = 0; ci < SEQ / RC; ++ci) {
            const int kbuf = (ci & 1) ? RT_KB : RT_K0;
            asm volatile("s_waitcnt vmcnt(0) lgkmcnt(0)" ::: "memory"); __builtin_amdgcn_s_barrier(); asm volatile("" ::: "memory");
            const bool more = ci + 1 < SEQ / RC;
#pragma unroll
            for (int ks = 0; ks < 8; ++ks) asm volatile("" : "+v"(qf[ks]));
            if (more) {
                if (ci & 1) RT_STAGE_K(RT_K0, ci + 1); else RT_STAGE_K(RT_KB, ci + 1);
                vreg = *(const GAS u32x4*)(Vh + (size_t)((ci + 1) * 128 + vm) * 2048 + vp * 8);
            }
            if (ci > 0) {
                const size_t row = (size_t)(ci - 1) * 128 + jrow;
#pragma unroll
                for (int eb = 0; eb < 2; ++eb) *(GAS u32x2*)(Vh + row * 2048 + 16 * eb + 4 * fq) = pend_ow[eb];
                if (fq == 0) hs[row * RH * 16] = pend_ss;
            }
            f32x4 oacc[2] = {(f32x4){0.f, 0.f, 0.f, 0.f}, (f32x4){0.f, 0.f, 0.f, 0.f}};
            {
                bf16x8 sf[2][8];
#pragma unroll
                for (int ks = 0; ks < 8; ++ks)
#pragma unroll
                    for (int eb = 0; eb < 2; ++eb) sf[eb][ks] = *(const LAS bf16x8*)(lds + RT_ST + (16 * eb + fr) * RT_STSTR + ks * 64 + fq * 16);
                __builtin_amdgcn_sched_barrier(0);
#pragma unroll
                for (int ks = 0; ks < 8; ++ks)
#pragma unroll
                    for (int eb = 0; eb < 2; ++eb) oacc[eb] = __builtin_amdgcn_mfma_f32_16x16x32_bf16(sf[eb][ks], qf[ks], oacc[eb], 0, 0, 0);
            }
            oacc[0] *= qdec; oacc[1] *= qdec;
#pragma unroll
            for (int kp = 0; kp < 4; ++kp) {
                if (2 * kp <= jb) {
                    const bool two = (2 * kp + 1 <= jb);
                    bf16x8 k0[8], k1[8];
#pragma unroll
                    for (int ks = 0; ks < 8; ++ks) k0[ks] = *(const LAS bf16x8*)(lds + kbuf + (2 * kp) * 8192 + koffx[ks & 3] + (ks >> 2) * 256);
                    if (two) {
#pragma unroll
                        for (int ks = 0; ks < 8; ++ks) k1[ks] = *(const LAS bf16x8*)(lds + kbuf + (2 * kp + 1) * 8192 + koffx[ks & 3] + (ks >> 2) * 256);
                    }
                    u32x2 vlo[2], vhi[2];
#pragma unroll
                    for (int eb = 0; eb < 2; ++eb) { const LAS unsigned char* vb = lds + RT_VT + (16 * eb + fr) * RT_VTSTR + (32 * kp + 4 * fq) * 2; vlo[eb] = *(const LAS u32x2*)vb; vhi[eb] = *(const LAS u32x2*)(vb + 32); }
                    __builtin_amdgcn_sched_barrier(0);
                    f32x4 s0 = (f32x4){0.f, 0.f, 0.f, 0.f}, s1 = (f32x4){0.f, 0.f, 0.f, 0.f};
#pragma unroll
                    for (int ks = 0; ks < 8; ++ks) s0 = __builtin_amdgcn_mfma_f32_16x16x32_bf16(k0[ks], qf[ks], s0, 0, 0, 0);
                    if (two) {
#pragma unroll
                        for (int ks = 0; ks < 8; ++ks) s1 = __builtin_amdgcn_mfma_f32_16x16x32_bf16(k1[ks], qf[ks], s1, 0, 0, 0);
                    }
                    s0 *= pdec; s1 *= pdec;
                    if (2 * kp == jb) {
#pragma unroll
                        for (int r = 0; r < 4; ++r) s0[r] = (4 * fq + r <= fr) ? s0[r] : 0.f;
                    }
                    if (2 * kp + 1 == jb) {
#pragma unroll
                        for (int r = 0; r < 4; ++r) s1[r] = (4 * fq + r <= fr) ? s1[r] : 0.f;
                    }
                    u32x4 pw; pw.x = pk2(s0[0], s0[1]); pw.y = pk2(s0[2], s0[3]); pw.z = pk2(s1[0], s1[1]); pw.w = pk2(s1[2], s1[3]);
                    const bf16x8 pf = __builtin_bit_cast(bf16x8, pw);
#pragma unroll
                    for (int eb = 0; eb < 2; ++eb) {
                        u32x4 vw; vw.x = vlo[eb].x; vw.y = vlo[eb].y; vw.z = vhi[eb].x; vw.w = vhi[eb].y;
                        oacc[eb] = __builtin_amdgcn_mfma_f32_16x16x32_bf16(__builtin_bit_cast(bf16x8, vw), pf, oacc[eb], 0, 0, 0);
                    }
                }
            }
            if (more) {
#pragma unroll
                for (int ks = 0; ks < 8; ++ks) qf[ks] = *(const GAS bf16x8*)(Qh + (size_t)((ci + 1) * 128 + 16 * jb + fr) * D + 32 * ks + 8 * fq);
            }
            {
                float ss = 0.f;
#pragma unroll
                for (int eb = 0; eb < 2; ++eb) {
                    pend_ow[eb].x = pk2(oacc[eb].x, oacc[eb].y); pend_ow[eb].y = pk2(oacc[eb].z, oacc[eb].w);
                    ss += (oacc[eb].x * oacc[eb].x + oacc[eb].y * oacc[eb].y) + (oacc[eb].z * oacc[eb].z + oacc[eb].w * oacc[eb].w);
                }
                ss += __shfl_xor(ss, 16); ss += __shfl_xor(ss, 32);
                pend_ss = ss;
            }
            bf16x8 vtn[2][4]; u32x2 kt[2][4][2];
#pragma unroll
            for (int eb = 0; eb < 2; ++eb)
#pragma unroll
                for (int ks = 0; ks < 4; ++ks) vtn[eb][ks] = *(const LAS bf16x8*)(lds + RT_VT + (16 * eb + fr) * RT_VTSTR + ks * 64 + fq * 16);
            {
                const unsigned a00 = (unsigned)(kbuf + troff[0][0]), a01 = (unsigned)(kbuf + troff[0][1]), a10 = (unsigned)(kbuf + troff[1][0]), a11 = (unsigned)(kbuf + troff[1][1]);
                asm volatile(
                    "ds_read_b64_tr_b16 %0, %16\n\t"  "ds_read_b64_tr_b16 %1, %17\n\t"
                    "ds_read_b64_tr_b16 %2, %16 offset:16384\n\t"  "ds_read_b64_tr_b16 %3, %17 offset:16384\n\t"
                    "ds_read_b64_tr_b16 %4, %16 offset:32768\n\t"  "ds_read_b64_tr_b16 %5, %17 offset:32768\n\t"
                    "ds_read_b64_tr_b16 %6, %16 offset:49152\n\t"  "ds_read_b64_tr_b16 %7, %17 offset:49152\n\t"
                    "ds_read_b64_tr_b16 %8, %18\n\t"  "ds_read_b64_tr_b16 %9, %19\n\t"
                    "ds_read_b64_tr_b16 %10, %18 offset:16384\n\t"  "ds_read_b64_tr_b16 %11, %19 offset:16384\n\t"
                    "ds_read_b64_tr_b16 %12, %18 offset:32768\n\t"  "ds_read_b64_tr_b16 %13, %19 offset:32768\n\t"
                    "ds_read_b64_tr_b16 %14, %18 offset:49152\n\t"  "ds_read_b64_tr_b16 %15, %19 offset:49152\n\t"
                    "s_waitcnt lgkmcnt(0)"
                    : "=&v"(kt[0][0][0]), "=&v"(kt[0][0][1]), "=&v"(kt[0][1][0]), "=&v"(kt[0][1][1]), "=&v"(kt[0][2][0]), "=&v"(kt[0][2][1]), "=&v"(kt[0][3][0]), "=&v"(kt[0][3][1]),
                      "=&v"(kt[1][0][0]), "=&v"(kt[1][0][1]), "=&v"(kt[1][1][0]), "=&v"(kt[1][1][1]), "=&v"(kt[1][2][0]), "=&v"(kt[1][2][1]), "=&v"(kt[1][3][0]), "=&v"(kt[1][3][1])
                    : "v"(a00), "v"(a01), "v"(a10), "v"(a11)
                    : "memory");
            }
            asm volatile("s_waitcnt lgkmcnt(0)" ::: "memory"); __builtin_amdgcn_s_barrier(); asm volatile("" ::: "memory");
#pragma unroll
            for (int eb = 0; eb < 2; ++eb)
#pragma unroll
                for (int db = 0; db < 2; ++db) {
                    sst[eb][db] *= cdec;
#pragma unroll
                    for (int ks = 0; ks < 4; ++ks) {
                        u32x4 kw; kw.x = kt[db][ks][0].x; kw.y = kt[db][ks][0].y; kw.z = kt[db][ks][1].x; kw.w = kt[db][ks][1].y;
                        sst[eb][db] = __builtin_amdgcn_mfma_f32_16x16x32_bf16(__builtin_bit_cast(bf16x8, kw), vtn[eb][ks], sst[eb][db], 0, 0, 0);
                    }
                    u32x2 sw; sw.x = pk2(sst[eb][db].x, sst[eb][db].y); sw.y = pk2(sst[eb][db].z, sst[eb][db].w);
                    *(LAS u32x2*)(lds + RT_ST + (16 * eb + fr) * RT_STSTR + (32 * w + 16 * db + 4 * fq) * 2) = sw;
                }
            __builtin_amdgcn_sched_barrier(0);
            if (more) {
                LAS bf16_t* vt = (LAS bf16_t*)(lds + RT_VT + (8 * vp) * RT_VTSTR) + vm;
#pragma unroll
                for (int q = 0; q < 4; ++q) { vt[(2 * q) * (RT_VTSTR / 2)] = (bf16_t)(vreg[q] & 0xffffu); vt[(2 * q + 1) * (RT_VTSTR / 2)] = (bf16_t)(vreg[q] >> 16); }
            }
        }
        {
            const size_t row = (size_t)(SEQ / RC - 1) * 128 + jrow;
#pragma unroll
            for (int eb = 0; eb < 2; ++eb) *(GAS u32x2*)(Vh + row * 2048 + 16 * eb + 4 * fq) = pend_ow[eb];
            if (fq == 0) hs[row * RH * 16] = pend_ss;
        }
#undef RT_STAGE_K
    }
    __syncthreads();
}

__device__ __forceinline__ void final_phase(const Frame& F, const GAS bf16_t* xb, GAS float* out, const GAS float* g) {
    const int tid_ = opq_tid(), lane_ = tid_ & 63, wave_ = __builtin_amdgcn_readfirstlane(tid_ >> 6);
    const int gw = F.vcu * 8 + wave_, NGW = F.G * 8;
    f32x4 gv[2][2];
#pragma unroll
    for (int j = 0; j < 2; ++j) { gv[j][0] = ((const GAS f32x4*)g)[2 * (lane_ + 64 * j)]; gv[j][1] = ((const GAS f32x4*)g)[2 * (lane_ + 64 * j) + 1]; }
    for (int row = 4 * gw; row < M; row += 4 * NGW) {
        u32x4 w[4][2];
#pragma unroll
        for (int r = 0; r < 4; ++r)
#pragma unroll
            for (int j = 0; j < 2; ++j) w[r][j] = ((const GAS u32x4*)(xb + (size_t)(row + r) * D))[lane_ + 64 * j];
#pragma unroll
        for (int r = 0; r < 4; ++r) {
            f32x4 v[2][2]; float s = 0.f;
#pragma unroll
            for (int j = 0; j < 2; ++j) { const u32x4 ww = w[r][j];
                v[j][0] = (f32x4){bf_lo(ww.x), bf_hi(ww.x), bf_lo(ww.y), bf_hi(ww.y)}; v[j][1] = (f32x4){bf_lo(ww.z), bf_hi(ww.z), bf_lo(ww.w), bf_hi(ww.w)};
                s += (v[j][0].x * v[j][0].x + v[j][0].y * v[j][0].y) + (v[j][0].z * v[j][0].z + v[j][0].w * v[j][0].w) + (v[j][1].x * v[j][1].x + v[j][1].y * v[j][1].y) + (v[j][1].z * v[j][1].z + v[j][1].w * v[j][1].w); }
            const float rs = rsqrtf(wave_sum(s) * (1.0f / D) + RMS_EPS);
            GAS f32x4* o = (GAS f32x4*)(out + (size_t)(row + r) * D) + 2 * lane_;
#pragma unroll
            for (int j = 0; j < 2; ++j) { o[128 * j] = v[j][0] * rs * gv[j][0]; o[128 * j + 1] = v[j][1] * rs * gv[j][1]; }
        }
    }
}

__global__ void __launch_bounds__(512, 2) trunk_fwd(Args args) {
    extern __shared__ __attribute__((aligned(16))) unsigned char lds_raw[];
    Frame F;
    F.lds = (LAS unsigned char*)lds_raw;
    F.tid = threadIdx.x; F.lane = F.tid & 63; F.wave = __builtin_amdgcn_readfirstlane(F.tid >> 6);
    F.G = gridDim.x; { const int bx = blockIdx.x; F.vcu = (F.G % 8 == 0) ? (bx % 8) * (F.G / 8) + bx / 8 : bx; }
    unsigned char* ws = args.ws;
    unsigned* ctl = (unsigned*)(ws + WS_CTL);
    volatile LAS unsigned* MISC = (volatile LAS unsigned*)(F.lds + LDS_MISC);
    for (int u = F.tid; u < (LDS_BYTES - LDS_MISC) / 4; u += 512) ((LAS unsigned*)(F.lds + LDS_MISC))[u] = 0u;
    __syncthreads();
    XcdBarrier bar = xcd_barrier_post(ctl + 4096 + args.li * XCD_BAR_WORDS, MISC + 8);
    const int lo = args.ph_lo, hi = args.ph_hi;
#define IN(k) (lo <= (k) && (k) < hi)
#define GRID_BAR(k) do { if (hi > (k) + 1) xcd_barrier(bar); } while (0)

    bf16_t* xb = (bf16_t*)(ws + WS_XB);
    float* ssq = (float*)(ws + WS_SSQ);

    if (IN(0)) { if (I8_F1_LAYERS || I8_RET || I8_SGU || I8_CONV3) { p0_wabs(F, args); xcd_barrier(bar); } p0_prologue(F, args); GRID_BAR(0); }

#pragma unroll 1
    for (int L = 0; L < NLAYER; ++L) {
        const int pb = 1 + 6 * L;
        const int kind = (L == 1) ? 1 : (L == 2) ? 2 : 0;
        int pmo;
        const bf16_t* moA; const bf16_t* moB; int moK;
        if (kind == 0) {
            const int j = (L == 0) ? 0 : 1;
            bf16_t* Bo = (bf16_t*)(ws + AR_CB); bf16_t* CZ = (bf16_t*)(ws + AR_CZ); bf16_t* CY = (bf16_t*)(ws + AR_CY);
            if (IN(pb)) {
                if (I8_CONV3 && j == 1) {
                quant_phase(F, (const GAS bf16_t*)opq((const bf16_t*)xb), (GAS unsigned char*)opq(ws + WS_X8), (GAS float*)opq((float*)(ws + WS_SA)));
                xcd_barrier(bar);
                pg8::Gemm g{opq((const bf16_t*)(ws + WS_X8)), opq((const bf16_t*)(ws + W_CI + j * W_CI_SZ)), M, 3072, 1024 / 2}; pg8::StaticOrder S; S.init(M, 3072, F.G, (int)blockIdx.x);
                EpiConvIn E{(const GAS float*)opq(ssq), (GAS bf16_t*)opq(Bo), (GAS bf16_t*)opq(CZ), (const GAS float*)opq((const float*)(ws + WS_SA)), i8_wfull(ws, 7, F.lane, 1.0f / (1024.0f * 3072.0f)) * (1.0f / 127.0f)};
                pg8::gemm_phase<EpiConvIn, true, true, false, true, true>(F.lds, g, S, E);
                } else {
                pg8::Gemm g{opq(xb), opq((const bf16_t*)(ws + W_CI + j * W_CI_SZ)), M, 3072, 1024}; pg8::StaticOrder S; S.init(M, 3072, F.G, (int)blockIdx.x);
                EpiConvIn E{(const GAS float*)opq(ssq), (GAS bf16_t*)opq(Bo), (GAS bf16_t*)opq(CZ), (const GAS float*)nullptr, 1.0f};
                pg8::gemm_phase<EpiConvIn>(F.lds, g, S, E);
                }
                GRID_BAR(pb);
            }
            if (IN(pb + 1)) { conv_phase(F, (const GAS bf16_t*)opq(Bo), (const GAS bf16_t*)opq(CZ), (const GAS float*)opq(args.in[5] + (size_t)j * 3 * D), (GAS bf16_t*)opq(CY)); GRID_BAR(pb + 1); }
            pmo = pb + 2; moA = CY; moB = (const bf16_t*)(ws + W_CO + j * W_CO_SZ); moK = 1024;
        } else if (kind == 1) {
            bf16_t* U = (bf16_t*)(ws + AR_SU); bf16_t* V = (bf16_t*)(ws + AR_SV); float* lnp = (float*)(ws + WS_LNP);
            {
            if (IN(pb)) {
                if constexpr (I8_SGU) {
                quant_phase(F, (const GAS bf16_t*)opq((const bf16_t*)xb), (GAS unsigned char*)opq(ws + WS_X8), (GAS float*)opq((float*)(ws + WS_SA)));
                xcd_barrier(bar);
                pg8::Gemm g{opq((const bf16_t*)(ws + WS_X8)), opq((const bf16_t*)(ws + W_SI)), M, 4096, 1024 / 2}; pg8::StaticOrder S; S.init(M, 4096, F.G, (int)blockIdx.x);
                EpiSguIn E{(const GAS float*)opq(ssq), (GAS bf16_t*)opq(U), (GAS bf16_t*)opq(V), (GAS float*)opq(lnp), (const GAS float*)opq((const float*)(ws + WS_SA)), i8_wfull(ws, 6, F.lane, 1.0f / (1024.0f * 4096.0f)) * (1.0f / 127.0f)};
                pg8::gemm_phase<EpiSguIn, true, true, false, true, true>(F.lds, g, S, E);
                } else {
                pg8::Gemm g{opq(xb), opq((const bf16_t*)(ws + W_SI)), M, 4096, 1024}; pg8::StaticOrder S; S.init(M, 4096, F.G, (int)blockIdx.x);
                EpiSguIn E{(const GAS float*)opq(ssq), (GAS bf16_t*)opq(U), (GAS bf16_t*)opq(V), (GAS float*)opq(lnp), (const GAS float*)nullptr, 1.0f};
                pg8::gemm_phase<EpiSguIn>(F.lds, g, S, E);
                }
                GRID_BAR(pb);
            }
            if (IN(pb + 1)) { sgu_phase(F, (GAS bf16_t*)opq(U), (const GAS bf16_t*)opq(V), (const GAS float*)opq(lnp), (const GAS bf16_t*)opq((const bf16_t*)(ws + W_WS)), (const GAS float*)opq(args.in[8]), (const GAS float*)opq(args.in[9]), (const GAS float*)opq(args.in[11])); GRID_BAR(pb + 1); }
            }
            pmo = pb + 2; moA = U; moB = (const bf16_t*)(ws + W_SO); moK = 2048;
        } else {
            bf16_t* Q = (bf16_t*)(ws + AR_RQ); bf16_t* Kn = (bf16_t*)(ws + AR_RK); bf16_t* V = (bf16_t*)(ws + AR_RV);
            float* hss = args.out;
            {
            {
            if (IN(pb)) {
                if constexpr (I8_RET) {
                quant_phase(F, (const GAS bf16_t*)opq((const bf16_t*)xb), (GAS unsigned char*)opq(ws + WS_X8), (GAS float*)opq((float*)(ws + WS_SA)));
                xcd_barrier(bar);
                pg8::Gemm g{opq((const bf16_t*)(ws + WS_X8)), opq((const bf16_t*)(ws + W_RQ)), M, 4096, 1024 / 2}; pg8::StaticOrder S; S.init(M, 4096, F.G, (int)blockIdx.x);
                EpiRetQkv E{(const GAS float*)opq(ssq), (const GAS float*)opq((const float*)(ws + WS_ROT)), (const GAS float*)opq((const float*)(ws + WS_ROT) + (size_t)SEQ * 128), (GAS bf16_t*)opq(Q), (GAS bf16_t*)opq(Kn), (GAS bf16_t*)opq(V),
                            (const GAS float*)opq((const float*)(ws + WS_SA)), i8_wfull(ws, 4, F.lane, 1.0f / (1024.0f * 4096.0f)) * (1.0f / 127.0f)};
                pg8::gemm_phase<EpiRetQkv, true, true, false, true, true>(F.lds, g, S, E);
                } else {
                pg8::Gemm g{opq(xb), opq((const bf16_t*)(ws + W_RQ)), M, 4096, 1024}; pg8::StaticOrder S; S.init(M, 4096, F.G, (int)blockIdx.x);
                EpiRetQkv E{(const GAS float*)opq(ssq), (const GAS float*)opq((const float*)(ws + WS_ROT)), (const GAS float*)opq((const float*)(ws + WS_ROT) + (size_t)SEQ * 128), (GAS bf16_t*)opq(Q), (GAS bf16_t*)opq(Kn), (GAS bf16_t*)opq(V), (const GAS float*)nullptr, 1.0f};
                pg8::gemm_phase<EpiRetQkv>(F.lds, g, S, E);
                }
                GRID_BAR(pb);
            }
            if (IN(pb + 1)) { ret_phase(F, (const GAS bf16_t*)opq(Q), (const GAS bf16_t*)opq(Kn), (GAS bf16_t*)opq(V), (GAS float*)opq(hss)); GRID_BAR(pb + 1); }
            }
            if (IN(pb + 2)) {
                if constexpr (I8_RET) {
                pg8::Gemm g{opq((const bf16_t*)(ws + WS_X8)), opq((const bf16_t*)(ws + W_RG)), M, 2048, 1024 / 2}; pg8::StaticOrder S; S.init(M, 2048, F.G, (int)blockIdx.x);
                EpiRetG E{(const GAS float*)opq(ssq), (const GAS float*)opq(hss), (GAS bf16_t*)opq(V), (const GAS float*)opq((const float*)(ws + WS_SA)), i8_wfull(ws, 5, F.lane, 1.0f / (1024.0f * 2048.0f)) * (1.0f / 127.0f)};
                pg8::gemm_phase<EpiRetG, true, true, false, true, true>(F.lds, g, S, E);
                } else {
                pg8::Gemm g{opq(xb), opq((const bf16_t*)(ws + W_RG)), M, 2048, 1024}; pg8::StaticOrder S; S.init(M, 2048, F.G, (int)blockIdx.x);
                EpiRetG E{(const GAS float*)opq(ssq), (const GAS float*)opq(hss), (GAS bf16_t*)opq(V), (const GAS float*)nullptr, 1.0f};
                pg8::gemm_phase<EpiRetG>(F.lds, g, S, E);
                }
                GRID_BAR(pb + 2);
            }
            }
            pmo = pb + 3; moA = V; moB = (const bf16_t*)(ws + W_RO); moK = 2048;
        }
        if (IN(pmo)) {
            pg8::Gemm g{opq(moA), opq(moB), M, 1024, moK}; pg8::StaticOrder S; S.init(M, 1024, F.G, (int)blockIdx.x);
            EpiResid E{(GAS bf16_t*)opq(xb), (GAS float*)opq(ssq), 1.0f, ((F8_F1_LAYERS >> L) & 1) ? (GAS unsigned char*)opq(ws + WS_X8) : (GAS unsigned char*)nullptr};
            pg8::gemm_phase<EpiResid>(F.lds, g, S, E);
            GRID_BAR(pmo);
        }
        if (IN(pb + 4)) {
            if ((I8_F1_LAYERS >> L) & 1) {
                quant_phase(F, (const GAS bf16_t*)opq((const bf16_t*)xb), (GAS unsigned char*)opq(ws + WS_X8), (GAS float*)opq((float*)(ws + WS_SA)));
                xcd_barrier(bar);
                pg8::Gemm g{opq((const bf16_t*)(ws + WS_X8)), opq((const bf16_t*)(ws + W_FI + L * W_FI_SZ)), M, 2 * DFF, 1024 / 2}; pg8::StaticOrder S; S.init(M, 2 * DFF, F.G, (int)blockIdx.x);
                const float wsc = i8_wfull(ws, L, F.lane) * (1.0f / 127.0f);
                EpiFfnIn E{(const GAS float*)opq(ssq), (GAS unsigned char*)opq(ws + AR_FA), ((F8_LAYERS >> L) & 1) != 0, wsc, (const GAS float*)opq((const float*)(ws + WS_SA)), true};
                pg8::gemm_phase<EpiFfnIn, true, true, false, true>(F.lds, g, S, E);
            } else if ((F8_F1_LAYERS >> L) & 1) {
                pg8::Gemm g{opq((const bf16_t*)(ws + WS_X8)), opq((const bf16_t*)(ws + W_FI + L * W_FI_SZ)), M, 2 * DFF, 1024 / 2}; pg8::StaticOrder S; S.init(M, 2 * DFF, F.G, (int)blockIdx.x);
                EpiFfnIn E{(const GAS float*)opq(ssq), (GAS unsigned char*)opq(ws + AR_FA), ((F8_LAYERS >> L) & 1) != 0, 1.0f / FI_WSCALE, (const GAS float*)nullptr, false};
                pg8::gemm_phase<EpiFfnIn, true, true, true>(F.lds, g, S, E);
            } else {
                pg8::Gemm g{opq(xb), opq((const bf16_t*)(ws + W_FI + L * W_FI_SZ)), M, 2 * DFF, 1024}; pg8::StaticOrder S; S.init(M, 2 * DFF, F.G, (int)blockIdx.x);
                EpiFfnIn E{(const GAS float*)opq(ssq), (GAS unsigned char*)opq(ws + AR_FA), ((F8_LAYERS >> L) & 1) != 0, 1.0f, (const GAS float*)nullptr, false};
                pg8::gemm_phase<EpiFfnIn>(F.lds, g, S, E);
            }
            GRID_BAR(pb + 4);
        }
        if (IN(pb + 5)) {
            if ((F8_LAYERS >> L) & 1) {
                pg8::Gemm g{opq((const bf16_t*)(ws + AR_FA)), opq((const bf16_t*)(ws + W_FD + L * W_FD_SZ)), M, 1024, DFF / 2}; pg8::StaticOrder S; S.init(M, 1024, F.G, (int)blockIdx.x);
                EpiResidT<2> E{(GAS bf16_t*)opq(xb), (GAS float*)opq(ssq), 1.0f / FD_WSCALE, (GAS unsigned char*)nullptr};
                pg8::gemm_phase<EpiResidT<2>, true, true, true>(F.lds, g, S, E);
            } else {
                pg8::Gemm g{opq((const bf16_t*)(ws + AR_FA)), opq((const bf16_t*)(ws + W_FD + L * W_FD_SZ)), M, 1024, DFF}; pg8::StaticOrder S; S.init(M, 1024, F.G, (int)blockIdx.x);
                EpiResid E{(GAS bf16_t*)opq(xb), (GAS float*)opq(ssq), 1.0f, (GAS unsigned char*)nullptr};
                pg8::gemm_phase<EpiResid>(F.lds, g, S, E);
            }
            GRID_BAR(pb + 5);
        }
    }
    if (IN(NPH - 1)) final_phase(F, (const GAS bf16_t*)opq((const bf16_t*)xb), (GAS float*)opq(args.out), (const GAS float*)opq(args.in[3]));
#undef IN
#undef GRID_BAR
}

extern "C" void kernel_launch(void* const* d_in, const int* in_sizes, int n_in, void* d_out, int out_size, void* d_ws, size_t ws_size, hipStream_t stream) {
    static int grid = 0;
    if (grid == 0) {
        if (n_in != 18 || out_size != M * D || ws_size < WS_END) { fprintf(stderr, "kernel_launch: unexpected shapes (n_in %d out %d ws %zu)\n", n_in, out_size, ws_size); grid = -1; return; }
        int dev = 0, cus = 0, per_cu = 0;
        if (hipGetDevice(&dev) != hipSuccess || hipDeviceGetAttribute(&cus, hipDeviceAttributeMultiprocessorCount, dev) != hipSuccess) { grid = -1; return; }
        if (hipFuncSetAttribute((const void*)trunk_fwd, hipFuncAttributeMaxDynamicSharedMemorySize, LDS_BYTES) != hipSuccess) { fprintf(stderr, "kernel_launch: hipFuncSetAttribute failed\n"); grid = -1; return; }
        if (hipOccupancyMaxActiveBlocksPerMultiprocessor(&per_cu, (const void*)trunk_fwd, 512, LDS_BYTES) != hipSuccess || per_cu < 1)
            fprintf(stderr, "kernel_launch: occupancy query reports %d\n", per_cu);
        (void)hipGetLastError();
        grid = cus;
    }
    if (grid < 0) return;
    (void)in_sizes;
    if (hipMemsetAsync((char*)d_ws + WS_CTL, 0, CTL_BYTES, stream) != hipSuccess) return;
    Args a{};
    for (int i = 0; i < 18; ++i) a.in[i] = (const float*)d_in[i];
    a.out = (float*)d_out; a.ws = (unsigned char*)d_ws; a.pad = 0;
#if MK_ONE_LAUNCH
    a.ph_lo = 0; a.ph_hi = NPH; a.li = 0;
    hipLaunchKernelGGL(trunk_fwd, dim3(grid), dim3(512), LDS_BYTES, stream, a);
#else
    int li = 0;
    for (int ph = 0; ph < NPH; ++ph) {
        const int r = (ph - 1) % 6, L = (ph - 1) / 6;
        if (ph >= 1 && ph < NPH - 1 && r == 3 && L != 2) continue;
        a.ph_lo = ph; a.ph_hi = ph + 1; a.li = li++;
        hipLaunchKernelGGL(trunk_fwd, dim3(grid), dim3(512), LDS_BYTES, stream, a);
    }
#endif
}
```

```cpp
#include <hip/hip_runtime.h>
#include <cstdio>
#include <cstdint>

#ifndef MK_ONE_LAUNCH
#define MK_ONE_LAUNCH 1
#endif

#define LAS __attribute__((address_space(3)))
#define GAS __attribute__((address_space(1)))
typedef unsigned short bf16_t;
typedef short bf16x8 __attribute__((ext_vector_type(8)));
typedef short bf16x4 __attribute__((ext_vector_type(4)));
typedef float f32x4 __attribute__((ext_vector_type(4)));
typedef float f32x2 __attribute__((ext_vector_type(2)));
typedef unsigned u32x4 __attribute__((ext_vector_type(4)));
typedef unsigned u32x2 __attribute__((ext_vector_type(2)));
typedef int i32x4 __attribute__((ext_vector_type(4)));
typedef int i32x8 __attribute__((ext_vector_type(8)));

constexpr int D = 1024, NB = 4, SEQ = 8192, M = NB * SEQ, DFF = 2816, NLAYER = 4;
constexpr int RH = 4, RQK = 256, RV = 512, RC = 128;
constexpr float RMS_EPS = 1e-6f, LN_EPS = 1e-5f;
constexpr int F8_LAYERS = 0xC;
constexpr bool I8_CONV3 = true;
constexpr bool I8_SGU = true;
constexpr bool I8_RET = true;
constexpr int I8_F1_LAYERS = 0xF;
constexpr int F8_F1_LAYERS = 0x0;
constexpr float FD_WSCALE = 64.0f, FI_WSCALE = 32.0f;
constexpr float WCLIP = 4.0f;
constexpr int CTL_WSS = 131072;

constexpr size_t MiB = 1u << 20;
constexpr size_t WS_CTL = 0, CTL_BYTES = 1 * MiB;
constexpr size_t WS_SSQ = 1 * MiB;
constexpr size_t WS_W = 3 * MiB;
constexpr size_t W_CI = WS_W, W_CI_SZ = (size_t)3072 * 1024 * 2;
constexpr size_t W_CO = W_CI + 2 * W_CI_SZ, W_CO_SZ = (size_t)1024 * 1024 * 2;
constexpr size_t W_SI = W_CO + 2 * W_CO_SZ, W_SI_SZ = (size_t)4096 * 1024 * 2;
constexpr size_t W_SO = W_SI + W_SI_SZ, W_SO_SZ = (size_t)1024 * 2048 * 2;
constexpr size_t W_RQ = W_SO + W_SO_SZ, W_RQ_SZ = (size_t)4096 * 1024 * 2;
constexpr size_t W_RG = W_RQ + W_RQ_SZ, W_RG_SZ = (size_t)2048 * 1024 * 2;
constexpr size_t W_RO = W_RG + W_RG_SZ, W_RO_SZ = (size_t)1024 * 2048 * 2;
constexpr size_t W_FI = W_RO + W_RO_SZ, W_FI_SZ = (size_t)5632 * 1024 * 2;
constexpr size_t W_FD = W_FI + 4 * W_FI_SZ, W_FD_SZ = (size_t)1024 * 2816 * 2;
constexpr size_t W_WS = W_FD + 4 * W_FD_SZ, W_WS_SZ = (size_t)8 * 128 * 128 * 2;
constexpr size_t WS_WEND = W_WS + W_WS_SZ;
static_assert(WS_WEND <= 114 * MiB, "weights");
constexpr size_t WS_ROT = 114 * MiB;
constexpr size_t WS_HSS = WS_ROT;
constexpr size_t WS_XB = 122 * MiB;
constexpr size_t WS_AR = 186 * MiB;
constexpr size_t WS_SA = 491 * MiB;
constexpr size_t WS_X8 = 458 * MiB;
constexpr size_t WS_KT = 442 * MiB;
constexpr size_t WS_LNP = WS_KT;
constexpr size_t WS_END = 506 * MiB;
constexpr size_t AR_CB = WS_AR, AR_CZ = WS_AR + 64 * MiB, AR_CY = WS_AR + 128 * MiB;
constexpr size_t AR_SU = WS_AR, AR_SV = WS_AR + 128 * MiB;
constexpr size_t AR_RQ = WS_AR, AR_RK = WS_AR + 64 * MiB, AR_RV = WS_AR + 128 * MiB;
constexpr size_t AR_FA = WS_AR;

constexpr int NPH = 26;
constexpr int LDS_BYTES = 159744;
constexpr int LDS_MISC = 159232;

#define RLX_AGENT __ATOMIC_RELAXED, __HIP_MEMORY_SCOPE_AGENT
__device__ __forceinline__ unsigned f2bf(float f) { unsigned u = __builtin_bit_cast(unsigned, f); return (u + 0x7fffu + ((u >> 16) & 1u)) >> 16; }
typedef __bf16 bf16v2 __attribute__((ext_vector_type(2)));
__device__ __forceinline__ unsigned pk2(float lo, float hi) { const f32x2 v = {lo, hi}; return __builtin_bit_cast(unsigned, __builtin_convertvector(v, bf16v2)); }
__device__ __forceinline__ float bf_lo(unsigned w) { return __builtin_bit_cast(float, w << 16); }
__device__ __forceinline__ float bf_hi(unsigned w) { return __builtin_bit_cast(float, w & 0xffff0000u); }
__device__ __forceinline__ float wave_max(float v) {
#pragma unroll
    for (int o = 1; o < 64; o <<= 1) v = fmaxf(v, __shfl_xor(v, o));
    return v;
}
__device__ __forceinline__ float wave_sum(float v) {
#pragma unroll
    for (int o = 1; o < 64; o <<= 1) v += __shfl_xor(v, o);
    return v;
}
template <class T> __device__ __forceinline__ T* opq(T* p) { asm volatile("" : "+s"(p)); return p; }
__device__ __forceinline__ int opq_tid() { int t = threadIdx.x; asm volatile("" : "+v"(t)); return t; }
__device__ __forceinline__ float fast_rcp(float x) { return __builtin_amdgcn_rcpf(x); }
__device__ __forceinline__ float silu_f(float x) { return x * fast_rcp(1.0f + __builtin_amdgcn_exp2f(-1.44269504089f * x)); }

#define XB_TMO      128
#define XB_XCNT(j)  (256  + 64 * (j))
#define XB_XSUB(j)  (1280 + 64 * (j))
#define XB_XGEN(j)  (2304 + 64 * (j))
#define XB_TOP      3328
#define XB_TOPGEN   3392
#define XCD_BAR_WORDS 3456
#define XB_SPIN_CAP (1u << 18)
__device__ __forceinline__ unsigned xb_ld(unsigned* p)              { return __hip_atomic_load(p, __ATOMIC_RELAXED, __HIP_MEMORY_SCOPE_AGENT); }
__device__ __forceinline__ unsigned xb_add(unsigned* p, unsigned v) { return __hip_atomic_fetch_add(p, v, __ATOMIC_RELAXED, __HIP_MEMORY_SCOPE_AGENT); }
__device__ __forceinline__ unsigned xb_xcc_id() { return (unsigned)__builtin_amdgcn_s_getreg((3 << 11) | 20) & 0xFu; }
#define XB_SPIN(cond, bar) do { unsigned _sp = 0; while (cond) { __builtin_amdgcn_s_sleep(1); \
    if ((++_sp & 255u) == 0u) { if (xb_ld(&(bar)[XB_TMO])) break; if (_sp > XB_SPIN_CAP) { atomicAdd(&(bar)[XB_TMO], 1u); break; } } } } while (0)
struct XcdBarrier { unsigned* bar; unsigned x; volatile LAS unsigned* st; };
__device__ __forceinline__ XcdBarrier xcd_barrier_post(unsigned* bar, volatile LAS unsigned* st) {
    XcdBarrier b; b.bar = bar; b.x = xb_xcc_id(); b.st = st;
    if (threadIdx.x == 0) (void)xb_add(&bar[XB_XCNT(b.x)], 1u);
    return b;
}
__device__ __forceinline__ void xcd_barrier_complete(unsigned* bar, unsigned x, unsigned& nloc, unsigned& nx) {
    const unsigned G = gridDim.x * gridDim.y * gridDim.z;
    unsigned sum, cnt, mine, sp = 0u;
    for (;;) {
        sum = 0u; cnt = 0u; mine = 0u;
#pragma unroll
        for (unsigned j = 0; j < 16; ++j) { const unsigned c = xb_ld(&bar[XB_XCNT(j)]); sum += c; cnt += (c > 0u) ? 1u : 0u; mine = (j == x) ? c : mine; }
        if (sum == G) break;
        __builtin_amdgcn_s_sleep(1);
        if ((++sp & 255u) == 0u) { if (xb_ld(&bar[XB_TMO])) break; if (sp > XB_SPIN_CAP) { atomicAdd(&bar[XB_TMO], 1u); break; } }
    }
    nloc = mine > 0u ? mine : 1u; nx = cnt > 0u ? cnt : 1u;
}
__device__ __forceinline__ void xcd_barrier(const XcdBarrier& b) {
    asm volatile("s_waitcnt vmcnt(0)" ::: "memory");
    __syncthreads();
    if (threadIdx.x == 0) {
        unsigned* bar = b.bar;
        __builtin_amdgcn_s_waitcnt(0);
        unsigned nloc = b.st[0], nx = b.st[1];
        if (nloc == 0u) { xcd_barrier_complete(bar, b.x, nloc, nx); b.st[0] = nloc; b.st[1] = nx; }
        const unsigned old = xb_add(&bar[XB_XSUB(b.x)], 1u);
        const unsigned gen = old / nloc;
        if (old + 1u == (gen + 1u) * nloc) {
            __builtin_amdgcn_fence(__ATOMIC_RELEASE, "agent");
            asm volatile("s_waitcnt vmcnt(0)" ::: "memory");
            const unsigned og = xb_add(&bar[XB_TOP], 1u);
            const unsigned tg = og / nx;
            if (og + 1u == (tg + 1u) * nx) xb_add(&bar[XB_TOPGEN], 1u);
            else XB_SPIN(xb_ld(&bar[XB_TOPGEN]) == tg, bar);
            __builtin_amdgcn_fence(__ATOMIC_ACQUIRE, "agent");
            xb_add(&bar[XB_XGEN(b.x)], 1u);
            asm volatile("s_waitcnt vmcnt(0)" ::: "memory");
        } else {
            XB_SPIN(xb_ld(&bar[XB_XGEN(b.x)]) == gen, bar);
            __builtin_amdgcn_fence(__ATOMIC_ACQUIRE, "agent");
            asm volatile("s_waitcnt vmcnt(0)" ::: "memory");
        }
    }
    __syncthreads();
}

namespace pg8 {
constexpr int BM = 256, BK = 64, HALF = 128, HTB = HALF * BK * 2, STAGE_BYTES = 8 * HTB, NXCD = 8, WGM = 8;
__host__ __device__ __forceinline__ int lds_byte(int r, int c) { const int st = (r >> 4) * 2 + (c >> 5), rr = r & 15, cc = c & 31, ob = rr * 64 + cc * 2; return st * 1024 + (ob ^ (((ob >> 9) & 1) << 5)); }
__host__ __device__ __forceinline__ void stage_rc(int b, int& R, int& C) { const int st = b / 1024, sb = b % 1024, swz = sb ^ (((sb >> 9) & 1) << 5); R = (st >> 1) * 16 + swz / 64; C = (st & 1) * 32 + (swz % 64) / 2; }
__host__ __device__ __forceinline__ int perm32(int rho) { const int n = rho >> 4, i = rho & 15; return 8 * (i >> 2) + 4 * n + (i & 3); }

struct Unit { int pm, pn; };
struct Gemm { const bf16_t* A; const bf16_t* Bt; int M, N, K; };
struct StaticOrder {
    int nM, nN, nwg, G, c;
    __host__ __device__ void init(int M_, int N_, int G_, int c_) { nM = M_ / BM; nN = N_ / BM; nwg = nM * nN; G = G_; c = c_; }
    __host__ __device__ bool next(int i, Unit& u) const {
        const long L = (long)i * G + c; if (L >= nwg) return false;
        int wgid = (int)L; { const int q = nwg / NXCD, r = nwg % NXCD, xcd = wgid % NXCD, off = wgid / NXCD; wgid = (xcd < r ? xcd * (q + 1) : r * (q + 1) + (xcd - r) * q) + off; }
        const int nig = WGM * nN, gid = wgid / nig, fm = gid * WGM, gsz = (nM - fm) < WGM ? (nM - fm) : WGM;
        u.pm = fm + ((wgid % nig) % gsz); u.pn = (wgid % nig) / gsz; return true;
    }
};

template <class E_> __device__ __forceinline__ auto rowsc_of(const E_& e, int) -> decltype(e.rowsc) { return e.rowsc; }
template <class E_> __device__ __forceinline__ const GAS float* rowsc_of(const E_&, long) { return nullptr; }
template <class E_> __device__ __forceinline__ auto tsc_of(const E_& e, int) -> decltype(e.tsc) { return e.tsc; }
template <class E_> __device__ __forceinline__ float tsc_of(const E_&, long) { return 1.0f; }
template <class Epi, bool ALIGN_EPI = true, bool SP2 = true, bool F8 = false, bool I8 = false, bool CVT = false>
__device__ __forceinline__ void gemm_phase(LAS unsigned char* lds, const Gemm g, const StaticOrder& S, const Epi& E) {
    const int tid = opq_tid(), wid = __builtin_amdgcn_readfirstlane(tid >> 6), lane = tid & 63, wr = wid >> 2, wc = wid & 3, fr = lane & 15, fq = lane >> 4;
    const int K = g.K, nt = K / BK;
    unsigned voffA[2];
#pragma unroll
    for (int i = 0; i < 2; ++i) { int R, C; stage_rc(tid * 16 + i * 8192, R, C); voffA[i] = (unsigned)(R * K + C) * 2u; }
    const size_t kstep = (size_t)(BK * 2);
    const size_t hstep = (size_t)HALF * K * 2;
    const size_t tstep = 2 * hstep;
    const unsigned ldsw = (unsigned)wid * 1024u;
    const int aoff = lds_byte(wr * 64 + fr, fq * 8), boff = lds_byte(wc * 32 + fr, fq * 8);
#define PG8_SA(b, h) (((b) * 2 + (h)) * HTB)
#define PG8_SB(b, h) ((4 + (b) * 2 + (h)) * HTB)
#define PG8_STAGE(bufoff, gbase, voff) do { _Pragma("unroll") for (int _i = 0; _i < 2; ++_i) \
        __builtin_amdgcn_global_load_lds((const unsigned*)((const char*)(gbase) + (voff)[_i]), (LAS unsigned*)(lds + (bufoff) + ldsw + _i * 8192), 16, 0, 0); } while (0)
#define PG8_LDA(dst, b, h) do { _Pragma("unroll") for (int m = 0; m < 4; ++m) _Pragma("unroll") for (int k = 0; k < 2; ++k) dst[m][k] = *(const LAS bf16x8*)(lds + PG8_SA(b, h) + aoff + m * 2048 + k * 1024); } while (0)
#define PG8_LDB(dst, b, h) do { _Pragma("unroll") for (int n = 0; n < 2; ++n) _Pragma("unroll") for (int k = 0; k < 2; ++k) dst[n][k] = *(const LAS bf16x8*)(lds + PG8_SB(b, h) + boff + n * 2048 + k * 1024); } while (0)
#define PG8_CAT8(lo, hi) __builtin_shufflevector(__builtin_bit_cast(i32x4, lo), __builtin_bit_cast(i32x4, hi), 0, 1, 2, 3, 4, 5, 6, 7)
#define PG8_MMA(ai, bj, At, Bt) do { __builtin_amdgcn_s_setprio(1); _Pragma("unroll") for (int m = 0; m < 4; ++m) _Pragma("unroll") for (int n = 0; n < 2; ++n) { \
        if constexpr (F8) { const i32x8 b8_ = PG8_CAT8(Bt[n][0], Bt[n][1]), a8_ = PG8_CAT8(At[m][0], At[m][1]); asm volatile("v_mfma_f32_16x16x128_f8f6f4 %0, %1, %2, %0" : "+v"(acc[ai][bj][m][n]) : "v"(b8_), "v"(a8_)); } \
        else if constexpr (I8) { _Pragma("unroll") for (int k = 0; k < 2; ++k) acc[ai][bj][m][n] = __builtin_bit_cast(f32x4, __builtin_amdgcn_mfma_i32_16x16x64_i8(__builtin_bit_cast(i32x4, Bt[n][k]), __builtin_bit_cast(i32x4, At[m][k]), __builtin_bit_cast(i32x4, acc[ai][bj][m][n]), 0, 0, 0)); } \
        else { _Pragma("unroll") for (int k = 0; k < 2; ++k) acc[ai][bj][m][n] = __builtin_amdgcn_mfma_f32_16x16x32_bf16(Bt[n][k], At[m][k], acc[ai][bj][m][n], 0, 0, 0); } } __builtin_amdgcn_s_setprio(0); } while (0)
#define PG8_WAIT_V(n) asm volatile("s_waitcnt vmcnt(" #n ")" ::: "memory")
#define PG8_WAIT_L(n) asm volatile("s_waitcnt lgkmcnt(" #n ")" ::: "memory")
#define PG8_BAR __builtin_amdgcn_s_barrier()
#define PG8_SCHED __builtin_amdgcn_sched_barrier(0)
    LAS int* utab = (LAS int*)(lds + LDS_MISC + 128);
    if (tid < 16) { Unit tu; tu.pm = 0; tu.pn = 0; const bool ok = S.next(tid, tu); utab[2 * tid] = ok ? tu.pm : -1; utab[2 * tid + 1] = tu.pn; }
    __syncthreads();
#define PG8_NEXT(i, u) ((i) < 16 && ((u).pm = __builtin_amdgcn_readfirstlane(utab[2 * (i)]), (u).pn = __builtin_amdgcn_readfirstlane(utab[2 * (i) + 1]), (u).pm >= 0))
    Unit cur, nxt; int ui = 0;
    if (!PG8_NEXT(0, cur)) return;
    const char* cA = (const char*)g.A + (size_t)cur.pm * tstep; const char* cB = (const char*)g.Bt + (size_t)cur.pn * tstep;
    if constexpr (SP2) {
        PG8_STAGE(PG8_SB(0, 0), cB, voffA); PG8_STAGE(PG8_SB(0, 1), cB + hstep, voffA); PG8_STAGE(PG8_SA(0, 0), cA, voffA); PG8_STAGE(PG8_SA(0, 1), cA + hstep, voffA);
    }
    if constexpr (Epi::NEEDS_RS) {
        LAS float* rst = (LAS float*)(lds + STAGE_BYTES);
        const GAS float* rsc = rowsc_of(E, 0); const float tsc = tsc_of(E, 0);
        for (int q = tid; q < 16 * 256; q += 512) { const int i = q >> 8, r = q & 255, pm = utab[2 * i];
            if (pm >= 0) { const GAS f32x4* p = (const GAS f32x4*)(E.ssq + (size_t)(pm * 256 + r) * 16); const f32x4 a0 = p[0], a1 = p[1], a2 = p[2], a3 = p[3];
                const float xs = (rsc ? rsc[pm * 256 + r] : 1.0f) * tsc;
                rst[q] = xs * rsqrtf((((a0.x + a0.y) + (a0.z + a0.w)) + ((a1.x + a1.y) + (a1.z + a1.w)) + ((a2.x + a2.y) + (a2.z + a2.w)) + ((a3.x + a3.y) + (a3.z + a3.w))) * (1.0f / D) + RMS_EPS); } }
        if constexpr (Epi::NEEDS_RH) {
            LAS float* rht = (LAS float*)(lds + STAGE_BYTES + 16384);
            for (int q = tid; q < 8 * 256; q += 512) { const int i = q >> 8, r = q & 255, pm = utab[2 * i], hh = utab[2 * i + 1] >> 1;
                if (pm >= 0) { const GAS f32x4* p = (const GAS f32x4*)(E.hss + ((size_t)(pm * 256 + r) * RH + hh) * 16); const f32x4 a0 = p[0], a1 = p[1], a2 = p[2], a3 = p[3];
                    rht[q] = rsqrtf((((a0.x + a0.y) + (a0.z + a0.w)) + ((a1.x + a1.y) + (a1.z + a1.w)) + ((a2.x + a2.y) + (a2.z + a2.w)) + ((a3.x + a3.y) + (a3.z + a3.w))) * (1.0f / RV) + RMS_EPS); } }
        }
        __syncthreads();
    }
    f32x4 acc[2][2][4][2];
#define PG8_ZERO_ACC do { bf16x8 z_ = (bf16x8){0, 0, 0, 0, 0, 0, 0, 0}; asm volatile("" : "+v"(z_)); \
        _Pragma("unroll") for (int a = 0; a < 2; ++a) _Pragma("unroll") for (int b = 0; b < 2; ++b) _Pragma("unroll") for (int m = 0; m < 4; ++m) _Pragma("unroll") for (int n = 0; n < 2; ++n) \
            acc[a][b][m][n] = __builtin_amdgcn_mfma_f32_16x16x32_bf16(z_, z_, (f32x4){0.f, 0.f, 0.f, 0.f}, 0, 0, 0); } while (0)
    PG8_ZERO_ACC;
    bf16x8 At[4][2], B0[2][2], B1[2][2];
    if constexpr (SP2) {
        if (wr == 1) PG8_BAR;
        PG8_WAIT_V(2); PG8_BAR;
        PG8_STAGE(PG8_SB(1, 0), cB + kstep, voffA); PG8_STAGE(PG8_SA(1, 0), cA + kstep, voffA); PG8_STAGE(PG8_SB(1, 1), cB + hstep + kstep, voffA);
        PG8_WAIT_V(6); PG8_BAR;
    } else {
        PG8_STAGE(PG8_SB(0, 0), cB, voffA); PG8_STAGE(PG8_SA(0, 0), cA, voffA); PG8_STAGE(PG8_SB(0, 1), cB + hstep, voffA); PG8_STAGE(PG8_SA(0, 1), cA + hstep, voffA);
        if (wr == 1) PG8_BAR;
        PG8_WAIT_V(4); PG8_BAR;
        PG8_STAGE(PG8_SB(1, 0), cB + kstep, voffA); PG8_STAGE(PG8_SA(1, 0), cA + kstep, voffA); PG8_STAGE(PG8_SB(1, 1), cB + hstep + kstep, voffA);
        PG8_WAIT_V(6); PG8_BAR;
    }
    for (;;) {
        const bool has_next = PG8_NEXT(ui + 1, nxt);
        const char* nA = has_next ? (const char*)g.A + (size_t)nxt.pm * tstep : cA; const char* nB = has_next ? (const char*)g.Bt + (size_t)nxt.pn * tstep : cB;
        __builtin_amdgcn_s_waitcnt(0xC07F);
        for (int t = 0; t < nt; t += 2) {
            const bool last = (t == nt - 2);
            const char* a1 = cA + (size_t)(t + 1) * kstep;
            const char* a2 = last ? nA : cA + (size_t)(t + 2) * kstep; const char* b2 = last ? nB : cB + (size_t)(t + 2) * kstep;
            const char* a3 = a2 + kstep; const char* b3 = b2 + kstep;
            if constexpr (SP2) {
            PG8_LDB(B0, 0, 0); PG8_LDB(B1, 0, 1); PG8_SCHED; PG8_LDA(At, 0, 0); PG8_STAGE(PG8_SA(1, 1), a1 + hstep, voffA);
            PG8_WAIT_V(8); PG8_WAIT_L(0); PG8_BAR; PG8_MMA(0, 0, At, B0); PG8_MMA(0, 1, At, B1); PG8_BAR; PG8_SCHED;
            PG8_LDA(At, 0, 1); PG8_STAGE(PG8_SB(0, 0), b2, voffA); PG8_STAGE(PG8_SB(0, 1), b2 + hstep, voffA); PG8_STAGE(PG8_SA(0, 0), a2, voffA);
            PG8_WAIT_V(8); PG8_WAIT_L(0); PG8_BAR; PG8_MMA(1, 0, At, B0); PG8_MMA(1, 1, At, B1); PG8_BAR; PG8_SCHED;
            PG8_LDB(B0, 1, 0); PG8_LDB(B1, 1, 1); PG8_SCHED; PG8_LDA(At, 1, 0); PG8_STAGE(PG8_SA(0, 1), a2 + hstep, voffA);
            PG8_WAIT_V(8); PG8_WAIT_L(0); PG8_BAR; PG8_MMA(0, 0, At, B0); PG8_MMA(0, 1, At, B1); PG8_BAR; PG8_SCHED;
            PG8_LDA(At, 1, 1); PG8_STAGE(PG8_SB(1, 0), b3, voffA); PG8_STAGE(PG8_SB(1, 1), b3 + hstep, voffA); PG8_STAGE(PG8_SA(1, 0), a3, voffA);
            PG8_WAIT_V(8); PG8_WAIT_L(0); PG8_BAR; PG8_MMA(1, 0, At, B0); PG8_MMA(1, 1, At, B1); PG8_BAR; PG8_SCHED;
            } else {
            PG8_LDB(B0, 0, 0); PG8_SCHED; PG8_LDA(At, 0, 0); PG8_STAGE(PG8_SA(1, 1), a1 + hstep, voffA);
            PG8_WAIT_L(8); PG8_BAR; PG8_WAIT_L(0); PG8_MMA(0, 0, At, B0); PG8_BAR; PG8_SCHED;
            PG8_LDB(B1, 0, 1); PG8_STAGE(PG8_SB(0, 0), b2, voffA);
            PG8_BAR; PG8_WAIT_L(0); PG8_MMA(0, 1, At, B1); PG8_BAR;
            PG8_LDA(At, 0, 1); PG8_STAGE(PG8_SA(0, 0), a2, voffA);
            PG8_BAR; PG8_WAIT_L(0); PG8_MMA(1, 0, At, B0); PG8_BAR; PG8_SCHED;
            PG8_STAGE(PG8_SB(0, 1), b2 + hstep, voffA);
            PG8_WAIT_V(6); PG8_BAR; PG8_MMA(1, 1, At, B1); PG8_BAR;
            PG8_LDB(B0, 1, 0); PG8_SCHED; PG8_LDA(At, 1, 0); PG8_STAGE(PG8_SA(0, 1), a2 + hstep, voffA);
            PG8_WAIT_L(8); PG8_BAR; PG8_WAIT_L(0); PG8_MMA(0, 0, At, B0); PG8_BAR; PG8_SCHED;
            PG8_LDB(B1, 1, 1); PG8_STAGE(PG8_SB(1, 0), b3, voffA);
            PG8_BAR; PG8_WAIT_L(0); PG8_MMA(0, 1, At, B1); PG8_BAR;
            PG8_LDA(At, 1, 1); PG8_STAGE(PG8_SA(1, 0), a3, voffA);
            PG8_BAR; PG8_WAIT_L(0); PG8_MMA(1, 0, At, B0); PG8_BAR; PG8_SCHED;
            PG8_STAGE(PG8_SB(1, 1), b3 + hstep, voffA);
            PG8_WAIT_V(6); PG8_BAR; PG8_MMA(1, 1, At, B1); PG8_BAR;
            }
        }
        if constexpr (ALIGN_EPI) { if (wr == 0) PG8_BAR; }
        if constexpr (F8) asm volatile("s_nop 15\n\ts_nop 7" ::: "memory");
        if constexpr (CVT) {
#pragma unroll
            for (int a = 0; a < 2; ++a)
#pragma unroll
                for (int b = 0; b < 2; ++b)
#pragma unroll
                    for (int m = 0; m < 4; ++m)
#pragma unroll
                        for (int n = 0; n < 2; ++n) acc[a][b][m][n] = __builtin_convertvector(__builtin_bit_cast(i32x4, acc[a][b][m][n]), f32x4);
        }
        { int efr = fr, efq = fq; asm volatile("" : "+v"(efr), "+v"(efq));
          E(acc, cur, wr, wc, efr, efq, (const LAS float*)(lds + STAGE_BYTES) + ui * 256 + wr * 64 + efr); }
        if (!has_next) break;
        PG8_ZERO_ACC;
        cur = nxt; cA = nA; cB = nB; ++ui;
        if constexpr (ALIGN_EPI) { if (wr == 1) PG8_BAR; }
    }
    PG8_WAIT_V(0);
    if constexpr (!ALIGN_EPI) { if (wr == 0) PG8_BAR; }
    PG8_BAR;
#undef PG8_NEXT
#undef PG8_SA
#undef PG8_SB
#undef PG8_STAGE
#undef PG8_LDA
#undef PG8_LDB
#undef PG8_MMA
#undef PG8_CAT8
#undef PG8_ZERO_ACC
#undef PG8_WAIT_V
#undef PG8_WAIT_L
#undef PG8_BAR
#undef PG8_SCHED
}
}

typedef f32x4 Acc[2][2][4][2];
__device__ __forceinline__ u32x4 pack8(const f32x4 a, const f32x4 b) { u32x4 w; w.x = pk2(a.x, a.y); w.y = pk2(a.z, a.w); w.z = pk2(b.x, b.y); w.w = pk2(b.z, b.w); return w; }
__device__ __forceinline__ void row_scales(const GAS float* part, size_t stride, int row0, int fq, float inv_n, float eps, float (&sc)[8]) {
    f32x4 v[8];
#pragma unroll
    for (int k = 0; k < 8; ++k) v[k] = *(const GAS f32x4*)(part + (size_t)(row0 + (k >> 2) * 128 + (k & 3) * 16) * stride + 4 * fq);
#pragma unroll
    for (int k = 0; k < 8; ++k) { float t = (v[k].x + v[k].y) + (v[k].z + v[k].w); t += __shfl_xor(t, 16); t += __shfl_xor(t, 32); sc[k] = rsqrtf(t * inv_n + eps); }
}

struct EpiConvIn {
    static constexpr bool NEEDS_RS = true, NEEDS_RH = false;
    const GAS float* ssq; GAS bf16_t* Bo; GAS bf16_t* CZ; const GAS float* rowsc; float tsc;
    __device__ __forceinline__ void operator()(const Acc& acc, const pg8::Unit& u, int wr, int wc, int fr, int fq, const LAS float* rst) const {
        const int row0 = u.pm * 256 + wr * 64 + fr;
        float rs[8];
#pragma unroll
        for (int k = 0; k < 8; ++k) rs[k] = rst[(k >> 2) * 128 + (k & 3) * 16];
#pragma unroll
        for (int ai = 0; ai < 2; ++ai)
#pragma unroll
            for (int m = 0; m < 4; ++m) {
                const int row = row0 + ai * 128 + m * 16; const float r1 = rs[4 * ai + m];
                if (u.pn < 4) {
#pragma unroll
                    for (int bj = 0; bj < 2; ++bj)
                        *(GAS u32x4*)(Bo + (size_t)row * D + u.pn * 256 + bj * 128 + wc * 32 + fq * 8) = pack8(acc[ai][bj][m][0] * r1, acc[ai][bj][m][1] * r1);
                } else {
                    const float r2 = r1 * r1;
                    const f32x4 p0 = acc[ai][0][m][0] * acc[ai][0][m][1] * r2, p1 = acc[ai][1][m][0] * acc[ai][1][m][1] * r2;
                    *(GAS u32x4*)(CZ + (size_t)row * D + (u.pn - 4) * 128 + wc * 32 + fq * 8) = pack8(p0, p1);
                }
            }
    }
};
struct EpiFfnIn {
    static constexpr bool NEEDS_RS = true, NEEDS_RH = false;
    const GAS float* ssq; GAS unsigned char* ACT; bool f8; float isc; const GAS float* rowsc; bool i8;
    __device__ __forceinline__ void operator()(const Acc& acc, const pg8::Unit& u, int wr, int wc, int fr, int fq, const LAS float* rst) const {
        const int row0 = u.pm * 256 + wr * 64 + fr;
        float rs[8];
#pragma unroll
        for (int k = 0; k < 8; ++k) rs[k] = rst[(k >> 2) * 128 + (k & 3) * 16];
#pragma unroll
        for (int ai = 0; ai < 2; ++ai)
#pragma unroll
            for (int m = 0; m < 4; ++m) {
                const int row = row0 + ai * 128 + m * 16; const float r1 = rs[4 * ai + m] * isc;
                const float c1 = -1.44269504089f * r1, r2 = r1 * r1;
                f32x2 g[4], p[4], e[4];
#pragma unroll
                for (int bj = 0; bj < 2; ++bj) { f32x4 gt = acc[ai][bj][m][0], up = acc[ai][bj][m][1];
                    if (i8) { gt = __builtin_convertvector(__builtin_bit_cast(i32x4, gt), f32x4); up = __builtin_convertvector(__builtin_bit_cast(i32x4, up), f32x4); }
                    g[2 * bj] = (f32x2){gt.x, gt.y}; g[2 * bj + 1] = (f32x2){gt.z, gt.w};
                    p[2 * bj] = (f32x2){gt.x, gt.y} * (f32x2){up.x, up.y}; p[2 * bj + 1] = (f32x2){gt.z, gt.w} * (f32x2){up.z, up.w}; }
#pragma unroll
                for (int k = 0; k < 4; ++k) { const f32x2 t = g[k] * c1; e[k].x = __builtin_amdgcn_exp2f(t.x); e[k].y = __builtin_amdgcn_exp2f(t.y); }
#pragma unroll
                for (int k = 0; k < 4; ++k) { const f32x2 d = e[k] + 1.0f; e[k].x = __builtin_amdgcn_rcpf(d.x); e[k].y = __builtin_amdgcn_rcpf(d.y); }
#pragma unroll
                for (int k = 0; k < 4; ++k) p[k] = (p[k] * r2) * e[k];
                const size_t eoff = (size_t)row * DFF + u.pn * 128 + wc * 32 + fq * 8;
                if (f8) {
                    u32x2 w;
                    w.x = (unsigned)__builtin_amdgcn_cvt_pk_fp8_f32(p[1].x, p[1].y, __builtin_amdgcn_cvt_pk_fp8_f32(p[0].x, p[0].y, 0, false), true);
                    w.y = (unsigned)__builtin_amdgcn_cvt_pk_fp8_f32(p[3].x, p[3].y, __builtin_amdgcn_cvt_pk_fp8_f32(p[2].x, p[2].y, 0, false), true);
                    __builtin_nontemporal_store(w, (GAS u32x2*)(ACT + eoff));
                } else {
                    u32x4 w; w.x = pk2(p[0].x, p[0].y); w.y = pk2(p[1].x, p[1].y); w.z = pk2(p[2].x, p[2].y); w.w = pk2(p[3].x, p[3].y);
                    __builtin_nontemporal_store(w, (GAS u32x4*)(ACT + 2 * eoff));
                }
            }
    }
};
__device__ __forceinline__ f32x2 gelu_pk(f32x2 v) {
    const f32x2 av = __builtin_elementwise_abs(v), d = av * 0.2316418882f + 1.0f;
    f32x2 t; t.x = __builtin_amdgcn_rcpf(d.x); t.y = __builtin_amdgcn_rcpf(d.y);
    f32x2 q = t * 0.5307027145f + (-0.7265760135f); q = q * t + 0.7107068705f; q = q * t + (-0.142248368f); q = q * t + 0.127414796f; q = q * t;
    const f32x2 s = (v * v) * (-0.72134752044f);
    f32x2 e; e.x = __builtin_amdgcn_exp2f(s.x); e.y = __builtin_amdgcn_exp2f(s.y);
    return v * 0.5f + av * (0.5f - q * e);
}
__device__ __forceinline__ f32x4 gelu4(f32x4 v) { const f32x2 a = gelu_pk((f32x2){v.x, v.y}), b = gelu_pk((f32x2){v.z, v.w}); return (f32x4){a.x, a.y, b.x, b.y}; }
struct EpiSguIn {
    static constexpr bool NEEDS_RS = true, NEEDS_RH = false;
    const GAS float* ssq; GAS bf16_t* U; GAS bf16_t* V; GAS float* lnp; const GAS float* rowsc; float tsc;
    __device__ __forceinline__ void operator()(const Acc& acc, const pg8::Unit& u, int wr, int wc, int fr, int fq, const LAS float* rst) const {
        const int row0 = u.pm * 256 + wr * 64 + fr;
        const bool isv = u.pn >= 8;
        GAS bf16_t* dst = isv ? V + (u.pn - 8) * 256 : U + u.pn * 256;
        float rs[8];
#pragma unroll
        for (int k = 0; k < 8; ++k) rs[k] = rst[(k >> 2) * 128 + (k & 3) * 16];
#pragma unroll
        for (int ai = 0; ai < 2; ++ai)
#pragma unroll
            for (int m = 0; m < 4; ++m) {
                const int row = row0 + ai * 128 + m * 16; const float r1 = rs[4 * ai + m];
                float s1 = 0.f, s2 = 0.f;
#pragma unroll
                for (int bj = 0; bj < 2; ++bj) {
                    const f32x4 a = gelu4(acc[ai][bj][m][0] * r1), b = gelu4(acc[ai][bj][m][1] * r1);
                    *(GAS u32x4*)(dst + (size_t)row * 2048 + bj * 128 + wc * 32 + fq * 8) = pack8(a, b);
                    s1 += (a.x + a.y) + (a.z + a.w) + (b.x + b.y) + (b.z + b.w);
                    s2 += (a.x * a.x + a.y * a.y) + (a.z * a.z + a.w * a.w) + (b.x * b.x + b.y * b.y) + (b.z * b.z + b.w * b.w);
                }
                if (isv) {
                    s1 += __shfl_xor(s1, 16); s1 += __shfl_xor(s1, 32); s2 += __shfl_xor(s2, 16); s2 += __shfl_xor(s2, 32);
                    if (fq == 0) *(GAS f32x2*)(lnp + ((size_t)row * 32 + (u.pn - 8) * 4 + wc) * 2) = (f32x2){s1, s2};
                }
            }
    }
};
struct EpiRetQkv {
    static constexpr bool NEEDS_RS = true, NEEDS_RH = false;
    const GAS float* ssq; const GAS float* rcos; const GAS float* rsin; GAS bf16_t* Q; GAS bf16_t* Kn; GAS bf16_t* V; const GAS float* rowsc; float tsc;
    __device__ __forceinline__ void operator()(const Acc& acc, const pg8::Unit& u, int wr, int wc, int fr, int fq, const LAS float* rst) const {
        const int row0 = u.pm * 256 + wr * 64 + fr;
        const int i0 = wc * 32 + fq * 8;
        const bool isk = u.pn >= 4; const int h = u.pn & 3;
        const float l2g = __builtin_amdgcn_logf(1.0f - __builtin_amdgcn_exp2f(-5.0f - (float)h));
        float rs[8];
#pragma unroll
        for (int k = 0; k < 8; ++k) rs[k] = rst[(k >> 2) * 128 + (k & 3) * 16];
        if (u.pn >= 8) {
#pragma unroll
            for (int ai = 0; ai < 2; ++ai)
#pragma unroll
                for (int m = 0; m < 4; ++m) { const int row = row0 + ai * 128 + m * 16; const float r1 = rs[4 * ai + m];
#pragma unroll
                    for (int bj = 0; bj < 2; ++bj)
                        *(GAS u32x4*)(V + (size_t)row * 2048 + (u.pn - 8) * 256 + bj * 128 + i0) = pack8(acc[ai][bj][m][0] * r1, acc[ai][bj][m][1] * r1); }
        } else {
#pragma unroll
            for (int hp = 0; hp < 4; ++hp) {
                const int ai = hp >> 1;
                f32x4 cs[2][2], sn[2][2];
#pragma unroll
                for (int mm = 0; mm < 2; ++mm) { const int pos = (row0 + ai * 128 + (2 * (hp & 1) + mm) * 16) & (SEQ - 1);
#pragma unroll
                    for (int bj = 0; bj < 2; ++bj) { cs[mm][bj] = *(const GAS f32x4*)(rcos + (size_t)pos * 128 + i0 + 4 * bj); sn[mm][bj] = *(const GAS f32x4*)(rsin + (size_t)pos * 128 + i0 + 4 * bj); } }
#pragma unroll
                for (int mm = 0; mm < 2; ++mm) {
                    const int m = 2 * (hp & 1) + mm;
                    const int row = row0 + ai * 128 + m * 16, pos = row & (SEQ - 1); const float r1 = rs[4 * ai + m];
                    const float sc = isk ? r1 * 0.0625f * __builtin_amdgcn_exp2f(l2g * (float)(127 - (pos & 127))) : r1;
                    f32x4 o1[2], o2[2];
#pragma unroll
                    for (int bj = 0; bj < 2; ++bj) { const f32x4 x1 = acc[ai][bj][m][0] * sc, x2 = acc[ai][bj][m][1] * sc;
                        o1[bj] = x1 * cs[mm][bj] - x2 * sn[mm][bj]; o2[bj] = x2 * cs[mm][bj] + x1 * sn[mm][bj]; }
                    GAS bf16_t* dst = (isk ? Kn : Q) + (size_t)row * D + h * 256 + i0;
                    *(GAS u32x4*)dst = pack8(o1[0], o1[1]); *(GAS u32x4*)(dst + 128) = pack8(o2[0], o2[1]);
                }
            }
        }
    }
};
struct EpiRetG {
    static constexpr bool NEEDS_RS = true, NEEDS_RH = true;
    const GAS float* ssq; const GAS float* hss; GAS bf16_t* Y; const GAS float* rowsc; float tsc;
    __device__ __forceinline__ void operator()(const Acc& acc, const pg8::Unit& u, int wr, int wc, int fr, int fq, const LAS float* rst) const {
        const int row0 = u.pm * 256 + wr * 64 + fr; const int h = u.pn >> 1;
        float rs[8], rh[8];
#pragma unroll
        for (int k = 0; k < 8; ++k) { rs[k] = rst[(k >> 2) * 128 + (k & 3) * 16]; rh[k] = rst[4096 + (k >> 2) * 128 + (k & 3) * 16]; }
#pragma unroll
        for (int ai = 0; ai < 2; ++ai) {
            u32x4 ov[4][2];
#pragma unroll
            for (int m = 0; m < 4; ++m)
#pragma unroll
                for (int bj = 0; bj < 2; ++bj) ov[m][bj] = *(const GAS u32x4*)(Y + (size_t)(row0 + ai * 128 + m * 16) * 2048 + u.pn * 256 + bj * 128 + wc * 32 + fq * 8);
#pragma unroll
            for (int m = 0; m < 4; ++m) {
                const int row = row0 + ai * 128 + m * 16; const float r1 = rs[4 * ai + m], r3 = rh[4 * ai + m];
#pragma unroll
                for (int bj = 0; bj < 2; ++bj) {
                    GAS bf16_t* p = Y + (size_t)row * 2048 + u.pn * 256 + bj * 128 + wc * 32 + fq * 8;
                    const u32x4 o = ov[m][bj];
                    const f32x4 g0 = acc[ai][bj][m][0] * r1, g1 = acc[ai][bj][m][1] * r1;
                    const f32x4 a = (f32x4){silu_f(g0.x) * bf_lo(o.x), silu_f(g0.y) * bf_hi(o.x), silu_f(g0.z) * bf_lo(o.y), silu_f(g0.w) * bf_hi(o.y)} * r3;
                    const f32x4 b = (f32x4){silu_f(g1.x) * bf_lo(o.z), silu_f(g1.y) * bf_hi(o.z), silu_f(g1.z) * bf_lo(o.w), silu_f(g1.w) * bf_hi(o.w)} * r3;
                    *(GAS u32x4*)p = pack8(a, b);
                }
            }
        }
    }
};
template <int MB = 4> struct EpiResidT {
    static constexpr bool NEEDS_RS = false, NEEDS_RH = false;
    GAS bf16_t* xb; GAS float* ssq; float osc; GAS unsigned char* x8;
    __device__ __forceinline__ void operator()(const Acc& acc, const pg8::Unit& u, int wr, int wc, int fr, int fq, const LAS float* rst) const {
        const int row0 = u.pm * 256 + wr * 64 + fr, col0 = u.pn * 256 + wc * 32 + fq * 8;
#pragma unroll
        for (int ai = 0; ai < 2; ++ai)
#pragma unroll
        for (int mh = 0; mh < 4; mh += MB) {
            u32x4 bv[4][2];
#pragma unroll
            for (int m = mh; m < mh + MB; ++m)
#pragma unroll
                for (int bj = 0; bj < 2; ++bj) bv[m][bj] = *(const GAS u32x4*)(xb + (size_t)(row0 + ai * 128 + m * 16) * D + col0 + bj * 128);
#pragma unroll
            for (int m = mh; m < mh + MB; ++m) {
                const int row = row0 + ai * 128 + m * 16;
                GAS bf16_t* p = xb + (size_t)row * D + col0;
                float s2 = 0.f;
#pragma unroll
                for (int bj = 0; bj < 2; ++bj) {
                    const u32x4 b = bv[m][bj];
                    const f32x4 x0 = (f32x4){bf_lo(b.x), bf_hi(b.x), bf_lo(b.y), bf_hi(b.y)} + acc[ai][bj][m][0] * osc;
                    const f32x4 x1 = (f32x4){bf_lo(b.z), bf_hi(b.z), bf_lo(b.w), bf_hi(b.w)} + acc[ai][bj][m][1] * osc;
                    *(GAS u32x4*)(p + bj * 128) = pack8(x0, x1);
                    if (x8) { u32x2 w8;
                        w8.x = (unsigned)__builtin_amdgcn_cvt_pk_fp8_f32(x0.z, x0.w, __builtin_amdgcn_cvt_pk_fp8_f32(x0.x, x0.y, 0, false), true);
                        w8.y = (unsigned)__builtin_amdgcn_cvt_pk_fp8_f32(x1.z, x1.w, __builtin_amdgcn_cvt_pk_fp8_f32(x1.x, x1.y, 0, false), true);
                        *(GAS u32x2*)(x8 + (size_t)row * D + col0 + bj * 128) = w8; }
                    s2 += (x0.x * x0.x + x0.y * x0.y) + (x0.z * x0.z + x0.w * x0.w) + (x1.x * x1.x + x1.y * x1.y) + (x1.z * x1.z + x1.w * x1.w);
                }
                s2 += __shfl_xor(s2, 16); s2 += __shfl_xor(s2, 32);
                if (fq == 0) ssq[(size_t)row * 16 + u.pn * 4 + wc] = s2;
            }
        }
    }
};
typedef EpiResidT<4> EpiResid;

struct Args { const float* in[18]; float* out; unsigned char* ws; int ph_lo, ph_hi, li, pad; };

struct Frame {
    LAS unsigned char* lds;
    int tid, lane, wave, vcu, G;
};

enum { MAP_NAT = 0, MAP_P8 = 1, MAP_CONV = 2, MAP_RETQKV = 3, MAP_FFN = 4 };
struct PrepJob { const GAS float* src; const GAS float* src2; const GAS float* gain; GAS bf16_t* dst; int ld, N, K, map; float f8scale, i8scale; };
__device__ __forceinline__ void prep_item(const PrepJob& J, int item, LAS float* scr, int lane) {
    const int nb = J.N / 64, kb = item / nb, r = item % nb, pn = r >> 2, wc = r & 3;
    const int k0 = kb * 64;
    const int sl = 128 * (lane >> 5) + 32 * wc + (lane & 31);
    const int slot = 256 * pn + sl;
    const GAS float* src = J.src; int col;
    {
        const int bj = sl >> 7, n = (sl >> 4) & 1, fq = (sl >> 2) & 3, j = sl & 3, ch = 32 * wc + 8 * fq + 4 * bj + j;
        const int p8 = (slot & ~31) + pg8::perm32(slot & 31);
        if (J.map == MAP_NAT) col = slot;
        else if (J.map == MAP_P8) col = p8;
        else if (J.map == MAP_CONV) col = (pn < 4) ? p8 : (1024 + 1024 * n + 128 * (pn - 4) + ch);
        else if (J.map == MAP_RETQKV) col = (pn < 8) ? (256 * pn + 128 * n + ch) : p8;
        else { col = 128 * pn + ch; if (n) src = J.src2; }
    }
    const GAS float* sp = src + (size_t)k0 * J.ld + col;
#pragma unroll
    for (int hk = 0; hk < 2; ++hk) {
        float wv[32];
#pragma unroll
        for (int k = 0; k < 32; ++k) wv[k] = sp[(size_t)(32 * hk + k) * J.ld];
#pragma unroll
        for (int k = 0; k < 32; ++k) scr[(32 * hk + k) * 65 + lane] = wv[k];
    }
    asm volatile("s_waitcnt lgkmcnt(0)" ::: "memory");
    const int c = lane & 7;
    float gn[8];
#pragma unroll
    for (int e = 0; e < 8; ++e) gn[e] = J.gain ? J.gain[k0 + 8 * c + e] : 1.0f;
#pragma unroll
    for (int it = 0; it < 8; ++it) {
        const int l2 = it * 8 + (lane >> 3);
        const int slot2 = 256 * pn + 128 * (l2 >> 5) + 32 * wc + (l2 & 31);
        const LAS float* s = scr + (8 * c) * 65 + l2;
        if (J.i8scale != 0.f) {
            const float f = J.i8scale; unsigned b8[8];
#pragma unroll
            for (int e = 0; e < 8; ++e) b8[e] = (unsigned)(int)fminf(fmaxf(rintf(s[e * 65] * gn[e] * f), -127.f), 127.f) & 255u;
            u32x2 o8; o8.x = b8[0] | (b8[1] << 8) | (b8[2] << 16) | (b8[3] << 24); o8.y = b8[4] | (b8[5] << 8) | (b8[6] << 16) | (b8[7] << 24);
            *(GAS u32x2*)((GAS unsigned char*)J.dst + (size_t)slot2 * J.K + k0 + 8 * c) = o8;
        } else if (J.f8scale != 0.f) {
            const float f = J.f8scale; u32x2 o8;
            o8.x = (unsigned)__builtin_amdgcn_cvt_pk_fp8_f32(s[2 * 65] * gn[2] * f, s[3 * 65] * gn[3] * f, __builtin_amdgcn_cvt_pk_fp8_f32(s[0] * gn[0] * f, s[65] * gn[1] * f, 0, false), true);
            o8.y = (unsigned)__builtin_amdgcn_cvt_pk_fp8_f32(s[6 * 65] * gn[6] * f, s[7 * 65] * gn[7] * f, __builtin_amdgcn_cvt_pk_fp8_f32(s[4 * 65] * gn[4] * f, s[5 * 65] * gn[5] * f, 0, false), true);
            *(GAS u32x2*)((GAS unsigned char*)J.dst + (size_t)slot2 * J.K + k0 + 8 * c) = o8;
        } else {
        u32x4 o; o.x = pk2(s[0] * gn[0], s[65] * gn[1]); o.y = pk2(s[2 * 65] * gn[2], s[3 * 65] * gn[3]); o.z = pk2(s[4 * 65] * gn[4], s[5 * 65] * gn[5]); o.w = pk2(s[6 * 65] * gn[6], s[7 * 65] * gn[7]);
        *(GAS u32x4*)(J.dst + (size_t)slot2 * J.K + k0 + 8 * c) = o;
        }
    }
    asm volatile("s_waitcnt lgkmcnt(0)" ::: "memory");
}
__device__ __forceinline__ void p0_wabs(const Frame& F, const Args& a) {
    const int tid_ = opq_tid(), lane_ = tid_ & 63, wave_ = __builtin_amdgcn_readfirstlane(tid_ >> 6);
    const int gw = F.vcu * 8 + wave_, NGW = F.G * 8;
#pragma unroll 1
    for (int L = 0; L < NLAYER; ++L) {
        if (!((I8_F1_LAYERS >> L) & 1)) continue;
        float sq = 0.f;
        for (int rr = gw; rr < 2 * 1024; rr += NGW) {
            const int k = rr & 1023; const GAS float* src = (const GAS float*)((rr < 1024 ? a.in[15] : a.in[16]) + ((size_t)L * 1024 + k) * DFF);
            const float gk = ((const GAS float*)a.in[2])[L * D + k];
            float m = 0.f;
#pragma unroll
            for (int j = 0; j < 11; ++j) { const f32x4 v = ((const GAS f32x4*)src)[lane_ + 64 * j]; m += (v.x * v.x + v.y * v.y) + (v.z * v.z + v.w * v.w); }
            sq += m * (gk * gk);
        }
        sq = wave_sum(sq);
        if (lane_ == 0 && gw < 2048) ((GAS float*)(a.ws + WS_CTL))[CTL_WSS + 2048 * L + gw] = sq;
    }
    if (I8_CONV3) {
        float sq0 = 0.f;
        for (int k = gw; k < 1024; k += NGW) {
            const GAS f32x4* src = (const GAS f32x4*)(a.in[4] + ((size_t)1024 + k) * 3072);
            const float gk = ((const GAS float*)a.in[1])[3 * D + k];
            float m0 = 0.f;
#pragma unroll
            for (int j = 0; j < 12; ++j) { const f32x4 v = src[lane_ + 64 * j]; m0 += (v.x * v.x + v.y * v.y) + (v.z * v.z + v.w * v.w); }
            sq0 += m0 * (gk * gk);
        }
        sq0 = wave_sum(sq0);
        if (lane_ == 0 && gw < 2048) ((GAS float*)(a.ws + WS_CTL))[CTL_WSS + 2048 * 7 + gw] = sq0;
    }
    if (I8_SGU) {
        float sq0 = 0.f;
        for (int k = gw; k < 1024; k += NGW) {
            const GAS f32x4* src = (const GAS f32x4*)(a.in[7] + (size_t)k * 4096);
            const float gk = ((const GAS float*)a.in[1])[1 * D + k];
            float m0 = 0.f;
#pragma unroll
            for (int j = 0; j < 16; ++j) { const f32x4 v = src[lane_ + 64 * j]; m0 += (v.x * v.x + v.y * v.y) + (v.z * v.z + v.w * v.w); }
            sq0 += m0 * (gk * gk);
        }
        sq0 = wave_sum(sq0);
        if (lane_ == 0 && gw < 2048) ((GAS float*)(a.ws + WS_CTL))[CTL_WSS + 2048 * 6 + gw] = sq0;
    }
    if (I8_RET) {
        float sq0 = 0.f, sq1 = 0.f;
        for (int k = gw; k < 1024; k += NGW) {
            const GAS f32x4* src = (const GAS f32x4*)(a.in[13] + (size_t)k * 6144);
            const float gk = ((const GAS float*)a.in[1])[2 * D + k];
            float m0 = 0.f, m1 = 0.f;
#pragma unroll
            for (int j = 0; j < 16; ++j) { const f32x4 v = src[lane_ + 64 * j]; m0 += (v.x * v.x + v.y * v.y) + (v.z * v.z + v.w * v.w); }
#pragma unroll
            for (int j = 16; j < 24; ++j) { const f32x4 v = src[lane_ + 64 * j]; m1 += (v.x * v.x + v.y * v.y) + (v.z * v.z + v.w * v.w); }
            sq0 += m0 * (gk * gk); sq1 += m1 * (gk * gk);
        }
        sq0 = wave_sum(sq0); sq1 = wave_sum(sq1);
        if (lane_ == 0 && gw < 2048) { ((GAS float*)(a.ws + WS_CTL))[CTL_WSS + 2048 * 4 + gw] = sq0; ((GAS float*)(a.ws + WS_CTL))[CTL_WSS + 2048 * 5 + gw] = sq1; }
    }
}
__device__ __forceinline__ float i8_wfull(const unsigned char* ws, int L, int lane, float inv_count = 1.0f / (2.0f * 1024.0f * DFF)) {
    const GAS float* p = (const GAS float*)(ws + WS_CTL) + CTL_WSS + 2048 * L;
    float t = 0.f;
#pragma unroll 4
    for (int j = 0; j < 32; ++j) t += p[lane + 64 * j];
    t = wave_sum(t);
    return fmaxf(WCLIP * sqrtf(t * inv_count), 1e-30f);
}
__device__ __forceinline__ void quant_phase(const Frame& F, const GAS bf16_t* xb, GAS unsigned char* x8, GAS float* sa) {
    const int tid_ = opq_tid(), lane_ = tid_ & 63, wave_ = __builtin_amdgcn_readfirstlane(tid_ >> 6);
    const int gw = F.vcu * 8 + wave_, NGW = F.G * 8;
    for (int row = 4 * gw; row < M; row += 4 * NGW) {
        u32x4 v[4][2];
#pragma unroll
        for (int r = 0; r < 4; ++r) { const GAS u32x4* p = (const GAS u32x4*)(xb + (size_t)(row + r) * D) + 2 * lane_; v[r][0] = p[0]; v[r][1] = p[1]; }
#pragma unroll
        for (int r = 0; r < 4; ++r) {
            float x[16];
#pragma unroll
            for (int h = 0; h < 2; ++h)
#pragma unroll
                for (int e = 0; e < 4; ++e) { x[8 * h + 2 * e] = bf_lo(v[r][h][e]); x[8 * h + 2 * e + 1] = bf_hi(v[r][h][e]); }
            float m = 0.f;
#pragma unroll
            for (int e = 0; e < 16; ++e) m = fmaxf(m, fabsf(x[e]));
            m = fmaxf(wave_max(m), 1e-30f);
            const float qs = 127.0f / m;
            unsigned w[4];
#pragma unroll
            for (int d = 0; d < 4; ++d) { unsigned t = 0u;
#pragma unroll
                for (int e = 0; e < 4; ++e) t |= ((unsigned)(int)rintf(x[4 * d + e] * qs) & 255u) << (8 * e);
                w[d] = t; }
            *((GAS u32x4*)(x8 + (size_t)(row + r) * D) + lane_) = (u32x4){w[0], w[1], w[2], w[3]};
            if (lane_ == 0) sa[row + r] = m * (1.0f / 127.0f);
        }
    }
}
__device__ __forceinline__ void p0_prologue(const Frame& F, const Args& a) {
    unsigned char* ws = a.ws;
    const int tid_ = opq_tid(), lane_ = tid_ & 63, wave_ = __builtin_amdgcn_readfirstlane(tid_ >> 6);
    LAS float* scr = (LAS float*)(F.lds + wave_ * 16640);
    const int gw = F.vcu * 8 + wave_, NGW = F.G * 8;
    constexpr int NJOB = 17;
    int start = 0;
#pragma unroll 1
    for (int jb = 0; jb < NJOB; ++jb) {
        PrepJob J; J.f8scale = 0.f; J.i8scale = 0.f;
        if (jb < 2)       { J.src = (const GAS float*)(a.in[4] + (size_t)jb * 1024 * 3072); J.src2 = nullptr; J.gain = (const GAS float*)(a.in[1] + (jb == 0 ? 0 : 3) * D); J.dst = (GAS bf16_t*)(ws + W_CI + jb * W_CI_SZ); J.ld = 3072; J.N = 3072; J.K = 1024; J.map = MAP_CONV; if (I8_CONV3 && jb == 1) J.i8scale = 127.0f / i8_wfull(ws, 7, lane_, 1.0f / (1024.0f * 3072.0f)); }
        else if (jb < 4)  { const int j = jb - 2; J.src = (const GAS float*)(a.in[6] + (size_t)j * 1024 * 1024); J.src2 = nullptr; J.gain = nullptr; J.dst = (GAS bf16_t*)(ws + W_CO + j * W_CO_SZ); J.ld = 1024; J.N = 1024; J.K = 1024; J.map = MAP_P8; }
        else if (jb == 4) { J.src = (const GAS float*)(a.in[7]); J.src2 = nullptr; J.gain = (const GAS float*)(a.in[1] + 1 * D); J.dst = (GAS bf16_t*)(ws + W_SI); J.ld = 4096; J.N = 4096; J.K = 1024; J.map = MAP_P8; if (I8_SGU) J.i8scale = 127.0f / i8_wfull(ws, 6, lane_, 1.0f / (1024.0f * 4096.0f)); }
        else if (jb == 5) { J.src = (const GAS float*)(a.in[12]); J.src2 = nullptr; J.gain = nullptr; J.dst = (GAS bf16_t*)(ws + W_SO); J.ld = 1024; J.N = 1024; J.K = 2048; J.map = MAP_P8; }
        else if (jb == 6) { J.src = (const GAS float*)(a.in[13]); J.src2 = nullptr; J.gain = (const GAS float*)(a.in[1] + 2 * D); J.dst = (GAS bf16_t*)(ws + W_RQ); J.ld = 6144; J.N = 4096; J.K = 1024; J.map = MAP_RETQKV; if (I8_RET) J.i8scale = 127.0f / i8_wfull(ws, 4, lane_, 1.0f / (1024.0f * 4096.0f)); }
        else if (jb == 7) { J.src = (const GAS float*)(a.in[13] + 4096); J.src2 = nullptr; J.gain = (const GAS float*)(a.in[1] + 2 * D); J.dst = (GAS bf16_t*)(ws + W_RG); J.ld = 6144; J.N = 2048; J.K = 1024; J.map = MAP_P8; if (I8_RET) J.i8scale = 127.0f / i8_wfull(ws, 5, lane_, 1.0f / (1024.0f * 2048.0f)); }
        else if (jb == 8) { J.src = (const GAS float*)(a.in[14]); J.src2 = nullptr; J.gain = nullptr; J.dst = (GAS bf16_t*)(ws + W_RO); J.ld = 1024; J.N = 1024; J.K = 2048; J.map = MAP_P8; }
        else if (jb < 13) { const int L = jb - 9; J.src = (const GAS float*)(a.in[15] + (size_t)L * 1024 * DFF); J.src2 = (const GAS float*)(a.in[16] + (size_t)L * 1024 * DFF); J.gain = (const GAS float*)(a.in[2] + L * D); J.dst = (GAS bf16_t*)(ws + W_FI + L * W_FI_SZ); J.ld = DFF; J.N = 2 * DFF; J.K = 1024; J.map = MAP_FFN; J.f8scale = ((F8_F1_LAYERS >> L) & 1) ? FI_WSCALE : 0.f;
                            if ((I8_F1_LAYERS >> L) & 1) J.i8scale = 127.0f / i8_wfull(ws, L, lane_); }
        else              { const int L = jb - 13; J.src = (const GAS float*)(a.in[17] + (size_t)L * DFF * 1024); J.src2 = nullptr; J.gain = nullptr; J.dst = (GAS bf16_t*)(ws + W_FD + L * W_FD_SZ); J.ld = 1024; J.N = 1024; J.K = DFF; J.map = MAP_P8; J.f8scale = ((F8_LAYERS >> L) & 1) ? FD_WSCALE : 0.f; }
        const int nitems = (J.K / 64) * (J.N / 64);
        int first = (gw - start % NGW + NGW) % NGW;
        for (int it = first; it < nitems; it += NGW) prep_item(J, it, scr, lane_);
        start += nitems;
    }
    {
        const GAS float* x = (const GAS float*)a.in[0]; GAS bf16_t* xb = (GAS bf16_t*)(ws + WS_XB); GAS float* ssq = (GAS float*)(ws + WS_SSQ);
        for (int row = 4 * gw; row < M; row += 4 * NGW) {
            f32x4 v[4][4];
#pragma unroll
            for (int r = 0; r < 4; ++r)
#pragma unroll
                for (int j = 0; j < 4; ++j) v[r][j] = ((const GAS f32x4*)(x + (size_t)(row + r) * D))[lane_ + 64 * j];
#pragma unroll
            for (int r = 0; r < 4; ++r) {
                float sq = 0.f;
#pragma unroll
                for (int j = 0; j < 4; ++j) sq += (v[r][j].x * v[r][j].x + v[r][j].y * v[r][j].y) + (v[r][j].z * v[r][j].z + v[r][j].w * v[r][j].w);
                sq = wave_sum(sq);
                GAS u32x2* o8 = (GAS u32x2*)(xb + (size_t)(row + r) * D) + lane_;
#pragma unroll
                for (int j = 0; j < 4; ++j) { u32x2 w; w.x = pk2(v[r][j].x, v[r][j].y); w.y = pk2(v[r][j].z, v[r][j].w); o8[64 * j] = w; }
                if (lane_ < 16) ssq[(size_t)(row + r) * 16 + lane_] = (lane_ == 0) ? sq : 0.f;
            }
        }
    }
    {
        GAS float* rc = (GAS float*)(ws + WS_ROT); GAS float* rsn = rc + (size_t)SEQ * 128;
        const int gt = F.vcu * 512 + tid_, NGT = F.G * 512;
        for (int idx = gt; idx < SEQ * 128; idx += NGT) {
            const int i = idx & 127, pos = idx >> 7;
            const float inv = __builtin_amdgcn_exp2f(-(float)i * (13.287712379549449f / 128.0f));
            const float ang = (float)pos * inv;
            const double ad = (double)ang;
            const double kq = __builtin_rint(ad * 0.63661977236758134308);
            const double y = __builtin_fma(-kq, 1.57079632679489661923, ad) - kq * 6.123233995736766e-17;
            const double y2 = y * y;
            const double sp = y * (1.0 + y2 * (-1.0 / 6 + y2 * (1.0 / 120 + y2 * (-1.0 / 5040 + y2 * (1.0 / 362880 + y2 * (-1.0 / 39916800))))));
            const double cp = 1.0 + y2 * (-0.5 + y2 * (1.0 / 24 + y2 * (-1.0 / 720 + y2 * (1.0 / 40320 + y2 * (-1.0 / 3628800 + y2 * (1.0 / 479001600))))));
            const int q = ((int)(long long)kq) & 3;
            const double sv = (q == 0) ? sp : (q == 1) ? cp : (q == 2) ? -sp : -cp;
            const double cv = (q == 0) ? cp : (q == 1) ? -sp : (q == 2) ? -cp : sp;
            rc[idx] = (float)cv; rsn[idx] = (float)sv;
        }
        const GAS float* wsp = (const GAS float*)a.in[10]; GAS bf16_t* wd = (GAS bf16_t*)(ws + W_WS);
        for (int idx = gt; idx < 8 * 128 * 128; idx += NGT) { const int s = idx & 127, t = (idx >> 7) & 127; wd[idx] = (bf16_t)f2bf(s <= t ? wsp[idx] : 0.f); }
    }
}

__device__ __forceinline__ void conv_phase(const Frame& F, const GAS bf16_t* Bo, const GAS bf16_t* CZ, const GAS float* cw, GAS bf16_t* Y) {
    constexpr int RB = 16;
    const int nitem = (M / RB) * 128;
    const int tid_ = opq_tid();
    for (int it = F.vcu * 512 + tid_; it < nitem; it += F.G * 512) {
        const int cc = it & 127, rb = it >> 7, r0 = rb * RB, c0 = cc * 8;
        float w0[8], w1[8], w2[8];
#pragma unroll
        for (int e = 0; e < 8; ++e) { w0[e] = cw[c0 + e]; w1[e] = cw[D + c0 + e]; w2[e] = cw[2 * D + c0 + e]; }
        u32x4 p2 = (u32x4){0, 0, 0, 0}, p1 = (u32x4){0, 0, 0, 0};
        if ((r0 & (SEQ - 1)) != 0) { p2 = *(const GAS u32x4*)(CZ + (size_t)(r0 - 2) * D + c0); p1 = *(const GAS u32x4*)(CZ + (size_t)(r0 - 1) * D + c0); }
#pragma unroll
        for (int hb = 0; hb < 2; ++hb) {
            u32x4 pz[8], pb[8];
#pragma unroll
            for (int r = 0; r < 8; ++r) { const size_t off = (size_t)(r0 + 8 * hb + r) * D + c0; pz[r] = *(const GAS u32x4*)(CZ + off); pb[r] = *(const GAS u32x4*)(Bo + off); }
#pragma unroll
            for (int r = 0; r < 8; ++r) {
                const size_t off = (size_t)(r0 + 8 * hb + r) * D + c0;
                const u32x4 p0 = pz[r], bv = pb[r];
                u32x4 o;
#pragma unroll
                for (int q = 0; q < 4; ++q) {
                    const float lo = bf_lo(bv[q]) * (w0[2 * q] * bf_lo(p2[q]) + w1[2 * q] * bf_lo(p1[q]) + w2[2 * q] * bf_lo(p0[q]));
                    const float hi = bf_hi(bv[q]) * (w0[2 * q + 1] * bf_hi(p2[q]) + w1[2 * q + 1] * bf_hi(p1[q]) + w2[2 * q + 1] * bf_hi(p0[q]));
                    o[q] = pk2(lo, hi);
                }
                *(GAS u32x4*)(Y + off) = o;
                p2 = p1; p1 = p0;
            }
        }
    }
}

constexpr int SG_W = 0, SG_WSTR = 272, SG_T = 128 * SG_WSTR, SG_TSTR = 272, SG_ST = SG_T + 256 * SG_TSTR, SG_LG = SG_ST + 1024, SG_END = SG_LG + 2048;
static_assert(SG_END <= LDS_MISC, "sgu lds");
__device__ __forceinline__ void sgu_phase(const Frame& F, GAS bf16_t* U, const GAS bf16_t* V, const GAS float* lnp, const GAS bf16_t* Wt, const GAS float* lng, const GAS float* lnb, const GAS float* bs) {
    LAS unsigned char* lds = F.lds;
    const int tid = opq_tid(), lane = tid & 63, w = __builtin_amdgcn_readfirstlane(tid >> 6), fr = lane & 15, fq = lane >> 4;
    const int s = tid & 127, dg = tid >> 7;
    const int srow = tid >> 2, spart = tid & 3;
    int gcur = -1;
    u32x4 vreg[8]; f32x4 lnv[4];
    int un = F.vcu;
    if (un < 2048) {
        const int g = un & 7, row0 = (un >> 3) * 128;
        const GAS bf16_t* vp = V + (size_t)(row0 + s) * 2048 + g * 256;
#pragma unroll
        for (int i = 0; i < 8; ++i) vreg[i] = *(const GAS u32x4*)(vp + (dg + 4 * i) * 8);
        const GAS f32x4* lp = (const GAS f32x4*)(lnp + (size_t)(row0 + srow) * 64 + spart * 16);
#pragma unroll
        for (int i = 0; i < 4; ++i) lnv[i] = lp[i];
    }
    for (; un < 2048; un += F.G) {
        const int g = un & 7, c = un >> 3, row0 = c * 128;
        __syncthreads();
        if (g != gcur) {
            gcur = g;
            const GAS bf16_t* wg = Wt + (size_t)g * 128 * 128;
#pragma unroll
            for (int i = 0; i < 4; ++i) { const int p = tid + 512 * i, t = p >> 4, c16 = p & 15; *(LAS u32x4*)(lds + SG_W + t * SG_WSTR + c16 * 16) = *(const GAS u32x4*)(wg + t * 128 + c16 * 8); }
            if (tid < 256) { ((LAS float*)(lds + SG_LG))[tid] = lng[g * 256 + tid]; } else { ((LAS float*)(lds + SG_LG))[tid] = lnb[g * 256 + tid - 256]; }
        }
        {
            float s1 = 0.f, s2 = 0.f;
#pragma unroll
            for (int i = 0; i < 4; ++i) { s1 += lnv[i].x + lnv[i].z; s2 += lnv[i].y + lnv[i].w; }
            s1 += __shfl_xor(s1, 1); s2 += __shfl_xor(s2, 1); s1 += __shfl_xor(s1, 2); s2 += __shfl_xor(s2, 2);
            const float mu = s1 * (1.0f / 2048.0f), var = s2 * (1.0f / 2048.0f) - mu * mu;
            if (spart == 0) { ((LAS float*)(lds + SG_ST))[srow] = mu; ((LAS float*)(lds + SG_ST))[128 + srow] = rsqrtf(fmaxf(var, 0.f) + LN_EPS); }
        }
        __syncthreads();
        {
            const float mu = ((LAS float*)(lds + SG_ST))[s], r = ((LAS float*)(lds + SG_ST))[128 + s];
#pragma unroll
            for (int i = 0; i < 8; ++i) {
                const int dc = dg + 4 * i, d0 = dc * 8;
                const u32x4 v = vreg[i];
                const f32x4 g0 = *(const LAS f32x4*)(lds + SG_LG + d0 * 4), g1 = *(const LAS f32x4*)(lds + SG_LG + d0 * 4 + 16);
                const f32x4 b0 = *(const LAS f32x4*)(lds + SG_LG + 1024 + d0 * 4), b1 = *(const LAS f32x4*)(lds + SG_LG + 1024 + d0 * 4 + 16);
                LAS bf16_t* tp = (LAS bf16_t*)(lds + SG_T + d0 * SG_TSTR) + s;
                tp[0 * (SG_TSTR / 2)] = (bf16_t)f2bf((bf_lo(v.x) - mu) * r * g0.x + b0.x);
                tp[1 * (SG_TSTR / 2)] = (bf16_t)f2bf((bf_hi(v.x) - mu) * r * g0.y + b0.y);
                tp[2 * (SG_TSTR / 2)] = (bf16_t)f2bf((bf_lo(v.y) - mu) * r * g0.z + b0.z);
                tp[3 * (SG_TSTR / 2)] = (bf16_t)f2bf((bf_hi(v.y) - mu) * r * g0.w + b0.w);
                tp[4 * (SG_TSTR / 2)] = (bf16_t)f2bf((bf_lo(v.z) - mu) * r * g1.x + b1.x);
                tp[5 * (SG_TSTR / 2)] = (bf16_t)f2bf((bf_hi(v.z) - mu) * r * g1.y + b1.y);
                tp[6 * (SG_TSTR / 2)] = (bf16_t)f2bf((bf_lo(v.w) - mu) * r * g1.z + b1.z);
                tp[7 * (SG_TSTR / 2)] = (bf16_t)f2bf((bf_hi(v.w) - mu) * r * g1.w + b1.w);
            }
        }
        u32x4 uv[8];
#pragma unroll
        for (int tb = 0; tb < 8; ++tb) uv[tb] = *(const GAS u32x4*)(U + (size_t)(row0 + 16 * tb + fr) * 2048 + g * 256 + 32 * w + 8 * fq);
        if (un + F.G < 2048) {
            const int un2 = un + F.G, g2 = un2 & 7, row2 = (un2 >> 3) * 128;
            const GAS bf16_t* vp = V + (size_t)(row2 + s) * 2048 + g2 * 256;
#pragma unroll
            for (int i = 0; i < 8; ++i) vreg[i] = *(const GAS u32x4*)(vp + (dg + 4 * i) * 8);
            const GAS f32x4* lp = (const GAS f32x4*)(lnp + (size_t)(row2 + srow) * 64 + spart * 16);
#pragma unroll
            for (int i = 0; i < 4; ++i) lnv[i] = lp[i];
        }
        __syncthreads();
        f32x4 acc[8][2];
#pragma unroll
        for (int tb = 0; tb < 8; ++tb) { acc[tb][0] = (f32x4){0.f, 0.f, 0.f, 0.f}; acc[tb][1] = (f32x4){0.f, 0.f, 0.f, 0.f}; }
        const int drow0 = 32 * w + 8 * (fr >> 2) + (fr & 3);
#pragma unroll
        for (int ks = 0; ks < 4; ++ks) {
            const bf16x8 t0 = *(const LAS bf16x8*)(lds + SG_T + drow0 * SG_TSTR + ks * 64 + fq * 16);
            const bf16x8 t1 = *(const LAS bf16x8*)(lds + SG_T + (drow0 + 4) * SG_TSTR + ks * 64 + fq * 16);
#pragma unroll
            for (int tb = 2 * ks; tb < 8; ++tb) {
                const bf16x8 wf = *(const LAS bf16x8*)(lds + SG_W + (16 * tb + fr) * SG_WSTR + ks * 64 + fq * 16);
                acc[tb][0] = __builtin_amdgcn_mfma_f32_16x16x32_bf16(t0, wf, acc[tb][0], 0, 0, 0);
                acc[tb][1] = __builtin_amdgcn_mfma_f32_16x16x32_bf16(t1, wf, acc[tb][1], 0, 0, 0);
            }
        }
#pragma unroll
        for (int tb = 0; tb < 8; ++tb) {
            const int t = 16 * tb + fr;
            const float bb = bs[g * 128 + t];
            GAS bf16_t* up = U + (size_t)(row0 + t) * 2048 + g * 256 + 32 * w + 8 * fq;
            const f32x4 a = acc[tb][0] + bb, b = acc[tb][1] + bb;
            const f32x4 ya = (f32x4){a.x * bf_lo(uv[tb].x), a.y * bf_hi(uv[tb].x), a.z * bf_lo(uv[tb].y), a.w * bf_hi(uv[tb].y)};
            const f32x4 yb = (f32x4){b.x * bf_lo(uv[tb].z), b.y * bf_hi(uv[tb].z), b.z * bf_lo(uv[tb].w), b.w * bf_hi(uv[tb].w)};
            *(GAS u32x4*)up = pack8(ya, yb);
        }
    }
    __syncthreads();
}

constexpr int RT_K0 = 0, RT_KB = 65536, RT_ST = 131072, RT_STSTR = 528, RT_VT = RT_ST + 32 * RT_STSTR, RT_VTSTR = 288, RT_END = RT_VT + 32 * RT_VTSTR;
static_assert(RT_END <= LDS_MISC, "ret lds");
typedef short s16x4 __attribute__((ext_vector_type(4)));
__device__ __forceinline__ void ret_phase(const Frame& F, const GAS bf16_t* Q, const GAS bf16_t* Kn, GAS bf16_t* Vb, GAS float* hss) {
    LAS unsigned char* lds = F.lds;
    const int tid = opq_tid(), lane = tid & 63, w = __builtin_amdgcn_readfirstlane(tid >> 6), fr = lane & 15, fq = lane >> 4;
    const int jb = (w < 4) ? w : 11 - w;
    const int srow = tid >> 5, sslot = tid & 31, spiece = ((sslot & 15) ^ (srow & 15)) | (sslot & 16);
    const unsigned voffK = (unsigned)(srow * D + 8 * spiece) * 2u;
    int koffx[4];
#pragma unroll
    for (int k4 = 0; k4 < 4; ++k4) koffx[k4] = fr * 512 + ((((4 * k4 + fq) & 15) ^ fr) << 4);
    int troff[2][2];
#pragma unroll
    for (int db = 0; db < 2; ++db)
#pragma unroll
        for (int t = 0; t < 2; ++t) {
            const int q = fr >> 2, p = fr & 3, m = 8 * fq + 4 * t + q, c = 4 * w + 2 * db + (p >> 1);
            troff[db][t] = m * 512 + ((((c & 15) ^ (m & 15)) | (c & 16)) << 4) + 8 * (p & 1);
        }
    for (int item = F.vcu; item < 256; item += F.G) {
        const int es = item & 15, bh = item >> 4, h = bh & 3, b = bh >> 2;
        const float gam = 1.0f - __builtin_amdgcn_exp2f(-5.0f - (float)h);
        const float l2g = __builtin_amdgcn_logf(gam);
        const float cdec = __builtin_amdgcn_exp2f(128.0f * l2g);
        const size_t rowb = (size_t)b * SEQ;
        const GAS bf16_t* Qh = Q + rowb * D + h * 256;
        const GAS char* Kh = (const GAS char*)(Kn + rowb * D + h * 256);
        GAS bf16_t* Vh = Vb + rowb * 2048 + h * 512 + es * 32;
        GAS float* hs = hss + (rowb * RH + h) * 16 + es;
        __syncthreads();
        for (int i = tid; i < 32 * RT_STSTR / 4; i += 512) ((LAS unsigned*)(lds + RT_ST))[i] = 0u;
        f32x4 sst[2][2];
#pragma unroll
        for (int eb = 0; eb < 2; ++eb)
#pragma unroll
            for (int db = 0; db < 2; ++db) sst[eb][db] = (f32x4){0.f, 0.f, 0.f, 0.f};
#define RT_STAGE_K(buf, ci) do { _Pragma("unroll") for (int _i = 0; _i < 8; ++_i) \
            __builtin_amdgcn_global_load_lds((const GAS unsigned*)(Kh + (size_t)(ci) * 128 * D * 2 + (size_t)_i * 16 * D * 2 + voffK), (LAS unsigned*)(lds + (buf) + _i * 8192 + w * 1024), 16, 0, 0); } while (0)
        RT_STAGE_K(RT_K0, 0);
        const int vm = tid >> 2, vp = tid & 3;
        u32x4 vreg = *(const GAS u32x4*)(Vh + (size_t)vm * 2048 + vp * 8);
        bf16x8 qf[8];
#pragma unroll
        for (int ks = 0; ks < 8; ++ks) qf[ks] = *(const GAS bf16x8*)(Qh + (size_t)(16 * jb + fr) * D + 32 * ks + 8 * fq);
        {
            LAS bf16_t* vt = (LAS bf16_t*)(lds + RT_VT + (8 * vp) * RT_VTSTR) + vm;
#pragma unroll
            for (int q = 0; q < 4; ++q) { vt[(2 * q) * (RT_VTSTR / 2)] = (bf16_t)(vreg[q] & 0xffffu); vt[(2 * q + 1) * (RT_VTSTR / 2)] = (bf16_t)(vreg[q] >> 16); }
        }
        u32x2 pend_ow[2] = {(u32x2){0u, 0u}, (u32x2){0u, 0u}}; float pend_ss = 0.f;
        const int jrow = 16 * jb + fr;
        const float qdec = __builtin_amdgcn_exp2f(l2g * (float)(jrow + 1));
        const float pdec = __builtin_amdgcn_exp2f(l2g * (float)(jrow - 127));
#pragma unroll 1
        for (int ci = 0; ci < SEQ / RC; ++ci) {
            const int kbuf = (ci & 1) ? RT_KB : RT_K0;
            asm volatile("s_waitcnt vmcnt(0) lgkmcnt(0)" ::: "memory"); __builtin_amdgcn_s_barrier(); asm volatile("" ::: "memory");
            const bool more = ci + 1 < SEQ / RC;
#pragma unroll
            for (int ks = 0; ks < 8; ++ks) asm volatile("" : "+v"(qf[ks]));
            if (more) {
                if (ci & 1) RT_STAGE_K(RT_K0, ci + 1); else RT_STAGE_K(RT_KB, ci + 1);
                vreg = *(const GAS u32x4*)(Vh + (size_t)((ci + 1) * 128 + vm) * 2048 + vp * 8);
            }
            if (ci > 0) {
                const size_t row = (size_t)(ci - 1) * 128 + jrow;
#pragma unroll
                for (int eb = 0; eb < 2; ++eb) *(GAS u32x2*)(Vh + row * 2048 + 16 * eb + 4 * fq) = pend_ow[eb];
                if (fq == 0) hs[row * RH * 16] = pend_ss;
            }
            f32x4 oacc[2] = {(f32x4){0.f, 0.f, 0.f, 0.f}, (f32x4){0.f, 0.f, 0.f, 0.f}};
            {
                bf16x8 sf[2][8];
#pragma unroll
                for (int ks = 0; ks < 8; ++ks)
#pragma unroll
                    for (int eb = 0; eb < 2; ++eb) sf[eb][ks] = *(const LAS bf16x8*)(lds + RT_ST + (16 * eb + fr) * RT_STSTR + ks * 64 + fq * 16);
                __builtin_amdgcn_sched_barrier(0);
#pragma unroll
                for (int ks = 0; ks < 8; ++ks)
#pragma unroll
                    for (int eb = 0; eb < 2; ++eb) oacc[eb] = __builtin_amdgcn_mfma_f32_16x16x32_bf16(sf[eb][ks], qf[ks], oacc[eb], 0, 0, 0);
            }
            oacc[0] *= qdec; oacc[1] *= qdec;
#pragma unroll
            for (int kp = 0; kp < 4; ++kp) {
                if (2 * kp <= jb) {
                    const bool two = (2 * kp + 1 <= jb);
                    bf16x8 k0[8], k1[8];
#pragma unroll
                    for (int ks = 0; ks < 8; ++ks) k0[ks] = *(const LAS bf16x8*)(lds + kbuf + (2 * kp) * 8192 + koffx[ks & 3] + (ks >> 2) * 256);
                    if (two) {
#pragma unroll
                        for (int ks = 0; ks < 8; ++ks) k1[ks] = *(const LAS bf16x8*)(lds + kbuf + (2 * kp + 1) * 8192 + koffx[ks & 3] + (ks >> 2) * 256);
                    }
                    u32x2 vlo[2], vhi[2];
#pragma unroll
                    for (int eb = 0; eb < 2; ++eb) { const LAS unsigned char* vb = lds + RT_VT + (16 * eb + fr) * RT_VTSTR + (32 * kp + 4 * fq) * 2; vlo[eb] = *(const LAS u32x2*)vb; vhi[eb] = *(const LAS u32x2*)(vb + 32); }
                    __builtin_amdgcn_sched_barrier(0);
                    f32x4 s0 = (f32x4){0.f, 0.f, 0.f, 0.f}, s1 = (f32x4){0.f, 0.f, 0.f, 0.f};
#pragma unroll
                    for (int ks = 0; ks < 8; ++ks) s0 = __builtin_amdgcn_mfma_f32_16x16x32_bf16(k0[ks], qf[ks], s0, 0, 0, 0);
                    if (two) {
#pragma unroll
                        for (int ks = 0; ks < 8; ++ks) s1 = __builtin_amdgcn_mfma_f32_16x16x32_bf16(k1[ks], qf[ks], s1, 0, 0, 0);
                    }
                    s0 *= pdec; s1 *= pdec;
                    if (2 * kp == jb) {
#pragma unroll
                        for (int r = 0; r < 4; ++r) s0[r] = (4 * fq + r <= fr) ? s0[r] : 0.f;
                    }
                    if (2 * kp + 1 == jb) {
#pragma unroll
                        for (int r = 0; r < 4; ++r) s1[r] = (4 * fq + r <= fr) ? s1[r] : 0.f;
                    }
                    u32x4 pw; pw.x = pk2(s0[0], s0[1]); pw.y = pk2(s0[2], s0[3]); pw.z = pk2(s1[0], s1[1]); pw.w = pk2(s1[2], s1[3]);
                    const bf16x8 pf = __builtin_bit_cast(bf16x8, pw);
#pragma unroll
                    for (int eb = 0; eb < 2; ++eb) {
                        u32x4 vw; vw.x = vlo[eb].x; vw.y = vlo[eb].y; vw.z = vhi[eb].x; vw.w = vhi[eb].y;
                        oacc[eb] = __builtin_amdgcn_mfma_f32_16x16x32_bf16(__builtin_bit_cast(bf16x8, vw), pf, oacc[eb], 0, 0, 0);
                    }
                }
            }
            if (more) {
#pragma unroll
                for (int ks = 0; ks < 8; ++ks) qf[ks] = *(const GAS bf16x8*)(Qh + (size_t)((ci + 1) * 128 + 16 * jb + fr) * D + 32 * ks + 8 * fq);
            }
            {
                float ss = 0.f;
#pragma unroll
                for (int eb = 0; eb < 2; ++eb) {
                    pend_ow[eb].x = pk2(oacc[eb].x, oacc[eb].y); pend_ow[eb].y = pk2(oacc[eb].z, oacc[eb].w);
                    ss += (oacc[eb].x * oacc[eb].x + oacc[eb].y * oacc[eb].y) + (oacc[eb].z * oacc[eb].z + oacc[eb].w * oacc[eb].w);
                }
                ss += __shfl_xor(ss, 16); ss += __shfl_xor(ss, 32);
                pend_ss = ss;
            }
            bf16x8 vtn[2][4]; u32x2 kt[2][4][2];
#pragma unroll
            for (int eb = 0; eb < 2; ++eb)
#pragma unroll
                for (int ks = 0; ks < 4; ++ks) vtn[eb][ks] = *(const LAS bf16x8*)(lds + RT_VT + (16 * eb + fr) * RT_VTSTR + ks * 64 + fq * 16);
            {
                const unsigned a00 = (unsigned)(kbuf + troff[0][0]), a01 = (unsigned)(kbuf + troff[0][1]), a10 = (unsigned)(kbuf + troff[1][0]), a11 = (unsigned)(kbuf + troff[1][1]);
                asm volatile(
                    "ds_read_b64_tr_b16 %0, %16\n\t"  "ds_read_b64_tr_b16 %1, %17\n\t"
                    "ds_read_b64_tr_b16 %2, %16 offset:16384\n\t"  "ds_read_b64_tr_b16 %3, %17 offset:16384\n\t"
                    "ds_read_b64_tr_b16 %4, %16 offset:32768\n\t"  "ds_read_b64_tr_b16 %5, %17 offset:32768\n\t"
                    "ds_read_b64_tr_b16 %6, %16 offset:49152\n\t"  "ds_read_b64_tr_b16 %7, %17 offset:49152\n\t"
                    "ds_read_b64_tr_b16 %8, %18\n\t"  "ds_read_b64_tr_b16 %9, %19\n\t"
                    "ds_read_b64_tr_b16 %10, %18 offset:16384\n\t"  "ds_read_b64_tr_b16 %11, %19 offset:16384\n\t"
                    "ds_read_b64_tr_b16 %12, %18 offset:32768\n\t"  "ds_read_b64_tr_b16 %13, %19 offset:32768\n\t"
                    "ds_read_b64_tr_b16 %14, %18 offset:49152\n\t"  "ds_read_b64_tr_b16 %15, %19 offset:49152\n\t"
                    "s_waitcnt lgkmcnt(0)"
                    : "=&v"(kt[0][0][0]), "=&v"(kt[0][0][1]), "=&v"(kt[0][1][0]), "=&v"(kt[0][1][1]), "=&v"(kt[0][2][0]), "=&v"(kt[0][2][1]), "=&v"(kt[0][3][0]), "=&v"(kt[0][3][1]),
                      "=&v"(kt[1][0][0]), "=&v"(kt[1][0][1]), "=&v"(kt[1][1][0]), "=&v"(kt[1][1][1]), "=&v"(kt[1][2][0]), "=&v"(kt[1][2][1]), "=&v"(kt[1][3][0]), "=&v"(kt[1][3][1])
                    : "v"(a00), "v"(a01), "v"(a10), "v"(a11)
                    : "memory");
            }
            asm volatile("s_waitcnt lgkmcnt(0)" ::: "memory"); __builtin_amdgcn_s_barrier(); asm volatile("" ::: "memory");
#pragma unroll
            for (int eb = 0; eb < 2; ++eb)
#pragma unroll
                for (int db = 0; db < 2; ++db) {
                    sst[eb][db] *= cdec;
#pragma unroll
                    for (int ks = 0; ks < 4; ++ks) {
                        u32x4 kw; kw.x = kt[db][ks][0].x; kw.y = kt[db][ks][0].y; kw.z = kt[db][ks][1].x; kw.w = kt[db][ks][1].y;
                        sst[eb][db] = __builtin_amdgcn_mfma_f32_16x16x32_bf16(__builtin_bit_cast(bf16x8, kw), vtn[eb][ks], sst[eb][db], 0, 0, 0);
                    }
                    u32x2 sw; sw.x = pk2(sst[eb][db].x, sst[eb][db].y); sw.y = pk2(sst[eb][db].z, sst[eb][db].w);
                    *(LAS u32x2*)(lds + RT_ST + (16 * eb + fr) * RT_STSTR + (32 * w + 16 * db + 4 * fq) * 2) = sw;
                }
            __builtin_amdgcn_sched_barrier(0);
            if (more) {
                LAS bf16_t* vt = (LAS bf16_t*)(lds + RT_VT + (8 * vp) * RT_VTSTR) + vm;
#pragma unroll
                for (int q = 0; q < 4; ++q) { vt[(2 * q) * (RT_VTSTR / 2)] = (bf16_t)(vreg[q] & 0xffffu); vt[(2 * q + 1) * (RT_VTSTR / 2)] = (bf16_t)(vreg[q] >> 16); }
            }
        }
        {
            const size_t row = (size_t)(SEQ / RC - 1) * 128 + jrow;
#pragma unroll
            for (int eb = 0; eb < 2; ++eb) *(GAS u32x2*)(Vh + row * 2048 + 16 * eb + 4 * fq) = pend_ow[eb];
            if (fq == 0) hs[row * RH * 16] = pend_ss;
        }
#undef RT_STAGE_K
    }
    __syncthreads();
}

__device__ __forceinline__ void final_phase(const Frame& F, const GAS bf16_t* xb, GAS float* out, const GAS float* g) {
    const int tid_ = opq_tid(), lane_ = tid_ & 63, wave_ = __builtin_amdgcn_readfirstlane(tid_ >> 6);
    const int gw = F.vcu * 8 + wave_, NGW = F.G * 8;
    f32x4 gv[2][2];
#pragma unroll
    for (int j = 0; j < 2; ++j) { gv[j][0] = ((const GAS f32x4*)g)[2 * (lane_ + 64 * j)]; gv[j][1] = ((const GAS f32x4*)g)[2 * (lane_ + 64 * j) + 1]; }
    for (int row = 4 * gw; row < M; row += 4 * NGW) {
        u32x4 w[4][2];
#pragma unroll
        for (int r = 0; r < 4; ++r)
#pragma unroll
            for (int j = 0; j < 2; ++j) w[r][j] = ((const GAS u32x4*)(xb + (size_t)(row + r) * D))[lane_ + 64 * j];
#pragma unroll
        for (int r = 0; r < 4; ++r) {
            f32x4 v[2][2]; float s = 0.f;
#pragma unroll
            for (int j = 0; j < 2; ++j) { const u32x4 ww = w[r][j];
                v[j][0] = (f32x4){bf_lo(ww.x), bf_hi(ww.x), bf_lo(ww.y), bf_hi(ww.y)}; v[j][1] = (f32x4){bf_lo(ww.z), bf_hi(ww.z), bf_lo(ww.w), bf_hi(ww.w)};
                s += (v[j][0].x * v[j][0].x + v[j][0].y * v[j][0].y) + (v[j][0].z * v[j][0].z + v[j][0].w * v[j][0].w) + (v[j][1].x * v[j][1].x + v[j][1].y * v[j][1].y) + (v[j][1].z * v[j][1].z + v[j][1].w * v[j][1].w); }
            const float rs = rsqrtf(wave_sum(s) * (1.0f / D) + RMS_EPS);
            GAS f32x4* o = (GAS f32x4*)(out + (size_t)(row + r) * D) + 2 * lane_;
#pragma unroll
            for (int j = 0; j < 2; ++j) { o[128 * j] = v[j][0] * rs * gv[j][0]; o[128 * j + 1] = v[j][1] * rs * gv[j][1]; }
        }
    }
}

__global__ void __launch_bounds__(512, 2) trunk_fwd(Args args) {
    extern __shared__ __attribute__((aligned(16))) unsigned char lds_raw[];
    Frame F;
    F.lds = (LAS unsigned char*)lds_raw;
    F.tid = threadIdx.x; F.lane = F.tid & 63; F.wave = __builtin_amdgcn_readfirstlane(F.tid >> 6);
    F.G = gridDim.x; { const int bx = blockIdx.x; F.vcu = (F.G % 8 == 0) ? (bx % 8) * (F.G / 8) + bx / 8 : bx; }
    unsigned char* ws = args.ws;
    unsigned* ctl = (unsigned*)(ws + WS_CTL);
    volatile LAS unsigned* MISC = (volatile LAS unsigned*)(F.lds + LDS_MISC);
    for (int u = F.tid; u < (LDS_BYTES - LDS_MISC) / 4; u += 512) ((LAS unsigned*)(F.lds + LDS_MISC))[u] = 0u;
    __syncthreads();
    XcdBarrier bar = xcd_barrier_post(ctl + 4096 + args.li * XCD_BAR_WORDS, MISC + 8);
    const int lo = args.ph_lo, hi = args.ph_hi;
#define IN(k) (lo <= (k) && (k) < hi)
#define GRID_BAR(k) do { if (hi > (k) + 1) xcd_barrier(bar); } while (0)

    bf16_t* xb = (bf16_t*)(ws + WS_XB);
    float* ssq = (float*)(ws + WS_SSQ);

    if (IN(0)) { if (I8_F1_LAYERS || I8_RET || I8_SGU || I8_CONV3) { p0_wabs(F, args); xcd_barrier(bar); } p0_prologue(F, args); GRID_BAR(0); }

#pragma unroll 1
    for (int L = 0; L < NLAYER; ++L) {
        const int pb = 1 + 6 * L;
        const int kind = (L == 1) ? 1 : (L == 2) ? 2 : 0;
        int pmo;
        const bf16_t* moA; const bf16_t* moB; int moK;
        if (kind == 0) {
            const int j = (L == 0) ? 0 : 1;
            bf16_t* Bo = (bf16_t*)(ws + AR_CB); bf16_t* CZ = (bf16_t*)(ws + AR_CZ); bf16_t* CY = (bf16_t*)(ws + AR_CY);
            if (IN(pb)) {
                if (I8_CONV3 && j == 1) {
                quant_phase(F, (const GAS bf16_t*)opq((const bf16_t*)xb), (GAS unsigned char*)opq(ws + WS_X8), (GAS float*)opq((float*)(ws + WS_SA)));
                xcd_barrier(bar);
                pg8::Gemm g{opq((const bf16_t*)(ws + WS_X8)), opq((const bf16_t*)(ws + W_CI + j * W_CI_SZ)), M, 3072, 1024 / 2}; pg8::StaticOrder S; S.init(M, 3072, F.G, (int)blockIdx.x);
                EpiConvIn E{(const GAS float*)opq(ssq), (GAS bf16_t*)opq(Bo), (GAS bf16_t*)opq(CZ), (const GAS float*)opq((const float*)(ws + WS_SA)), i8_wfull(ws, 7, F.lane, 1.0f / (1024.0f * 3072.0f)) * (1.0f / 127.0f)};
                pg8::gemm_phase<EpiConvIn, true, true, false, true, true>(F.lds, g, S, E);
                } else {
                pg8::Gemm g{opq(xb), opq((const bf16_t*)(ws + W_CI + j * W_CI_SZ)), M, 3072, 1024}; pg8::StaticOrder S; S.init(M, 3072, F.G, (int)blockIdx.x);
                EpiConvIn E{(const GAS float*)opq(ssq), (GAS bf16_t*)opq(Bo), (GAS bf16_t*)opq(CZ), (const GAS float*)nullptr, 1.0f};
                pg8::gemm_phase<EpiConvIn>(F.lds, g, S, E);
                }
                GRID_BAR(pb);
            }
            if (IN(pb + 1)) { conv_phase(F, (const GAS bf16_t*)opq(Bo), (const GAS bf16_t*)opq(CZ), (const GAS float*)opq(args.in[5] + (size_t)j * 3 * D), (GAS bf16_t*)opq(CY)); GRID_BAR(pb + 1); }
            pmo = pb + 2; moA = CY; moB = (const bf16_t*)(ws + W_CO + j * W_CO_SZ); moK = 1024;
        } else if (kind == 1) {
            bf16_t* U = (bf16_t*)(ws + AR_SU); bf16_t* V = (bf16_t*)(ws + AR_SV); float* lnp = (float*)(ws + WS_LNP);
            {
            if (IN(pb)) {
                if constexpr (I8_SGU) {
                quant_phase(F, (const GAS bf16_t*)opq((const bf16_t*)xb), (GAS unsigned char*)opq(ws + WS_X8), (GAS float*)opq((float*)(ws + WS_SA)));
                xcd_barrier(bar);
                pg8::Gemm g{opq((const bf16_t*)(ws + WS_X8)), opq((const bf16_t*)(ws + W_SI)), M, 4096, 1024 / 2}; pg8::StaticOrder S; S.init(M, 4096, F.G, (int)blockIdx.x);
                EpiSguIn E{(const GAS float*)opq(ssq), (GAS bf16_t*)opq(U), (GAS bf16_t*)opq(V), (GAS float*)opq(lnp), (const GAS float*)opq((const float*)(ws + WS_SA)), i8_wfull(ws, 6, F.lane, 1.0f / (1024.0f * 4096.0f)) * (1.0f / 127.0f)};
                pg8::gemm_phase<EpiSguIn, true, true, false, true, true>(F.lds, g, S, E);
                } else {
                pg8::Gemm g{opq(xb), opq((const bf16_t*)(ws + W_SI)), M, 4096, 1024}; pg8::StaticOrder S; S.init(M, 4096, F.G, (int)blockIdx.x);
                EpiSguIn E{(const GAS float*)opq(ssq), (GAS bf16_t*)opq(U), (GAS bf16_t*)opq(V), (GAS float*)opq(lnp), (const GAS float*)nullptr, 1.0f};
                pg8::gemm_phase<EpiSguIn>(F.lds, g, S, E);
                }
                GRID_BAR(pb);
            }
            if (IN(pb + 1)) { sgu_phase(F, (GAS bf16_t*)opq(U), (const GAS bf16_t*)opq(V), (const GAS float*)opq(lnp), (const GAS bf16_t*)opq((const bf16_t*)(ws + W_WS)), (const GAS float*)opq(args.in[8]), (const GAS float*)opq(args.in[9]), (const GAS float*)opq(args.in[11])); GRID_BAR(pb + 1); }
            }
            pmo = pb + 2; moA = U; moB = (const bf16_t*)(ws + W_SO); moK = 2048;
        } else {
            bf16_t* Q = (bf16_t*)(ws + AR_RQ); bf16_t* Kn = (bf16_t*)(ws + AR_RK); bf16_t* V = (bf16_t*)(ws + AR_RV);
            float* hss = args.out;
            {
            {
            if (IN(pb)) {
                if constexpr (I8_RET) {
                quant_phase(F, (const GAS bf16_t*)opq((const bf16_t*)xb), (GAS unsigned char*)opq(ws + WS_X8), (GAS float*)opq((float*)(ws + WS_SA)));
                xcd_barrier(bar);
                pg8::Gemm g{opq((const bf16_t*)(ws + WS_X8)), opq((const bf16_t*)(ws + W_RQ)), M, 4096, 1024 / 2}; pg8::StaticOrder S; S.init(M, 4096, F.G, (int)blockIdx.x);
                EpiRetQkv E{(const GAS float*)opq(ssq), (const GAS float*)opq((const float*)(ws + WS_ROT)), (const GAS float*)opq((const float*)(ws + WS_ROT) + (size_t)SEQ * 128), (GAS bf16_t*)opq(Q), (GAS bf16_t*)opq(Kn), (GAS bf16_t*)opq(V),
                            (const GAS float*)opq((const float*)(ws + WS_SA)), i8_wfull(ws, 4, F.lane, 1.0f / (1024.0f * 4096.0f)) * (1.0f / 127.0f)};
                pg8::gemm_phase<EpiRetQkv, true, true, false, true, true>(F.lds, g, S, E);
                } else {
                pg8::Gemm g{opq(xb), opq((const bf16_t*)(ws + W_RQ)), M, 4096, 1024}; pg8::StaticOrder S; S.init(M, 4096, F.G, (int)blockIdx.x);
                EpiRetQkv E{(const GAS float*)opq(ssq), (const GAS float*)opq((const float*)(ws + WS_ROT)), (const GAS float*)opq((const float*)(ws + WS_ROT) + (size_t)SEQ * 128), (GAS bf16_t*)opq(Q), (GAS bf16_t*)opq(Kn), (GAS bf16_t*)opq(V), (const GAS float*)nullptr, 1.0f};
                pg8::gemm_phase<EpiRetQkv>(F.lds, g, S, E);
                }
                GRID_BAR(pb);
            }
            if (IN(pb + 1)) { ret_phase(F, (const GAS bf16_t*)opq(Q), (const GAS bf16_t*)opq(Kn), (GAS bf16_t*)opq(V), (GAS float*)opq(hss)); GRID_BAR(pb + 1); }
            }
            if (IN(pb + 2)) {
                if constexpr (I8_RET) {
                pg8::Gemm g{opq((const bf16_t*)(ws + WS_X8)), opq((const bf16_t*)(ws + W_RG)), M, 2048, 1024 / 2}; pg8::StaticOrder S; S.init(M, 2048, F.G, (int)blockIdx.x);
                EpiRetG E{(const GAS float*)opq(ssq), (const GAS float*)opq(hss), (GAS bf16_t*)opq(V), (const GAS float*)opq((const float*)(ws + WS_SA)), i8_wfull(ws, 5, F.lane, 1.0f / (1024.0f * 2048.0f)) * (1.0f / 127.0f)};
                pg8::gemm_phase<EpiRetG, true, true, false, true, true>(F.lds, g, S, E);
                } else {
                pg8::Gemm g{opq(xb), opq((const bf16_t*)(ws + W_RG)), M, 2048, 1024}; pg8::StaticOrder S; S.init(M, 2048, F.G, (int)blockIdx.x);
                EpiRetG E{(const GAS float*)opq(ssq), (const GAS float*)opq(hss), (GAS bf16_t*)opq(V), (const GAS float*)nullptr, 1.0f};
                pg8::gemm_phase<EpiRetG>(F.lds, g, S, E);
                }
                GRID_BAR(pb + 2);
            }
            }
            pmo = pb + 3; moA = V; moB = (const bf16_t*)(ws + W_RO); moK = 2048;
        }
        if (IN(pmo)) {
            pg8::Gemm g{opq(moA), opq(moB), M, 1024, moK}; pg8::StaticOrder S; S.init(M, 1024, F.G, (int)blockIdx.x);
            EpiResid E{(GAS bf16_t*)opq(xb), (GAS float*)opq(ssq), 1.0f, ((F8_F1_LAYERS >> L) & 1) ? (GAS unsigned char*)opq(ws + WS_X8) : (GAS unsigned char*)nullptr};
            pg8::gemm_phase<EpiResid>(F.lds, g, S, E);
            GRID_BAR(pmo);
        }
        if (IN(pb + 4)) {
            if ((I8_F1_LAYERS >> L) & 1) {
                quant_phase(F, (const GAS bf16_t*)opq((const bf16_t*)xb), (GAS unsigned char*)opq(ws + WS_X8), (GAS float*)opq((float*)(ws + WS_SA)));
                xcd_barrier(bar);
                pg8::Gemm g{opq((const bf16_t*)(ws + WS_X8)), opq((const bf16_t*)(ws + W_FI + L * W_FI_SZ)), M, 2 * DFF, 1024 / 2}; pg8::StaticOrder S; S.init(M, 2 * DFF, F.G, (int)blockIdx.x);
                const float wsc = i8_wfull(ws, L, F.lane) * (1.0f / 127.0f);
                EpiFfnIn E{(const GAS float*)opq(ssq), (GAS unsigned char*)opq(ws + AR_FA), ((F8_LAYERS >> L) & 1) != 0, wsc, (const GAS float*)opq((const float*)(ws + WS_SA)), true};
                pg8::gemm_phase<EpiFfnIn, true, true, false, true>(F.lds, g, S, E);
            } else if ((F8_F1_LAYERS >> L) & 1) {
                pg8::Gemm g{opq((const bf16_t*)(ws + WS_X8)), opq((const bf16_t*)(ws + W_FI + L * W_FI_SZ)), M, 2 * DFF, 1024 / 2}; pg8::StaticOrder S; S.init(M, 2 * DFF, F.G, (int)blockIdx.x);
                EpiFfnIn E{(const GAS float*)opq(ssq), (GAS unsigned char*)opq(ws + AR_FA), ((F8_LAYERS >> L) & 1) != 0, 1.0f / FI_WSCALE, (const GAS float*)nullptr, false};
                pg8::gemm_phase<EpiFfnIn, true, true, true>(F.lds, g, S, E);
            } else {
                pg8::Gemm g{opq(xb), opq((const bf16_t*)(ws + W_FI + L * W_FI_SZ)), M, 2 * DFF, 1024}; pg8::StaticOrder S; S.init(M, 2 * DFF, F.G, (int)blockIdx.x);
                EpiFfnIn E{(const GAS float*)opq(ssq), (GAS unsigned char*)opq(ws + AR_FA), ((F8_LAYERS >> L) & 1) != 0, 1.0f, (const GAS float*)nullptr, false};
                pg8::gemm_phase<EpiFfnIn>(F.lds, g, S, E);
            }
            GRID_BAR(pb + 4);
        }
        if (IN(pb + 5)) {
            if ((F8_LAYERS >> L) & 1) {
                pg8::Gemm g{opq((const bf16_t*)(ws + AR_FA)), opq((const bf16_t*)(ws + W_FD + L * W_FD_SZ)), M, 1024, DFF / 2}; pg8::StaticOrder S; S.init(M, 1024, F.G, (int)blockIdx.x);
                EpiResidT<2> E{(GAS bf16_t*)opq(xb), (GAS float*)opq(ssq), 1.0f / FD_WSCALE, (GAS unsigned char*)nullptr};
                pg8::gemm_phase<EpiResidT<2>, true, true, true>(F.lds, g, S, E);
            } else {
                pg8::Gemm g{opq((const bf16_t*)(ws + AR_FA)), opq((const bf16_t*)(ws + W_FD + L * W_FD_SZ)), M, 1024, DFF}; pg8::StaticOrder S; S.init(M, 1024, F.G, (int)blockIdx.x);
                EpiResid E{(GAS bf16_t*)opq(xb), (GAS float*)opq(ssq), 1.0f, (GAS unsigned char*)nullptr};
                pg8::gemm_phase<EpiResid>(F.lds, g, S, E);
            }
            GRID_BAR(pb + 5);
        }
    }
    if (IN(NPH - 1)) final_phase(F, (const GAS bf16_t*)opq((const bf16_t*)xb), (GAS float*)opq(args.out), (const GAS float*)opq(args.in[3]));
#undef IN
#undef GRID_BAR
}

extern "C" void kernel_launch(void* const* d_in, const int* in_sizes, int n_in, void* d_out, int out_size, void* d_ws, size_t ws_size, hipStream_t stream) {
    static int grid = 0;
    if (grid == 0) {
        if (n_in != 18 || out_size != M * D || ws_size < WS_END) { fprintf(stderr, "kernel_launch: unexpected shapes (n_in %d out %d ws %zu)\n", n_in, out_size, ws_size); grid = -1; return; }
        int dev = 0, cus = 0, per_cu = 0;
        if (hipGetDevice(&dev) != hipSuccess || hipDeviceGetAttribute(&cus, hipDeviceAttributeMultiprocessorCount, dev) != hipSuccess) { grid = -1; return; }
        if (hipFuncSetAttribute((const void*)trunk_fwd, hipFuncAttributeMaxDynamicSharedMemorySize, LDS_BYTES) != hipSuccess) { fprintf(stderr, "kernel_launch: hipFuncSetAttribute failed\n"); grid = -1; return; }
        if (hipOccupancyMaxActiveBlocksPerMultiprocessor(&per_cu, (const void*)trunk_fwd, 512, LDS_BYTES) != hipSuccess || per_cu < 1)
            fprintf(stderr, "kernel_launch: occupancy query reports %d\n", per_cu);
        (void)hipGetLastError();
        grid = cus;
    }
    if (grid < 0) return;
    (void)in_sizes;
    if (hipMemsetAsync((char*)d_ws + WS_CTL, 0, CTL_BYTES, stream) != hipSuccess) return;
    Args a{};
    for (int i = 0; i < 18; ++i) a.in[i] = (const float*)d_in[i];
    a.out = (float*)d_out; a.ws = (unsigned char*)d_ws; a.pad = 0;
#if MK_ONE_LAUNCH
    a.ph_lo = 0; a.ph_hi = NPH; a.li = 0;
    hipLaunchKernelGGL(trunk_fwd, dim3(grid), dim3(512), LDS_BYTES, stream, a);
#else
    int li = 0;
    for (int ph = 0; ph < NPH; ++ph) {
        const int r = (ph - 1) % 6, L = (ph - 1) / 6;
        if (ph >= 1 && ph < NPH - 1 && r == 3 && L != 2) continue;
        a.ph_lo = ph; a.ph_hi = ph + 1; a.li = li++;
        hipLaunchKernelGGL(trunk_fwd, dim3(grid), dim3(512), LDS_BYTES, stream, a);
    }
#endif
}
```
